# Optimizing an MI355X kernel written in HIP

```python
import math
import jax, jax.numpy as jnp
from jax import lax
import numpy as np

D_MODEL = 1024
BATCH = 1
SEQ = 16384
DEPTH = 1
DEC_BATCH = 128
DEC_SEQ = 1
PAST_LEN = 16384
PAGE_SIZE = 128

HEAD_DIM_A = 64
N_HEADS_A = D_MODEL // 128
N_KV_A = N_HEADS_A // 4
GROUP_A = N_HEADS_A // N_KV_A
WIDTH_A = N_HEADS_A * HEAD_DIM_A
WINDOW = 128
BLOCK_Q = 128
ROT_DIM = HEAD_DIM_A // 4
ROPE_THETA = 500000.0
HEAD_DIM_B = 128
N_HEADS_B = D_MODEL // 256
WIDTH_B = N_HEADS_B * HEAD_DIM_B
CHUNK_B = 64
EPS = 1e-6
PROJ_SIZES = [WIDTH_A, N_KV_A * HEAD_DIM_A, N_KV_A * HEAD_DIM_A, WIDTH_A,
              WIDTH_B, WIDTH_B, WIDTH_B, WIDTH_B]
D_IN = sum(PROJ_SIZES)
SPLIT_POINTS = [int(s) for s in np.cumsum(PROJ_SIZES)[:-1]]

kernel_name = 'hybrid_swa_sink_hgrn2_gated_merge_adaln_step'


def rms_norm(x, g):
    xf = x.astype(jnp.float32)
    y = xf * lax.rsqrt(jnp.mean(xf * xf, axis=-1, keepdims=True) + EPS)
    return (y * g.astype(jnp.float32)).astype(x.dtype)


def rope_partial(x, pos0):
    T = x.shape[1]
    pos = (pos0 + jnp.arange(T)).astype(jnp.float32)
    inv = jnp.power(ROPE_THETA, -jnp.arange(0, ROT_DIM, 2, dtype=jnp.float32) / ROT_DIM)
    ang = pos[:, None] * inv[None, :]
    cos = jnp.cos(ang)[None, :, None, :]
    sin = jnp.sin(ang)[None, :, None, :]
    xr = x[..., :ROT_DIM].astype(jnp.float32)
    x1, x2 = xr[..., :ROT_DIM // 2], xr[..., ROT_DIM // 2:]
    rot = jnp.concatenate([x1 * cos - x2 * sin, x2 * cos + x1 * sin], axis=-1).astype(x.dtype)
    return jnp.concatenate([rot, x[..., ROT_DIM:]], axis=-1)


def window_attention(q, k_all, v_all, pos0, sinks):
    B, T, H, d = q.shape
    blk = math.gcd(T, BLOCK_Q)
    nb = T // blk
    span = WINDOW + blk
    idx = (jnp.arange(nb) * blk)[:, None] + jnp.arange(span)[None, :]
    kb = k_all[:, idx]
    vb = v_all[:, idx]
    qb = q.reshape(B, nb, blk, N_KV_A, GROUP_A, d)
    s = jnp.einsum('bnikgd,bnjkd->bnkgij', qb, kb).astype(jnp.float32) * (d ** -0.5)
    tq = pos0 + jnp.arange(T).reshape(nb, blk)
    tk = pos0 - WINDOW + idx
    rel = tq[:, :, None] - tk[:, None, :]
    valid = (rel >= 0) & (rel < WINDOW) & (tk[:, None, :] >= 0)
    s = jnp.where(valid[None, :, None, None], s, -jnp.inf)
    sink = sinks.astype(jnp.float32).reshape(N_KV_A, GROUP_A)[None, None, :, :, None, None]
    m = jnp.maximum(jnp.max(s, axis=-1, keepdims=True), sink)
    p = jnp.exp(s - m)
    p = p / (jnp.sum(p, axis=-1, keepdims=True) + jnp.exp(sink - m))
    o = jnp.einsum('bnkgij,bnjkd->bnikgd', p.astype(v_all.dtype), vb)
    return o.reshape(B, T, H * d)


def hgrn2_chunked(q, log_f, k, v, s0):
    B, T, H, DK = q.shape
    C = math.gcd(T, CHUNK_B)
    n = T // C
    to_chunks = lambda a: a.reshape(B, n, C, H, a.shape[-1]).swapaxes(0, 1)
    xs = (to_chunks(q), to_chunks(log_f), to_chunks(k), to_chunks(v))
    causal = jnp.tril(jnp.ones((C, C), dtype=bool))

    def step(S, inp):
        qc, gc, kc, vc = inp
        L = jnp.cumsum(gc, axis=1)
        o_inter = jnp.einsum('bchk,bhkv->bchv', qc * jnp.exp(L), S)
        diff = L[:, :, None] - L[:, None, :]
        decay = jnp.exp(jnp.where(causal[None, :, :, None, None], diff, -jnp.inf))
        A = jnp.einsum('bihk,bjhk,bijhk->bhij', qc, kc, decay)
        o_intra = jnp.einsum('bhij,bjhv->bihv', A, vc)
        Lc = L[:, -1]
        S_new = jnp.exp(Lc)[..., None] * S + jnp.einsum(
            'bjhk,bjhv->bhkv', kc * jnp.exp(Lc[:, None] - L), vc)
        return S_new, o_inter + o_intra

    s_fin, o = lax.scan(step, s0, xs)
    o = o.swapaxes(0, 1).reshape(B, T, H, v.shape[-1])
    return o, s_fin


def mixer_layer(x, c, k_buf, v_buf, s0, pos0, lb, w_ada, b_ada, norm_g, w_in,
                q_norm_g, k_norm_g, sinks, o_norm_g, w_merge, b_merge,
                w_proj_a, w_proj_b, w_out):
    B, T, _ = x.shape
    mod = c @ w_ada + b_ada
    shift, scale, gate = jnp.split(mod[:, None, :], 3, axis=-1)
    h = rms_norm(x, norm_g) * (1 + scale) + shift
    proj = h @ w_in
    qa, ka, va, za, qb, fb, ib, zb = jnp.split(proj, SPLIT_POINTS, axis=-1)

    qa = rope_partial(rms_norm(qa.reshape(B, T, N_HEADS_A, HEAD_DIM_A), q_norm_g), pos0)
    ka = rope_partial(rms_norm(ka.reshape(B, T, N_KV_A, HEAD_DIM_A), k_norm_g), pos0)
    va = va.reshape(B, T, N_KV_A, HEAD_DIM_A)
    k_all = jnp.concatenate([k_buf.astype(ka.dtype), ka], axis=1)
    v_all = jnp.concatenate([v_buf.astype(va.dtype), va], axis=1)
    ya = window_attention(qa, k_all, v_all, pos0, sinks) * jax.nn.silu(za)

    zf = fb.reshape(B, T, N_HEADS_B, HEAD_DIM_B).astype(jnp.float32)
    lbh = lb.reshape(N_HEADS_B, HEAD_DIM_B)
    log_f = jnp.log(lbh + (1 - lbh) * jax.nn.sigmoid(zf))
    k_in = (1 - lbh) * jax.nn.sigmoid(-zf)
    o, s_new = hgrn2_chunked(qb.reshape(B, T, N_HEADS_B, HEAD_DIM_B).astype(jnp.float32), log_f, k_in,
                             ib.reshape(B, T, N_HEADS_B, HEAD_DIM_B).astype(jnp.float32),
                             s0.astype(jnp.float32))
    yb = rms_norm(o, o_norm_g).astype(x.dtype).reshape(B, T, WIDTH_B) * jax.nn.silu(zb)

    g_a, g_b = jnp.split(jax.nn.sigmoid(h @ w_merge + b_merge), 2, axis=-1)
    y = g_a * (ya @ w_proj_a) + g_b * (yb @ w_proj_b)
    out = x + gate * (y @ w_out)
    return out, k_all[:, -WINDOW:], v_all[:, -WINDOW:], s_new.astype(x.dtype)


def setup_inputs(seed: int = 0) -> dict:
    key = jax.random.key(seed)
    ks = jax.random.split(key, 24)
    f32 = jnp.float32
    nrm = lambda k, shape, s: jax.random.normal(k, shape, f32) * s
    D = D_MODEL
    return {
        'x_prompt': nrm(ks[0], (BATCH, SEQ, D), 1.0),
        'x_sample': nrm(ks[1], (DEC_BATCH, DEC_SEQ, D), 1.0),
        'cache_win_k': nrm(ks[2], (DEPTH, DEC_BATCH, WINDOW, N_KV_A, HEAD_DIM_A), 1.0),
        'cache_win_v': nrm(ks[3], (DEPTH, DEC_BATCH, WINDOW, N_KV_A, HEAD_DIM_A), 1.0),
        'state_hgrn': nrm(ks[4], (DEPTH, DEC_BATCH, N_HEADS_B, HEAD_DIM_B, HEAD_DIM_B), 0.3),
        'c_prompt': nrm(ks[5], (BATCH, D), 1.0),
        'c_sample': nrm(ks[6], (DEC_BATCH, D), 1.0),
        'w_ada': nrm(ks[7], (DEPTH, D, 3 * D), 0.5 * D ** -0.5),
        'b_ada': nrm(ks[8], (DEPTH, 3 * D), 0.02),
        'norm_g': 1.0 + nrm(ks[9], (DEPTH, D), 0.05),
        'w_in': nrm(ks[10], (DEPTH, D, D_IN), D ** -0.5),
        'q_norm_g': 1.0 + nrm(ks[11], (DEPTH, HEAD_DIM_A), 0.05),
        'k_norm_g': 1.0 + nrm(ks[12], (DEPTH, HEAD_DIM_A), 0.05),
        'sinks': nrm(ks[13], (DEPTH, N_HEADS_A), 0.5),
        'lb_logits': nrm(ks[14], (DEPTH + 1, WIDTH_B), 0.5),
        'o_norm_g': 1.0 + nrm(ks[15], (DEPTH, HEAD_DIM_B), 0.05),
        'w_merge': nrm(ks[16], (DEPTH, D, 2 * D), D ** -0.5),
        'b_merge': nrm(ks[17], (DEPTH, 2 * D), 0.1),
        'w_proj_a': nrm(ks[18], (DEPTH, WIDTH_A, D), WIDTH_A ** -0.5),
        'w_proj_b': nrm(ks[19], (DEPTH, WIDTH_B, D), WIDTH_B ** -0.5),
        'w_out': nrm(ks[20], (DEPTH, D, D), D ** -0.5),
    }


def reference(x_prompt, x_sample, cache_win_k, cache_win_v, state_hgrn, c_prompt, c_sample,
              w_ada, b_ada, norm_g, w_in, q_norm_g, k_norm_g, sinks, lb_logits, o_norm_g,
              w_merge, b_merge, w_proj_a, w_proj_b, w_out):
    lb_all = jnp.cumsum(jax.nn.softmax(lb_logits.astype(jnp.float32), axis=0), axis=0)
    xp, xs = x_prompt, x_sample
    bp = x_prompt.shape[0]
    kp_l, vp_l, sp_l, ks_l, vs_l, ss_l = [], [], [], [], [], []
    for l in range(DEPTH):
        params = (w_ada[l], b_ada[l], norm_g[l], w_in[l], q_norm_g[l], k_norm_g[l], sinks[l],
                  o_norm_g[l], w_merge[l], b_merge[l], w_proj_a[l], w_proj_b[l], w_out[l])
        zero_buf = jnp.zeros((bp, WINDOW, N_KV_A, HEAD_DIM_A), xp.dtype)
        zero_state = jnp.zeros((bp, N_HEADS_B, HEAD_DIM_B, HEAD_DIM_B), jnp.float32)
        xp, kp, vp, sp = mixer_layer(xp, c_prompt, zero_buf, zero_buf, zero_state, 0, lb_all[l], *params)
        xs, kq, vq, sq = mixer_layer(xs, c_sample, cache_win_k[l], cache_win_v[l], state_hgrn[l],
                                     PAST_LEN, lb_all[l], *params)
        kp_l.append(kp); vp_l.append(vp); sp_l.append(sp)
        ks_l.append(kq); vs_l.append(vq); ss_l.append(sq)
    return (xp, xs, jnp.stack(kp_l), jnp.stack(vp_l), jnp.stack(sp_l),
            jnp.stack(ks_l), jnp.stack(vs_l), jnp.stack(ss_l))
```

```cpp
#include <hip/hip_runtime.h>
#include <hip/hip_cooperative_groups.h>
#include <cstdio>
namespace cg = cooperative_groups;

#define DI __device__ __forceinline__
typedef unsigned short bfr;
using bf16x8 = __attribute__((ext_vector_type(8))) short;
using f32x16 = __attribute__((ext_vector_type(16))) float;
using u32x4 = __attribute__((ext_vector_type(4))) unsigned;
using u32x2 = __attribute__((ext_vector_type(2))) unsigned;

constexpr int DM = 1024, SEQ = 16384, NBT = 128, MTOT = SEQ + NBT;
constexpr int NALL = 5376;
constexpr int NCH = 256;
constexpr float EPS = 1e-6f;
constexpr int LDT = 72;
constexpr int SMEM_BYTES = 65536;

struct Params {
  const float *x_prompt, *x_sample, *cache_k, *cache_v, *state, *c_prompt, *c_sample;
  const float *w_ada, *b_ada, *norm_g, *w_in, *qg, *kg, *sinks, *lb_logits, *og, *w_merge, *b_merge, *w_pa, *w_pb, *w_out;
  float *out_yp, *out_ys, *out_kp, *out_vp, *out_sp, *out_ks, *out_vs, *out_ss;
  bfr *Wt_all, *Wt_pa, *Wt_pb, *Wt_out, *Wt_ada, *Cb, *H, *Q, *QB, *Kb, *Vb, *ZA, *IB, *ZB, *GA, *GB, *YA, *YB, *Y;
  float *mod, *ZF, *dec, *Ust;
  int phase_lo, phase_hi;
};

DI unsigned f2bf(float x) { unsigned u = __float_as_uint(x); u += 0x7fffu + ((u >> 16) & 1u); return u >> 16; }
DI unsigned pk2(float a, float b) { return f2bf(a) | (f2bf(b) << 16); }
DI float bf2f(unsigned b) { return __uint_as_float(b << 16); }
DI float bflo(unsigned u) { return __uint_as_float(u << 16); }
DI float bfhi(unsigned u) { return __uint_as_float(u & 0xffff0000u); }
DI int crow(int i, int h) { return (i & 3) + 8 * (i >> 2) + 4 * h; }
DI f32x16 mfma(bf16x8 a, bf16x8 b, f32x16 c) { return __builtin_amdgcn_mfma_f32_32x32x16_bf16(a, b, c, 0, 0, 0); }
DI f32x16 zero16() { f32x16 z; _Pragma("unroll") for (int i = 0; i < 16; ++i) z[i] = 0.f; return z; }
DI float sigmoidf_(float x) { return 1.f / (1.f + __expf(-x)); }
DI float siluf_(float x) { return x / (1.f + __expf(-x)); }
DI u32x2 pack4(float a, float b, float c, float d) { u32x2 r; r[0] = pk2(a, b); r[1] = pk2(c, d); return r; }

DI void gemm_mainloop(const bfr* __restrict__ A, int lda, int m0, const bfr* __restrict__ W, int ldw, int n0, int K,
                      bfr* sA, bfr* sW, f32x16 (&acc)[2][2]) {
  const int t = threadIdx.x, lane = t & 63, w = t >> 6, wn = w >> 1, wm = w & 1, r = lane & 31, h = lane >> 5;
  const int lrow = t >> 3, lk = (t & 7) * 8;
  const bfr* ap = A + (size_t)(m0 + lrow) * lda + lk;
  const bfr* wp = W + (size_t)(n0 + lrow) * ldw + lk;
  u32x4 ra[4], rw[4];
  _Pragma("unroll") for (int i = 0; i < 4; ++i) {
    ra[i] = *(const u32x4*)(ap + (size_t)(32 * i) * lda);
    rw[i] = *(const u32x4*)(wp + (size_t)(32 * i) * ldw);
  }
  const int nk = K >> 6;
  for (int kt = 0; kt < nk; ++kt) {
    __syncthreads();
    _Pragma("unroll") for (int i = 0; i < 4; ++i) {
      *(u32x4*)(sA + (lrow + 32 * i) * LDT + lk) = ra[i];
      *(u32x4*)(sW + (lrow + 32 * i) * LDT + lk) = rw[i];
    }
    __syncthreads();
    if (kt + 1 < nk) {
      ap += 64; wp += 64;
      _Pragma("unroll") for (int i = 0; i < 4; ++i) {
        ra[i] = *(const u32x4*)(ap + (size_t)(32 * i) * lda);
        rw[i] = *(const u32x4*)(wp + (size_t)(32 * i) * ldw);
      }
    }
    _Pragma("unroll") for (int kk = 0; kk < 4; ++kk) {
      bf16x8 af[2], bf[2];
      _Pragma("unroll") for (int x = 0; x < 2; ++x) {
        af[x] = *(const bf16x8*)(sW + (wn * 64 + x * 32 + r) * LDT + kk * 16 + 8 * h);
        bf[x] = *(const bf16x8*)(sA + (wm * 64 + x * 32 + r) * LDT + kk * 16 + 8 * h);
      }
      _Pragma("unroll") for (int nt = 0; nt < 2; ++nt)
        _Pragma("unroll") for (int mt = 0; mt < 2; ++mt) acc[nt][mt] = mfma(af[nt], bf[mt], acc[nt][mt]);
    }
  }
}

DI void transpose_tile(const float* __restrict__ src, int N, bfr* __restrict__ dst, int K, int kt, int nt, float* sm) {
  const int t = threadIdx.x, k0 = kt * 64, n0 = nt * 64;
  __syncthreads();
  _Pragma("unroll") for (int i = 0; i < 16; ++i) {
    int idx = i * 256 + t, kk = idx >> 6, nn = idx & 63;
    sm[kk * 65 + nn] = src[(size_t)(k0 + kk) * N + n0 + nn];
  }
  __syncthreads();
  _Pragma("unroll") for (int i = 0; i < 8; ++i) {
    int idx = i * 256 + t, nn = idx >> 5, kk = (idx & 31) * 2;
    *(unsigned*)(dst + (size_t)(n0 + nn) * K + k0 + kk) = pk2(sm[kk * 65 + nn], sm[(kk + 1) * 65 + nn]);
  }
}

DI void phase_prep(const Params& p, char* smem) {
  float* sm = (float*)smem;
  for (int it = blockIdx.x; it < 2624; it += gridDim.x) {
    int i = it;
    if (i < 832) { transpose_tile(p.w_in, 3328, p.Wt_all, 1024, i / 52, i % 52, sm); continue; }
    i -= 832;
    if (i < 512) { transpose_tile(p.w_merge, 2048, p.Wt_all + (size_t)3328 * 1024, 1024, i / 32, i % 32, sm); continue; }
    i -= 512;
    if (i < 768) { transpose_tile(p.w_ada, 3072, p.Wt_ada, 1024, i / 48, i % 48, sm); continue; }
    i -= 768;
    if (i < 128) { transpose_tile(p.w_pa, 1024, p.Wt_pa, 512, i / 16, i % 16, sm); continue; }
    i -= 128;
    if (i < 128) { transpose_tile(p.w_pb, 1024, p.Wt_pb, 512, i / 16, i % 16, sm); continue; }
    i -= 128;
    transpose_tile(p.w_out, 1024, p.Wt_out, 1024, i / 16, i % 16, sm);
  }
  for (int idx = blockIdx.x * 256 + threadIdx.x; idx < 256 * 1024; idx += gridDim.x * 256) {
    int row = idx >> 10, col = idx & 1023;
    float v = row < 128 ? p.c_sample[row * 1024 + col] : (row == 128 ? p.c_prompt[col] : 0.f);
    p.Cb[idx] = (bfr)f2bf(v);
  }
}

DI void phase_mod(const Params& p, char* smem) {
  bfr* sA = (bfr*)smem; bfr* sW = sA + 128 * LDT;
  const int t = threadIdx.x, lane = t & 63, w = t >> 6, wn = w >> 1, wm = w & 1, r = lane & 31, h = lane >> 5;
  for (int tile = blockIdx.x; tile < 48; tile += gridDim.x) {
    int m0 = (tile / 24) * 128, n0 = (tile % 24) * 128;
    f32x16 acc[2][2];
    _Pragma("unroll") for (int a = 0; a < 2; ++a) _Pragma("unroll") for (int b = 0; b < 2; ++b) acc[a][b] = zero16();
    gemm_mainloop(p.Cb, 1024, m0, p.Wt_ada, 1024, n0, 1024, sA, sW, acc);
    _Pragma("unroll") for (int nt = 0; nt < 2; ++nt) _Pragma("unroll") for (int mt = 0; mt < 2; ++mt) {
      int m = m0 + wm * 64 + mt * 32 + r;
      _Pragma("unroll") for (int g = 0; g < 4; ++g) {
        int n = n0 + wn * 64 + nt * 32 + 8 * g + 4 * h;
        float4 b = *(const float4*)(p.b_ada + n);
        float4 o; o.x = acc[nt][mt][4 * g] + b.x; o.y = acc[nt][mt][4 * g + 1] + b.y; o.z = acc[nt][mt][4 * g + 2] + b.z; o.w = acc[nt][mt][4 * g + 3] + b.w;
        *(float4*)(p.mod + (size_t)m * 3072 + n) = o;
      }
    }
  }
}

DI void phase_h(const Params& p) {
  const int lane = threadIdx.x & 63, w = threadIdx.x >> 6;
  for (int row = blockIdx.x * 4 + w; row < MTOT; row += gridDim.x * 4) {
    const float* xr = row < SEQ ? p.x_prompt + (size_t)row * DM : p.x_sample + (size_t)(row - SEQ) * DM;
    const float* mr = p.mod + (size_t)(row < SEQ ? 128 : row - SEQ) * 3072;
    float4 xv[4]; float ss = 0.f;
    _Pragma("unroll") for (int j = 0; j < 4; ++j) {
      xv[j] = *(const float4*)(xr + j * 256 + lane * 4);
      ss += xv[j].x * xv[j].x + xv[j].y * xv[j].y + xv[j].z * xv[j].z + xv[j].w * xv[j].w;
    }
    _Pragma("unroll") for (int o = 32; o >= 1; o >>= 1) ss += __shfl_xor(ss, o);
    float rs = rsqrtf(ss * (1.f / DM) + EPS);
    _Pragma("unroll") for (int j = 0; j < 4; ++j) {
      int col = j * 256 + lane * 4;
      float4 g = *(const float4*)(p.norm_g + col);
      float4 sh = *(const float4*)(mr + col);
      float4 sc = *(const float4*)(mr + 1024 + col);
      float a = xv[j].x * rs * g.x * (1.f + sc.x) + sh.x;
      float b = xv[j].y * rs * g.y * (1.f + sc.y) + sh.y;
      float c = xv[j].z * rs * g.z * (1.f + sc.z) + sh.z;
      float d = xv[j].w * rs * g.w * (1.f + sc.w) + sh.w;
      *(u32x2*)(p.H + (size_t)row * DM + col) = pack4(a, b, c, d);
    }
  }
}

DI void sincos_red(float a, float& s, float& c) {
  float n = rintf(a * 0.15915494309189535f);
  float rr = fmaf(-n, 6.2831854820251465f, a);
  rr = fmaf(-n, -1.7484555e-7f, rr);
  s = __sinf(rr); c = __cosf(rr);
}

DI void epi_main(const Params& p, f32x16 (&acc)[2][2], int m0, int n0) {
  const int t = threadIdx.x, lane = t & 63, w = t >> 6, wn = w >> 1, wm = w & 1, r = lane & 31, h = lane >> 5;
  const int nb = n0 + wn * 64, mb = m0 + wm * 64;
  if (nb < 640) {
    const bool isq = nb < 512;
    const float* gp = isq ? p.qg : p.kg;
    _Pragma("unroll") for (int mt = 0; mt < 2; ++mt) {
      const int m = mb + mt * 32 + r;
      float ss = 0.f;
      _Pragma("unroll") for (int nt = 0; nt < 2; ++nt) _Pragma("unroll") for (int i = 0; i < 16; ++i) ss += acc[nt][mt][i] * acc[nt][mt][i];
      ss += __shfl_xor(ss, 32);
      const float sc = rsqrtf(ss * (1.f / 64.f) + EPS);
      float v[2][16];
      _Pragma("unroll") for (int nt = 0; nt < 2; ++nt) _Pragma("unroll") for (int g = 0; g < 4; ++g) {
        float4 gg = *(const float4*)(gp + nt * 32 + 8 * g + 4 * h);
        v[nt][4 * g] = acc[nt][mt][4 * g] * sc * gg.x; v[nt][4 * g + 1] = acc[nt][mt][4 * g + 1] * sc * gg.y;
        v[nt][4 * g + 2] = acc[nt][mt][4 * g + 2] * sc * gg.z; v[nt][4 * g + 3] = acc[nt][mt][4 * g + 3] * sc * gg.w;
      }
      const float pos = (float)(m < SEQ ? m : SEQ);
      const float invlo[4] = {1.0f, 0.19392274f, 0.03760603f, 0.0072926646f};
      const float invhi[4] = {0.0014142136f, 0.0002742482f, 5.3182957e-05f, 1.0313385e-05f};
      _Pragma("unroll") for (int i = 0; i < 4; ++i) {
        float inv = h ? invhi[i] : invlo[i];
        float s_, c_; sincos_red(pos * inv, s_, c_);
        float x1 = v[0][i], x2 = v[0][i + 4];
        v[0][i] = x1 * c_ - x2 * s_; v[0][i + 4] = x2 * c_ + x1 * s_;
      }
      if (isq) {
        _Pragma("unroll") for (int nt = 0; nt < 2; ++nt) _Pragma("unroll") for (int g = 0; g < 4; ++g) {
          int d = nt * 32 + 8 * g + 4 * h;
          *(u32x2*)(p.Q + (size_t)m * 512 + nb + d) = pack4(v[nt][4 * g] * 0.125f, v[nt][4 * g + 1] * 0.125f, v[nt][4 * g + 2] * 0.125f, v[nt][4 * g + 3] * 0.125f);
        }
      } else {
        const int j = (nb - 512) >> 6;
        _Pragma("unroll") for (int nt = 0; nt < 2; ++nt) _Pragma("unroll") for (int g = 0; g < 4; ++g) {
          int d = nt * 32 + 8 * g + 4 * h;
          *(u32x2*)(p.Kb + (size_t)m * 128 + j * 64 + d) = pack4(v[nt][4 * g], v[nt][4 * g + 1], v[nt][4 * g + 2], v[nt][4 * g + 3]);
          float4 o; o.x = v[nt][4 * g]; o.y = v[nt][4 * g + 1]; o.z = v[nt][4 * g + 2]; o.w = v[nt][4 * g + 3];
          if (m >= SEQ) *(float4*)(p.out_ks + ((size_t)((m - SEQ) * 128 + 127) * 2 + j) * 64 + d) = o;
          else if (m >= SEQ - 128) *(float4*)(p.out_kp + ((size_t)(m - (SEQ - 128)) * 2 + j) * 64 + d) = o;
        }
      }
    }
    return;
  }
  if (nb < 768) {
    const int j = (nb - 640) >> 6;
    _Pragma("unroll") for (int mt = 0; mt < 2; ++mt) {
      const int m = mb + mt * 32 + r;
      _Pragma("unroll") for (int nt = 0; nt < 2; ++nt) _Pragma("unroll") for (int g = 0; g < 4; ++g) {
        int d = nt * 32 + 8 * g + 4 * h;
        float4 o; o.x = acc[nt][mt][4 * g]; o.y = acc[nt][mt][4 * g + 1]; o.z = acc[nt][mt][4 * g + 2]; o.w = acc[nt][mt][4 * g + 3];
        *(u32x2*)(p.Vb + (size_t)m * 128 + j * 64 + d) = pack4(o.x, o.y, o.z, o.w);
        if (m >= SEQ) *(float4*)(p.out_vs + ((size_t)((m - SEQ) * 128 + 127) * 2 + j) * 64 + d) = o;
        else if (m >= SEQ - 128) *(float4*)(p.out_vp + ((size_t)(m - (SEQ - 128)) * 2 + j) * 64 + d) = o;
      }
    }
    return;
  }
  if (nb >= 1792 && nb < 2304) {
    _Pragma("unroll") for (int mt = 0; mt < 2; ++mt) {
      const int m = mb + mt * 32 + r;
      _Pragma("unroll") for (int nt = 0; nt < 2; ++nt) _Pragma("unroll") for (int g = 0; g < 4; ++g) {
        int n = nb - 1792 + nt * 32 + 8 * g + 4 * h;
        float4 o; o.x = acc[nt][mt][4 * g]; o.y = acc[nt][mt][4 * g + 1]; o.z = acc[nt][mt][4 * g + 2]; o.w = acc[nt][mt][4 * g + 3];
        *(float4*)(p.ZF + (size_t)m * 512 + n) = o;
      }
    }
    return;
  }
  bfr* dst; int ld, col, op;
  if (nb < 1280) { dst = p.ZA; ld = 512; col = nb - 768; op = 1; }
  else if (nb < 1792) { dst = p.QB; ld = 512; col = nb - 1280; op = 0; }
  else if (nb < 2816) { dst = p.IB; ld = 512; col = nb - 2304; op = 0; }
  else if (nb < 3328) { dst = p.ZB; ld = 512; col = nb - 2816; op = 1; }
  else if (nb < 4352) { dst = p.GA; ld = 1024; col = nb - 3328; op = 2; }
  else { dst = p.GB; ld = 1024; col = nb - 4352; op = 2; }
  _Pragma("unroll") for (int mt = 0; mt < 2; ++mt) {
    const int m = mb + mt * 32 + r;
    _Pragma("unroll") for (int nt = 0; nt < 2; ++nt) _Pragma("unroll") for (int g = 0; g < 4; ++g) {
      int cc = nt * 32 + 8 * g + 4 * h;
      float a = acc[nt][mt][4 * g], b = acc[nt][mt][4 * g + 1], c = acc[nt][mt][4 * g + 2], d = acc[nt][mt][4 * g + 3];
      if (op == 1) { a = siluf_(a); b = siluf_(b); c = siluf_(c); d = siluf_(d); }
      else if (op == 2) {
        float4 bm = *(const float4*)(p.b_merge + (nb - 3328) + cc);
        a = sigmoidf_(a + bm.x); b = sigmoidf_(b + bm.y); c = sigmoidf_(c + bm.z); d = sigmoidf_(d + bm.w);
      }
      *(u32x2*)(dst + (size_t)m * ld + col + cc) = pack4(a, b, c, d);
    }
  }
}

DI void phase_main_gemm(const Params& p, char* smem) {
  bfr* sA = (bfr*)smem; bfr* sW = sA + 128 * LDT;
  constexpr int NT = NALL / 128, MTL = MTOT / 128;
  for (int tile = blockIdx.x; tile < NT * MTL; tile += gridDim.x) {
    int m0 = (tile / NT) * 128, n0 = (tile % NT) * 128;
    f32x16 acc[2][2];
    _Pragma("unroll") for (int a = 0; a < 2; ++a) _Pragma("unroll") for (int b = 0; b < 2; ++b) acc[a][b] = zero16();
    gemm_mainloop(p.H, 1024, m0, p.Wt_all, 1024, n0, 1024, sA, sW, acc);
    epi_main(p, acc, m0, n0);
  }
}

DI void attn_prompt_item(const Params& p, int qb, int hd, bfr* sVt  ) {
  const int t = threadIdx.x, lane = t & 63, w = t >> 6, r = lane & 31, h = lane >> 5;
  const int j = hd >> 2, kb0 = qb * 128 - 128;
  __syncthreads();
  _Pragma("unroll") for (int it = 0; it < 8; ++it) {
    int kl = it * 32 + (t & 31), dg = t >> 5, kpos = kb0 + kl;
    u32x4 v = {0u, 0u, 0u, 0u};
    if (kpos >= 0) v = *(const u32x4*)(p.Vb + (size_t)kpos * 128 + j * 64 + dg * 8);
    _Pragma("unroll") for (int e = 0; e < 8; ++e) sVt[(dg * 8 + e) * 264 + kl] = (bfr)((v[e >> 1] >> ((e & 1) * 16)) & 0xffffu);
  }
  __syncthreads();
  const int q0 = qb * 128 + 32 * w, q = q0 + r;
  bf16x8 qf[4];
  _Pragma("unroll") for (int s = 0; s < 4; ++s) qf[s] = *(const bf16x8*)(p.Q + (size_t)q * 512 + hd * 64 + 16 * s + 8 * h);
  f32x16 sacc[5];
  _Pragma("unroll") for (int kt = 0; kt < 5; ++kt) {
    sacc[kt] = zero16();
    int kr = q0 - 128 + 32 * kt + r; kr = kr < 0 ? 0 : kr;
    _Pragma("unroll") for (int s = 0; s < 4; ++s) {
      bf16x8 kf = *(const bf16x8*)(p.Kb + (size_t)kr * 128 + j * 64 + 16 * s + 8 * h);
      sacc[kt] = mfma(kf, qf[s], sacc[kt]);
    }
  }
  const float sink = p.sinks[hd];
  float mx = sink;
  _Pragma("unroll") for (int kt = 0; kt < 5; ++kt) _Pragma("unroll") for (int i = 0; i < 16; ++i) {
    int key = q0 - 128 + 32 * kt + crow(i, h), rel = q - key;
    bool valid = (rel >= 0) && (rel < 128) && (key >= 0);
    float sv = valid ? sacc[kt][i] : -INFINITY;
    sacc[kt][i] = sv; mx = fmaxf(mx, sv);
  }
  mx = fmaxf(mx, __shfl_xor(mx, 32));
  float l = 0.f;
  _Pragma("unroll") for (int kt = 0; kt < 5; ++kt) _Pragma("unroll") for (int i = 0; i < 16; ++i) {
    float pv = __expf(sacc[kt][i] - mx); sacc[kt][i] = pv; l += pv;
  }
  l += __shfl_xor(l, 32);
  l += __expf(sink - mx);
  f32x16 oacc[2]; oacc[0] = zero16(); oacc[1] = zero16();
  _Pragma("unroll") for (int kt = 0; kt < 5; ++kt) _Pragma("unroll") for (int s2 = 0; s2 < 2; ++s2) {
    u32x4 pp;
    _Pragma("unroll") for (int e = 0; e < 4; ++e) pp[e] = pk2(sacc[kt][8 * s2 + 2 * e], sacc[kt][8 * s2 + 2 * e + 1]);
    bf16x8 pf = __builtin_bit_cast(bf16x8, pp);
    _Pragma("unroll") for (int dt = 0; dt < 2; ++dt) {
      const bfr* vp = sVt + (dt * 32 + r) * 264 + 32 * w + 32 * kt + 16 * s2 + 4 * h;
      u32x2 lo = *(const u32x2*)vp, hi = *(const u32x2*)(vp + 8);
      u32x4 vv; vv[0] = lo[0]; vv[1] = lo[1]; vv[2] = hi[0]; vv[3] = hi[1];
      oacc[dt] = mfma(__builtin_bit_cast(bf16x8, vv), pf, oacc[dt]);
    }
  }
  const float il = 1.f / l;
  _Pragma("unroll") for (int dt = 0; dt < 2; ++dt) _Pragma("unroll") for (int g = 0; g < 4; ++g) {
    int d = dt * 32 + 8 * g + 4 * h;
    size_t off = (size_t)q * 512 + hd * 64 + d;
    u32x2 za = *(const u32x2*)(p.ZA + off);
    *(u32x2*)(p.YA + off) = pack4(oacc[dt][4 * g] * il * bflo(za[0]), oacc[dt][4 * g + 1] * il * bfhi(za[0]),
                                  oacc[dt][4 * g + 2] * il * bflo(za[1]), oacc[dt][4 * g + 3] * il * bfhi(za[1]));
  }
}

DI void attn_sample_wave(const Params& p, int b, int hd) {
  const int lane = threadIdx.x & 63, j = hd >> 2, m = SEQ + b;
  u32x4 qv[8];
  _Pragma("unroll") for (int i = 0; i < 8; ++i) qv[i] = *(const u32x4*)(p.Q + (size_t)m * 512 + hd * 64 + 8 * i);
  float dn = 0.f;
  _Pragma("unroll") for (int i = 0; i < 8; ++i) {
    u32x4 kv = *(const u32x4*)(p.Kb + (size_t)m * 128 + j * 64 + 8 * i);
    _Pragma("unroll") for (int e = 0; e < 4; ++e) dn += bflo(qv[i][e]) * bflo(kv[e]) + bfhi(qv[i][e]) * bfhi(kv[e]);
  }
  float s[2];
  _Pragma("unroll") for (int u = 0; u < 2; ++u) {
    int idx = lane + 1 + 64 * u;
    int ic = idx < 128 ? idx : 127;
    const float* kp = p.cache_k + ((size_t)(b * 128 + ic) * 2 + j) * 64;
    float d = 0.f;
    _Pragma("unroll") for (int i = 0; i < 8; ++i) {
      float4 k0 = *(const float4*)(kp + 8 * i), k1 = *(const float4*)(kp + 8 * i + 4);
      d += bflo(qv[i][0]) * k0.x + bfhi(qv[i][0]) * k0.y + bflo(qv[i][1]) * k0.z + bfhi(qv[i][1]) * k0.w;
      d += bflo(qv[i][2]) * k1.x + bfhi(qv[i][2]) * k1.y + bflo(qv[i][3]) * k1.z + bfhi(qv[i][3]) * k1.w;
    }
    s[u] = idx < 128 ? d : dn;
  }
  const float sink = p.sinks[hd];
  float mx = fmaxf(fmaxf(s[0], s[1]), sink);
  _Pragma("unroll") for (int o = 32; o >= 1; o >>= 1) mx = fmaxf(mx, __shfl_xor(mx, o));
  float p0 = __expf(s[0] - mx), p1 = __expf(s[1] - mx);
  float l = p0 + p1;
  _Pragma("unroll") for (int o = 32; o >= 1; o >>= 1) l += __shfl_xor(l, o);
  l += __expf(sink - mx);
  float o = 0.f;
  const float* vb = p.cache_v + ((size_t)(b * 128) * 2 + j) * 64 + lane;
  _Pragma("unroll 8") for (int idx = 1; idx < 128; ++idx) {
    float pv = __shfl(idx <= 64 ? p0 : p1, (idx - 1) & 63);
    o += pv * vb[(size_t)idx * 128];
  }
  o += __shfl(p1, 63) * bf2f(p.Vb[(size_t)m * 128 + j * 64 + lane]);
  size_t off = (size_t)m * 512 + hd * 64 + lane;
  p.YA[off] = (bfr)f2bf(o / l * bf2f(p.ZA[off]));
}

DI void hgrn_gates(const Params& p, int row0, int hh, float* sTot, float (&L)[32], float (&kin)[32], float& t0, float& lc) {
  const int t = threadIdx.x, c = t & 127, half = t >> 7, ch = hh * 128 + c;
  const float lbv = 1.f / (1.f + __expf(p.lb_logits[512 + ch] - p.lb_logits[ch]));
  const float* zp = p.ZF + (size_t)(row0 + half * 32) * 512 + ch;
  float run = 0.f;
  _Pragma("unroll") for (int jj = 0; jj < 32; ++jj) {
    float z = zp[(size_t)jj * 512];
    z = fminf(fmaxf(z, -30.f), 30.f);
    float em = __expf(-z), sg = 1.f / (1.f + em);
    float f = lbv + (1.f - lbv) * sg;
    kin[jj] = (1.f - lbv) * em * sg;
    run += __logf(f);
    L[jj] = run;
  }
  sTot[half * 128 + c] = run;
  __syncthreads();
  t0 = sTot[c]; lc = t0 + sTot[128 + c];
  if (half) { _Pragma("unroll") for (int jj = 0; jj < 32; ++jj) L[jj] += t0; }
}

DI void hgrn_local_item(const Params& p, int n, int hh, char* smem) {
  bfr* sKt = (bfr*)smem; bfr* sVt = sKt + 128 * LDT; float* sTot = (float*)(sVt + 128 * LDT);
  const int t = threadIdx.x, lane = t & 63, w = t >> 6, r = lane & 31, h = lane >> 5, c = t & 127, half = t >> 7;
  const int row0 = n * 64;
  __syncthreads();
  float L[32], kin[32], t0, lc;
  hgrn_gates(p, row0, hh, sTot, L, kin, t0, lc);
  _Pragma("unroll") for (int q4 = 0; q4 < 4; ++q4) {
    u32x4 o;
    _Pragma("unroll") for (int e = 0; e < 4; ++e) {
      int jj = q4 * 8 + 2 * e;
      o[e] = pk2(kin[jj] * __expf(lc - L[jj]), kin[jj + 1] * __expf(lc - L[jj + 1]));
    }
    *(u32x4*)(sKt + c * LDT + half * 32 + q4 * 8) = o;
  }
  const bfr* ip = p.IB + (size_t)(row0 + half * 32) * 512 + hh * 128 + c;
  _Pragma("unroll") for (int q4 = 0; q4 < 4; ++q4) {
    u32x4 o;
    _Pragma("unroll") for (int e = 0; e < 4; ++e) {
      int jj = q4 * 8 + 2 * e;
      o[e] = (unsigned)ip[(size_t)jj * 512] | ((unsigned)ip[(size_t)(jj + 1) * 512] << 16);
    }
    *(u32x4*)(sVt + c * LDT + half * 32 + q4 * 8) = o;
  }
  if (half == 0) p.dec[(n * 4 + hh) * 128 + c] = __expf(lc);
  __syncthreads();
  const int wv = w >> 1, wk = w & 1;
  f32x16 acc[2][2];
  _Pragma("unroll") for (int a = 0; a < 2; ++a) _Pragma("unroll") for (int b = 0; b < 2; ++b) acc[a][b] = zero16();
  _Pragma("unroll") for (int s = 0; s < 4; ++s) {
    bf16x8 af[2], bf[2];
    _Pragma("unroll") for (int x = 0; x < 2; ++x) {
      af[x] = *(const bf16x8*)(sVt + (wv * 64 + x * 32 + r) * LDT + 16 * s + 8 * h);
      bf[x] = *(const bf16x8*)(sKt + (wk * 64 + x * 32 + r) * LDT + 16 * s + 8 * h);
    }
    _Pragma("unroll") for (int a = 0; a < 2; ++a) _Pragma("unroll") for (int b = 0; b < 2; ++b) acc[a][b] = mfma(af[a], bf[b], acc[a][b]);
  }
  float* up = p.Ust + (size_t)(n * 4 + hh) * 16384;
  _Pragma("unroll") for (int a = 0; a < 2; ++a) _Pragma("unroll") for (int b = 0; b < 2; ++b) _Pragma("unroll") for (int i = 0; i < 16; ++i) {
    int v = wv * 64 + a * 32 + crow(i, h), k = wk * 64 + b * 32 + r;
    up[v * 128 + k] = acc[a][b][i];
  }
}

DI void hgrn_sample_item(const Params& p, int b, int hh, char* smem) {
  float* sf = (float*)smem; float* skin = sf + 128; float* sq = skin + 128; float* sv = sq + 128; float* sred = sv + 128; float* s2 = sred + 8 * 128;
  const int t = threadIdx.x, m = SEQ + b;
  __syncthreads();
  if (t < 128) {
    int ch = hh * 128 + t;
    float lbv = 1.f / (1.f + __expf(p.lb_logits[512 + ch] - p.lb_logits[ch]));
    float z = p.ZF[(size_t)m * 512 + ch];
    z = fminf(fmaxf(z, -30.f), 30.f);
    float em = __expf(-z), sg = 1.f / (1.f + em);
    sf[t] = lbv + (1.f - lbv) * sg; skin[t] = (1.f - lbv) * em * sg;
    sq[t] = bf2f(p.QB[(size_t)m * 512 + ch]); sv[t] = bf2f(p.IB[(size_t)m * 512 + ch]);
  }
  __syncthreads();
  const int v4 = (t & 31) * 4, kg = t >> 5;
  float4 vv = *(const float4*)(sv + v4);
  float4 o = {0.f, 0.f, 0.f, 0.f};
  const size_t sb = (size_t)(b * 4 + hh) * 16384;
  _Pragma("unroll 8") for (int kk = 0; kk < 16; ++kk) {
    int k = kg * 16 + kk;
    float4 S = *(const float4*)(p.state + sb + k * 128 + v4);
    float f = sf[k], ki = skin[k], qq = sq[k];
    float4 Sn; Sn.x = f * S.x + ki * vv.x; Sn.y = f * S.y + ki * vv.y; Sn.z = f * S.z + ki * vv.z; Sn.w = f * S.w + ki * vv.w;
    *(float4*)(p.out_ss + sb + k * 128 + v4) = Sn;
    o.x += qq * Sn.x; o.y += qq * Sn.y; o.z += qq * Sn.z; o.w += qq * Sn.w;
  }
  *(float4*)(sred + kg * 128 + v4) = o;
  __syncthreads();
  float ov = 0.f;
  if (t < 128) {
    _Pragma("unroll") for (int g = 0; g < 8; ++g) ov += sred[g * 128 + t];
    float ss = ov * ov;
    _Pragma("unroll") for (int of = 32; of >= 1; of >>= 1) ss += __shfl_xor(ss, of);
    if ((t & 63) == 0) s2[t >> 6] = ss;
  }
  __syncthreads();
  if (t < 128) {
    float sc = rsqrtf((s2[0] + s2[1]) * (1.f / 128.f) + EPS);
    size_t off = (size_t)m * 512 + hh * 128 + t;
    p.YB[off] = (bfr)f2bf(ov * sc * p.og[t] * bf2f(p.ZB[off]));
  }
}

DI void phase_mix(const Params& p, char* smem) {
  for (int it = blockIdx.x; it < 1024; it += gridDim.x) attn_prompt_item(p, it >> 3, it & 7, (bfr*)smem);
  for (int it = blockIdx.x; it < 1024; it += gridDim.x) hgrn_local_item(p, it >> 2, it & 3, smem);
  for (int it = blockIdx.x; it < 512; it += gridDim.x) hgrn_sample_item(p, it >> 2, it & 3, smem);
  for (int it = blockIdx.x * 4 + (threadIdx.x >> 6); it < 1024; it += gridDim.x * 4) attn_sample_wave(p, it >> 3, it & 7);
  for (int idx = blockIdx.x * 256 + threadIdx.x; idx < 128 * 4064; idx += gridDim.x * 256) {
    int b = idx / 4064, i4 = idx - b * 4064;
    size_t so = (size_t)b * 16384 + 128 + i4 * 4, dof = (size_t)b * 16384 + i4 * 4;
    *(float4*)(p.out_ks + dof) = *(const float4*)(p.cache_k + so);
    *(float4*)(p.out_vs + dof) = *(const float4*)(p.cache_v + so);
  }
}

DI void phase_scan(const Params& p) {
  const int e = blockIdx.x * 256 + threadIdx.x;
  if (e >= 65536) return;
  const int hh = e >> 14, k = e & 127, v = (e >> 7) & 127;
  float S = 0.f;
  for (int n0 = 0; n0 < NCH; n0 += 16) {
    float u[16], d[16];
    _Pragma("unroll") for (int i = 0; i < 16; ++i) {
      u[i] = p.Ust[(size_t)(n0 + i) * 65536 + e];
      d[i] = p.dec[((n0 + i) * 4 + hh) * 128 + k];
    }
    _Pragma("unroll") for (int i = 0; i < 16; ++i) {
      p.Ust[(size_t)(n0 + i) * 65536 + e] = S;
      S = d[i] * S + u[i];
    }
  }
  p.out_sp[(hh * 128 + k) * 128 + v] = S;
}

DI void hgrn_out_item(const Params& p, int n, int hh, char* smem) {
  bfr* sQh = (bfr*)smem;
  bfr* sKh = sQh + 64 * 136;
  bfr* sVt = sKh + 64 * 136;
  bfr* sAm = sVt + 128 * LDT;
  float* sTot = (float*)(sAm + 64 * LDT);
  float* sEm = sTot + 256;
  float* sRed = sEm + 128;
  const int t = threadIdx.x, lane = t & 63, w = t >> 6, r = lane & 31, h = lane >> 5, c = t & 127, half = t >> 7;
  const int row0 = n * 64;
  __syncthreads();
  {
    float L[32], kin[32], t0, lc;
    hgrn_gates(p, row0, hh, sTot, L, kin, t0, lc);
    const bfr* qp = p.QB + (size_t)(row0 + half * 32) * 512 + hh * 128 + c;
    _Pragma("unroll") for (int jj = 0; jj < 32; ++jj) {
      float dl = L[jj] - t0;
      float eq = __expf(fminf(dl, 80.f)), ek = __expf(fminf(-dl, 80.f));
      float qv = bf2f(qp[(size_t)jj * 512]);
      sQh[(half * 32 + jj) * 136 + c] = (bfr)f2bf(qv * eq);
      sKh[(half * 32 + jj) * 136 + c] = (bfr)f2bf(kin[jj] * ek);
    }
    if (half == 0) sEm[c] = __expf(t0);
  }
  const bfr* ip = p.IB + (size_t)(row0 + half * 32) * 512 + hh * 128 + c;
  _Pragma("unroll") for (int q4 = 0; q4 < 4; ++q4) {
    u32x4 o;
    _Pragma("unroll") for (int e = 0; e < 4; ++e) {
      int jj = q4 * 8 + 2 * e;
      o[e] = (unsigned)ip[(size_t)jj * 512] | ((unsigned)ip[(size_t)(jj + 1) * 512] << 16);
    }
    *(u32x4*)(sVt + c * LDT + half * 32 + q4 * 8) = o;
  }
  __syncthreads();
  {
    const int jt = w >> 1, it = w & 1;
    f32x16 a = zero16();
    if (jt <= it) {
      _Pragma("unroll") for (int s = 0; s < 8; ++s) {
        bf16x8 kf = *(const bf16x8*)(sKh + (jt * 32 + r) * 136 + 16 * s + 8 * h);
        bf16x8 qf = *(const bf16x8*)(sQh + (it * 32 + r) * 136 + 16 * s + 8 * h);
        a = mfma(kf, qf, a);
      }
    }
    const int i = it * 32 + r;
    _Pragma("unroll") for (int g = 0; g < 4; ++g) {
      int j0 = jt * 32 + 8 * g + 4 * h;
      float x0 = (j0 <= i) ? a[4 * g] : 0.f, x1 = (j0 + 1 <= i) ? a[4 * g + 1] : 0.f;
      float x2 = (j0 + 2 <= i) ? a[4 * g + 2] : 0.f, x3 = (j0 + 3 <= i) ? a[4 * g + 3] : 0.f;
      *(u32x2*)(sAm + i * LDT + j0) = pack4(x0, x1, x2, x3);
    }
  }
  __syncthreads();
  f32x16 oacc[2]; oacc[0] = zero16(); oacc[1] = zero16();
  {
    const float* sp = p.Ust + (size_t)(n * 4 + hh) * 16384 + (size_t)(32 * w + r) * 128;
    _Pragma("unroll") for (int s = 0; s < 8; ++s) {
      float4 a0 = *(const float4*)(sp + 16 * s + 8 * h), a1 = *(const float4*)(sp + 16 * s + 8 * h + 4);
      float4 e0 = *(const float4*)(sEm + 16 * s + 8 * h), e1 = *(const float4*)(sEm + 16 * s + 8 * h + 4);
      u32x4 pa; pa[0] = pk2(a0.x * e0.x, a0.y * e0.y); pa[1] = pk2(a0.z * e0.z, a0.w * e0.w);
      pa[2] = pk2(a1.x * e1.x, a1.y * e1.y); pa[3] = pk2(a1.z * e1.z, a1.w * e1.w);
      bf16x8 af = __builtin_bit_cast(bf16x8, pa);
      _Pragma("unroll") for (int it = 0; it < 2; ++it) {
        bf16x8 qf = *(const bf16x8*)(sQh + (it * 32 + r) * 136 + 16 * s + 8 * h);
        oacc[it] = mfma(af, qf, oacc[it]);
      }
    }
    _Pragma("unroll") for (int s = 0; s < 4; ++s) {
      bf16x8 vf = *(const bf16x8*)(sVt + (32 * w + r) * LDT + 16 * s + 8 * h);
      _Pragma("unroll") for (int it = 0; it < 2; ++it) {
        bf16x8 af2 = *(const bf16x8*)(sAm + (it * 32 + r) * LDT + 16 * s + 8 * h);
        oacc[it] = mfma(vf, af2, oacc[it]);
      }
    }
  }
  _Pragma("unroll") for (int it = 0; it < 2; ++it) {
    float ss = 0.f;
    _Pragma("unroll") for (int i = 0; i < 16; ++i) ss += oacc[it][i] * oacc[it][i];
    ss += __shfl_xor(ss, 32);
    if (h == 0) sRed[w * 64 + it * 32 + r] = ss;
  }
  __syncthreads();
  _Pragma("unroll") for (int it = 0; it < 2; ++it) {
    const int i = it * 32 + r;
    float tot = sRed[i] + sRed[64 + i] + sRed[128 + i] + sRed[192 + i];
    float sc = rsqrtf(tot * (1.f / 128.f) + EPS);
    _Pragma("unroll") for (int g = 0; g < 4; ++g) {
      int v = 32 * w + 8 * g + 4 * h;
      size_t off = (size_t)(row0 + i) * 512 + hh * 128 + v;
      float4 og = *(const float4*)(p.og + v);
      u32x2 zb = *(const u32x2*)(p.ZB + off);
      *(u32x2*)(p.YB + off) = pack4(oacc[it][4 * g] * sc * og.x * bflo(zb[0]), oacc[it][4 * g + 1] * sc * og.y * bfhi(zb[0]),
                                    oacc[it][4 * g + 2] * sc * og.z * bflo(zb[1]), oacc[it][4 * g + 3] * sc * og.w * bfhi(zb[1]));
    }
  }
}

DI void phase_merge(const Params& p, char* smem) {
  bfr* sA = (bfr*)smem; bfr* sW = sA + 128 * LDT;
  const int t = threadIdx.x, lane = t & 63, w = t >> 6, wn = w >> 1, wm = w & 1, r = lane & 31, h = lane >> 5;
  for (int tile = blockIdx.x; tile < 129 * 8; tile += gridDim.x) {
    int m0 = (tile >> 3) * 128, n0 = (tile & 7) * 128;
    f32x16 acc[2][2], acc2[2][2];
    _Pragma("unroll") for (int a = 0; a < 2; ++a) _Pragma("unroll") for (int b = 0; b < 2; ++b) { acc[a][b] = zero16(); acc2[a][b] = zero16(); }
    gemm_mainloop(p.YA, 512, m0, p.Wt_pa, 512, n0, 512, sA, sW, acc);
    gemm_mainloop(p.YB, 512, m0, p.Wt_pb, 512, n0, 512, sA, sW, acc2);
    _Pragma("unroll") for (int nt = 0; nt < 2; ++nt) _Pragma("unroll") for (int mt = 0; mt < 2; ++mt) {
      int m = m0 + wm * 64 + mt * 32 + r;
      _Pragma("unroll") for (int g = 0; g < 4; ++g) {
        int n = n0 + wn * 64 + nt * 32 + 8 * g + 4 * h;
        size_t off = (size_t)m * 1024 + n;
        u32x2 ga = *(const u32x2*)(p.GA + off), gb = *(const u32x2*)(p.GB + off);
        *(u32x2*)(p.Y + off) = pack4(bflo(ga[0]) * acc[nt][mt][4 * g] + bflo(gb[0]) * acc2[nt][mt][4 * g],
                                     bfhi(ga[0]) * acc[nt][mt][4 * g + 1] + bfhi(gb[0]) * acc2[nt][mt][4 * g + 1],
                                     bflo(ga[1]) * acc[nt][mt][4 * g + 2] + bflo(gb[1]) * acc2[nt][mt][4 * g + 2],
                                     bfhi(ga[1]) * acc[nt][mt][4 * g + 3] + bfhi(gb[1]) * acc2[nt][mt][4 * g + 3]);
      }
    }
  }
}

DI void phase_out(const Params& p, char* smem) {
  bfr* sA = (bfr*)smem; bfr* sW = sA + 128 * LDT;
  const int t = threadIdx.x, lane = t & 63, w = t >> 6, wn = w >> 1, wm = w & 1, r = lane & 31, h = lane >> 5;
  for (int tile = blockIdx.x; tile < 129 * 8; tile += gridDim.x) {
    int m0 = (tile >> 3) * 128, n0 = (tile & 7) * 128;
    f32x16 acc[2][2];
    _Pragma("unroll") for (int a = 0; a < 2; ++a) _Pragma("unroll") for (int b = 0; b < 2; ++b) acc[a][b] = zero16();
    gemm_mainloop(p.Y, 1024, m0, p.Wt_out, 1024, n0, 1024, sA, sW, acc);
    _Pragma("unroll") for (int nt = 0; nt < 2; ++nt) _Pragma("unroll") for (int mt = 0; mt < 2; ++mt) {
      int m = m0 + wm * 64 + mt * 32 + r;
      const float* xr = m < SEQ ? p.x_prompt + (size_t)m * DM : p.x_sample + (size_t)(m - SEQ) * DM;
      float* orow = m < SEQ ? p.out_yp + (size_t)m * DM : p.out_ys + (size_t)(m - SEQ) * DM;
      const float* gr = p.mod + (size_t)(m < SEQ ? 128 : m - SEQ) * 3072 + 2048;
      _Pragma("unroll") for (int g = 0; g < 4; ++g) {
        int n = n0 + wn * 64 + nt * 32 + 8 * g + 4 * h;
        float4 xv = *(const float4*)(xr + n), gt = *(const float4*)(gr + n), o;
        o.x = xv.x + gt.x * acc[nt][mt][4 * g]; o.y = xv.y + gt.y * acc[nt][mt][4 * g + 1];
        o.z = xv.z + gt.z * acc[nt][mt][4 * g + 2]; o.w = xv.w + gt.w * acc[nt][mt][4 * g + 3];
        *(float4*)(orow + n) = o;
      }
    }
  }
}

__global__ void __launch_bounds__(256, 2) hybrid_megakernel(Params p) {
  __shared__ __attribute__((aligned(16))) char smem[SMEM_BYTES];
  cg::grid_group grid = cg::this_grid();
#define RUN_PHASE(n, call) if (p.phase_lo <= n && n <= p.phase_hi) { if (n != p.phase_lo) grid.sync(); call; }
  RUN_PHASE(0, phase_prep(p, smem))
  RUN_PHASE(1, phase_mod(p, smem))
  RUN_PHASE(2, phase_h(p))
  RUN_PHASE(3, phase_main_gemm(p, smem))
  RUN_PHASE(4, phase_mix(p, smem))
  RUN_PHASE(5, phase_scan(p))
  RUN_PHASE(6, for (int it = blockIdx.x; it < 1024; it += gridDim.x) hgrn_out_item(p, it >> 2, it & 3, smem))
  RUN_PHASE(7, phase_merge(p, smem))
  RUN_PHASE(8, phase_out(p, smem))
}

#ifndef ONE_LAUNCH
#define ONE_LAUNCH 1
#endif

extern "C" void kernel_launch(void* const* d_in, const int* in_sizes, int n_in, void* d_out, int out_size, void* d_ws, size_t ws_size,
                              hipStream_t stream) {
  static int grid_blocks = 0;
  if (!grid_blocks) {
    int dev = 0, cus = 0, per_cu = 0;
    hipGetDevice(&dev);
    hipDeviceGetAttribute(&cus, hipDeviceAttributeMultiprocessorCount, dev);
    hipOccupancyMaxActiveBlocksPerMultiprocessor(&per_cu, hybrid_megakernel, 256, 0);
    if (per_cu > 2) per_cu = 2;
    if (per_cu < 1) per_cu = 1;
    grid_blocks = cus * per_cu;
  }
  Params p{};
  const float* const* in = (const float* const*)d_in;
  p.x_prompt = in[0]; p.x_sample = in[1]; p.cache_k = in[2]; p.cache_v = in[3]; p.state = in[4]; p.c_prompt = in[5]; p.c_sample = in[6];
  p.w_ada = in[7]; p.b_ada = in[8]; p.norm_g = in[9]; p.w_in = in[10]; p.qg = in[11]; p.kg = in[12]; p.sinks = in[13]; p.lb_logits = in[14];
  p.og = in[15]; p.w_merge = in[16]; p.b_merge = in[17]; p.w_pa = in[18]; p.w_pb = in[19]; p.w_out = in[20];
  float* o = (float*)d_out;
  p.out_yp = o; o += (size_t)SEQ * DM;
  p.out_ys = o; o += (size_t)NBT * DM;
  p.out_kp = o; o += 128 * 128;
  p.out_vp = o; o += 128 * 128;
  p.out_sp = o; o += 4 * 128 * 128;
  p.out_ks = o; o += (size_t)NBT * 128 * 128;
  p.out_vs = o; o += (size_t)NBT * 128 * 128;
  p.out_ss = o;
  char* wsp = (char*)d_ws;
  auto take = [&](size_t bytes) { char* r = wsp; wsp += (bytes + 255) & ~(size_t)255; return r; };
  p.Wt_all = (bfr*)take((size_t)NALL * 1024 * 2);
  p.Wt_pa = (bfr*)take((size_t)1024 * 512 * 2);
  p.Wt_pb = (bfr*)take((size_t)1024 * 512 * 2);
  p.Wt_out = (bfr*)take((size_t)1024 * 1024 * 2);
  p.Wt_ada = (bfr*)take((size_t)3072 * 1024 * 2);
  p.Cb = (bfr*)take((size_t)256 * 1024 * 2);
  p.mod = (float*)take((size_t)256 * 3072 * 4);
  p.H = (bfr*)take((size_t)MTOT * 1024 * 2);
  p.YA = p.H; p.YB = p.H + (size_t)MTOT * 512;
  p.Q = (bfr*)take((size_t)MTOT * 512 * 2);
  p.QB = (bfr*)take((size_t)MTOT * 512 * 2);
  p.Y = p.Q;
  p.Kb = (bfr*)take((size_t)MTOT * 128 * 2);
  p.Vb = (bfr*)take((size_t)MTOT * 128 * 2);
  p.ZA = (bfr*)take((size_t)MTOT * 512 * 2);
  p.IB = (bfr*)take((size_t)MTOT * 512 * 2);
  p.ZB = (bfr*)take((size_t)MTOT * 512 * 2);
  p.ZF = (float*)take((size_t)MTOT * 512 * 4);
  p.GA = (bfr*)take((size_t)MTOT * 1024 * 2);
  p.GB = (bfr*)take((size_t)MTOT * 1024 * 2);
  p.dec = (float*)take((size_t)NCH * 4 * 128 * 4);
  p.Ust = p.out_yp;
  if ((size_t)(wsp - (char*)d_ws) > ws_size) { fprintf(stderr, "workspace too small\n"); return; }
#if ONE_LAUNCH
  p.phase_lo = 0; p.phase_hi = 8;
  void* args[] = {&p};
  hipError_t e = hipLaunchCooperativeKernel((void*)hybrid_megakernel, dim3(grid_blocks), dim3(256), args, 0, stream);
  if (e != hipSuccess) fprintf(stderr, "cooperative launch failed: %s (grid %d)\n", hipGetErrorString(e), grid_blocks);
#else
  for (int ph = 0; ph <= 8; ++ph) {
    p.phase_lo = ph; p.phase_hi = ph;
    hipLaunchKernelGGL(hybrid_megakernel, dim3(grid_blocks), dim3(256), 0, stream, p);
  }
#endif
}
```

```cpp
#include <hip/hip_runtime.h>
#include <hip/hip_cooperative_groups.h>
#include <cstdio>
namespace cg = cooperative_groups;

#define DI __device__ __forceinline__
typedef unsigned short bfr;
using bf16x8 = __attribute__((ext_vector_type(8))) short;
using f32x16 = __attribute__((ext_vector_type(16))) float;
using u32x4 = __attribute__((ext_vector_type(4))) unsigned;
using u32x2 = __attribute__((ext_vector_type(2))) unsigned;

constexpr int DM = 1024, SEQ = 16384, NBT = 128, MTOT = SEQ + NBT;
constexpr int NALL = 5376;
constexpr int NCH = 256;
constexpr float EPS = 1e-6f;
constexpr int LDT = 72;
constexpr int MPAD = 16640;
#define TID ((int)(threadIdx.x & 255))
#define VBID ((int)(blockIdx.x * 2 + (threadIdx.x >> 8)))
#define VGRID ((int)(gridDim.x * 2))

struct Params {
  const float *x_prompt, *x_sample, *cache_k, *cache_v, *state, *c_prompt, *c_sample;
  const float *w_ada, *b_ada, *norm_g, *w_in, *qg, *kg, *sinks, *lb_logits, *og, *w_merge, *b_merge, *w_pa, *w_pb, *w_out;
  float *out_yp, *out_ys, *out_kp, *out_vp, *out_sp, *out_ks, *out_vs, *out_ss;
  bfr *Wt_all, *Wt_pa, *Wt_pb, *Wt_out, *Wt_ada, *Cb, *H, *Q, *QB, *Kb, *Vb, *ZA, *IB, *ZB, *GA, *GB, *YA, *YB, *Y;
  float *mod, *ZF, *dec, *Ust;
  bfr* Ys;
  int phase_lo, phase_hi;
};

DI unsigned f2bf(float x) { unsigned u = __float_as_uint(x); u += 0x7fffu + ((u >> 16) & 1u); return u >> 16; }
DI unsigned pk2(float a, float b) { return f2bf(a) | (f2bf(b) << 16); }
DI float bf2f(unsigned b) { return __uint_as_float(b << 16); }
DI float bflo(unsigned u) { return __uint_as_float(u << 16); }
DI float bfhi(unsigned u) { return __uint_as_float(u & 0xffff0000u); }
DI int crow(int i, int h) { return (i & 3) + 8 * (i >> 2) + 4 * h; }
DI f32x16 mfma(bf16x8 a, bf16x8 b, f32x16 c) { return __builtin_amdgcn_mfma_f32_32x32x16_bf16(a, b, c, 0, 0, 0); }
DI f32x16 zero16() { f32x16 z; _Pragma("unroll") for (int i = 0; i < 16; ++i) z[i] = 0.f; return z; }
DI float sigmoidf_(float x) { return 1.f / (1.f + __expf(-x)); }
DI float siluf_(float x) { return x / (1.f + __expf(-x)); }
DI u32x2 pack4(float a, float b, float c, float d) { u32x2 r; r[0] = pk2(a, b); r[1] = pk2(c, d); return r; }

DI int wt_row_of_col(int c) {
  const int pn = c >> 8, cl = c & 255;
  int slot;
  if (pn < 3) {
    const int g = cl >> 6, d = cl & 63;
    if (d >= 32) { const int x = d - 32; slot = 128 + 32 * g + 16 * ((x >> 2) & 1) + 4 * (x >> 3) + (x & 3); }
    else { const int fq = 2 * (d >> 4) + ((d >> 2) & 1), n = (d >> 3) & 1, j = d & 3; slot = 32 * g + 16 * n + 4 * fq + j; }
  } else {
    const int bj = cl >> 7, g = (cl >> 5) & 3, x = cl & 31;
    slot = 128 * bj + 32 * g + 16 * ((x >> 2) & 1) + 4 * (x >> 3) + (x & 3);
  }
  return (pn << 8) + slot;
}

DI void gemm_mainloop(const bfr* __restrict__ A, int lda, int m0, const bfr* __restrict__ W, int ldw, int n0, int K,
                      bfr* sA, bfr* sW, f32x16 (&acc)[2][2]) {
  const int t = TID, lane = t & 63, w = t >> 6, wn = w >> 1, wm = w & 1, r = lane & 31, h = lane >> 5;
  const int lrow = t >> 3, lk = (t & 7) * 8;
  const bfr* ap = A + (size_t)(m0 + lrow) * lda + lk;
  const bfr* wp = W + (size_t)(n0 + lrow) * ldw + lk;
  u32x4 ra[4], rw[4];
  _Pragma("unroll") for (int i = 0; i < 4; ++i) {
    ra[i] = *(const u32x4*)(ap + (size_t)(32 * i) * lda);
    rw[i] = *(const u32x4*)(wp + (size_t)(32 * i) * ldw);
  }
  const int nk = K >> 6;
  for (int kt = 0; kt < nk; ++kt) {
    __syncthreads();
    _Pragma("unroll") for (int i = 0; i < 4; ++i) {
      *(u32x4*)(sA + (lrow + 32 * i) * LDT + lk) = ra[i];
      *(u32x4*)(sW + (lrow + 32 * i) * LDT + lk) = rw[i];
    }
    __syncthreads();
    if (kt + 1 < nk) {
      ap += 64; wp += 64;
      _Pragma("unroll") for (int i = 0; i < 4; ++i) {
        ra[i] = *(const u32x4*)(ap + (size_t)(32 * i) * lda);
        rw[i] = *(const u32x4*)(wp + (size_t)(32 * i) * ldw);
      }
    }
    _Pragma("unroll") for (int kk = 0; kk < 4; ++kk) {
      bf16x8 af[2], bf[2];
      _Pragma("unroll") for (int x = 0; x < 2; ++x) {
        af[x] = *(const bf16x8*)(sW + (wn * 64 + x * 32 + r) * LDT + kk * 16 + 8 * h);
        bf[x] = *(const bf16x8*)(sA + (wm * 64 + x * 32 + r) * LDT + kk * 16 + 8 * h);
      }
      _Pragma("unroll") for (int nt = 0; nt < 2; ++nt)
        _Pragma("unroll") for (int mt = 0; mt < 2; ++mt) acc[nt][mt] = mfma(af[nt], bf[mt], acc[nt][mt]);
    }
  }
}

template <int PERMBASE> DI void transpose_tile(const float* __restrict__ src, int N, bfr* __restrict__ dst, int K, int kt, int nt, float* sm) {
  const int t = TID, k0 = kt * 64, n0 = nt * 64;
  __syncthreads();
  _Pragma("unroll") for (int i = 0; i < 16; ++i) {
    int idx = i * 256 + t, kk = idx >> 6, nn = idx & 63;
    sm[kk * 65 + nn] = src[(size_t)(k0 + kk) * N + n0 + nn];
  }
  __syncthreads();
  _Pragma("unroll") for (int i = 0; i < 8; ++i) {
    int idx = i * 256 + t, nn = idx >> 5, kk = (idx & 31) * 2;
    const int drow = PERMBASE >= 0 ? wt_row_of_col(PERMBASE + n0 + nn) : n0 + nn;
    *(unsigned*)(dst + (size_t)drow * K + k0 + kk) = pk2(sm[kk * 65 + nn], sm[(kk + 1) * 65 + nn]);
  }
}

DI void phase_prep(const Params& p, char* smem) {
  float* sm = (float*)smem;
  for (int it = VBID; it < 2624; it += VGRID) {
    int i = it;
    if (i < 832) { transpose_tile<0>(p.w_in, 3328, p.Wt_all, 1024, i / 52, i % 52, sm); continue; }
    i -= 832;
    if (i < 512) { transpose_tile<3328>(p.w_merge, 2048, p.Wt_all, 1024, i / 32, i % 32, sm); continue; }
    i -= 512;
    if (i < 768) { transpose_tile<-1>(p.w_ada, 3072, p.Wt_ada, 1024, i / 48, i % 48, sm); continue; }
    i -= 768;
    if (i < 128) { transpose_tile<-1>(p.w_pa, 1024, p.Wt_pa, 512, i / 16, i % 16, sm); continue; }
    i -= 128;
    if (i < 128) { transpose_tile<-1>(p.w_pb, 1024, p.Wt_pb, 512, i / 16, i % 16, sm); continue; }
    i -= 128;
    transpose_tile<-1>(p.w_out, 1024, p.Wt_out, 1024, i / 16, i % 16, sm);
  }
  for (int idx = VBID * 256 + TID; idx < 256 * 1024; idx += VGRID * 256) {
    int row = idx >> 10, col = idx & 1023;
    float v = row < 128 ? p.c_sample[row * 1024 + col] : (row == 128 ? p.c_prompt[col] : 0.f);
    p.Cb[idx] = (bfr)f2bf(v);
  }
}

DI void phase_mod(const Params& p, char* smem) {
  bfr* sA = (bfr*)smem; bfr* sW = sA + 128 * LDT;
  const int t = TID, lane = t & 63, w = t >> 6, wn = w >> 1, wm = w & 1, r = lane & 31, h = lane >> 5;
  for (int tile = VBID; tile < 48; tile += VGRID) {
    int m0 = (tile / 24) * 128, n0 = (tile % 24) * 128;
    f32x16 acc[2][2];
    _Pragma("unroll") for (int a = 0; a < 2; ++a) _Pragma("unroll") for (int b = 0; b < 2; ++b) acc[a][b] = zero16();
    gemm_mainloop(p.Cb, 1024, m0, p.Wt_ada, 1024, n0, 1024, sA, sW, acc);
    _Pragma("unroll") for (int nt = 0; nt < 2; ++nt) _Pragma("unroll") for (int mt = 0; mt < 2; ++mt) {
      int m = m0 + wm * 64 + mt * 32 + r;
      _Pragma("unroll") for (int g = 0; g < 4; ++g) {
        int n = n0 + wn * 64 + nt * 32 + 8 * g + 4 * h;
        float4 b = *(const float4*)(p.b_ada + n);
        float4 o; o.x = acc[nt][mt][4 * g] + b.x; o.y = acc[nt][mt][4 * g + 1] + b.y; o.z = acc[nt][mt][4 * g + 2] + b.z; o.w = acc[nt][mt][4 * g + 3] + b.w;
        *(float4*)(p.mod + (size_t)m * 3072 + n) = o;
      }
    }
  }
}

DI void phase_h(const Params& p) {
  const int lane = TID & 63, w = TID >> 6;
  for (int row = VBID * 4 + w; row < MTOT; row += VGRID * 4) {
    const float* xr = row < SEQ ? p.x_prompt + (size_t)row * DM : p.x_sample + (size_t)(row - SEQ) * DM;
    const float* mr = p.mod + (size_t)(row < SEQ ? 128 : row - SEQ) * 3072;
    float4 xv[4]; float ss = 0.f;
    _Pragma("unroll") for (int j = 0; j < 4; ++j) {
      xv[j] = *(const float4*)(xr + j * 256 + lane * 4);
      ss += xv[j].x * xv[j].x + xv[j].y * xv[j].y + xv[j].z * xv[j].z + xv[j].w * xv[j].w;
    }
    _Pragma("unroll") for (int o = 32; o >= 1; o >>= 1) ss += __shfl_xor(ss, o);
    float rs = rsqrtf(ss * (1.f / DM) + EPS);
    _Pragma("unroll") for (int j = 0; j < 4; ++j) {
      int col = j * 256 + lane * 4;
      float4 g = *(const float4*)(p.norm_g + col);
      float4 sh = *(const float4*)(mr + col);
      float4 sc = *(const float4*)(mr + 1024 + col);
      float a = xv[j].x * rs * g.x * (1.f + sc.x) + sh.x;
      float b = xv[j].y * rs * g.y * (1.f + sc.y) + sh.y;
      float c = xv[j].z * rs * g.z * (1.f + sc.z) + sh.z;
      float d = xv[j].w * rs * g.w * (1.f + sc.w) + sh.w;
      *(u32x2*)(p.H + (size_t)row * DM + col) = pack4(a, b, c, d);
    }
  }
}

DI void sincos_red(float a, float& s, float& c) {
  float n = rintf(a * 0.15915494309189535f);
  float rr = fmaf(-n, 6.2831854820251465f, a);
  rr = fmaf(-n, -1.7484555e-7f, rr);
  s = __sinf(rr); c = __cosf(rr);
}

namespace pg8 {
#define PG8_LAS __attribute__((address_space(3)))
typedef unsigned short bf16_t;
typedef short bf16x8 __attribute__((ext_vector_type(8)));
typedef float f32x4 __attribute__((ext_vector_type(4)));
typedef unsigned u32x4 __attribute__((ext_vector_type(4)));
constexpr int BM = 256, BK = 64, HALF = 128, HTB = HALF * BK * 2  , STAGE_BYTES = 8 * HTB, NXCD = 8, WGM = 8;

__host__ __device__ __forceinline__ int lds_byte(int r, int c) { const int st = (r >> 4) * 2 + (c >> 5), rr = r & 15, cc = c & 31, ob = rr * 64 + cc * 2; return st * 1024 + (ob ^ (((ob >> 9) & 1) << 5)); }
__host__ __device__ __forceinline__ void stage_rc(int b, int& R, int& C) { const int st = b / 1024, sb = b % 1024, swz = sb ^ (((sb >> 9) & 1) << 5); R = (st >> 1) * 16 + swz / 64; C = (st & 1) * 32 + (swz % 64) / 2; }
__host__ __device__ __forceinline__ int perm32(int rho) { const int n = rho >> 4, i = rho & 15; return 8 * (i >> 2) + 4 * n + (i & 3); }

struct Unit { int pm, pn; };
struct Gemm { const bf16_t* A; const bf16_t* Bt; int M, N, K; };

struct StaticOrder {
    int nM, nN, nwg, G, c;
    __host__ __device__ void init(int M, int N, int G_, int c_) { nM = M / BM; nN = N / BM; nwg = nM * nN; G = G_; c = c_; }
    __host__ __device__ bool next(int i, Unit& u) const {
        const long L = (long)i * G + c; if (L >= nwg) return false;
        int wgid = (int)L; { const int q = nwg / NXCD, r = nwg % NXCD, xcd = wgid % NXCD, off = wgid / NXCD; wgid = (xcd < r ? xcd * (q + 1) : r * (q + 1) + (xcd - r) * q) + off; }
        const int nig = WGM * nN, gid = wgid / nig, fm = gid * WGM, gsz = (nM - fm) < WGM ? (nM - fm) : WGM;
        u.pm = fm + ((wgid % nig) % gsz); u.pn = (wgid % nig) / gsz; return true;
    }
    __device__ __forceinline__ void a_ready(const Unit&) const {}
    __device__ __forceinline__ void done(const Unit&) const {}
};
template <class Epi, class Sched, bool STAMP = false>
__device__ __forceinline__ void gemm_phase(PG8_LAS unsigned char* lds, const Gemm g, const Sched& S, const Epi& E, unsigned long long* stamps) {
    const int tid = threadIdx.x, wid = __builtin_amdgcn_readfirstlane(tid >> 6), lane = tid & 63, wr = wid >> 2, wc = wid & 3, fr = lane & 15, fq = lane >> 4;
    const int K = g.K, nt = K / BK;
    int ts_lo = 0, ts_hi = 0, nts = 0; const unsigned long long rt_entry = STAMP ? (unsigned long long)wall_clock64() : 0ull;
#define PG8_STAMP() do { if (STAMP && wid == 0 && nts < 64) { const unsigned long long _c = (unsigned long long)clock64(); \
        ts_lo = (lane == nts) ? (int)(unsigned)_c : ts_lo; ts_hi = (lane == nts) ? (int)(unsigned)(_c >> 32) : ts_hi; ++nts; } } while (0)
    PG8_STAMP();
    unsigned voffA[2], voffB[2];
#pragma unroll
    for (int i = 0; i < 2; ++i) { int R, C; stage_rc(tid * 16 + i * 8192, R, C); const int Rb = Epi::PERM ? ((R & ~31) + perm32(R & 31)) : R;
        voffA[i] = (unsigned)(R * K + C) * 2u; voffB[i] = (unsigned)(Rb * K + C) * 2u; }
    const size_t kstep = (size_t)(BK * 2);
    const size_t hstep = (size_t)HALF * K * 2;
    const size_t tstep = 2 * hstep;
    const unsigned ldsw = (unsigned)wid * 1024u;
    const int aoff = lds_byte(wr * 64 + fr, fq * 8), boff = lds_byte(wc * 32 + fr, fq * 8);
#define PG8_SA(b, h) (((b) * 2 + (h)) * HTB)
#define PG8_SB(b, h) ((4 + (b) * 2 + (h)) * HTB)
#define PG8_STAGE(bufoff, gbase, voff) do { _Pragma("unroll") for (int _i = 0; _i < 2; ++_i) \
        __builtin_amdgcn_global_load_lds((const unsigned*)((const char*)(gbase) + (voff)[_i]), (PG8_LAS unsigned*)(lds + (bufoff) + ldsw + _i * 8192), 16, 0, 0); } while (0)
#define PG8_LDA(dst, b, h) do { _Pragma("unroll") for (int m = 0; m < 4; ++m) _Pragma("unroll") for (int k = 0; k < 2; ++k) dst[m][k] = *(const PG8_LAS bf16x8*)(lds + PG8_SA(b, h) + aoff + m * 2048 + k * 1024); } while (0)
#define PG8_LDB(dst, b, h) do { _Pragma("unroll") for (int n = 0; n < 2; ++n) _Pragma("unroll") for (int k = 0; k < 2; ++k) dst[n][k] = *(const PG8_LAS bf16x8*)(lds + PG8_SB(b, h) + boff + n * 2048 + k * 1024); } while (0)
#define PG8_MMA(ai, bj, At, Bt) do { __builtin_amdgcn_s_setprio(1); _Pragma("unroll") for (int m = 0; m < 4; ++m) _Pragma("unroll") for (int n = 0; n < 2; ++n) _Pragma("unroll") for (int k = 0; k < 2; ++k) \
        acc[ai][bj][m][n] = __builtin_amdgcn_mfma_f32_16x16x32_bf16(Bt[n][k], At[m][k], acc[ai][bj][m][n], 0, 0, 0); __builtin_amdgcn_s_setprio(0); } while (0)
#define PG8_WAIT_V(n) asm volatile("s_waitcnt vmcnt(" #n ")" ::: "memory")
#define PG8_WAIT_L(n) asm volatile("s_waitcnt lgkmcnt(" #n ")" ::: "memory")
#define PG8_BAR __builtin_amdgcn_s_barrier()
#define PG8_SCHED __builtin_amdgcn_sched_barrier(0)
    Unit cur, nxt; int ui = 0;
    if (!S.next(0, cur)) return;
    f32x4 acc[2][2][4][2];
#pragma unroll
    for (int a = 0; a < 2; ++a)
#pragma unroll
        for (int b = 0; b < 2; ++b)
#pragma unroll
            for (int m = 0; m < 4; ++m)
#pragma unroll
                for (int n = 0; n < 2; ++n) acc[a][b][m][n] = (f32x4){0.f, 0.f, 0.f, 0.f};
    bf16x8 At[4][2], B0[2][2], B1[2][2];
    const char* cA = (const char*)g.A + (size_t)cur.pm * tstep; const char* cB = (const char*)g.Bt + (size_t)cur.pn * tstep;
    S.a_ready(cur);
    PG8_STAGE(PG8_SB(0, 0), cB, voffB); PG8_STAGE(PG8_SA(0, 0), cA, voffA); PG8_STAGE(PG8_SB(0, 1), cB + hstep, voffB); PG8_STAGE(PG8_SA(0, 1), cA + hstep, voffA);
    if (wr == 1) PG8_BAR;
    PG8_WAIT_V(4); PG8_BAR;
    PG8_STAGE(PG8_SB(1, 0), cB + kstep, voffB); PG8_STAGE(PG8_SA(1, 0), cA + kstep, voffA); PG8_STAGE(PG8_SB(1, 1), cB + hstep + kstep, voffB);
    PG8_WAIT_V(6); PG8_BAR;
    PG8_STAMP();
    for (;;) {
        const bool has_next = S.next(ui + 1, nxt);
        const char* nA = has_next ? (const char*)g.A + (size_t)nxt.pm * tstep : cA; const char* nB = has_next ? (const char*)g.Bt + (size_t)nxt.pn * tstep : cB;
        for (int t = 0; t < nt; t += 2) {
            const bool last = (t == nt - 2);
            const char* a1 = cA + (size_t)(t + 1) * kstep;
            const char* a2 = last ? nA : cA + (size_t)(t + 2) * kstep; const char* b2 = last ? nB : cB + (size_t)(t + 2) * kstep;
            const char* a3 = a2 + kstep; const char* b3 = b2 + kstep;
            if (last && has_next) S.a_ready(nxt);
            PG8_LDB(B0, 0, 0); PG8_SCHED; PG8_LDA(At, 0, 0); PG8_STAGE(PG8_SA(1, 1), a1 + hstep, voffA);
            PG8_WAIT_L(8); PG8_BAR; PG8_WAIT_L(0); PG8_MMA(0, 0, At, B0); PG8_BAR; PG8_SCHED;
            PG8_LDB(B1, 0, 1); PG8_STAGE(PG8_SB(0, 0), b2, voffB);
            PG8_BAR; PG8_WAIT_L(0); PG8_MMA(0, 1, At, B1); PG8_BAR;
            PG8_LDA(At, 0, 1); PG8_STAGE(PG8_SA(0, 0), a2, voffA);
            PG8_BAR; PG8_WAIT_L(0); PG8_MMA(1, 0, At, B0); PG8_BAR; PG8_SCHED;
            PG8_STAGE(PG8_SB(0, 1), b2 + hstep, voffB);
            PG8_WAIT_V(6); PG8_BAR; PG8_MMA(1, 1, At, B1); PG8_BAR;
            PG8_LDB(B0, 1, 0); PG8_SCHED; PG8_LDA(At, 1, 0); PG8_STAGE(PG8_SA(0, 1), a2 + hstep, voffA);
            PG8_WAIT_L(8); PG8_BAR; PG8_WAIT_L(0); PG8_MMA(0, 0, At, B0); PG8_BAR; PG8_SCHED;
            PG8_LDB(B1, 1, 1); PG8_STAGE(PG8_SB(1, 0), b3, voffB);
            PG8_BAR; PG8_WAIT_L(0); PG8_MMA(0, 1, At, B1); PG8_BAR;
            PG8_LDA(At, 1, 1); PG8_STAGE(PG8_SA(1, 0), a3, voffA);
            PG8_BAR; PG8_WAIT_L(0); PG8_MMA(1, 0, At, B0); PG8_BAR; PG8_SCHED;
            PG8_STAGE(PG8_SB(1, 1), b3 + hstep, voffB);
            PG8_WAIT_V(6); PG8_BAR; PG8_MMA(1, 1, At, B1); PG8_BAR;
        }
        PG8_STAMP();
        if constexpr (!Epi::AFTER_DRAIN) { E(acc, cur, wr, wc, fr, fq); S.done(cur); }
        PG8_STAMP();
        if (!has_next) break;
#pragma unroll
        for (int a = 0; a < 2; ++a)
#pragma unroll
            for (int b = 0; b < 2; ++b)
#pragma unroll
                for (int m = 0; m < 4; ++m)
#pragma unroll
                    for (int n = 0; n < 2; ++n) acc[a][b][m][n] = (f32x4){0.f, 0.f, 0.f, 0.f};
        cur = nxt; cA = nA; cB = nB; ++ui;
    }
    PG8_WAIT_V(0);
    if (wr == 0) PG8_BAR;
    PG8_BAR;
    if constexpr (Epi::AFTER_DRAIN) { E.fused(acc, cur, wr, wc, fr, fq, lds, wid, lane); S.done(cur); }
    PG8_STAMP();
    if (STAMP && wid == 0) { stamps[lane] = lane < nts ? (((unsigned long long)(unsigned)ts_hi << 32) | (unsigned)ts_lo) : 0ull;
        if (lane == 62) stamps[62] = rt_entry; if (lane == 63) stamps[63] = (unsigned long long)wall_clock64(); }
#undef PG8_STAMP
#undef PG8_SA
#undef PG8_SB
#undef PG8_STAGE
#undef PG8_LDA
#undef PG8_LDB
#undef PG8_MMA
#undef PG8_WAIT_V
#undef PG8_WAIT_L
#undef PG8_BAR
#undef PG8_SCHED
}
}
using pf4 = pg8::f32x4;

struct EpiMain {
  static constexpr bool PERM = false, AFTER_DRAIN = false;
  const Params& p;
  DI void operator()(const pf4 (&acc)[2][2][4][2], const pg8::Unit& u, int wr, int wc, int fr, int fq) const {
    const int pn = u.pn;
    const int rbase = u.pm * 256 + wr * 64 + fr;
    if (pn < 3) {
      const bool isq = pn < 2, isv = (pn == 2) && (wc >= 2);
      const float* gp = isq ? p.qg : p.kg;
      const int d0 = 16 * (fq >> 1) + 4 * (fq & 1), d1 = 32 + 8 * fq;
      float4 g00 = {1.f, 1.f, 1.f, 1.f}, g01 = g00, g10 = g00, g11 = g00;
      if (!isv) { g00 = *(const float4*)(gp + d0); g01 = *(const float4*)(gp + d0 + 8); g10 = *(const float4*)(gp + d1); g11 = *(const float4*)(gp + d1 + 4); }
      _Pragma("unroll") for (int ai = 0; ai < 2; ++ai) {
        if (u.pm * 256 + 128 * ai >= MTOT) continue;
        _Pragma("unroll") for (int m = 0; m < 4; ++m) {
          const int row = rbase + 128 * ai + 16 * m;
          pf4 a00 = acc[ai][0][m][0], a01 = acc[ai][0][m][1], a10 = acc[ai][1][m][0], a11 = acc[ai][1][m][1];
          if (!isv) {
            float ss = 0.f;
            _Pragma("unroll") for (int j = 0; j < 4; ++j) ss += a00[j] * a00[j] + a01[j] * a01[j] + a10[j] * a10[j] + a11[j] * a11[j];
            ss += __shfl_xor(ss, 16); ss += __shfl_xor(ss, 32);
            const float sc = rsqrtf(ss * (1.f / 64.f) + EPS);
            a00[0] *= sc * g00.x; a00[1] *= sc * g00.y; a00[2] *= sc * g00.z; a00[3] *= sc * g00.w;
            a01[0] *= sc * g01.x; a01[1] *= sc * g01.y; a01[2] *= sc * g01.z; a01[3] *= sc * g01.w;
            a10[0] *= sc * g10.x; a10[1] *= sc * g10.y; a10[2] *= sc * g10.z; a10[3] *= sc * g10.w;
            a11[0] *= sc * g11.x; a11[1] *= sc * g11.y; a11[2] *= sc * g11.z; a11[3] *= sc * g11.w;
            if (fq < 2) {
              const float pos = (float)(row < SEQ ? row : SEQ);
              const float invlo[4] = {1.0f, 0.19392274f, 0.03760603f, 0.0072926646f};
              const float invhi[4] = {0.0014142136f, 0.0002742482f, 5.3182957e-05f, 1.0313385e-05f};
              _Pragma("unroll") for (int j = 0; j < 4; ++j) {
                const float inv = (fq & 1) ? invhi[j] : invlo[j];
                float s_, c_; sincos_red(pos * inv, s_, c_);
                const float x1 = a00[j], x2 = a01[j];
                a00[j] = x1 * c_ - x2 * s_; a01[j] = x2 * c_ + x1 * s_;
              }
            }
          }
          if (isq) {
            bfr* qp = p.Q + (size_t)row * 512 + (4 * pn + wc) * 64;
            *(u32x2*)(qp + d0) = pack4(a00[0] * 0.125f, a00[1] * 0.125f, a00[2] * 0.125f, a00[3] * 0.125f);
            *(u32x2*)(qp + d0 + 8) = pack4(a01[0] * 0.125f, a01[1] * 0.125f, a01[2] * 0.125f, a01[3] * 0.125f);
            u32x4 o; o[0] = pk2(a10[0] * 0.125f, a10[1] * 0.125f); o[1] = pk2(a10[2] * 0.125f, a10[3] * 0.125f);
            o[2] = pk2(a11[0] * 0.125f, a11[1] * 0.125f); o[3] = pk2(a11[2] * 0.125f, a11[3] * 0.125f);
            *(u32x4*)(qp + d1) = o;
          } else {
            const int jh = wc & 1;
            bfr* kp = (isv ? p.Vb : p.Kb) + (size_t)row * 128 + jh * 64;
            *(u32x2*)(kp + d0) = pack4(a00[0], a00[1], a00[2], a00[3]);
            *(u32x2*)(kp + d0 + 8) = pack4(a01[0], a01[1], a01[2], a01[3]);
            u32x4 o; o[0] = pk2(a10[0], a10[1]); o[1] = pk2(a10[2], a10[3]); o[2] = pk2(a11[0], a11[1]); o[3] = pk2(a11[2], a11[3]);
            *(u32x4*)(kp + d1) = o;
            float* op = nullptr;
            if (row >= SEQ) op = (isv ? p.out_vs : p.out_ks) + ((size_t)((row - SEQ) * 128 + 127) * 2 + jh) * 64;
            else if (row >= SEQ - 128) op = (isv ? p.out_vp : p.out_kp) + ((size_t)(row - (SEQ - 128)) * 2 + jh) * 64;
            if (op) {
              *(pf4*)(op + d0) = a00; *(pf4*)(op + d0 + 8) = a01; *(pf4*)(op + d1) = a10; *(pf4*)(op + d1 + 4) = a11;
            }
          }
        }
      }
      return;
    }
    const int cw = 32 * wc + 8 * fq;
    if (pn == 7 || pn == 8) {
      _Pragma("unroll") for (int ai = 0; ai < 2; ++ai) {
        if (u.pm * 256 + 128 * ai >= MTOT) continue;
        _Pragma("unroll") for (int m = 0; m < 4; ++m) {
          const int row = rbase + 128 * ai + 16 * m;
          _Pragma("unroll") for (int bj = 0; bj < 2; ++bj) {
            float* zp = p.ZF + (size_t)row * 512 + (pn - 7) * 256 + 128 * bj + cw;
            *(pf4*)zp = acc[ai][bj][m][0]; *(pf4*)(zp + 4) = acc[ai][bj][m][1];
          }
        }
      }
      return;
    }
    bfr* dst; int ld, col, op;
    if (pn < 5) { dst = p.ZA; ld = 512; col = (pn - 3) * 256; op = 1; }
    else if (pn < 7) { dst = p.QB; ld = 512; col = (pn - 5) * 256; op = 0; }
    else if (pn < 11) { dst = p.IB; ld = 512; col = (pn - 9) * 256; op = 0; }
    else if (pn < 13) { dst = p.ZB; ld = 512; col = (pn - 11) * 256; op = 1; }
    else if (pn < 17) { dst = p.GA; ld = 1024; col = (pn - 13) * 256; op = 2; }
    else { dst = p.GB; ld = 1024; col = (pn - 17) * 256; op = 2; }
    _Pragma("unroll") for (int bj = 0; bj < 2; ++bj) {
      float4 b0 = {0.f, 0.f, 0.f, 0.f}, b1 = b0;
      if (op == 2) { const float* bp = p.b_merge + (pn - 13) * 256 + 128 * bj + cw; b0 = *(const float4*)bp; b1 = *(const float4*)(bp + 4); }
      _Pragma("unroll") for (int ai = 0; ai < 2; ++ai) {
        if (u.pm * 256 + 128 * ai >= MTOT) continue;
        _Pragma("unroll") for (int m = 0; m < 4; ++m) {
          const int row = rbase + 128 * ai + 16 * m;
          pf4 x = acc[ai][bj][m][0], y = acc[ai][bj][m][1];
          if (op == 1) { _Pragma("unroll") for (int j = 0; j < 4; ++j) { x[j] = siluf_(x[j]); y[j] = siluf_(y[j]); } }
          else if (op == 2) {
            x[0] = sigmoidf_(x[0] + b0.x); x[1] = sigmoidf_(x[1] + b0.y); x[2] = sigmoidf_(x[2] + b0.z); x[3] = sigmoidf_(x[3] + b0.w);
            y[0] = sigmoidf_(y[0] + b1.x); y[1] = sigmoidf_(y[1] + b1.y); y[2] = sigmoidf_(y[2] + b1.z); y[3] = sigmoidf_(y[3] + b1.w);
          }
          u32x4 o; o[0] = pk2(x[0], x[1]); o[1] = pk2(x[2], x[3]); o[2] = pk2(y[0], y[1]); o[3] = pk2(y[2], y[3]);
          *(u32x4*)(dst + (size_t)row * ld + col + 128 * bj + cw) = o;
        }
      }
    }
  }
};

template <int PASS> struct EpiMerge {
  static constexpr bool PERM = true, AFTER_DRAIN = false;
  const Params& p;
  DI void operator()(const pf4 (&acc)[2][2][4][2], const pg8::Unit& u, int wr, int wc, int fr, int fq) const {
    const int rbase = u.pm * 256 + wr * 64 + fr, cbase = u.pn * 256 + 32 * wc + 8 * fq;
    const bfr* G = PASS == 0 ? p.GA : p.GB;
    _Pragma("unroll") for (int ai = 0; ai < 2; ++ai) _Pragma("unroll") for (int m = 0; m < 4; ++m) _Pragma("unroll") for (int bj = 0; bj < 2; ++bj) {
      const size_t off = (size_t)(rbase + 128 * ai + 16 * m) * 1024 + cbase + 128 * bj;
      const u32x4 g = *(const u32x4*)(G + off);
      const pf4 x = acc[ai][bj][m][0], y = acc[ai][bj][m][1];
      float r[8] = {bflo(g[0]) * x[0], bfhi(g[0]) * x[1], bflo(g[1]) * x[2], bfhi(g[1]) * x[3], bflo(g[2]) * y[0], bfhi(g[2]) * y[1], bflo(g[3]) * y[2], bfhi(g[3]) * y[3]};
      if (PASS == 1) {
        const u32x4 t = *(const u32x4*)(p.Y + off);
        r[0] += bflo(t[0]); r[1] += bfhi(t[0]); r[2] += bflo(t[1]); r[3] += bfhi(t[1]); r[4] += bflo(t[2]); r[5] += bfhi(t[2]); r[6] += bflo(t[3]); r[7] += bfhi(t[3]);
      }
      u32x4 o; o[0] = pk2(r[0], r[1]); o[1] = pk2(r[2], r[3]); o[2] = pk2(r[4], r[5]); o[3] = pk2(r[6], r[7]);
      *(u32x4*)(p.Y + off) = o;
    }
  }
};

struct EpiOut {
  static constexpr bool PERM = false, AFTER_DRAIN = false;
  const Params& p;
  DI void operator()(const pf4 (&acc)[2][2][4][2], const pg8::Unit& u, int wr, int wc, int fr, int fq) const {
    const int rbase = u.pm * 256 + wr * 64 + fr, cbase = u.pn * 256 + 32 * wc + 4 * fq;
    const float* gr = p.mod + (size_t)128 * 3072 + 2048;
    _Pragma("unroll") for (int bj = 0; bj < 2; ++bj) _Pragma("unroll") for (int n = 0; n < 2; ++n) {
      const int c = cbase + 128 * bj + 16 * n;
      const pf4 gt = *(const pf4*)(gr + c);
      _Pragma("unroll") for (int ai = 0; ai < 2; ++ai) _Pragma("unroll") for (int m = 0; m < 4; ++m) {
        const size_t off = (size_t)(rbase + 128 * ai + 16 * m) * DM + c;
        const pf4 xv = *(const pf4*)(p.x_prompt + off);
        *(pf4*)(p.out_yp + off) = xv + gt * acc[ai][bj][m][n];
      }
    }
  }
};

DI void sample_merge_tile(const Params& p, int tile, char* smem) {
  bfr* sA = (bfr*)smem; bfr* sW = sA + 128 * LDT;
  const int t = TID, lane = t & 63, w = t >> 6, wn = w >> 1, wm = w & 1, r = lane & 31, h = lane >> 5;
  const int n0 = tile * 128;
  _Pragma("unroll 1") for (int pass = 0; pass < 2; ++pass) {
    f32x16 acc[2][2];
    _Pragma("unroll") for (int a = 0; a < 2; ++a) _Pragma("unroll") for (int b = 0; b < 2; ++b) acc[a][b] = zero16();
    gemm_mainloop((pass ? p.YB : p.YA) + (size_t)SEQ * 512, 512, 0, pass ? p.Wt_pb : p.Wt_pa, 512, n0, 512, sA, sW, acc);
    const bfr* G = (pass ? p.GB : p.GA) + (size_t)SEQ * 1024;
    _Pragma("unroll") for (int nt = 0; nt < 2; ++nt) _Pragma("unroll") for (int mt = 0; mt < 2; ++mt) {
      const int m = wm * 64 + mt * 32 + r;
      _Pragma("unroll") for (int g = 0; g < 4; ++g) {
        const size_t off = (size_t)m * 1024 + n0 + wn * 64 + nt * 32 + 8 * g + 4 * h;
        const u32x2 gg = *(const u32x2*)(G + off);
        float r0 = bflo(gg[0]) * acc[nt][mt][4 * g], r1 = bfhi(gg[0]) * acc[nt][mt][4 * g + 1], r2 = bflo(gg[1]) * acc[nt][mt][4 * g + 2], r3 = bfhi(gg[1]) * acc[nt][mt][4 * g + 3];
        if (pass) { const u32x2 tt = *(const u32x2*)(p.Ys + off); r0 += bflo(tt[0]); r1 += bfhi(tt[0]); r2 += bflo(tt[1]); r3 += bfhi(tt[1]); }
        *(u32x2*)(p.Ys + off) = pack4(r0, r1, r2, r3);
      }
    }
  }
}

DI void sample_out_tile(const Params& p, int tile, char* smem) {
  bfr* sA = (bfr*)smem; bfr* sW = sA + 128 * LDT;
  const int t = TID, lane = t & 63, w = t >> 6, wn = w >> 1, wm = w & 1, r = lane & 31, h = lane >> 5;
  const int n0 = tile * 128;
  f32x16 acc[2][2];
  _Pragma("unroll") for (int a = 0; a < 2; ++a) _Pragma("unroll") for (int b = 0; b < 2; ++b) acc[a][b] = zero16();
  gemm_mainloop(p.Ys, 1024, 0, p.Wt_out, 1024, n0, 1024, sA, sW, acc);
  _Pragma("unroll") for (int nt = 0; nt < 2; ++nt) _Pragma("unroll") for (int mt = 0; mt < 2; ++mt) {
    const int m = wm * 64 + mt * 32 + r;
    _Pragma("unroll") for (int g = 0; g < 4; ++g) {
      const int n = n0 + wn * 64 + nt * 32 + 8 * g + 4 * h;
      const float4 xv = *(const float4*)(p.x_sample + (size_t)m * DM + n), gt = *(const float4*)(p.mod + (size_t)m * 3072 + 2048 + n);
      float4 o;
      o.x = xv.x + gt.x * acc[nt][mt][4 * g]; o.y = xv.y + gt.y * acc[nt][mt][4 * g + 1];
      o.z = xv.z + gt.z * acc[nt][mt][4 * g + 2]; o.w = xv.w + gt.w * acc[nt][mt][4 * g + 3];
      *(float4*)(p.out_ys + (size_t)m * DM + n) = o;
    }
  }
}

DI void attn_prompt_item(const Params& p, int qb, int hd, bfr* sVt  ) {
  const int t = TID, lane = t & 63, w = t >> 6, r = lane & 31, h = lane >> 5;
  const int j = hd >> 2, kb0 = qb * 128 - 128;
  __syncthreads();
  _Pragma("unroll") for (int it = 0; it < 8; ++it) {
    int kl = it * 32 + (t & 31), dg = t >> 5, kpos = kb0 + kl;
    u32x4 v = {0u, 0u, 0u, 0u};
    if (kpos >= 0) v = *(const u32x4*)(p.Vb + (size_t)kpos * 128 + j * 64 + dg * 8);
    _Pragma("unroll") for (int e = 0; e < 8; ++e) sVt[(dg * 8 + e) * 264 + kl] = (bfr)((v[e >> 1] >> ((e & 1) * 16)) & 0xffffu);
  }
  __syncthreads();
  const int q0 = qb * 128 + 32 * w, q = q0 + r;
  bf16x8 qf[4];
  _Pragma("unroll") for (int s = 0; s < 4; ++s) qf[s] = *(const bf16x8*)(p.Q + (size_t)q * 512 + hd * 64 + 16 * s + 8 * h);
  f32x16 sacc[5];
  _Pragma("unroll") for (int kt = 0; kt < 5; ++kt) {
    sacc[kt] = zero16();
    int kr = q0 - 128 + 32 * kt + r; kr = kr < 0 ? 0 : kr;
    _Pragma("unroll") for (int s = 0; s < 4; ++s) {
      bf16x8 kf = *(const bf16x8*)(p.Kb + (size_t)kr * 128 + j * 64 + 16 * s + 8 * h);
      sacc[kt] = mfma(kf, qf[s], sacc[kt]);
    }
  }
  const float sink = p.sinks[hd];
  float mx = sink;
  _Pragma("unroll") for (int kt = 0; kt < 5; ++kt) _Pragma("unroll") for (int i = 0; i < 16; ++i) {
    int key = q0 - 128 + 32 * kt + crow(i, h), rel = q - key;
    bool valid = (rel >= 0) && (rel < 128) && (key >= 0);
    float sv = valid ? sacc[kt][i] : -INFINITY;
    sacc[kt][i] = sv; mx = fmaxf(mx, sv);
  }
  mx = fmaxf(mx, __shfl_xor(mx, 32));
  float l = 0.f;
  _Pragma("unroll") for (int kt = 0; kt < 5; ++kt) _Pragma("unroll") for (int i = 0; i < 16; ++i) {
    float pv = __expf(sacc[kt][i] - mx); sacc[kt][i] = pv; l += pv;
  }
  l += __shfl_xor(l, 32);
  l += __expf(sink - mx);
  f32x16 oacc[2]; oacc[0] = zero16(); oacc[1] = zero16();
  _Pragma("unroll") for (int kt = 0; kt < 5; ++kt) _Pragma("unroll") for (int s2 = 0; s2 < 2; ++s2) {
    u32x4 pp;
    _Pragma("unroll") for (int e = 0; e < 4; ++e) pp[e] = pk2(sacc[kt][8 * s2 + 2 * e], sacc[kt][8 * s2 + 2 * e + 1]);
    bf16x8 pf = __builtin_bit_cast(bf16x8, pp);
    _Pragma("unroll") for (int dt = 0; dt < 2; ++dt) {
      const bfr* vp = sVt + (dt * 32 + r) * 264 + 32 * w + 32 * kt + 16 * s2 + 4 * h;
      u32x2 lo = *(const u32x2*)vp, hi = *(const u32x2*)(vp + 8);
      u32x4 vv; vv[0] = lo[0]; vv[1] = lo[1]; vv[2] = hi[0]; vv[3] = hi[1];
      oacc[dt] = mfma(__builtin_bit_cast(bf16x8, vv), pf, oacc[dt]);
    }
  }
  const float il = 1.f / l;
  _Pragma("unroll") for (int dt = 0; dt < 2; ++dt) _Pragma("unroll") for (int g = 0; g < 4; ++g) {
    int d = dt * 32 + 8 * g + 4 * h;
    size_t off = (size_t)q * 512 + hd * 64 + d;
    u32x2 za = *(const u32x2*)(p.ZA + off);
    *(u32x2*)(p.YA + off) = pack4(oacc[dt][4 * g] * il * bflo(za[0]), oacc[dt][4 * g + 1] * il * bfhi(za[0]),
                                  oacc[dt][4 * g + 2] * il * bflo(za[1]), oacc[dt][4 * g + 3] * il * bfhi(za[1]));
  }
}

DI void attn_sample_wave(const Params& p, int b, int hd) {
  const int lane = TID & 63, j = hd >> 2, m = SEQ + b;
  u32x4 qv[8];
  _Pragma("unroll") for (int i = 0; i < 8; ++i) qv[i] = *(const u32x4*)(p.Q + (size_t)m * 512 + hd * 64 + 8 * i);
  float dn = 0.f;
  _Pragma("unroll") for (int i = 0; i < 8; ++i) {
    u32x4 kv = *(const u32x4*)(p.Kb + (size_t)m * 128 + j * 64 + 8 * i);
    _Pragma("unroll") for (int e = 0; e < 4; ++e) dn += bflo(qv[i][e]) * bflo(kv[e]) + bfhi(qv[i][e]) * bfhi(kv[e]);
  }
  float s[2];
  _Pragma("unroll") for (int u = 0; u < 2; ++u) {
    int idx = lane + 1 + 64 * u;
    int ic = idx < 128 ? idx : 127;
    const float* kp = p.cache_k + ((size_t)(b * 128 + ic) * 2 + j) * 64;
    float d = 0.f;
    _Pragma("unroll") for (int i = 0; i < 8; ++i) {
      float4 k0 = *(const float4*)(kp + 8 * i), k1 = *(const float4*)(kp + 8 * i + 4);
      d += bflo(qv[i][0]) * k0.x + bfhi(qv[i][0]) * k0.y + bflo(qv[i][1]) * k0.z + bfhi(qv[i][1]) * k0.w;
      d += bflo(qv[i][2]) * k1.x + bfhi(qv[i][2]) * k1.y + bflo(qv[i][3]) * k1.z + bfhi(qv[i][3]) * k1.w;
    }
    s[u] = idx < 128 ? d : dn;
  }
  const float sink = p.sinks[hd];
  float mx = fmaxf(fmaxf(s[0], s[1]), sink);
  _Pragma("unroll") for (int o = 32; o >= 1; o >>= 1) mx = fmaxf(mx, __shfl_xor(mx, o));
  float p0 = __expf(s[0] - mx), p1 = __expf(s[1] - mx);
  float l = p0 + p1;
  _Pragma("unroll") for (int o = 32; o >= 1; o >>= 1) l += __shfl_xor(l, o);
  l += __expf(sink - mx);
  float o = 0.f;
  const float* vb = p.cache_v + ((size_t)(b * 128) * 2 + j) * 64 + lane;
  _Pragma("unroll 8") for (int idx = 1; idx < 128; ++idx) {
    float pv = __shfl(idx <= 64 ? p0 : p1, (idx - 1) & 63);
    o += pv * vb[(size_t)idx * 128];
  }
  o += __shfl(p1, 63) * bf2f(p.Vb[(size_t)m * 128 + j * 64 + lane]);
  size_t off = (size_t)m * 512 + hd * 64 + lane;
  p.YA[off] = (bfr)f2bf(o / l * bf2f(p.ZA[off]));
}

DI void hgrn_gates(const Params& p, int row0, int hh, float* sTot, float (&L)[32], float (&kin)[32], float& t0, float& lc) {
  const int t = TID, c = t & 127, half = t >> 7, ch = hh * 128 + c;
  const float lbv = 1.f / (1.f + __expf(p.lb_logits[512 + ch] - p.lb_logits[ch]));
  const float* zp = p.ZF + (size_t)(row0 + half * 32) * 512 + ch;
  float run = 0.f;
  _Pragma("unroll") for (int jj = 0; jj < 32; ++jj) {
    float z = zp[(size_t)jj * 512];
    z = fminf(fmaxf(z, -30.f), 30.f);
    float em = __expf(-z), sg = 1.f / (1.f + em);
    float f = lbv + (1.f - lbv) * sg;
    kin[jj] = (1.f - lbv) * em * sg;
    run += __logf(f);
    L[jj] = run;
  }
  sTot[half * 128 + c] = run;
  __syncthreads();
  t0 = sTot[c]; lc = t0 + sTot[128 + c];
  if (half) { _Pragma("unroll") for (int jj = 0; jj < 32; ++jj) L[jj] += t0; }
}

DI void hgrn_local_item(const Params& p, int n, int hh, char* smem) {
  bfr* sKt = (bfr*)smem; bfr* sVt = sKt + 128 * LDT; float* sTot = (float*)(sVt + 128 * LDT);
  const int t = TID, lane = t & 63, w = t >> 6, r = lane & 31, h = lane >> 5, c = t & 127, half = t >> 7;
  const int row0 = n * 64;
  __syncthreads();
  float L[32], kin[32], t0, lc;
  hgrn_gates(p, row0, hh, sTot, L, kin, t0, lc);
  _Pragma("unroll") for (int q4 = 0; q4 < 4; ++q4) {
    u32x4 o;
    _Pragma("unroll") for (int e = 0; e < 4; ++e) {
      int jj = q4 * 8 + 2 * e;
      o[e] = pk2(kin[jj] * __expf(lc - L[jj]), kin[jj + 1] * __expf(lc - L[jj + 1]));
    }
    *(u32x4*)(sKt + c * LDT + half * 32 + q4 * 8) = o;
  }
  const bfr* ip = p.IB + (size_t)(row0 + half * 32) * 512 + hh * 128 + c;
  _Pragma("unroll") for (int q4 = 0; q4 < 4; ++q4) {
    u32x4 o;
    _Pragma("unroll") for (int e = 0; e < 4; ++e) {
      int jj = q4 * 8 + 2 * e;
      o[e] = (unsigned)ip[(size_t)jj * 512] | ((unsigned)ip[(size_t)(jj + 1) * 512] << 16);
    }
    *(u32x4*)(sVt + c * LDT + half * 32 + q4 * 8) = o;
  }
  if (half == 0) p.dec[(n * 4 + hh) * 128 + c] = __expf(lc);
  __syncthreads();
  const int wv = w >> 1, wk = w & 1;
  f32x16 acc[2][2];
  _Pragma("unroll") for (int a = 0; a < 2; ++a) _Pragma("unroll") for (int b = 0; b < 2; ++b) acc[a][b] = zero16();
  _Pragma("unroll") for (int s = 0; s < 4; ++s) {
    bf16x8 af[2], bf[2];
    _Pragma("unroll") for (int x = 0; x < 2; ++x) {
      af[x] = *(const bf16x8*)(sVt + (wv * 64 + x * 32 + r) * LDT + 16 * s + 8 * h);
      bf[x] = *(const bf16x8*)(sKt + (wk * 64 + x * 32 + r) * LDT + 16 * s + 8 * h);
    }
    _Pragma("unroll") for (int a = 0; a < 2; ++a) _Pragma("unroll") for (int b = 0; b < 2; ++b) acc[a][b] = mfma(af[a], bf[b], acc[a][b]);
  }
  float* up = p.Ust + (size_t)(n * 4 + hh) * 16384;
  _Pragma("unroll") for (int a = 0; a < 2; ++a) _Pragma("unroll") for (int b = 0; b < 2; ++b) _Pragma("unroll") for (int i = 0; i < 16; ++i) {
    int v = wv * 64 + a * 32 + crow(i, h), k = wk * 64 + b * 32 + r;
    up[v * 128 + k] = acc[a][b][i];
  }
}

DI void hgrn_sample_item(const Params& p, int b, int hh, char* smem) {
  float* sf = (float*)smem; float* skin = sf + 128; float* sq = skin + 128; float* sv = sq + 128; float* sred = sv + 128; float* s2 = sred + 8 * 128;
  const int t = TID, m = SEQ + b;
  __syncthreads();
  if (t < 128) {
    int ch = hh * 128 + t;
    float lbv = 1.f / (1.f + __expf(p.lb_logits[512 + ch] - p.lb_logits[ch]));
    float z = p.ZF[(size_t)m * 512 + ch];
    z = fminf(fmaxf(z, -30.f), 30.f);
    float em = __expf(-z), sg = 1.f / (1.f + em);
    sf[t] = lbv + (1.f - lbv) * sg; skin[t] = (1.f - lbv) * em * sg;
    sq[t] = bf2f(p.QB[(size_t)m * 512 + ch]); sv[t] = bf2f(p.IB[(size_t)m * 512 + ch]);
  }
  __syncthreads();
  const int v4 = (t & 31) * 4, kg = t >> 5;
  float4 vv = *(const float4*)(sv + v4);
  float4 o = {0.f, 0.f, 0.f, 0.f};
  const size_t sb = (size_t)(b * 4 + hh) * 16384;
  _Pragma("unroll 8") for (int kk = 0; kk < 16; ++kk) {
    int k = kg * 16 + kk;
    float4 S = *(const float4*)(p.state + sb + k * 128 + v4);
    float f = sf[k], ki = skin[k], qq = sq[k];
    float4 Sn; Sn.x = f * S.x + ki * vv.x; Sn.y = f * S.y + ki * vv.y; Sn.z = f * S.z + ki * vv.z; Sn.w = f * S.w + ki * vv.w;
    *(float4*)(p.out_ss + sb + k * 128 + v4) = Sn;
    o.x += qq * Sn.x; o.y += qq * Sn.y; o.z += qq * Sn.z; o.w += qq * Sn.w;
  }
  *(float4*)(sred + kg * 128 + v4) = o;
  __syncthreads();
  float ov = 0.f;
  if (t < 128) {
    _Pragma("unroll") for (int g = 0; g < 8; ++g) ov += sred[g * 128 + t];
    float ss = ov * ov;
    _Pragma("unroll") for (int of = 32; of >= 1; of >>= 1) ss += __shfl_xor(ss, of);
    if ((t & 63) == 0) s2[t >> 6] = ss;
  }
  __syncthreads();
  if (t < 128) {
    float sc = rsqrtf((s2[0] + s2[1]) * (1.f / 128.f) + EPS);
    size_t off = (size_t)m * 512 + hh * 128 + t;
    p.YB[off] = (bfr)f2bf(ov * sc * p.og[t] * bf2f(p.ZB[off]));
  }
}

DI void phase_mix(const Params& p, char* smem) {
  for (int it = VBID; it < 1024; it += VGRID) attn_prompt_item(p, it >> 3, it & 7, (bfr*)smem);
  for (int it = VBID; it < 1024; it += VGRID) hgrn_local_item(p, it >> 2, it & 3, smem);
  for (int it = VBID; it < 512; it += VGRID) hgrn_sample_item(p, it >> 2, it & 3, smem);
  for (int it = VBID * 4 + (TID >> 6); it < 1024; it += VGRID * 4) attn_sample_wave(p, it >> 3, it & 7);
  for (int idx = VBID * 256 + TID; idx < 128 * 4064; idx += VGRID * 256) {
    int b = idx / 4064, i4 = idx - b * 4064;
    size_t so = (size_t)b * 16384 + 128 + i4 * 4, dof = (size_t)b * 16384 + i4 * 4;
    *(float4*)(p.out_ks + dof) = *(const float4*)(p.cache_k + so);
    *(float4*)(p.out_vs + dof) = *(const float4*)(p.cache_v + so);
  }
}

DI void phase_scan(const Params& p) {
  const int e = VBID * 256 + TID;
  if (e < 65536) {
  const int hh = e >> 14, k = e & 127, v = (e >> 7) & 127;
  float S = 0.f;
  for (int n0 = 0; n0 < NCH; n0 += 32) {
    float u[32], d[32];
    _Pragma("unroll") for (int i = 0; i < 32; ++i) {
      u[i] = p.Ust[(size_t)(n0 + i) * 65536 + e];
      d[i] = p.dec[((n0 + i) * 4 + hh) * 128 + k];
    }
    _Pragma("unroll") for (int i = 0; i < 32; ++i) {
      p.Ust[(size_t)(n0 + i) * 65536 + e] = S;
      S = d[i] * S + u[i];
    }
  }
  p.out_sp[(hh * 128 + k) * 128 + v] = S;
  }
}

DI void hgrn_out_item(const Params& p, int n, int hh, char* smem) {
  bfr* sQh = (bfr*)smem;
  bfr* sKh = sQh + 64 * 136;
  bfr* sVt = sKh + 64 * 136;
  bfr* sAm = sVt + 128 * LDT;
  float* sTot = (float*)(sAm + 64 * LDT);
  float* sEm = sTot + 256;
  float* sRed = sEm + 128;
  const int t = TID, lane = t & 63, w = t >> 6, r = lane & 31, h = lane >> 5, c = t & 127, half = t >> 7;
  const int row0 = n * 64;
  __syncthreads();
  {
    float L[32], kin[32], t0, lc;
    hgrn_gates(p, row0, hh, sTot, L, kin, t0, lc);
    const bfr* qp = p.QB + (size_t)(row0 + half * 32) * 512 + hh * 128 + c;
    _Pragma("unroll") for (int jj = 0; jj < 32; ++jj) {
      float dl = L[jj] - t0;
      float eq = __expf(fminf(dl, 80.f)), ek = __expf(fminf(-dl, 80.f));
      float qv = bf2f(qp[(size_t)jj * 512]);
      sQh[(half * 32 + jj) * 136 + c] = (bfr)f2bf(qv * eq);
      sKh[(half * 32 + jj) * 136 + c] = (bfr)f2bf(kin[jj] * ek);
    }
    if (half == 0) sEm[c] = __expf(t0);
  }
  const bfr* ip = p.IB + (size_t)(row0 + half * 32) * 512 + hh * 128 + c;
  _Pragma("unroll") for (int q4 = 0; q4 < 4; ++q4) {
    u32x4 o;
    _Pragma("unroll") for (int e = 0; e < 4; ++e) {
      int jj = q4 * 8 + 2 * e;
      o[e] = (unsigned)ip[(size_t)jj * 512] | ((unsigned)ip[(size_t)(jj + 1) * 512] << 16);
    }
    *(u32x4*)(sVt + c * LDT + half * 32 + q4 * 8) = o;
  }
  __syncthreads();
  {
    const int jt = w >> 1, it = w & 1;
    f32x16 a = zero16();
    if (jt <= it) {
      _Pragma("unroll") for (int s = 0; s < 8; ++s) {
        bf16x8 kf = *(const bf16x8*)(sKh + (jt * 32 + r) * 136 + 16 * s + 8 * h);
        bf16x8 qf = *(const bf16x8*)(sQh + (it * 32 + r) * 136 + 16 * s + 8 * h);
        a = mfma(kf, qf, a);
      }
    }
    const int i = it * 32 + r;
    _Pragma("unroll") for (int g = 0; g < 4; ++g) {
      int j0 = jt * 32 + 8 * g + 4 * h;
      float x0 = (j0 <= i) ? a[4 * g] : 0.f, x1 = (j0 + 1 <= i) ? a[4 * g + 1] : 0.f;
      float x2 = (j0 + 2 <= i) ? a[4 * g + 2] : 0.f, x3 = (j0 + 3 <= i) ? a[4 * g + 3] : 0.f;
      *(u32x2*)(sAm + i * LDT + j0) = pack4(x0, x1, x2, x3);
    }
  }
  __syncthreads();
  f32x16 oacc[2]; oacc[0] = zero16(); oacc[1] = zero16();
  {
    const float* sp = p.Ust + (size_t)(n * 4 + hh) * 16384 + (size_t)(32 * w + r) * 128;
    _Pragma("unroll") for (int s = 0; s < 8; ++s) {
      float4 a0 = *(const float4*)(sp + 16 * s + 8 * h), a1 = *(const float4*)(sp + 16 * s + 8 * h + 4);
      float4 e0 = *(const float4*)(sEm + 16 * s + 8 * h), e1 = *(const float4*)(sEm + 16 * s + 8 * h + 4);
      u32x4 pa; pa[0] = pk2(a0.x * e0.x, a0.y * e0.y); pa[1] = pk2(a0.z * e0.z, a0.w * e0.w);
      pa[2] = pk2(a1.x * e1.x, a1.y * e1.y); pa[3] = pk2(a1.z * e1.z, a1.w * e1.w);
      bf16x8 af = __builtin_bit_cast(bf16x8, pa);
      _Pragma("unroll") for (int it = 0; it < 2; ++it) {
        bf16x8 qf = *(const bf16x8*)(sQh + (it * 32 + r) * 136 + 16 * s + 8 * h);
        oacc[it] = mfma(af, qf, oacc[it]);
      }
    }
    _Pragma("unroll") for (int s = 0; s < 4; ++s) {
      bf16x8 vf = *(const bf16x8*)(sVt + (32 * w + r) * LDT + 16 * s + 8 * h);
      _Pragma("unroll") for (int it = 0; it < 2; ++it) {
        bf16x8 af2 = *(const bf16x8*)(sAm + (it * 32 + r) * LDT + 16 * s + 8 * h);
        oacc[it] = mfma(vf, af2, oacc[it]);
      }
    }
  }
  _Pragma("unroll") for (int it = 0; it < 2; ++it) {
    float ss = 0.f;
    _Pragma("unroll") for (int i = 0; i < 16; ++i) ss += oacc[it][i] * oacc[it][i];
    ss += __shfl_xor(ss, 32);
    if (h == 0) sRed[w * 64 + it * 32 + r] = ss;
  }
  __syncthreads();
  _Pragma("unroll") for (int it = 0; it < 2; ++it) {
    const int i = it * 32 + r;
    float tot = sRed[i] + sRed[64 + i] + sRed[128 + i] + sRed[192 + i];
    float sc = rsqrtf(tot * (1.f / 128.f) + EPS);
    _Pragma("unroll") for (int g = 0; g < 4; ++g) {
      int v = 32 * w + 8 * g + 4 * h;
      size_t off = (size_t)(row0 + i) * 512 + hh * 128 + v;
      float4 og = *(const float4*)(p.og + v);
      u32x2 zb = *(const u32x2*)(p.ZB + off);
      *(u32x2*)(p.YB + off) = pack4(oacc[it][4 * g] * sc * og.x * bflo(zb[0]), oacc[it][4 * g + 1] * sc * og.y * bfhi(zb[0]),
                                    oacc[it][4 * g + 2] * sc * og.z * bflo(zb[1]), oacc[it][4 * g + 3] * sc * og.w * bfhi(zb[1]));
    }
  }
}

__global__ void __launch_bounds__(512, 2) hybrid_megakernel(Params p) {
  extern __shared__ __attribute__((aligned(16))) char smem_all[];
  cg::grid_group grid = cg::this_grid();
  char* smem = smem_all + (threadIdx.x >> 8) * 65536;
#define RUN_PHASE(n, ...) if (p.phase_lo <= n && n <= p.phase_hi) { if (n != p.phase_lo) grid.sync(); __VA_ARGS__; }
  RUN_PHASE(0, phase_prep(p, smem))
  RUN_PHASE(1, phase_mod(p, smem))
  RUN_PHASE(2, phase_h(p))
  RUN_PHASE(3, {
    pg8::Gemm g{p.H, p.Wt_all, MPAD, NALL, 1024};
    pg8::StaticOrder S; S.init(MPAD, NALL, (int)gridDim.x, (int)blockIdx.x);
    EpiMain E{p};
    pg8::gemm_phase<EpiMain, pg8::StaticOrder, false>((PG8_LAS unsigned char*)smem_all, g, S, E, nullptr);
  })
  RUN_PHASE(4, phase_mix(p, smem))
  RUN_PHASE(5, {
    phase_scan(p);
    if (VBID >= 256 && VBID < 264) sample_merge_tile(p, VBID - 256, smem);
  })
  RUN_PHASE(6, {
    if (VBID >= VGRID - 8) sample_out_tile(p, VBID - (VGRID - 8), smem);
    for (int it = VBID; it < 1024; it += VGRID) hgrn_out_item(p, it >> 2, it & 3, smem);
  })
  RUN_PHASE(7, {
    pg8::StaticOrder S; S.init(SEQ, 1024, (int)gridDim.x, (int)blockIdx.x);
    { pg8::Gemm g{p.YA, p.Wt_pa, SEQ, 1024, 512}; EpiMerge<0> E{p};
      pg8::gemm_phase<EpiMerge<0>, pg8::StaticOrder, false>((PG8_LAS unsigned char*)smem_all, g, S, E, nullptr); }
    { pg8::Gemm g{p.YB, p.Wt_pb, SEQ, 1024, 512}; EpiMerge<1> E{p};
      pg8::gemm_phase<EpiMerge<1>, pg8::StaticOrder, false>((PG8_LAS unsigned char*)smem_all, g, S, E, nullptr); }
  })
  RUN_PHASE(8, {
    pg8::Gemm g{p.Y, p.Wt_out, SEQ, 1024, 1024};
    pg8::StaticOrder S; S.init(SEQ, 1024, (int)gridDim.x, (int)blockIdx.x);
    EpiOut E{p};
    pg8::gemm_phase<EpiOut, pg8::StaticOrder, false>((PG8_LAS unsigned char*)smem_all, g, S, E, nullptr);
  })
}

#ifndef ONE_LAUNCH
#define ONE_LAUNCH 1
#endif
constexpr size_t kDynLds = 131072;

extern "C" void kernel_launch(void* const* d_in, const int* in_sizes, int n_in, void* d_out, int out_size, void* d_ws, size_t ws_size,
                              hipStream_t stream) {
  static int grid_blocks = 0;
  if (!grid_blocks) {
    int dev = 0, cus = 0, per_cu = 0;
    (void)hipGetDevice(&dev);
    (void)hipDeviceGetAttribute(&cus, hipDeviceAttributeMultiprocessorCount, dev);
    (void)hipFuncSetAttribute((const void*)hybrid_megakernel, hipFuncAttributeMaxDynamicSharedMemorySize, (int)kDynLds);
    (void)hipOccupancyMaxActiveBlocksPerMultiprocessor(&per_cu, hybrid_megakernel, 512, kDynLds);
    if (per_cu > 1) per_cu = 1;
    if (per_cu < 1) per_cu = 1;
    grid_blocks = cus * per_cu;
  }
  Params p{};
  const float* const* in = (const float* const*)d_in;
  p.x_prompt = in[0]; p.x_sample = in[1]; p.cache_k = in[2]; p.cache_v = in[3]; p.state = in[4]; p.c_prompt = in[5]; p.c_sample = in[6];
  p.w_ada = in[7]; p.b_ada = in[8]; p.norm_g = in[9]; p.w_in = in[10]; p.qg = in[11]; p.kg = in[12]; p.sinks = in[13]; p.lb_logits = in[14];
  p.og = in[15]; p.w_merge = in[16]; p.b_merge = in[17]; p.w_pa = in[18]; p.w_pb = in[19]; p.w_out = in[20];
  float* o = (float*)d_out;
  p.out_yp = o; o += (size_t)SEQ * DM;
  p.out_ys = o; o += (size_t)NBT * DM;
  p.out_kp = o; o += 128 * 128;
  p.out_vp = o; o += 128 * 128;
  p.out_sp = o; o += 4 * 128 * 128;
  p.out_ks = o; o += (size_t)NBT * 128 * 128;
  p.out_vs = o; o += (size_t)NBT * 128 * 128;
  p.out_ss = o;
  char* wsp = (char*)d_ws;
  auto take = [&](size_t bytes) { char* r = wsp; wsp += (bytes + 255) & ~(size_t)255; return r; };
  p.Wt_all = (bfr*)take((size_t)NALL * 1024 * 2);
  p.Wt_pa = (bfr*)take((size_t)1024 * 512 * 2);
  p.Wt_pb = (bfr*)take((size_t)1024 * 512 * 2);
  p.Wt_out = (bfr*)take((size_t)1024 * 1024 * 2);
  p.Wt_ada = (bfr*)take((size_t)3072 * 1024 * 2);
  p.Cb = (bfr*)take((size_t)256 * 1024 * 2);
  p.mod = (float*)take((size_t)256 * 3072 * 4);
  p.Ys = (bfr*)take((size_t)128 * 1024 * 2);
  p.H = (bfr*)take((size_t)MPAD * 1024 * 2);
  p.YA = p.H; p.YB = p.H + (size_t)MTOT * 512;
  p.Q = (bfr*)take((size_t)MTOT * 512 * 2);
  p.QB = (bfr*)take((size_t)MTOT * 512 * 2);
  p.Y = p.Q;
  p.Kb = (bfr*)take((size_t)MTOT * 128 * 2);
  p.Vb = (bfr*)take((size_t)MTOT * 128 * 2);
  p.ZA = (bfr*)take((size_t)MTOT * 512 * 2);
  p.IB = (bfr*)take((size_t)MTOT * 512 * 2);
  p.ZB = (bfr*)take((size_t)MTOT * 512 * 2);
  p.ZF = (float*)take((size_t)MTOT * 512 * 4);
  p.GA = (bfr*)take((size_t)MTOT * 1024 * 2);
  p.GB = (bfr*)take((size_t)MTOT * 1024 * 2);
  p.dec = (float*)take((size_t)NCH * 4 * 128 * 4);
  p.Ust = p.out_yp;
  if ((size_t)(wsp - (char*)d_ws) > ws_size) { fprintf(stderr, "workspace too small\n"); return; }
#if ONE_LAUNCH
  p.phase_lo = 0; p.phase_hi = 8;
  void* args[] = {&p};
  hipError_t e = hipLaunchCooperativeKernel((void*)hybrid_megakernel, dim3(grid_blocks), dim3(512), args, kDynLds, stream);
  if (e != hipSuccess) fprintf(stderr, "cooperative launch failed: %s (grid %d)\n", hipGetErrorString(e), grid_blocks);
#else
  for (int ph = 0; ph <= 8; ++ph) {
    p.phase_lo = ph; p.phase_hi = ph;
    hipLaunchKernelGGL(hybrid_megakernel, dim3(grid_blocks), dim3(512), kDynLds, stream, p);
  }
#endif
}
```

```cpp
#include <hip/hip_runtime.h>
#include <cstdio>

#define DI __device__ __forceinline__
typedef unsigned short bfr;
using bf16x8 = __attribute__((ext_vector_type(8))) short;
using f32x16 = __attribute__((ext_vector_type(16))) float;
using u32x4 = __attribute__((ext_vector_type(4))) unsigned;
using u32x2 = __attribute__((ext_vector_type(2))) unsigned;

constexpr int DM = 1024, SEQ = 16384, NBT = 128, MTOT = SEQ + NBT;
constexpr int NALL = 5376;
constexpr int NCH = 256;
constexpr float EPS = 1e-6f;
constexpr int LDT = 72;
constexpr int MPAD = 16640;
#define TID ((int)(threadIdx.x & 255))
#define VBID ((int)(blockIdx.x * 2 + (threadIdx.x >> 8)))
#define VGRID ((int)(gridDim.x * 2))

struct Params {
  const float *x_prompt, *x_sample, *cache_k, *cache_v, *state, *c_prompt, *c_sample;
  const float *w_ada, *b_ada, *norm_g, *w_in, *qg, *kg, *sinks, *lb_logits, *og, *w_merge, *b_merge, *w_pa, *w_pb, *w_out;
  float *out_yp, *out_ys, *out_kp, *out_vp, *out_sp, *out_ks, *out_vs, *out_ss;
  bfr *Wt_all, *Wt_pa, *Wt_pb, *Wt_out, *Wt_ada, *Cb, *H, *Q, *QB, *Kb, *Vb, *ZA, *IB, *ZB, *GA, *GB, *YA, *YB, *Y;
  float *mod, *ZF, *dec, *Ust;
  bfr* Ys;
  unsigned* bar;
  int phase_lo, phase_hi;
};

DI unsigned f2bf(float x) { unsigned u = __float_as_uint(x); u += 0x7fffu + ((u >> 16) & 1u); return u >> 16; }
DI unsigned pk2(float a, float b) { return f2bf(a) | (f2bf(b) << 16); }
DI float bf2f(unsigned b) { return __uint_as_float(b << 16); }
DI float bflo(unsigned u) { return __uint_as_float(u << 16); }
DI float bfhi(unsigned u) { return __uint_as_float(u & 0xffff0000u); }
DI int crow(int i, int h) { return (i & 3) + 8 * (i >> 2) + 4 * h; }
DI f32x16 mfma(bf16x8 a, bf16x8 b, f32x16 c) { return __builtin_amdgcn_mfma_f32_32x32x16_bf16(a, b, c, 0, 0, 0); }
DI f32x16 zero16() { f32x16 z; _Pragma("unroll") for (int i = 0; i < 16; ++i) z[i] = 0.f; return z; }
DI float sigmoidf_(float x) { return 1.f / (1.f + __expf(-x)); }
DI float siluf_(float x) { return x / (1.f + __expf(-x)); }
DI u32x2 pack4(float a, float b, float c, float d) { u32x2 r; r[0] = pk2(a, b); r[1] = pk2(c, d); return r; }

DI int wt_row_of_col(int c) {
  const int pn = c >> 8, cl = c & 255;
  int slot;
  if (pn < 3) {
    const int g = cl >> 6, d = cl & 63;
    if (d >= 32) { const int x = d - 32; slot = 128 + 32 * g + 16 * ((x >> 2) & 1) + 4 * (x >> 3) + (x & 3); }
    else { const int fq = 2 * (d >> 4) + ((d >> 2) & 1), n = (d >> 3) & 1, j = d & 3; slot = 32 * g + 16 * n + 4 * fq + j; }
  } else {
    const int bj = cl >> 7, g = (cl >> 5) & 3, x = cl & 31;
    slot = 128 * bj + 32 * g + 16 * ((x >> 2) & 1) + 4 * (x >> 3) + (x & 3);
  }
  return (pn << 8) + slot;
}

DI void gemm_mainloop(const bfr* __restrict__ A, int lda, int m0, const bfr* __restrict__ W, int ldw, int n0, int K,
                      bfr* sA, bfr* sW, f32x16 (&acc)[2][2]) {
  const int t = TID, lane = t & 63, w = t >> 6, wn = w >> 1, wm = w & 1, r = lane & 31, h = lane >> 5;
  const int lrow = t >> 3, lk = (t & 7) * 8;
  const bfr* ap = A + (size_t)(m0 + lrow) * lda + lk;
  const bfr* wp = W + (size_t)(n0 + lrow) * ldw + lk;
  u32x4 ra[4], rw[4];
  _Pragma("unroll") for (int i = 0; i < 4; ++i) {
    ra[i] = *(const u32x4*)(ap + (size_t)(32 * i) * lda);
    rw[i] = *(const u32x4*)(wp + (size_t)(32 * i) * ldw);
  }
  const int nk = K >> 6;
  for (int kt = 0; kt < nk; ++kt) {
    __syncthreads();
    _Pragma("unroll") for (int i = 0; i < 4; ++i) {
      *(u32x4*)(sA + (lrow + 32 * i) * LDT + lk) = ra[i];
      *(u32x4*)(sW + (lrow + 32 * i) * LDT + lk) = rw[i];
    }
    __syncthreads();
    if (kt + 1 < nk) {
      ap += 64; wp += 64;
      _Pragma("unroll") for (int i = 0; i < 4; ++i) {
        ra[i] = *(const u32x4*)(ap + (size_t)(32 * i) * lda);
        rw[i] = *(const u32x4*)(wp + (size_t)(32 * i) * ldw);
      }
    }
    _Pragma("unroll") for (int kk = 0; kk < 4; ++kk) {
      bf16x8 af[2], bf[2];
      _Pragma("unroll") for (int x = 0; x < 2; ++x) {
        af[x] = *(const bf16x8*)(sW + (wn * 64 + x * 32 + r) * LDT + kk * 16 + 8 * h);
        bf[x] = *(const bf16x8*)(sA + (wm * 64 + x * 32 + r) * LDT + kk * 16 + 8 * h);
      }
      _Pragma("unroll") for (int nt = 0; nt < 2; ++nt)
        _Pragma("unroll") for (int mt = 0; mt < 2; ++mt) acc[nt][mt] = mfma(af[nt], bf[mt], acc[nt][mt]);
    }
  }
}

template <int PERMBASE> DI void transpose_tile(const float* __restrict__ src, int N, bfr* __restrict__ dst, int K, int kt, int nt, float* sm) {
  const int t = TID, k0 = kt * 64, n0 = nt * 64;
  __syncthreads();
  _Pragma("unroll") for (int i = 0; i < 16; ++i) {
    int idx = i * 256 + t, kk = idx >> 6, nn = idx & 63;
    sm[kk * 65 + nn] = src[(size_t)(k0 + kk) * N + n0 + nn];
  }
  __syncthreads();
  _Pragma("unroll") for (int i = 0; i < 8; ++i) {
    int idx = i * 256 + t, nn = idx >> 5, kk = (idx & 31) * 2;
    const int drow = PERMBASE >= 0 ? wt_row_of_col(PERMBASE + n0 + nn) : n0 + nn;
    *(unsigned*)(dst + (size_t)drow * K + k0 + kk) = pk2(sm[kk * 65 + nn], sm[(kk + 1) * 65 + nn]);
  }
}

DI void phase_prep(const Params& p, char* smem) {
  float* sm = (float*)smem;
  for (int it = VBID; it < 2624; it += VGRID) {
    int i = it;
    if (i < 832) { transpose_tile<0>(p.w_in, 3328, p.Wt_all, 1024, i / 52, i % 52, sm); continue; }
    i -= 832;
    if (i < 512) { transpose_tile<3328>(p.w_merge, 2048, p.Wt_all, 1024, i / 32, i % 32, sm); continue; }
    i -= 512;
    if (i < 768) { transpose_tile<-1>(p.w_ada, 3072, p.Wt_ada, 1024, i / 48, i % 48, sm); continue; }
    i -= 768;
    if (i < 128) { transpose_tile<-1>(p.w_pa, 1024, p.Wt_pa, 512, i / 16, i % 16, sm); continue; }
    i -= 128;
    if (i < 128) { transpose_tile<-1>(p.w_pb, 1024, p.Wt_pb, 512, i / 16, i % 16, sm); continue; }
    i -= 128;
    transpose_tile<-1>(p.w_out, 1024, p.Wt_out, 1024, i / 16, i % 16, sm);
  }
  for (int idx = VBID * 256 + TID; idx < 256 * 1024; idx += VGRID * 256) {
    int row = idx >> 10, col = idx & 1023;
    float v = row < 128 ? p.c_sample[row * 1024 + col] : (row == 128 ? p.c_prompt[col] : 0.f);
    p.Cb[idx] = (bfr)f2bf(v);
  }
}

DI void phase_mod(const Params& p, char* smem) {
  bfr* sA = (bfr*)smem; bfr* sW = sA + 128 * LDT;
  const int t = TID, lane = t & 63, w = t >> 6, wn = w >> 1, wm = w & 1, r = lane & 31, h = lane >> 5;
  for (int tile = VBID; tile < 48; tile += VGRID) {
    int m0 = (tile / 24) * 128, n0 = (tile % 24) * 128;
    f32x16 acc[2][2];
    _Pragma("unroll") for (int a = 0; a < 2; ++a) _Pragma("unroll") for (int b = 0; b < 2; ++b) acc[a][b] = zero16();
    gemm_mainloop(p.Cb, 1024, m0, p.Wt_ada, 1024, n0, 1024, sA, sW, acc);
    _Pragma("unroll") for (int nt = 0; nt < 2; ++nt) _Pragma("unroll") for (int mt = 0; mt < 2; ++mt) {
      int m = m0 + wm * 64 + mt * 32 + r;
      _Pragma("unroll") for (int g = 0; g < 4; ++g) {
        int n = n0 + wn * 64 + nt * 32 + 8 * g + 4 * h;
        float4 b = *(const float4*)(p.b_ada + n);
        float4 o; o.x = acc[nt][mt][4 * g] + b.x; o.y = acc[nt][mt][4 * g + 1] + b.y; o.z = acc[nt][mt][4 * g + 2] + b.z; o.w = acc[nt][mt][4 * g + 3] + b.w;
        *(float4*)(p.mod + (size_t)m * 3072 + n) = o;
      }
    }
  }
}

DI void phase_h(const Params& p) {
  const int lane = TID & 63, w = TID >> 6;
  for (int row = VBID * 4 + w; row < MTOT; row += VGRID * 4) {
    const float* xr = row < SEQ ? p.x_prompt + (size_t)row * DM : p.x_sample + (size_t)(row - SEQ) * DM;
    const float* mr = p.mod + (size_t)(row < SEQ ? 128 : row - SEQ) * 3072;
    float4 xv[4]; float ss = 0.f;
    _Pragma("unroll") for (int j = 0; j < 4; ++j) {
      xv[j] = *(const float4*)(xr + j * 256 + lane * 4);
      ss += xv[j].x * xv[j].x + xv[j].y * xv[j].y + xv[j].z * xv[j].z + xv[j].w * xv[j].w;
    }
    _Pragma("unroll") for (int o = 32; o >= 1; o >>= 1) ss += __shfl_xor(ss, o);
    float rs = rsqrtf(ss * (1.f / DM) + EPS);
    _Pragma("unroll") for (int j = 0; j < 4; ++j) {
      int col = j * 256 + lane * 4;
      float4 g = *(const float4*)(p.norm_g + col);
      float4 sh = *(const float4*)(mr + col);
      float4 sc = *(const float4*)(mr + 1024 + col);
      float a = xv[j].x * rs * g.x * (1.f + sc.x) + sh.x;
      float b = xv[j].y * rs * g.y * (1.f + sc.y) + sh.y;
      float c = xv[j].z * rs * g.z * (1.f + sc.z) + sh.z;
      float d = xv[j].w * rs * g.w * (1.f + sc.w) + sh.w;
      *(u32x2*)(p.H + (size_t)row * DM + col) = pack4(a, b, c, d);
    }
  }
}

DI void sincos_red(float a, float& s, float& c) {
  float n = rintf(a * 0.15915494309189535f);
  float rr = fmaf(-n, 6.2831854820251465f, a);
  rr = fmaf(-n, -1.7484555e-7f, rr);
  s = __sinf(rr); c = __cosf(rr);
}

namespace pg8 {
#define PG8_LAS __attribute__((address_space(3)))
typedef unsigned short bf16_t;
typedef short bf16x8 __attribute__((ext_vector_type(8)));
typedef float f32x4 __attribute__((ext_vector_type(4)));
typedef unsigned u32x4 __attribute__((ext_vector_type(4)));
constexpr int BM = 256, BK = 64, HALF = 128, HTB = HALF * BK * 2  , STAGE_BYTES = 8 * HTB, NXCD = 8, WGM = 8;

__host__ __device__ __forceinline__ int lds_byte(int r, int c) { const int st = (r >> 4) * 2 + (c >> 5), rr = r & 15, cc = c & 31, ob = rr * 64 + cc * 2; return st * 1024 + (ob ^ (((ob >> 9) & 1) << 5)); }
__host__ __device__ __forceinline__ void stage_rc(int b, int& R, int& C) { const int st = b / 1024, sb = b % 1024, swz = sb ^ (((sb >> 9) & 1) << 5); R = (st >> 1) * 16 + swz / 64; C = (st & 1) * 32 + (swz % 64) / 2; }
__host__ __device__ __forceinline__ int perm32(int rho) { const int n = rho >> 4, i = rho & 15; return 8 * (i >> 2) + 4 * n + (i & 3); }

struct Unit { int pm, pn; };
struct Gemm { const bf16_t* A; const bf16_t* Bt; int M, N, K; };

struct StaticOrder {
    int nM, nN, nwg, G, c;
    __host__ __device__ void init(int M, int N, int G_, int c_) { nM = M / BM; nN = N / BM; nwg = nM * nN; G = G_; c = c_; }
    __host__ __device__ bool next(int i, Unit& u) const {
        const long L = (long)i * G + c; if (L >= nwg) return false;
        int wgid = (int)L; { const int q = nwg / NXCD, r = nwg % NXCD, xcd = wgid % NXCD, off = wgid / NXCD; wgid = (xcd < r ? xcd * (q + 1) : r * (q + 1) + (xcd - r) * q) + off; }
        const int nig = WGM * nN, gid = wgid / nig, fm = gid * WGM, gsz = (nM - fm) < WGM ? (nM - fm) : WGM;
        u.pm = fm + ((wgid % nig) % gsz); u.pn = (wgid % nig) / gsz; return true;
    }
    __device__ __forceinline__ void a_ready(const Unit&) const {}
    __device__ __forceinline__ void done(const Unit&) const {}
};
template <class Epi, class Sched, bool STAMP = false>
__device__ __forceinline__ void gemm_phase(PG8_LAS unsigned char* lds, const Gemm g, const Sched& S, const Epi& E, unsigned long long* stamps) {
    const int tid = threadIdx.x, wid = __builtin_amdgcn_readfirstlane(tid >> 6), lane = tid & 63, wr = wid >> 2, wc = wid & 3, fr = lane & 15, fq = lane >> 4;
    const int K = g.K, nt = K / BK;
    int ts_lo = 0, ts_hi = 0, nts = 0; const unsigned long long rt_entry = STAMP ? (unsigned long long)wall_clock64() : 0ull;
#define PG8_STAMP() do { if (STAMP && wid == 0 && nts < 64) { const unsigned long long _c = (unsigned long long)clock64(); \
        ts_lo = (lane == nts) ? (int)(unsigned)_c : ts_lo; ts_hi = (lane == nts) ? (int)(unsigned)(_c >> 32) : ts_hi; ++nts; } } while (0)
    PG8_STAMP();
    unsigned voffA[2], voffB[2];
#pragma unroll
    for (int i = 0; i < 2; ++i) { int R, C; stage_rc(tid * 16 + i * 8192, R, C); const int Rb = Epi::PERM ? ((R & ~31) + perm32(R & 31)) : R;
        voffA[i] = (unsigned)(R * K + C) * 2u; voffB[i] = (unsigned)(Rb * K + C) * 2u; }
    const size_t kstep = (size_t)(BK * 2);
    const size_t hstep = (size_t)HALF * K * 2;
    const size_t tstep = 2 * hstep;
    const unsigned ldsw = (unsigned)wid * 1024u;
    const int aoff = lds_byte(wr * 64 + fr, fq * 8), boff = lds_byte(wc * 32 + fr, fq * 8);
#define PG8_SA(b, h) (((b) * 2 + (h)) * HTB)
#define PG8_SB(b, h) ((4 + (b) * 2 + (h)) * HTB)
#define PG8_STAGE(bufoff, gbase, voff) do { _Pragma("unroll") for (int _i = 0; _i < 2; ++_i) \
        __builtin_amdgcn_global_load_lds((const unsigned*)((const char*)(gbase) + (voff)[_i]), (PG8_LAS unsigned*)(lds + (bufoff) + ldsw + _i * 8192), 16, 0, 0); } while (0)
#define PG8_LDA(dst, b, h) do { _Pragma("unroll") for (int m = 0; m < 4; ++m) _Pragma("unroll") for (int k = 0; k < 2; ++k) dst[m][k] = *(const PG8_LAS bf16x8*)(lds + PG8_SA(b, h) + aoff + m * 2048 + k * 1024); } while (0)
#define PG8_LDB(dst, b, h) do { _Pragma("unroll") for (int n = 0; n < 2; ++n) _Pragma("unroll") for (int k = 0; k < 2; ++k) dst[n][k] = *(const PG8_LAS bf16x8*)(lds + PG8_SB(b, h) + boff + n * 2048 + k * 1024); } while (0)
#define PG8_MMA(ai, bj, At, Bt) do { __builtin_amdgcn_s_setprio(1); _Pragma("unroll") for (int m = 0; m < 4; ++m) _Pragma("unroll") for (int n = 0; n < 2; ++n) _Pragma("unroll") for (int k = 0; k < 2; ++k) \
        acc[ai][bj][m][n] = __builtin_amdgcn_mfma_f32_16x16x32_bf16(Bt[n][k], At[m][k], acc[ai][bj][m][n], 0, 0, 0); __builtin_amdgcn_s_setprio(0); } while (0)
#define PG8_WAIT_V(n) asm volatile("s_waitcnt vmcnt(" #n ")" ::: "memory")
#define PG8_WAIT_L(n) asm volatile("s_waitcnt lgkmcnt(" #n ")" ::: "memory")
#define PG8_BAR __builtin_amdgcn_s_barrier()
#define PG8_SCHED __builtin_amdgcn_sched_barrier(0)
    Unit cur, nxt; int ui = 0;
    if (!S.next(0, cur)) return;
    f32x4 acc[2][2][4][2];
#pragma unroll
    for (int a = 0; a < 2; ++a)
#pragma unroll
        for (int b = 0; b < 2; ++b)
#pragma unroll
            for (int m = 0; m < 4; ++m)
#pragma unroll
                for (int n = 0; n < 2; ++n) acc[a][b][m][n] = (f32x4){0.f, 0.f, 0.f, 0.f};
    bf16x8 At[4][2], B0[2][2], B1[2][2];
    const char* cA = (const char*)g.A + (size_t)cur.pm * tstep; const char* cB = (const char*)g.Bt + (size_t)cur.pn * tstep;
    S.a_ready(cur);
    PG8_STAGE(PG8_SB(0, 0), cB, voffB); PG8_STAGE(PG8_SA(0, 0), cA, voffA); PG8_STAGE(PG8_SB(0, 1), cB + hstep, voffB); PG8_STAGE(PG8_SA(0, 1), cA + hstep, voffA);
    if (wr == 1) PG8_BAR;
    PG8_WAIT_V(4); PG8_BAR;
    PG8_STAGE(PG8_SB(1, 0), cB + kstep, voffB); PG8_STAGE(PG8_SA(1, 0), cA + kstep, voffA); PG8_STAGE(PG8_SB(1, 1), cB + hstep + kstep, voffB);
    PG8_WAIT_V(6); PG8_BAR;
    PG8_STAMP();
    for (;;) {
        const bool has_next = S.next(ui + 1, nxt);
        const char* nA = has_next ? (const char*)g.A + (size_t)nxt.pm * tstep : cA; const char* nB = has_next ? (const char*)g.Bt + (size_t)nxt.pn * tstep : cB;
        for (int t = 0; t < nt; t += 2) {
            const bool last = (t == nt - 2);
            const char* a1 = cA + (size_t)(t + 1) * kstep;
            const char* a2 = last ? nA : cA + (size_t)(t + 2) * kstep; const char* b2 = last ? nB : cB + (size_t)(t + 2) * kstep;
            const char* a3 = a2 + kstep; const char* b3 = b2 + kstep;
            if (last && has_next) S.a_ready(nxt);
            PG8_LDB(B0, 0, 0); PG8_SCHED; PG8_LDA(At, 0, 0); PG8_STAGE(PG8_SA(1, 1), a1 + hstep, voffA);
            PG8_WAIT_L(8); PG8_BAR; PG8_WAIT_L(0); PG8_MMA(0, 0, At, B0); PG8_BAR; PG8_SCHED;
            PG8_LDB(B1, 0, 1); PG8_STAGE(PG8_SB(0, 0), b2, voffB);
            PG8_BAR; PG8_WAIT_L(0); PG8_MMA(0, 1, At, B1); PG8_BAR;
            PG8_LDA(At, 0, 1); PG8_STAGE(PG8_SA(0, 0), a2, voffA);
            PG8_BAR; PG8_WAIT_L(0); PG8_MMA(1, 0, At, B0); PG8_BAR; PG8_SCHED;
            PG8_STAGE(PG8_SB(0, 1), b2 + hstep, voffB);
            PG8_WAIT_V(6); PG8_BAR; PG8_MMA(1, 1, At, B1); PG8_BAR;
            PG8_LDB(B0, 1, 0); PG8_SCHED; PG8_LDA(At, 1, 0); PG8_STAGE(PG8_SA(0, 1), a2 + hstep, voffA);
            PG8_WAIT_L(8); PG8_BAR; PG8_WAIT_L(0); PG8_MMA(0, 0, At, B0); PG8_BAR; PG8_SCHED;
            PG8_LDB(B1, 1, 1); PG8_STAGE(PG8_SB(1, 0), b3, voffB);
            PG8_BAR; PG8_WAIT_L(0); PG8_MMA(0, 1, At, B1); PG8_BAR;
            PG8_LDA(At, 1, 1); PG8_STAGE(PG8_SA(1, 0), a3, voffA);
            PG8_BAR; PG8_WAIT_L(0); PG8_MMA(1, 0, At, B0); PG8_BAR; PG8_SCHED;
            PG8_STAGE(PG8_SB(1, 1), b3 + hstep, voffB);
            PG8_WAIT_V(6); PG8_BAR; PG8_MMA(1, 1, At, B1); PG8_BAR;
        }
        PG8_STAMP();
        if constexpr (!Epi::AFTER_DRAIN) { E(acc, cur, wr, wc, fr, fq); S.done(cur); }
        PG8_STAMP();
        if (!has_next) break;
#pragma unroll
        for (int a = 0; a < 2; ++a)
#pragma unroll
            for (int b = 0; b < 2; ++b)
#pragma unroll
                for (int m = 0; m < 4; ++m)
#pragma unroll
                    for (int n = 0; n < 2; ++n) acc[a][b][m][n] = (f32x4){0.f, 0.f, 0.f, 0.f};
        cur = nxt; cA = nA; cB = nB; ++ui;
    }
    PG8_WAIT_V(0);
    if (wr == 0) PG8_BAR;
    PG8_BAR;
    if constexpr (Epi::AFTER_DRAIN) { E.fused(acc, cur, wr, wc, fr, fq, lds, wid, lane); S.done(cur); }
    PG8_STAMP();
    if (STAMP && wid == 0) { stamps[lane] = lane < nts ? (((unsigned long long)(unsigned)ts_hi << 32) | (unsigned)ts_lo) : 0ull;
        if (lane == 62) stamps[62] = rt_entry; if (lane == 63) stamps[63] = (unsigned long long)wall_clock64(); }
#undef PG8_STAMP
#undef PG8_SA
#undef PG8_SB
#undef PG8_STAGE
#undef PG8_LDA
#undef PG8_LDB
#undef PG8_MMA
#undef PG8_WAIT_V
#undef PG8_WAIT_L
#undef PG8_BAR
#undef PG8_SCHED
}
}
using pf4 = pg8::f32x4;

struct EpiMain {
  static constexpr bool PERM = false, AFTER_DRAIN = false;
  const Params& p;
  DI void operator()(const pf4 (&acc)[2][2][4][2], const pg8::Unit& u, int wr, int wc, int fr, int fq) const {
    const int pn = u.pn;
    const int rbase = u.pm * 256 + wr * 64 + fr;
    if (pn < 3) {
      const bool isq = pn < 2, isv = (pn == 2) && (wc >= 2);
      const float* gp = isq ? p.qg : p.kg;
      const int d0 = 16 * (fq >> 1) + 4 * (fq & 1), d1 = 32 + 8 * fq;
      float4 g00 = {1.f, 1.f, 1.f, 1.f}, g01 = g00, g10 = g00, g11 = g00;
      if (!isv) { g00 = *(const float4*)(gp + d0); g01 = *(const float4*)(gp + d0 + 8); g10 = *(const float4*)(gp + d1); g11 = *(const float4*)(gp + d1 + 4); }
      _Pragma("unroll") for (int ai = 0; ai < 2; ++ai) {
        if (u.pm * 256 + 128 * ai >= MTOT) continue;
        _Pragma("unroll") for (int m = 0; m < 4; ++m) {
          const int row = rbase + 128 * ai + 16 * m;
          pf4 a00 = acc[ai][0][m][0], a01 = acc[ai][0][m][1], a10 = acc[ai][1][m][0], a11 = acc[ai][1][m][1];
          if (!isv) {
            float ss = 0.f;
            _Pragma("unroll") for (int j = 0; j < 4; ++j) ss += a00[j] * a00[j] + a01[j] * a01[j] + a10[j] * a10[j] + a11[j] * a11[j];
            ss += __shfl_xor(ss, 16); ss += __shfl_xor(ss, 32);
            const float sc = rsqrtf(ss * (1.f / 64.f) + EPS);
            a00[0] *= sc * g00.x; a00[1] *= sc * g00.y; a00[2] *= sc * g00.z; a00[3] *= sc * g00.w;
            a01[0] *= sc * g01.x; a01[1] *= sc * g01.y; a01[2] *= sc * g01.z; a01[3] *= sc * g01.w;
            a10[0] *= sc * g10.x; a10[1] *= sc * g10.y; a10[2] *= sc * g10.z; a10[3] *= sc * g10.w;
            a11[0] *= sc * g11.x; a11[1] *= sc * g11.y; a11[2] *= sc * g11.z; a11[3] *= sc * g11.w;
            if (fq < 2) {
              const float pos = (float)(row < SEQ ? row : SEQ);
              const float invlo[4] = {1.0f, 0.19392274f, 0.03760603f, 0.0072926646f};
              const float invhi[4] = {0.0014142136f, 0.0002742482f, 5.3182957e-05f, 1.0313385e-05f};
              _Pragma("unroll") for (int j = 0; j < 4; ++j) {
                const float inv = (fq & 1) ? invhi[j] : invlo[j];
                float s_, c_; sincos_red(pos * inv, s_, c_);
                const float x1 = a00[j], x2 = a01[j];
                a00[j] = x1 * c_ - x2 * s_; a01[j] = x2 * c_ + x1 * s_;
              }
            }
          }
          if (isq) {
            bfr* qp = p.Q + (size_t)row * 512 + (4 * pn + wc) * 64;
            *(u32x2*)(qp + d0) = pack4(a00[0] * 0.125f, a00[1] * 0.125f, a00[2] * 0.125f, a00[3] * 0.125f);
            *(u32x2*)(qp + d0 + 8) = pack4(a01[0] * 0.125f, a01[1] * 0.125f, a01[2] * 0.125f, a01[3] * 0.125f);
            u32x4 o; o[0] = pk2(a10[0] * 0.125f, a10[1] * 0.125f); o[1] = pk2(a10[2] * 0.125f, a10[3] * 0.125f);
            o[2] = pk2(a11[0] * 0.125f, a11[1] * 0.125f); o[3] = pk2(a11[2] * 0.125f, a11[3] * 0.125f);
            *(u32x4*)(qp + d1) = o;
          } else {
            const int jh = wc & 1;
            bfr* kp = (isv ? p.Vb : p.Kb) + (size_t)row * 128 + jh * 64;
            *(u32x2*)(kp + d0) = pack4(a00[0], a00[1], a00[2], a00[3]);
            *(u32x2*)(kp + d0 + 8) = pack4(a01[0], a01[1], a01[2], a01[3]);
            u32x4 o; o[0] = pk2(a10[0], a10[1]); o[1] = pk2(a10[2], a10[3]); o[2] = pk2(a11[0], a11[1]); o[3] = pk2(a11[2], a11[3]);
            *(u32x4*)(kp + d1) = o;
            float* op = nullptr;
            if (row >= SEQ) op = (isv ? p.out_vs : p.out_ks) + ((size_t)((row - SEQ) * 128 + 127) * 2 + jh) * 64;
            else if (row >= SEQ - 128) op = (isv ? p.out_vp : p.out_kp) + ((size_t)(row - (SEQ - 128)) * 2 + jh) * 64;
            if (op) {
              *(pf4*)(op + d0) = a00; *(pf4*)(op + d0 + 8) = a01; *(pf4*)(op + d1) = a10; *(pf4*)(op + d1 + 4) = a11;
            }
          }
        }
      }
      return;
    }
    const int cw = 32 * wc + 8 * fq;
    if (pn == 7 || pn == 8) {
      _Pragma("unroll") for (int ai = 0; ai < 2; ++ai) {
        if (u.pm * 256 + 128 * ai >= MTOT) continue;
        _Pragma("unroll") for (int m = 0; m < 4; ++m) {
          const int row = rbase + 128 * ai + 16 * m;
          _Pragma("unroll") for (int bj = 0; bj < 2; ++bj) {
            float* zp = p.ZF + (size_t)row * 512 + (pn - 7) * 256 + 128 * bj + cw;
            *(pf4*)zp = acc[ai][bj][m][0]; *(pf4*)(zp + 4) = acc[ai][bj][m][1];
          }
        }
      }
      return;
    }
    bfr* dst; int ld, col, op;
    if (pn < 5) { dst = p.ZA; ld = 512; col = (pn - 3) * 256; op = 1; }
    else if (pn < 7) { dst = p.QB; ld = 512; col = (pn - 5) * 256; op = 0; }
    else if (pn < 11) { dst = p.IB; ld = 512; col = (pn - 9) * 256; op = 0; }
    else if (pn < 13) { dst = p.ZB; ld = 512; col = (pn - 11) * 256; op = 1; }
    else if (pn < 17) { dst = p.GA; ld = 1024; col = (pn - 13) * 256; op = 2; }
    else { dst = p.GB; ld = 1024; col = (pn - 17) * 256; op = 2; }
    _Pragma("unroll") for (int bj = 0; bj < 2; ++bj) {
      float4 b0 = {0.f, 0.f, 0.f, 0.f}, b1 = b0;
      if (op == 2) { const float* bp = p.b_merge + (pn - 13) * 256 + 128 * bj + cw; b0 = *(const float4*)bp; b1 = *(const float4*)(bp + 4); }
      _Pragma("unroll") for (int ai = 0; ai < 2; ++ai) {
        if (u.pm * 256 + 128 * ai >= MTOT) continue;
        _Pragma("unroll") for (int m = 0; m < 4; ++m) {
          const int row = rbase + 128 * ai + 16 * m;
          pf4 x = acc[ai][bj][m][0], y = acc[ai][bj][m][1];
          if (op == 1) { _Pragma("unroll") for (int j = 0; j < 4; ++j) { x[j] = siluf_(x[j]); y[j] = siluf_(y[j]); } }
          else if (op == 2) {
            x[0] = sigmoidf_(x[0] + b0.x); x[1] = sigmoidf_(x[1] + b0.y); x[2] = sigmoidf_(x[2] + b0.z); x[3] = sigmoidf_(x[3] + b0.w);
            y[0] = sigmoidf_(y[0] + b1.x); y[1] = sigmoidf_(y[1] + b1.y); y[2] = sigmoidf_(y[2] + b1.z); y[3] = sigmoidf_(y[3] + b1.w);
          }
          u32x4 o; o[0] = pk2(x[0], x[1]); o[1] = pk2(x[2], x[3]); o[2] = pk2(y[0], y[1]); o[3] = pk2(y[2], y[3]);
          *(u32x4*)(dst + (size_t)row * ld + col + 128 * bj + cw) = o;
        }
      }
    }
  }
};

template <int PASS> struct EpiMerge {
  static constexpr bool PERM = true, AFTER_DRAIN = false;
  const Params& p;
  DI void operator()(const pf4 (&acc)[2][2][4][2], const pg8::Unit& u, int wr, int wc, int fr, int fq) const {
    const int rbase = u.pm * 256 + wr * 64 + fr, cbase = u.pn * 256 + 32 * wc + 8 * fq;
    const bfr* G = PASS == 0 ? p.GA : p.GB;
    _Pragma("unroll") for (int ai = 0; ai < 2; ++ai) _Pragma("unroll") for (int m = 0; m < 4; ++m) _Pragma("unroll") for (int bj = 0; bj < 2; ++bj) {
      const size_t off = (size_t)(rbase + 128 * ai + 16 * m) * 1024 + cbase + 128 * bj;
      const u32x4 g = *(const u32x4*)(G + off);
      const pf4 x = acc[ai][bj][m][0], y = acc[ai][bj][m][1];
      float r[8] = {bflo(g[0]) * x[0], bfhi(g[0]) * x[1], bflo(g[1]) * x[2], bfhi(g[1]) * x[3], bflo(g[2]) * y[0], bfhi(g[2]) * y[1], bflo(g[3]) * y[2], bfhi(g[3]) * y[3]};
      if (PASS == 1) {
        const u32x4 t = *(const u32x4*)(p.Y + off);
        r[0] += bflo(t[0]); r[1] += bfhi(t[0]); r[2] += bflo(t[1]); r[3] += bfhi(t[1]); r[4] += bflo(t[2]); r[5] += bfhi(t[2]); r[6] += bflo(t[3]); r[7] += bfhi(t[3]);
      }
      u32x4 o; o[0] = pk2(r[0], r[1]); o[1] = pk2(r[2], r[3]); o[2] = pk2(r[4], r[5]); o[3] = pk2(r[6], r[7]);
      *(u32x4*)(p.Y + off) = o;
    }
  }
};

struct EpiOut {
  static constexpr bool PERM = false, AFTER_DRAIN = false;
  const Params& p;
  DI void operator()(const pf4 (&acc)[2][2][4][2], const pg8::Unit& u, int wr, int wc, int fr, int fq) const {
    const int rbase = u.pm * 256 + wr * 64 + fr, cbase = u.pn * 256 + 32 * wc + 4 * fq;
    const float* gr = p.mod + (size_t)128 * 3072 + 2048;
    _Pragma("unroll") for (int bj = 0; bj < 2; ++bj) _Pragma("unroll") for (int n = 0; n < 2; ++n) {
      const int c = cbase + 128 * bj + 16 * n;
      const pf4 gt = *(const pf4*)(gr + c);
      _Pragma("unroll") for (int ai = 0; ai < 2; ++ai) _Pragma("unroll") for (int m = 0; m < 4; ++m) {
        const size_t off = (size_t)(rbase + 128 * ai + 16 * m) * DM + c;
        const pf4 xv = *(const pf4*)(p.x_prompt + off);
        *(pf4*)(p.out_yp + off) = xv + gt * acc[ai][bj][m][n];
      }
    }
  }
};

DI void sample_merge_tile(const Params& p, int tile, char* smem) {
  bfr* sA = (bfr*)smem; bfr* sW = sA + 128 * LDT;
  const int t = TID, lane = t & 63, w = t >> 6, wn = w >> 1, wm = w & 1, r = lane & 31, h = lane >> 5;
  const int n0 = tile * 128;
  _Pragma("unroll 1") for (int pass = 0; pass < 2; ++pass) {
    f32x16 acc[2][2];
    _Pragma("unroll") for (int a = 0; a < 2; ++a) _Pragma("unroll") for (int b = 0; b < 2; ++b) acc[a][b] = zero16();
    gemm_mainloop((pass ? p.YB : p.YA) + (size_t)SEQ * 512, 512, 0, pass ? p.Wt_pb : p.Wt_pa, 512, n0, 512, sA, sW, acc);
    const bfr* G = (pass ? p.GB : p.GA) + (size_t)SEQ * 1024;
    _Pragma("unroll") for (int nt = 0; nt < 2; ++nt) _Pragma("unroll") for (int mt = 0; mt < 2; ++mt) {
      const int m = wm * 64 + mt * 32 + r;
      _Pragma("unroll") for (int g = 0; g < 4; ++g) {
        const size_t off = (size_t)m * 1024 + n0 + wn * 64 + nt * 32 + 8 * g + 4 * h;
        const u32x2 gg = *(const u32x2*)(G + off);
        float r0 = bflo(gg[0]) * acc[nt][mt][4 * g], r1 = bfhi(gg[0]) * acc[nt][mt][4 * g + 1], r2 = bflo(gg[1]) * acc[nt][mt][4 * g + 2], r3 = bfhi(gg[1]) * acc[nt][mt][4 * g + 3];
        if (pass) { const u32x2 tt = *(const u32x2*)(p.Ys + off); r0 += bflo(tt[0]); r1 += bfhi(tt[0]); r2 += bflo(tt[1]); r3 += bfhi(tt[1]); }
        *(u32x2*)(p.Ys + off) = pack4(r0, r1, r2, r3);
      }
    }
  }
}

DI void sample_out_tile(const Params& p, int tile, char* smem) {
  bfr* sA = (bfr*)smem; bfr* sW = sA + 128 * LDT;
  const int t = TID, lane = t & 63, w = t >> 6, wn = w >> 1, wm = w & 1, r = lane & 31, h = lane >> 5;
  const int n0 = tile * 128;
  f32x16 acc[2][2];
  _Pragma("unroll") for (int a = 0; a < 2; ++a) _Pragma("unroll") for (int b = 0; b < 2; ++b) acc[a][b] = zero16();
  gemm_mainloop(p.Ys, 1024, 0, p.Wt_out, 1024, n0, 1024, sA, sW, acc);
  _Pragma("unroll") for (int nt = 0; nt < 2; ++nt) _Pragma("unroll") for (int mt = 0; mt < 2; ++mt) {
    const int m = wm * 64 + mt * 32 + r;
    _Pragma("unroll") for (int g = 0; g < 4; ++g) {
      const int n = n0 + wn * 64 + nt * 32 + 8 * g + 4 * h;
      const float4 xv = *(const float4*)(p.x_sample + (size_t)m * DM + n), gt = *(const float4*)(p.mod + (size_t)m * 3072 + 2048 + n);
      float4 o;
      o.x = xv.x + gt.x * acc[nt][mt][4 * g]; o.y = xv.y + gt.y * acc[nt][mt][4 * g + 1];
      o.z = xv.z + gt.z * acc[nt][mt][4 * g + 2]; o.w = xv.w + gt.w * acc[nt][mt][4 * g + 3];
      *(float4*)(p.out_ys + (size_t)m * DM + n) = o;
    }
  }
}

DI void attn_prompt_item(const Params& p, int qb, int hd, bfr* sVt  ) {
  const int t = TID, lane = t & 63, w = t >> 6, r = lane & 31, h = lane >> 5;
  const int j = hd >> 2, kb0 = qb * 128 - 128;
  __syncthreads();
  _Pragma("unroll") for (int it = 0; it < 8; ++it) {
    int kl = it * 32 + (t & 31), dg = t >> 5, kpos = kb0 + kl;
    u32x4 v = {0u, 0u, 0u, 0u};
    if (kpos >= 0) v = *(const u32x4*)(p.Vb + (size_t)kpos * 128 + j * 64 + dg * 8);
    _Pragma("unroll") for (int e = 0; e < 8; ++e) sVt[(dg * 8 + e) * 264 + kl] = (bfr)((v[e >> 1] >> ((e & 1) * 16)) & 0xffffu);
  }
  __syncthreads();
  const int q0 = qb * 128 + 32 * w, q = q0 + r;
  bf16x8 qf[4];
  _Pragma("unroll") for (int s = 0; s < 4; ++s) qf[s] = *(const bf16x8*)(p.Q + (size_t)q * 512 + hd * 64 + 16 * s + 8 * h);
  f32x16 sacc[5];
  _Pragma("unroll") for (int kt = 0; kt < 5; ++kt) {
    sacc[kt] = zero16();
    int kr = q0 - 128 + 32 * kt + r; kr = kr < 0 ? 0 : kr;
    _Pragma("unroll") for (int s = 0; s < 4; ++s) {
      bf16x8 kf = *(const bf16x8*)(p.Kb + (size_t)kr * 128 + j * 64 + 16 * s + 8 * h);
      sacc[kt] = mfma(kf, qf[s], sacc[kt]);
    }
  }
  const float sink = p.sinks[hd];
  float mx = sink;
  _Pragma("unroll") for (int kt = 0; kt < 5; ++kt) _Pragma("unroll") for (int i = 0; i < 16; ++i) {
    int key = q0 - 128 + 32 * kt + crow(i, h), rel = q - key;
    bool valid = (rel >= 0) && (rel < 128) && (key >= 0);
    float sv = valid ? sacc[kt][i] : -INFINITY;
    sacc[kt][i] = sv; mx = fmaxf(mx, sv);
  }
  mx = fmaxf(mx, __shfl_xor(mx, 32));
  float l = 0.f;
  _Pragma("unroll") for (int kt = 0; kt < 5; ++kt) _Pragma("unroll") for (int i = 0; i < 16; ++i) {
    float pv = __expf(sacc[kt][i] - mx); sacc[kt][i] = pv; l += pv;
  }
  l += __shfl_xor(l, 32);
  l += __expf(sink - mx);
  f32x16 oacc[2]; oacc[0] = zero16(); oacc[1] = zero16();
  _Pragma("unroll") for (int kt = 0; kt < 5; ++kt) _Pragma("unroll") for (int s2 = 0; s2 < 2; ++s2) {
    u32x4 pp;
    _Pragma("unroll") for (int e = 0; e < 4; ++e) pp[e] = pk2(sacc[kt][8 * s2 + 2 * e], sacc[kt][8 * s2 + 2 * e + 1]);
    bf16x8 pf = __builtin_bit_cast(bf16x8, pp);
    _Pragma("unroll") for (int dt = 0; dt < 2; ++dt) {
      const bfr* vp = sVt + (dt * 32 + r) * 264 + 32 * w + 32 * kt + 16 * s2 + 4 * h;
      u32x2 lo = *(const u32x2*)vp, hi = *(const u32x2*)(vp + 8);
      u32x4 vv; vv[0] = lo[0]; vv[1] = lo[1]; vv[2] = hi[0]; vv[3] = hi[1];
      oacc[dt] = mfma(__builtin_bit_cast(bf16x8, vv), pf, oacc[dt]);
    }
  }
  const float il = 1.f / l;
  _Pragma("unroll") for (int dt = 0; dt < 2; ++dt) _Pragma("unroll") for (int g = 0; g < 4; ++g) {
    int d = dt * 32 + 8 * g + 4 * h;
    size_t off = (size_t)q * 512 + hd * 64 + d;
    u32x2 za = *(const u32x2*)(p.ZA + off);
    *(u32x2*)(p.YA + off) = pack4(oacc[dt][4 * g] * il * bflo(za[0]), oacc[dt][4 * g + 1] * il * bfhi(za[0]),
                                  oacc[dt][4 * g + 2] * il * bflo(za[1]), oacc[dt][4 * g + 3] * il * bfhi(za[1]));
  }
}

DI void attn_sample_wave(const Params& p, int b, int hd) {
  const int lane = TID & 63, j = hd >> 2, m = SEQ + b;
  u32x4 qv[8];
  _Pragma("unroll") for (int i = 0; i < 8; ++i) qv[i] = *(const u32x4*)(p.Q + (size_t)m * 512 + hd * 64 + 8 * i);
  float dn = 0.f;
  _Pragma("unroll") for (int i = 0; i < 8; ++i) {
    u32x4 kv = *(const u32x4*)(p.Kb + (size_t)m * 128 + j * 64 + 8 * i);
    _Pragma("unroll") for (int e = 0; e < 4; ++e) dn += bflo(qv[i][e]) * bflo(kv[e]) + bfhi(qv[i][e]) * bfhi(kv[e]);
  }
  float s[2];
  _Pragma("unroll") for (int u = 0; u < 2; ++u) {
    int idx = lane + 1 + 64 * u;
    int ic = idx < 128 ? idx : 127;
    const float* kp = p.cache_k + ((size_t)(b * 128 + ic) * 2 + j) * 64;
    float d = 0.f;
    _Pragma("unroll") for (int i = 0; i < 8; ++i) {
      float4 k0 = *(const float4*)(kp + 8 * i), k1 = *(const float4*)(kp + 8 * i + 4);
      d += bflo(qv[i][0]) * k0.x + bfhi(qv[i][0]) * k0.y + bflo(qv[i][1]) * k0.z + bfhi(qv[i][1]) * k0.w;
      d += bflo(qv[i][2]) * k1.x + bfhi(qv[i][2]) * k1.y + bflo(qv[i][3]) * k1.z + bfhi(qv[i][3]) * k1.w;
    }
    s[u] = idx < 128 ? d : dn;
  }
  const float sink = p.sinks[hd];
  float mx = fmaxf(fmaxf(s[0], s[1]), sink);
  _Pragma("unroll") for (int o = 32; o >= 1; o >>= 1) mx = fmaxf(mx, __shfl_xor(mx, o));
  float p0 = __expf(s[0] - mx), p1 = __expf(s[1] - mx);
  float l = p0 + p1;
  _Pragma("unroll") for (int o = 32; o >= 1; o >>= 1) l += __shfl_xor(l, o);
  l += __expf(sink - mx);
  float o = 0.f;
  const float* vb = p.cache_v + ((size_t)(b * 128) * 2 + j) * 64 + lane;
  _Pragma("unroll 8") for (int idx = 1; idx < 128; ++idx) {
    float pv = __shfl(idx <= 64 ? p0 : p1, (idx - 1) & 63);
    o += pv * vb[(size_t)idx * 128];
  }
  o += __shfl(p1, 63) * bf2f(p.Vb[(size_t)m * 128 + j * 64 + lane]);
  size_t off = (size_t)m * 512 + hd * 64 + lane;
  p.YA[off] = (bfr)f2bf(o / l * bf2f(p.ZA[off]));
}

DI void hgrn_gates(const Params& p, int row0, int hh, float* sTot, float (&L)[32], float (&kin)[32], float& t0, float& lc) {
  const int t = TID, c = t & 127, half = t >> 7, ch = hh * 128 + c;
  const float lbv = 1.f / (1.f + __expf(p.lb_logits[512 + ch] - p.lb_logits[ch]));
  const float* zp = p.ZF + (size_t)(row0 + half * 32) * 512 + ch;
  float run = 0.f;
  _Pragma("unroll") for (int jj = 0; jj < 32; ++jj) {
    float z = zp[(size_t)jj * 512];
    z = fminf(fmaxf(z, -30.f), 30.f);
    float em = __expf(-z), sg = 1.f / (1.f + em);
    float f = lbv + (1.f - lbv) * sg;
    kin[jj] = (1.f - lbv) * em * sg;
    run += __logf(f);
    L[jj] = run;
  }
  sTot[half * 128 + c] = run;
  __syncthreads();
  t0 = sTot[c]; lc = t0 + sTot[128 + c];
  if (half) { _Pragma("unroll") for (int jj = 0; jj < 32; ++jj) L[jj] += t0; }
}

DI void hgrn_local_item(const Params& p, int n, int hh, char* smem) {
  bfr* sKt = (bfr*)smem; bfr* sVt = sKt + 128 * LDT; float* sTot = (float*)(sVt + 128 * LDT);
  const int t = TID, lane = t & 63, w = t >> 6, r = lane & 31, h = lane >> 5, c = t & 127, half = t >> 7;
  const int row0 = n * 64;
  __syncthreads();
  float L[32], kin[32], t0, lc;
  hgrn_gates(p, row0, hh, sTot, L, kin, t0, lc);
  _Pragma("unroll") for (int q4 = 0; q4 < 4; ++q4) {
    u32x4 o;
    _Pragma("unroll") for (int e = 0; e < 4; ++e) {
      int jj = q4 * 8 + 2 * e;
      o[e] = pk2(kin[jj] * __expf(lc - L[jj]), kin[jj + 1] * __expf(lc - L[jj + 1]));
    }
    *(u32x4*)(sKt + c * LDT + half * 32 + q4 * 8) = o;
  }
  const bfr* ip = p.IB + (size_t)(row0 + half * 32) * 512 + hh * 128 + c;
  _Pragma("unroll") for (int q4 = 0; q4 < 4; ++q4) {
    u32x4 o;
    _Pragma("unroll") for (int e = 0; e < 4; ++e) {
      int jj = q4 * 8 + 2 * e;
      o[e] = (unsigned)ip[(size_t)jj * 512] | ((unsigned)ip[(size_t)(jj + 1) * 512] << 16);
    }
    *(u32x4*)(sVt + c * LDT + half * 32 + q4 * 8) = o;
  }
  if (half == 0) p.dec[(n * 4 + hh) * 128 + c] = __expf(lc);
  __syncthreads();
  const int wv = w >> 1, wk = w & 1;
  f32x16 acc[2][2];
  _Pragma("unroll") for (int a = 0; a < 2; ++a) _Pragma("unroll") for (int b = 0; b < 2; ++b) acc[a][b] = zero16();
  _Pragma("unroll") for (int s = 0; s < 4; ++s) {
    bf16x8 af[2], bf[2];
    _Pragma("unroll") for (int x = 0; x < 2; ++x) {
      af[x] = *(const bf16x8*)(sVt + (wv * 64 + x * 32 + r) * LDT + 16 * s + 8 * h);
      bf[x] = *(const bf16x8*)(sKt + (wk * 64 + x * 32 + r) * LDT + 16 * s + 8 * h);
    }
    _Pragma("unroll") for (int a = 0; a < 2; ++a) _Pragma("unroll") for (int b = 0; b < 2; ++b) acc[a][b] = mfma(af[a], bf[b], acc[a][b]);
  }
  float* up = p.Ust + (size_t)(n * 4 + hh) * 16384;
  _Pragma("unroll") for (int a = 0; a < 2; ++a) _Pragma("unroll") for (int b = 0; b < 2; ++b) _Pragma("unroll") for (int i = 0; i < 16; ++i) {
    int v = wv * 64 + a * 32 + crow(i, h), k = wk * 64 + b * 32 + r;
    up[v * 128 + k] = acc[a][b][i];
  }
}

DI void hgrn_sample_item(const Params& p, int b, int hh, char* smem) {
  float* sf = (float*)smem; float* skin = sf + 128; float* sq = skin + 128; float* sv = sq + 128; float* sred = sv + 128; float* s2 = sred + 8 * 128;
  const int t = TID, m = SEQ + b;
  __syncthreads();
  if (t < 128) {
    int ch = hh * 128 + t;
    float lbv = 1.f / (1.f + __expf(p.lb_logits[512 + ch] - p.lb_logits[ch]));
    float z = p.ZF[(size_t)m * 512 + ch];
    z = fminf(fmaxf(z, -30.f), 30.f);
    float em = __expf(-z), sg = 1.f / (1.f + em);
    sf[t] = lbv + (1.f - lbv) * sg; skin[t] = (1.f - lbv) * em * sg;
    sq[t] = bf2f(p.QB[(size_t)m * 512 + ch]); sv[t] = bf2f(p.IB[(size_t)m * 512 + ch]);
  }
  __syncthreads();
  const int v4 = (t & 31) * 4, kg = t >> 5;
  float4 vv = *(const float4*)(sv + v4);
  float4 o = {0.f, 0.f, 0.f, 0.f};
  const size_t sb = (size_t)(b * 4 + hh) * 16384;
  _Pragma("unroll 8") for (int kk = 0; kk < 16; ++kk) {
    int k = kg * 16 + kk;
    float4 S = *(const float4*)(p.state + sb + k * 128 + v4);
    float f = sf[k], ki = skin[k], qq = sq[k];
    float4 Sn; Sn.x = f * S.x + ki * vv.x; Sn.y = f * S.y + ki * vv.y; Sn.z = f * S.z + ki * vv.z; Sn.w = f * S.w + ki * vv.w;
    *(float4*)(p.out_ss + sb + k * 128 + v4) = Sn;
    o.x += qq * Sn.x; o.y += qq * Sn.y; o.z += qq * Sn.z; o.w += qq * Sn.w;
  }
  *(float4*)(sred + kg * 128 + v4) = o;
  __syncthreads();
  float ov = 0.f;
  if (t < 128) {
    _Pragma("unroll") for (int g = 0; g < 8; ++g) ov += sred[g * 128 + t];
    float ss = ov * ov;
    _Pragma("unroll") for (int of = 32; of >= 1; of >>= 1) ss += __shfl_xor(ss, of);
    if ((t & 63) == 0) s2[t >> 6] = ss;
  }
  __syncthreads();
  if (t < 128) {
    float sc = rsqrtf((s2[0] + s2[1]) * (1.f / 128.f) + EPS);
    size_t off = (size_t)m * 512 + hh * 128 + t;
    p.YB[off] = (bfr)f2bf(ov * sc * p.og[t] * bf2f(p.ZB[off]));
  }
}

DI void phase_mix(const Params& p, char* smem) {
  for (int it = VBID; it < 1024; it += VGRID) attn_prompt_item(p, it >> 3, it & 7, (bfr*)smem);
  for (int it = VBID; it < 1024; it += VGRID) hgrn_local_item(p, it >> 2, it & 3, smem);
  for (int it = VBID; it < 512; it += VGRID) hgrn_sample_item(p, it >> 2, it & 3, smem);
  for (int it = VBID * 4 + (TID >> 6); it < 1024; it += VGRID * 4) attn_sample_wave(p, it >> 3, it & 7);
  for (int idx = VBID * 256 + TID; idx < 128 * 4064; idx += VGRID * 256) {
    int b = idx / 4064, i4 = idx - b * 4064;
    size_t so = (size_t)b * 16384 + 128 + i4 * 4, dof = (size_t)b * 16384 + i4 * 4;
    *(float4*)(p.out_ks + dof) = *(const float4*)(p.cache_k + so);
    *(float4*)(p.out_vs + dof) = *(const float4*)(p.cache_v + so);
  }
}

DI void phase_scan(const Params& p) {
  const int e = VBID * 256 + TID;
  if (e < 65536) {
  const int hh = e >> 14, k = e & 127, v = (e >> 7) & 127;
  float S = 0.f;
  for (int n0 = 0; n0 < NCH; n0 += 32) {
    float u[32], d[32];
    _Pragma("unroll") for (int i = 0; i < 32; ++i) {
      u[i] = p.Ust[(size_t)(n0 + i) * 65536 + e];
      d[i] = p.dec[((n0 + i) * 4 + hh) * 128 + k];
    }
    _Pragma("unroll") for (int i = 0; i < 32; ++i) {
      p.Ust[(size_t)(n0 + i) * 65536 + e] = S;
      S = d[i] * S + u[i];
    }
  }
  p.out_sp[(hh * 128 + k) * 128 + v] = S;
  }
}

DI void hgrn_out_item(const Params& p, int n, int hh, char* smem) {
  bfr* sQh = (bfr*)smem;
  bfr* sKh = sQh + 64 * 136;
  bfr* sVt = sKh + 64 * 136;
  bfr* sAm = sVt + 128 * LDT;
  float* sTot = (float*)(sAm + 64 * LDT);
  float* sEm = sTot + 256;
  float* sRed = sEm + 128;
  const int t = TID, lane = t & 63, w = t >> 6, r = lane & 31, h = lane >> 5, c = t & 127, half = t >> 7;
  const int row0 = n * 64;
  __syncthreads();
  {
    float L[32], kin[32], t0, lc;
    hgrn_gates(p, row0, hh, sTot, L, kin, t0, lc);
    const bfr* qp = p.QB + (size_t)(row0 + half * 32) * 512 + hh * 128 + c;
    _Pragma("unroll") for (int jj = 0; jj < 32; ++jj) {
      float dl = L[jj] - t0;
      float eq = __expf(fminf(dl, 80.f)), ek = __expf(fminf(-dl, 80.f));
      float qv = bf2f(qp[(size_t)jj * 512]);
      sQh[(half * 32 + jj) * 136 + c] = (bfr)f2bf(qv * eq);
      sKh[(half * 32 + jj) * 136 + c] = (bfr)f2bf(kin[jj] * ek);
    }
    if (half == 0) sEm[c] = __expf(t0);
  }
  const bfr* ip = p.IB + (size_t)(row0 + half * 32) * 512 + hh * 128 + c;
  _Pragma("unroll") for (int q4 = 0; q4 < 4; ++q4) {
    u32x4 o;
    _Pragma("unroll") for (int e = 0; e < 4; ++e) {
      int jj = q4 * 8 + 2 * e;
      o[e] = (unsigned)ip[(size_t)jj * 512] | ((unsigned)ip[(size_t)(jj + 1) * 512] << 16);
    }
    *(u32x4*)(sVt + c * LDT + half * 32 + q4 * 8) = o;
  }
  __syncthreads();
  {
    const int jt = w >> 1, it = w & 1;
    f32x16 a = zero16();
    if (jt <= it) {
      _Pragma("unroll") for (int s = 0; s < 8; ++s) {
        bf16x8 kf = *(const bf16x8*)(sKh + (jt * 32 + r) * 136 + 16 * s + 8 * h);
        bf16x8 qf = *(const bf16x8*)(sQh + (it * 32 + r) * 136 + 16 * s + 8 * h);
        a = mfma(kf, qf, a);
      }
    }
    const int i = it * 32 + r;
    _Pragma("unroll") for (int g = 0; g < 4; ++g) {
      int j0 = jt * 32 + 8 * g + 4 * h;
      float x0 = (j0 <= i) ? a[4 * g] : 0.f, x1 = (j0 + 1 <= i) ? a[4 * g + 1] : 0.f;
      float x2 = (j0 + 2 <= i) ? a[4 * g + 2] : 0.f, x3 = (j0 + 3 <= i) ? a[4 * g + 3] : 0.f;
      *(u32x2*)(sAm + i * LDT + j0) = pack4(x0, x1, x2, x3);
    }
  }
  __syncthreads();
  f32x16 oacc[2]; oacc[0] = zero16(); oacc[1] = zero16();
  {
    const float* sp = p.Ust + (size_t)(n * 4 + hh) * 16384 + (size_t)(32 * w + r) * 128;
    _Pragma("unroll") for (int s = 0; s < 8; ++s) {
      float4 a0 = *(const float4*)(sp + 16 * s + 8 * h), a1 = *(const float4*)(sp + 16 * s + 8 * h + 4);
      float4 e0 = *(const float4*)(sEm + 16 * s + 8 * h), e1 = *(const float4*)(sEm + 16 * s + 8 * h + 4);
      u32x4 pa; pa[0] = pk2(a0.x * e0.x, a0.y * e0.y); pa[1] = pk2(a0.z * e0.z, a0.w * e0.w);
      pa[2] = pk2(a1.x * e1.x, a1.y * e1.y); pa[3] = pk2(a1.z * e1.z, a1.w * e1.w);
      bf16x8 af = __builtin_bit_cast(bf16x8, pa);
      _Pragma("unroll") for (int it = 0; it < 2; ++it) {
        bf16x8 qf = *(const bf16x8*)(sQh + (it * 32 + r) * 136 + 16 * s + 8 * h);
        oacc[it] = mfma(af, qf, oacc[it]);
      }
    }
    _Pragma("unroll") for (int s = 0; s < 4; ++s) {
      bf16x8 vf = *(const bf16x8*)(sVt + (32 * w + r) * LDT + 16 * s + 8 * h);
      _Pragma("unroll") for (int it = 0; it < 2; ++it) {
        bf16x8 af2 = *(const bf16x8*)(sAm + (it * 32 + r) * LDT + 16 * s + 8 * h);
        oacc[it] = mfma(vf, af2, oacc[it]);
      }
    }
  }
  _Pragma("unroll") for (int it = 0; it < 2; ++it) {
    float ss = 0.f;
    _Pragma("unroll") for (int i = 0; i < 16; ++i) ss += oacc[it][i] * oacc[it][i];
    ss += __shfl_xor(ss, 32);
    if (h == 0) sRed[w * 64 + it * 32 + r] = ss;
  }
  __syncthreads();
  _Pragma("unroll") for (int it = 0; it < 2; ++it) {
    const int i = it * 32 + r;
    float tot = sRed[i] + sRed[64 + i] + sRed[128 + i] + sRed[192 + i];
    float sc = rsqrtf(tot * (1.f / 128.f) + EPS);
    _Pragma("unroll") for (int g = 0; g < 4; ++g) {
      int v = 32 * w + 8 * g + 4 * h;
      size_t off = (size_t)(row0 + i) * 512 + hh * 128 + v;
      float4 og = *(const float4*)(p.og + v);
      u32x2 zb = *(const u32x2*)(p.ZB + off);
      *(u32x2*)(p.YB + off) = pack4(oacc[it][4 * g] * sc * og.x * bflo(zb[0]), oacc[it][4 * g + 1] * sc * og.y * bfhi(zb[0]),
                                    oacc[it][4 * g + 2] * sc * og.z * bflo(zb[1]), oacc[it][4 * g + 3] * sc * og.w * bfhi(zb[1]));
    }
  }
}

#define XB_TMO      128
#define XB_XCNT(j)  (256  + 64 * (j))
#define XB_XSUB(j)  (1280 + 64 * (j))
#define XB_XGEN(j)  (2304 + 64 * (j))
#define XB_TOP      3328
#define XB_TOPGEN   3392
#define XCD_BAR_WORDS 3456
#define XB_SPIN_CAP (1u << 18)
#define LAS __attribute__((address_space(3)))

__device__ __forceinline__ unsigned xb_ld(unsigned* p)              { return __hip_atomic_load(p, __ATOMIC_RELAXED, __HIP_MEMORY_SCOPE_AGENT); }
__device__ __forceinline__ unsigned xb_add(unsigned* p, unsigned v) { return __hip_atomic_fetch_add(p, v, __ATOMIC_RELAXED, __HIP_MEMORY_SCOPE_AGENT); }
__device__ __forceinline__ unsigned xb_xcc_id() { return (unsigned)__builtin_amdgcn_s_getreg((3 << 11) | 20) & 0xFu; }
#define XB_SPIN(cond, bar) do { unsigned _sp = 0; while (cond) { __builtin_amdgcn_s_sleep(1); \
    if ((++_sp & 255u) == 0u) { if (xb_ld(&(bar)[XB_TMO])) break; if (_sp > XB_SPIN_CAP) { atomicAdd(&(bar)[XB_TMO], 1u); break; } } } } while (0)

struct XcdBarrier {
    unsigned* bar; unsigned x;
    volatile LAS unsigned* st;
};

__device__ __forceinline__ XcdBarrier xcd_barrier_post(unsigned* bar, volatile LAS unsigned* st) {
    XcdBarrier b; b.bar = bar; b.x = xb_xcc_id(); b.st = st;
    if (threadIdx.x == 0) (void)xb_add(&bar[XB_XCNT(b.x)], 1u);
    return b;
}
__device__ __forceinline__ void xcd_barrier_complete(unsigned* bar, unsigned x, unsigned& nloc, unsigned& nx) {
    const unsigned G = gridDim.x * gridDim.y * gridDim.z;
    unsigned sum, cnt, mine, sp = 0u;
    for (;;) {
        sum = 0u; cnt = 0u; mine = 0u;
#pragma unroll
        for (unsigned j = 0; j < 16; ++j) { const unsigned c = xb_ld(&bar[XB_XCNT(j)]); sum += c; cnt += (c > 0u) ? 1u : 0u; mine = (j == x) ? c : mine; }
        if (sum == G) break;
        __builtin_amdgcn_s_sleep(1);
        if ((++sp & 255u) == 0u) { if (xb_ld(&bar[XB_TMO])) break; if (sp > XB_SPIN_CAP) { atomicAdd(&bar[XB_TMO], 1u); break; } }
    }
    nloc = mine > 0u ? mine : 1u; nx = cnt > 0u ? cnt : 1u;
}

__device__ __forceinline__ void xcd_barrier(const XcdBarrier& b) {
    asm volatile("s_waitcnt vmcnt(0)" ::: "memory");
    __syncthreads();
    if (threadIdx.x == 0) {
        unsigned* bar = b.bar;
        __builtin_amdgcn_s_waitcnt(0);
        unsigned nloc = b.st[0], nx = b.st[1];
        if (nloc == 0u) { xcd_barrier_complete(bar, b.x, nloc, nx); b.st[0] = nloc; b.st[1] = nx; }
        const unsigned old = xb_add(&bar[XB_XSUB(b.x)], 1u);
        const unsigned gen = old / nloc;
        if (old + 1u == (gen + 1u) * nloc) {
            __builtin_amdgcn_fence(__ATOMIC_RELEASE, "agent");
            asm volatile("s_waitcnt vmcnt(0)" ::: "memory");
            const unsigned og = xb_add(&bar[XB_TOP], 1u);
            const unsigned tg = og / nx;
            if (og + 1u == (tg + 1u) * nx) xb_add(&bar[XB_TOPGEN], 1u);
            else XB_SPIN(xb_ld(&bar[XB_TOPGEN]) == tg, bar);
            __builtin_amdgcn_fence(__ATOMIC_ACQUIRE, "agent");
            xb_add(&bar[XB_XGEN(b.x)], 1u);
            asm volatile("s_waitcnt vmcnt(0)" ::: "memory");
        } else {
            XB_SPIN(xb_ld(&bar[XB_XGEN(b.x)]) == gen, bar);
            __builtin_amdgcn_fence(__ATOMIC_ACQUIRE, "agent");
            asm volatile("s_waitcnt vmcnt(0)" ::: "memory");
        }
    }
    __syncthreads();
}

__global__ void __launch_bounds__(512, 2) hybrid_megakernel(Params p) {
  extern __shared__ __attribute__((aligned(16))) char smem_all[];
  __shared__ uint4 xb_words;
  if (threadIdx.x == 0) xb_words = make_uint4(0u, 0u, 0u, 0u);
  __syncthreads();
  const XcdBarrier xb = xcd_barrier_post(p.bar, (volatile LAS unsigned*)&xb_words);
  char* smem = smem_all + (threadIdx.x >> 8) * 65536;
#ifndef REPMASK
#define REPMASK 0
#endif
#define RUN_PHASE(n, ...) if (p.phase_lo <= n && n <= p.phase_hi) { if (n != p.phase_lo) xcd_barrier(xb); __VA_ARGS__; if ((REPMASK >> n) & 1) { xcd_barrier(xb); __VA_ARGS__; } }
  RUN_PHASE(0, phase_prep(p, smem))
  RUN_PHASE(1, phase_mod(p, smem))
  RUN_PHASE(2, phase_h(p))
  RUN_PHASE(3, {
    pg8::Gemm g{p.H, p.Wt_all, MPAD, NALL, 1024};
    pg8::StaticOrder S; S.init(MPAD, NALL, (int)gridDim.x, (int)blockIdx.x);
    EpiMain E{p};
    pg8::gemm_phase<EpiMain, pg8::StaticOrder, false>((PG8_LAS unsigned char*)smem_all, g, S, E, nullptr);
  })
  RUN_PHASE(4, phase_mix(p, smem))
  RUN_PHASE(5, {
    phase_scan(p);
    if (VBID >= 256 && VBID < 264) sample_merge_tile(p, VBID - 256, smem);
  })
  RUN_PHASE(6, {
    if (VBID >= VGRID - 8) sample_out_tile(p, VBID - (VGRID - 8), smem);
    for (int it = VBID; it < 1024; it += VGRID) hgrn_out_item(p, it >> 2, it & 3, smem);
  })
  RUN_PHASE(7, {
    pg8::StaticOrder S; S.init(SEQ, 1024, (int)gridDim.x, (int)blockIdx.x);
    { pg8::Gemm g{p.YA, p.Wt_pa, SEQ, 1024, 512}; EpiMerge<0> E{p};
      pg8::gemm_phase<EpiMerge<0>, pg8::StaticOrder, false>((PG8_LAS unsigned char*)smem_all, g, S, E, nullptr); }
    { pg8::Gemm g{p.YB, p.Wt_pb, SEQ, 1024, 512}; EpiMerge<1> E{p};
      pg8::gemm_phase<EpiMerge<1>, pg8::StaticOrder, false>((PG8_LAS unsigned char*)smem_all, g, S, E, nullptr); }
  })
  RUN_PHASE(8, {
    pg8::Gemm g{p.Y, p.Wt_out, SEQ, 1024, 1024};
    pg8::StaticOrder S; S.init(SEQ, 1024, (int)gridDim.x, (int)blockIdx.x);
    EpiOut E{p};
    pg8::gemm_phase<EpiOut, pg8::StaticOrder, false>((PG8_LAS unsigned char*)smem_all, g, S, E, nullptr);
  })
}

#ifndef ONE_LAUNCH
#define ONE_LAUNCH 1
#endif
constexpr size_t kDynLds = 131072;

extern "C" void kernel_launch(void* const* d_in, const int* in_sizes, int n_in, void* d_out, int out_size, void* d_ws, size_t ws_size,
                              hipStream_t stream) {
  static int grid_blocks = 0;
  if (!grid_blocks) {
    int dev = 0, cus = 0, per_cu = 0;
    (void)hipGetDevice(&dev);
    (void)hipDeviceGetAttribute(&cus, hipDeviceAttributeMultiprocessorCount, dev);
    (void)hipFuncSetAttribute((const void*)hybrid_megakernel, hipFuncAttributeMaxDynamicSharedMemorySize, (int)kDynLds);
    (void)hipOccupancyMaxActiveBlocksPerMultiprocessor(&per_cu, hybrid_megakernel, 512, kDynLds);
    if (per_cu > 1) per_cu = 1;
    if (per_cu < 1) per_cu = 1;
    grid_blocks = cus * per_cu;
  }
  Params p{};
  const float* const* in = (const float* const*)d_in;
  p.x_prompt = in[0]; p.x_sample = in[1]; p.cache_k = in[2]; p.cache_v = in[3]; p.state = in[4]; p.c_prompt = in[5]; p.c_sample = in[6];
  p.w_ada = in[7]; p.b_ada = in[8]; p.norm_g = in[9]; p.w_in = in[10]; p.qg = in[11]; p.kg = in[12]; p.sinks = in[13]; p.lb_logits = in[14];
  p.og = in[15]; p.w_merge = in[16]; p.b_merge = in[17]; p.w_pa = in[18]; p.w_pb = in[19]; p.w_out = in[20];
  float* o = (float*)d_out;
  p.out_yp = o; o += (size_t)SEQ * DM;
  p.out_ys = o; o += (size_t)NBT * DM;
  p.out_kp = o; o += 128 * 128;
  p.out_vp = o; o += 128 * 128;
  p.out_sp = o; o += 4 * 128 * 128;
  p.out_ks = o; o += (size_t)NBT * 128 * 128;
  p.out_vs = o; o += (size_t)NBT * 128 * 128;
  p.out_ss = o;
  char* wsp = (char*)d_ws;
  auto take = [&](size_t bytes) { char* r = wsp; wsp += (bytes + 255) & ~(size_t)255; return r; };
  p.bar = (unsigned*)take((size_t)XCD_BAR_WORDS * 4);
  p.Wt_all = (bfr*)take((size_t)NALL * 1024 * 2);
  p.Wt_pa = (bfr*)take((size_t)1024 * 512 * 2);
  p.Wt_pb = (bfr*)take((size_t)1024 * 512 * 2);
  p.Wt_out = (bfr*)take((size_t)1024 * 1024 * 2);
  p.Wt_ada = (bfr*)take((size_t)3072 * 1024 * 2);
  p.Cb = (bfr*)take((size_t)256 * 1024 * 2);
  p.mod = (float*)take((size_t)256 * 3072 * 4);
  p.Ys = (bfr*)take((size_t)128 * 1024 * 2);
  p.H = (bfr*)take((size_t)MPAD * 1024 * 2);
  p.YA = p.H; p.YB = p.H + (size_t)MTOT * 512;
  p.Q = (bfr*)take((size_t)MTOT * 512 * 2);
  p.QB = (bfr*)take((size_t)MTOT * 512 * 2);
  p.Y = p.Q;
  p.Kb = (bfr*)take((size_t)MTOT * 128 * 2);
  p.Vb = (bfr*)take((size_t)MTOT * 128 * 2);
  p.ZA = (bfr*)take((size_t)MTOT * 512 * 2);
  p.IB = (bfr*)take((size_t)MTOT * 512 * 2);
  p.ZB = (bfr*)take((size_t)MTOT * 512 * 2);
  p.ZF = (float*)take((size_t)MTOT * 512 * 4);
  p.GA = (bfr*)take((size_t)MTOT * 1024 * 2);
  p.GB = (bfr*)take((size_t)MTOT * 1024 * 2);
  p.dec = (float*)take((size_t)NCH * 4 * 128 * 4);
  p.Ust = p.out_yp;
  if ((size_t)(wsp - (char*)d_ws) > ws_size) { fprintf(stderr, "workspace too small\n"); return; }
  (void)hipMemsetAsync(p.bar, 0, (size_t)XCD_BAR_WORDS * 4, stream);
#if ONE_LAUNCH
  p.phase_lo = 0; p.phase_hi = 8;
  void* args[] = {&p};
  hipError_t e = hipLaunchCooperativeKernel((void*)hybrid_megakernel, dim3(grid_blocks), dim3(512), args, kDynLds, stream);
  if (e != hipSuccess) fprintf(stderr, "cooperative launch failed: %s (grid %d)\n", hipGetErrorString(e), grid_blocks);
#else
  for (int ph = 0; ph <= 8; ++ph) {
    p.phase_lo = ph; p.phase_hi = ph;
    hipLaunchKernelGGL(hybrid_megakernel, dim3(grid_blocks), dim3(512), kDynLds, stream, p);
  }
#endif
}
```

```cpp
#include <hip/hip_runtime.h>
#include <cstdio>

#define DI __device__ __forceinline__
typedef unsigned short bfr;
using bf16x8 = __attribute__((ext_vector_type(8))) short;
using f32x16 = __attribute__((ext_vector_type(16))) float;
using u32x4 = __attribute__((ext_vector_type(4))) unsigned;
using u32x2 = __attribute__((ext_vector_type(2))) unsigned;

constexpr int DM = 1024, SEQ = 16384, NBT = 128, MTOT = SEQ + NBT;
constexpr int NALL = 5376;
constexpr int NCH = 256;
constexpr float EPS = 1e-6f;
constexpr int PANEL_CNT_WORD = 3456;
constexpr int LDT = 72;
constexpr int MPAD = 16640;
#define TID ((int)(threadIdx.x & 255))
#define VBID ((int)(blockIdx.x * 2 + (threadIdx.x >> 8)))
#define VGRID ((int)(gridDim.x * 2))

struct Params {
  const float *x_prompt, *x_sample, *cache_k, *cache_v, *state, *c_prompt, *c_sample;
  const float *w_ada, *b_ada, *norm_g, *w_in, *qg, *kg, *sinks, *lb_logits, *og, *w_merge, *b_merge, *w_pa, *w_pb, *w_out;
  float *out_yp, *out_ys, *out_kp, *out_vp, *out_sp, *out_ks, *out_vs, *out_ss;
  bfr *Wt_all, *Wt_pa, *Wt_pb, *Wt_out, *Wt_ada, *Cb, *H, *Q, *QB, *Kb, *Vb, *ZA, *IB, *ZB, *GA, *GB, *YA, *YB, *Y;
  float *mod, *ZF, *dec, *Ust;
  bfr* Ys;
  unsigned* bar;
  int phase_lo, phase_hi;
};

DI unsigned f2bf(float x) { unsigned u = __float_as_uint(x); u += 0x7fffu + ((u >> 16) & 1u); return u >> 16; }
typedef __bf16 hbf2 __attribute__((ext_vector_type(2)));
typedef float hf2 __attribute__((ext_vector_type(2)));
DI unsigned pk2(float a, float b) { hf2 v = {a, b}; return __builtin_bit_cast(unsigned, __builtin_convertvector(v, hbf2)); }
DI float bf2f(unsigned b) { return __uint_as_float(b << 16); }
DI float bflo(unsigned u) { return __uint_as_float(u << 16); }
DI float bfhi(unsigned u) { return __uint_as_float(u & 0xffff0000u); }
DI int crow(int i, int h) { return (i & 3) + 8 * (i >> 2) + 4 * h; }
DI f32x16 mfma(bf16x8 a, bf16x8 b, f32x16 c) { return __builtin_amdgcn_mfma_f32_32x32x16_bf16(a, b, c, 0, 0, 0); }
DI f32x16 zero16() { f32x16 z; _Pragma("unroll") for (int i = 0; i < 16; ++i) z[i] = 0.f; return z; }
DI float sigmoidf_(float x) { return 1.f / (1.f + __expf(-x)); }
DI float siluf_(float x) { return x / (1.f + __expf(-x)); }
DI u32x2 pack4(float a, float b, float c, float d) { u32x2 r; r[0] = pk2(a, b); r[1] = pk2(c, d); return r; }

DI int wt_row_of_col(int c) {
  const int pn = c >> 8, cl = c & 255;
  int slot;
  if (pn < 3) {
    const int g = cl >> 6, d = cl & 63;
    if (d >= 32) { const int x = d - 32; slot = 128 + 32 * g + 16 * ((x >> 2) & 1) + 4 * (x >> 3) + (x & 3); }
    else { const int fq = 2 * (d >> 4) + ((d >> 2) & 1), n = (d >> 3) & 1, j = d & 3; slot = 32 * g + 16 * n + 4 * fq + j; }
  } else {
    const int bj = cl >> 7, g = (cl >> 5) & 3, x = cl & 31;
    slot = 128 * bj + 32 * g + 16 * ((x >> 2) & 1) + 4 * (x >> 3) + (x & 3);
  }
  return (pn << 8) + slot;
}

DI void gemm_mainloop(const bfr* __restrict__ A, int lda, int m0, const bfr* __restrict__ W, int ldw, int n0, int K,
                      bfr* sA, bfr* sW, f32x16 (&acc)[2][2]) {
  const int t = TID, lane = t & 63, w = t >> 6, wn = w >> 1, wm = w & 1, r = lane & 31, h = lane >> 5;
  const int lrow = t >> 3, lk = (t & 7) * 8;
  const bfr* ap = A + (size_t)(m0 + lrow) * lda + lk;
  const bfr* wp = W + (size_t)(n0 + lrow) * ldw + lk;
  u32x4 ra[4], rw[4];
  _Pragma("unroll") for (int i = 0; i < 4; ++i) {
    ra[i] = *(const u32x4*)(ap + (size_t)(32 * i) * lda);
    rw[i] = *(const u32x4*)(wp + (size_t)(32 * i) * ldw);
  }
  const int nk = K >> 6;
  for (int kt = 0; kt < nk; ++kt) {
    __syncthreads();
    _Pragma("unroll") for (int i = 0; i < 4; ++i) {
      *(u32x4*)(sA + (lrow + 32 * i) * LDT + lk) = ra[i];
      *(u32x4*)(sW + (lrow + 32 * i) * LDT + lk) = rw[i];
    }
    __syncthreads();
    if (kt + 1 < nk) {
      ap += 64; wp += 64;
      _Pragma("unroll") for (int i = 0; i < 4; ++i) {
        ra[i] = *(const u32x4*)(ap + (size_t)(32 * i) * lda);
        rw[i] = *(const u32x4*)(wp + (size_t)(32 * i) * ldw);
      }
    }
    _Pragma("unroll") for (int kk = 0; kk < 4; ++kk) {
      bf16x8 af[2], bf[2];
      _Pragma("unroll") for (int x = 0; x < 2; ++x) {
        af[x] = *(const bf16x8*)(sW + (wn * 64 + x * 32 + r) * LDT + kk * 16 + 8 * h);
        bf[x] = *(const bf16x8*)(sA + (wm * 64 + x * 32 + r) * LDT + kk * 16 + 8 * h);
      }
      _Pragma("unroll") for (int nt = 0; nt < 2; ++nt)
        _Pragma("unroll") for (int mt = 0; mt < 2; ++mt) acc[nt][mt] = mfma(af[nt], bf[mt], acc[nt][mt]);
    }
  }
}

template <int PERMBASE> DI void transpose_tile(const float* __restrict__ src, int N, bfr* __restrict__ dst, int K, int kt, int nt, float* sm) {
  const int t = TID, k0 = kt * 64, n0 = nt * 64;
  __syncthreads();
  _Pragma("unroll") for (int i = 0; i < 16; ++i) {
    int idx = i * 256 + t, kk = idx >> 6, nn = idx & 63;
    sm[kk * 65 + nn] = src[(size_t)(k0 + kk) * N + n0 + nn];
  }
  __syncthreads();
  _Pragma("unroll") for (int i = 0; i < 8; ++i) {
    int idx = i * 256 + t, nn = idx >> 5, kk = (idx & 31) * 2;
    const int drow = PERMBASE >= 0 ? wt_row_of_col(PERMBASE + n0 + nn) : n0 + nn;
    *(unsigned*)(dst + (size_t)drow * K + k0 + kk) = pk2(sm[kk * 65 + nn], sm[(kk + 1) * 65 + nn]);
  }
}

DI void phase_prep(const Params& p, char* smem) {
  float* sm = (float*)smem;
  for (int it = VBID; it < 768; it += VGRID) transpose_tile<-1>(p.w_ada, 3072, p.Wt_ada, 1024, it / 48, it % 48, sm);
  for (int idx = VBID * 256 + TID; idx < 256 * 1024; idx += VGRID * 256) {
    int row = idx >> 10, col = idx & 1023;
    float v = row < 128 ? p.c_sample[row * 1024 + col] : (row == 128 ? p.c_prompt[col] : 0.f);
    p.Cb[idx] = (bfr)f2bf(v);
  }
}
DI void phase_prep2(const Params& p, char* smem, int vb0, int nvb) {
  float* sm = (float*)smem;
  for (int it = vb0; it < 1856; it += nvb) {
    int i = it;
    if (i < 832) { transpose_tile<0>(p.w_in, 3328, p.Wt_all, 1024, i / 52, i % 52, sm); continue; }
    i -= 832;
    if (i < 512) { transpose_tile<3328>(p.w_merge, 2048, p.Wt_all, 1024, i / 32, i % 32, sm); continue; }
    i -= 512;
    if (i < 128) { transpose_tile<-1>(p.w_pa, 1024, p.Wt_pa, 512, i / 16, i % 16, sm); continue; }
    i -= 128;
    if (i < 128) { transpose_tile<-1>(p.w_pb, 1024, p.Wt_pb, 512, i / 16, i % 16, sm); continue; }
    i -= 128;
    transpose_tile<-1>(p.w_out, 1024, p.Wt_out, 1024, i / 16, i % 16, sm);
  }
}

DI void phase_mod(const Params& p, char* smem) {
  bfr* sA = (bfr*)smem; bfr* sW = sA + 128 * LDT;
  const int t = TID, lane = t & 63, w = t >> 6, wn = w >> 1, wm = w & 1, r = lane & 31, h = lane >> 5;
  for (int tile = VBID; tile < 48; tile += VGRID) {
    int m0 = (tile / 24) * 128, n0 = (tile % 24) * 128;
    f32x16 acc[2][2];
    _Pragma("unroll") for (int a = 0; a < 2; ++a) _Pragma("unroll") for (int b = 0; b < 2; ++b) acc[a][b] = zero16();
    gemm_mainloop(p.Cb, 1024, m0, p.Wt_ada, 1024, n0, 1024, sA, sW, acc);
    _Pragma("unroll") for (int nt = 0; nt < 2; ++nt) _Pragma("unroll") for (int mt = 0; mt < 2; ++mt) {
      int m = m0 + wm * 64 + mt * 32 + r;
      _Pragma("unroll") for (int g = 0; g < 4; ++g) {
        int n = n0 + wn * 64 + nt * 32 + 8 * g + 4 * h;
        float4 b = *(const float4*)(p.b_ada + n);
        float4 o; o.x = acc[nt][mt][4 * g] + b.x; o.y = acc[nt][mt][4 * g + 1] + b.y; o.z = acc[nt][mt][4 * g + 2] + b.z; o.w = acc[nt][mt][4 * g + 3] + b.w;
        *(float4*)(p.mod + (size_t)m * 3072 + n) = o;
      }
    }
  }
}

DI void phase_h(const Params& p) {
  const int lane = TID & 63, w = TID >> 6;
  for (int row = VBID * 4 + w; row < MTOT; row += VGRID * 4) {
    const float* xr = row < SEQ ? p.x_prompt + (size_t)row * DM : p.x_sample + (size_t)(row - SEQ) * DM;
    const float* mr = p.mod + (size_t)(row < SEQ ? 128 : row - SEQ) * 3072;
    float4 xv[4]; float ss = 0.f;
    _Pragma("unroll") for (int j = 0; j < 4; ++j) {
      xv[j] = *(const float4*)(xr + j * 256 + lane * 4);
      ss += xv[j].x * xv[j].x + xv[j].y * xv[j].y + xv[j].z * xv[j].z + xv[j].w * xv[j].w;
    }
    _Pragma("unroll") for (int o = 32; o >= 1; o >>= 1) ss += __shfl_xor(ss, o);
    float rs = rsqrtf(ss * (1.f / DM) + EPS);
    _Pragma("unroll") for (int j = 0; j < 4; ++j) {
      int col = j * 256 + lane * 4;
      float4 g = *(const float4*)(p.norm_g + col);
      float4 sh = *(const float4*)(mr + col);
      float4 sc = *(const float4*)(mr + 1024 + col);
      float a = xv[j].x * rs * g.x * (1.f + sc.x) + sh.x;
      float b = xv[j].y * rs * g.y * (1.f + sc.y) + sh.y;
      float c = xv[j].z * rs * g.z * (1.f + sc.z) + sh.z;
      float d = xv[j].w * rs * g.w * (1.f + sc.w) + sh.w;
      *(u32x2*)(p.H + (size_t)row * DM + col) = pack4(a, b, c, d);
    }
  }
}

DI void sincos_red(float a, float& s, float& c) {
  float n = rintf(a * 0.15915494309189535f);
  float rr = fmaf(-n, 6.2831854820251465f, a);
  rr = fmaf(-n, -1.7484555e-7f, rr);
  s = __sinf(rr); c = __cosf(rr);
}

namespace pg8 {
#define PG8_LAS __attribute__((address_space(3)))
typedef unsigned short bf16_t;
typedef short bf16x8 __attribute__((ext_vector_type(8)));
typedef float f32x4 __attribute__((ext_vector_type(4)));
typedef unsigned u32x4 __attribute__((ext_vector_type(4)));
constexpr int BM = 256, BK = 64, HALF = 128, HTB = HALF * BK * 2  , STAGE_BYTES = 8 * HTB, NXCD = 8, WGM = 8;

__host__ __device__ __forceinline__ int lds_byte(int r, int c) { const int st = (r >> 4) * 2 + (c >> 5), rr = r & 15, cc = c & 31, ob = rr * 64 + cc * 2; return st * 1024 + (ob ^ (((ob >> 9) & 1) << 5)); }
__host__ __device__ __forceinline__ void stage_rc(int b, int& R, int& C) { const int st = b / 1024, sb = b % 1024, swz = sb ^ (((sb >> 9) & 1) << 5); R = (st >> 1) * 16 + swz / 64; C = (st & 1) * 32 + (swz % 64) / 2; }
__host__ __device__ __forceinline__ int perm32(int rho) { const int n = rho >> 4, i = rho & 15; return 8 * (i >> 2) + 4 * n + (i & 3); }

struct Unit { int pm, pn; };
struct Gemm { const bf16_t* A; const bf16_t* Bt; int M, N, K; };

struct StaticOrder {
    int nM, nN, nwg, G, c;
    __host__ __device__ void init(int M, int N, int G_, int c_) { nM = M / BM; nN = N / BM; nwg = nM * nN; G = G_; c = c_; }
    __host__ __device__ bool next(int i, Unit& u) const {
        const long L = (long)i * G + c; if (L >= nwg) return false;
        int wgid = (int)L; { const int q = nwg / NXCD, r = nwg % NXCD, xcd = wgid % NXCD, off = wgid / NXCD; wgid = (xcd < r ? xcd * (q + 1) : r * (q + 1) + (xcd - r) * q) + off; }
        const int nig = WGM * nN, gid = wgid / nig, fm = gid * WGM, gsz = (nM - fm) < WGM ? (nM - fm) : WGM;
        u.pm = fm + ((wgid % nig) % gsz); u.pn = (wgid % nig) / gsz; return true;
    }
    __device__ __forceinline__ void a_ready(const Unit&) const {}
    __device__ __forceinline__ void done(const Unit&) const {}
};
template <class Epi, class Sched, bool STAMP = false>
__device__ __forceinline__ void gemm_phase(PG8_LAS unsigned char* lds, const Gemm g, const Sched& S, const Epi& E, unsigned long long* stamps) {
    const int tid = threadIdx.x, wid = __builtin_amdgcn_readfirstlane(tid >> 6), lane = tid & 63, wr = wid >> 2, wc = wid & 3, fr = lane & 15, fq = lane >> 4;
    const int K = g.K, nt = K / BK;
    int ts_lo = 0, ts_hi = 0, nts = 0; const unsigned long long rt_entry = STAMP ? (unsigned long long)wall_clock64() : 0ull;
#define PG8_STAMP() do { if (STAMP && wid == 0 && nts < 64) { const unsigned long long _c = (unsigned long long)clock64(); \
        ts_lo = (lane == nts) ? (int)(unsigned)_c : ts_lo; ts_hi = (lane == nts) ? (int)(unsigned)(_c >> 32) : ts_hi; ++nts; } } while (0)
    PG8_STAMP();
    unsigned voffA[2], voffB[2];
#pragma unroll
    for (int i = 0; i < 2; ++i) { int R, C; stage_rc(tid * 16 + i * 8192, R, C); const int Rb = Epi::PERM ? ((R & ~31) + perm32(R & 31)) : R;
        voffA[i] = (unsigned)(R * K + C) * 2u; voffB[i] = (unsigned)(Rb * K + C) * 2u; }
    const size_t kstep = (size_t)(BK * 2);
    const size_t hstep = (size_t)HALF * K * 2;
    const size_t tstep = 2 * hstep;
    const unsigned ldsw = (unsigned)wid * 1024u;
    const int aoff = lds_byte(wr * 64 + fr, fq * 8), boff = lds_byte(wc * 32 + fr, fq * 8);
#define PG8_SA(b, h) (((b) * 2 + (h)) * HTB)
#define PG8_SB(b, h) ((4 + (b) * 2 + (h)) * HTB)
#define PG8_STAGE(bufoff, gbase, voff) do { _Pragma("unroll") for (int _i = 0; _i < 2; ++_i) \
        __builtin_amdgcn_global_load_lds((const unsigned*)((const char*)(gbase) + (voff)[_i]), (PG8_LAS unsigned*)(lds + (bufoff) + ldsw + _i * 8192), 16, 0, 0); } while (0)
#define PG8_LDA(dst, b, h) do { _Pragma("unroll") for (int m = 0; m < 4; ++m) _Pragma("unroll") for (int k = 0; k < 2; ++k) dst[m][k] = *(const PG8_LAS bf16x8*)(lds + PG8_SA(b, h) + aoff + m * 2048 + k * 1024); } while (0)
#define PG8_LDB(dst, b, h) do { _Pragma("unroll") for (int n = 0; n < 2; ++n) _Pragma("unroll") for (int k = 0; k < 2; ++k) dst[n][k] = *(const PG8_LAS bf16x8*)(lds + PG8_SB(b, h) + boff + n * 2048 + k * 1024); } while (0)
#define PG8_MMA(ai, bj, At, Bt) do { __builtin_amdgcn_s_setprio(1); _Pragma("unroll") for (int m = 0; m < 4; ++m) _Pragma("unroll") for (int n = 0; n < 2; ++n) _Pragma("unroll") for (int k = 0; k < 2; ++k) \
        acc[ai][bj][m][n] = __builtin_amdgcn_mfma_f32_16x16x32_bf16(Bt[n][k], At[m][k], acc[ai][bj][m][n], 0, 0, 0); __builtin_amdgcn_s_setprio(0); } while (0)
#define PG8_WAIT_V(n) asm volatile("s_waitcnt vmcnt(" #n ")" ::: "memory")
#define PG8_WAIT_L(n) asm volatile("s_waitcnt lgkmcnt(" #n ")" ::: "memory")
#define PG8_BAR __builtin_amdgcn_s_barrier()
#define PG8_SCHED __builtin_amdgcn_sched_barrier(0)
    Unit cur, nxt; int ui = 0;
    if (!S.next(0, cur)) return;
    f32x4 acc[2][2][4][2];
#pragma unroll
    for (int a = 0; a < 2; ++a)
#pragma unroll
        for (int b = 0; b < 2; ++b)
#pragma unroll
            for (int m = 0; m < 4; ++m)
#pragma unroll
                for (int n = 0; n < 2; ++n) acc[a][b][m][n] = (f32x4){0.f, 0.f, 0.f, 0.f};
    bf16x8 At[4][2], B0[2][2], B1[2][2];
    const char* cA = (const char*)g.A + (size_t)cur.pm * tstep; const char* cB = (const char*)g.Bt + (size_t)cur.pn * tstep;
    S.a_ready(cur);
    PG8_STAGE(PG8_SB(0, 0), cB, voffB); PG8_STAGE(PG8_SA(0, 0), cA, voffA); PG8_STAGE(PG8_SB(0, 1), cB + hstep, voffB); PG8_STAGE(PG8_SA(0, 1), cA + hstep, voffA);
    if (wr == 1) PG8_BAR;
    PG8_WAIT_V(4); PG8_BAR;
    PG8_STAGE(PG8_SB(1, 0), cB + kstep, voffB); PG8_STAGE(PG8_SA(1, 0), cA + kstep, voffA); PG8_STAGE(PG8_SB(1, 1), cB + hstep + kstep, voffB);
    PG8_WAIT_V(6); PG8_BAR;
    PG8_STAMP();
    for (;;) {
        const bool has_next = S.next(ui + 1, nxt);
        const char* nA = has_next ? (const char*)g.A + (size_t)nxt.pm * tstep : cA; const char* nB = has_next ? (const char*)g.Bt + (size_t)nxt.pn * tstep : cB;
        for (int t = 0; t < nt; t += 2) {
            const bool last = (t == nt - 2);
            const char* a1 = cA + (size_t)(t + 1) * kstep;
            const char* a2 = last ? nA : cA + (size_t)(t + 2) * kstep; const char* b2 = last ? nB : cB + (size_t)(t + 2) * kstep;
            const char* a3 = a2 + kstep; const char* b3 = b2 + kstep;
            if (last && has_next) S.a_ready(nxt);
            PG8_LDB(B0, 0, 0); PG8_SCHED; PG8_LDA(At, 0, 0); PG8_STAGE(PG8_SA(1, 1), a1 + hstep, voffA);
            PG8_WAIT_L(8); PG8_BAR; PG8_WAIT_L(0); PG8_MMA(0, 0, At, B0); PG8_BAR; PG8_SCHED;
            PG8_LDB(B1, 0, 1); PG8_STAGE(PG8_SB(0, 0), b2, voffB);
            PG8_BAR; PG8_WAIT_L(0); PG8_MMA(0, 1, At, B1); PG8_BAR;
            PG8_LDA(At, 0, 1); PG8_STAGE(PG8_SA(0, 0), a2, voffA);
            PG8_BAR; PG8_WAIT_L(0); PG8_MMA(1, 0, At, B0); PG8_BAR; PG8_SCHED;
            PG8_STAGE(PG8_SB(0, 1), b2 + hstep, voffB);
            PG8_WAIT_V(6); PG8_BAR; PG8_MMA(1, 1, At, B1); PG8_BAR;
            PG8_LDB(B0, 1, 0); PG8_SCHED; PG8_LDA(At, 1, 0); PG8_STAGE(PG8_SA(0, 1), a2 + hstep, voffA);
            PG8_WAIT_L(8); PG8_BAR; PG8_WAIT_L(0); PG8_MMA(0, 0, At, B0); PG8_BAR; PG8_SCHED;
            PG8_LDB(B1, 1, 1); PG8_STAGE(PG8_SB(1, 0), b3, voffB);
            PG8_BAR; PG8_WAIT_L(0); PG8_MMA(0, 1, At, B1); PG8_BAR;
            PG8_LDA(At, 1, 1); PG8_STAGE(PG8_SA(1, 0), a3, voffA);
            PG8_BAR; PG8_WAIT_L(0); PG8_MMA(1, 0, At, B0); PG8_BAR; PG8_SCHED;
            PG8_STAGE(PG8_SB(1, 1), b3 + hstep, voffB);
            PG8_WAIT_V(6); PG8_BAR; PG8_MMA(1, 1, At, B1); PG8_BAR;
        }
        PG8_STAMP();
        if constexpr (!Epi::AFTER_DRAIN) { E(acc, cur, wr, wc, fr, fq); S.done(cur); }
        PG8_STAMP();
        if (!has_next) break;
#pragma unroll
        for (int a = 0; a < 2; ++a)
#pragma unroll
            for (int b = 0; b < 2; ++b)
#pragma unroll
                for (int m = 0; m < 4; ++m)
#pragma unroll
                    for (int n = 0; n < 2; ++n) acc[a][b][m][n] = (f32x4){0.f, 0.f, 0.f, 0.f};
        cur = nxt; cA = nA; cB = nB; ++ui;
    }
    PG8_WAIT_V(0);
    if (wr == 0) PG8_BAR;
    PG8_BAR;
    if constexpr (Epi::AFTER_DRAIN) { E.fused(acc, cur, wr, wc, fr, fq, lds, wid, lane); S.done(cur); }
    PG8_STAMP();
    if (STAMP && wid == 0) { stamps[lane] = lane < nts ? (((unsigned long long)(unsigned)ts_hi << 32) | (unsigned)ts_lo) : 0ull;
        if (lane == 62) stamps[62] = rt_entry; if (lane == 63) stamps[63] = (unsigned long long)wall_clock64(); }
#undef PG8_STAMP
#undef PG8_SA
#undef PG8_SB
#undef PG8_STAGE
#undef PG8_LDA
#undef PG8_LDB
#undef PG8_MMA
#undef PG8_WAIT_V
#undef PG8_WAIT_L
#undef PG8_BAR
#undef PG8_SCHED
}
}
using pf4 = pg8::f32x4;

struct EpiMain {
  static constexpr bool PERM = false, AFTER_DRAIN = false;
  const Params& p;
  DI void operator()(const pf4 (&acc)[2][2][4][2], const pg8::Unit& u, int wr, int wc, int fr, int fq) const {
    const int pn = u.pn;
    const int rbase = u.pm * 256 + wr * 64 + fr;
    if (pn < 3) {
      const bool isq = pn < 2, isv = (pn == 2) && (wc >= 2);
      const float* gp = isq ? p.qg : p.kg;
      const int d0 = 16 * (fq >> 1) + 4 * (fq & 1), d1 = 32 + 8 * fq;
      float4 g00 = {1.f, 1.f, 1.f, 1.f}, g01 = g00, g10 = g00, g11 = g00;
      if (!isv) { g00 = *(const float4*)(gp + d0); g01 = *(const float4*)(gp + d0 + 8); g10 = *(const float4*)(gp + d1); g11 = *(const float4*)(gp + d1 + 4); }
      _Pragma("unroll") for (int ai = 0; ai < 2; ++ai) {
        if (u.pm * 256 + 128 * ai >= MTOT) continue;
        _Pragma("unroll") for (int m = 0; m < 4; ++m) {
          const int row = rbase + 128 * ai + 16 * m;
          pf4 a00 = acc[ai][0][m][0], a01 = acc[ai][0][m][1], a10 = acc[ai][1][m][0], a11 = acc[ai][1][m][1];
          if (!isv) {
            float ss = 0.f;
            _Pragma("unroll") for (int j = 0; j < 4; ++j) ss += a00[j] * a00[j] + a01[j] * a01[j] + a10[j] * a10[j] + a11[j] * a11[j];
            ss += __shfl_xor(ss, 16); ss += __shfl_xor(ss, 32);
            const float sc = rsqrtf(ss * (1.f / 64.f) + EPS);
            a00[0] *= sc * g00.x; a00[1] *= sc * g00.y; a00[2] *= sc * g00.z; a00[3] *= sc * g00.w;
            a01[0] *= sc * g01.x; a01[1] *= sc * g01.y; a01[2] *= sc * g01.z; a01[3] *= sc * g01.w;
            a10[0] *= sc * g10.x; a10[1] *= sc * g10.y; a10[2] *= sc * g10.z; a10[3] *= sc * g10.w;
            a11[0] *= sc * g11.x; a11[1] *= sc * g11.y; a11[2] *= sc * g11.z; a11[3] *= sc * g11.w;
            if (fq < 2) {
              const float pos = (float)(row < SEQ ? row : SEQ);
              const float invlo[4] = {1.0f, 0.19392274f, 0.03760603f, 0.0072926646f};
              const float invhi[4] = {0.0014142136f, 0.0002742482f, 5.3182957e-05f, 1.0313385e-05f};
              _Pragma("unroll") for (int j = 0; j < 4; ++j) {
                const float inv = (fq & 1) ? invhi[j] : invlo[j];
                float s_, c_; sincos_red(pos * inv, s_, c_);
                const float x1 = a00[j], x2 = a01[j];
                a00[j] = x1 * c_ - x2 * s_; a01[j] = x2 * c_ + x1 * s_;
              }
            }
          }
          if (isq) {
            bfr* qp = p.Q + (size_t)row * 512 + (4 * pn + wc) * 64;
            *(u32x2*)(qp + d0) = pack4(a00[0] * 0.125f, a00[1] * 0.125f, a00[2] * 0.125f, a00[3] * 0.125f);
            *(u32x2*)(qp + d0 + 8) = pack4(a01[0] * 0.125f, a01[1] * 0.125f, a01[2] * 0.125f, a01[3] * 0.125f);
            u32x4 o; o[0] = pk2(a10[0] * 0.125f, a10[1] * 0.125f); o[1] = pk2(a10[2] * 0.125f, a10[3] * 0.125f);
            o[2] = pk2(a11[0] * 0.125f, a11[1] * 0.125f); o[3] = pk2(a11[2] * 0.125f, a11[3] * 0.125f);
            *(u32x4*)(qp + d1) = o;
          } else {
            const int jh = wc & 1;
            bfr* kp = (isv ? p.Vb : p.Kb) + (size_t)row * 128 + jh * 64;
            *(u32x2*)(kp + d0) = pack4(a00[0], a00[1], a00[2], a00[3]);
            *(u32x2*)(kp + d0 + 8) = pack4(a01[0], a01[1], a01[2], a01[3]);
            u32x4 o; o[0] = pk2(a10[0], a10[1]); o[1] = pk2(a10[2], a10[3]); o[2] = pk2(a11[0], a11[1]); o[3] = pk2(a11[2], a11[3]);
            *(u32x4*)(kp + d1) = o;
            float* op = nullptr;
            if (row >= SEQ) op = (isv ? p.out_vs : p.out_ks) + ((size_t)((row - SEQ) * 128 + 127) * 2 + jh) * 64;
            else if (row >= SEQ - 128) op = (isv ? p.out_vp : p.out_kp) + ((size_t)(row - (SEQ - 128)) * 2 + jh) * 64;
            if (op) {
              *(pf4*)(op + d0) = a00; *(pf4*)(op + d0 + 8) = a01; *(pf4*)(op + d1) = a10; *(pf4*)(op + d1 + 4) = a11;
            }
          }
        }
      }
      return;
    }
    const int cw = 32 * wc + 8 * fq;
    if (pn == 7 || pn == 8) {
      _Pragma("unroll") for (int ai = 0; ai < 2; ++ai) {
        if (u.pm * 256 + 128 * ai >= MTOT) continue;
        _Pragma("unroll") for (int m = 0; m < 4; ++m) {
          const int row = rbase + 128 * ai + 16 * m;
          _Pragma("unroll") for (int bj = 0; bj < 2; ++bj) {
            float* zp = p.ZF + (size_t)row * 512 + (pn - 7) * 256 + 128 * bj + cw;
            *(pf4*)zp = acc[ai][bj][m][0]; *(pf4*)(zp + 4) = acc[ai][bj][m][1];
          }
        }
      }
      return;
    }
    bfr* dst; int ld, col, op;
    if (pn < 5) { dst = p.ZA; ld = 512; col = (pn - 3) * 256; op = 1; }
    else if (pn < 7) { dst = p.QB; ld = 512; col = (pn - 5) * 256; op = 0; }
    else if (pn < 11) { dst = p.IB; ld = 512; col = (pn - 9) * 256; op = 0; }
    else if (pn < 13) { dst = p.ZB; ld = 512; col = (pn - 11) * 256; op = 1; }
    else if (pn < 17) { dst = p.GA; ld = 1024; col = (pn - 13) * 256; op = 2; }
    else { dst = p.GB; ld = 1024; col = (pn - 17) * 256; op = 2; }
    _Pragma("unroll") for (int bj = 0; bj < 2; ++bj) {
      float4 b0 = {0.f, 0.f, 0.f, 0.f}, b1 = b0;
      if (op == 2) { const float* bp = p.b_merge + (pn - 13) * 256 + 128 * bj + cw; b0 = *(const float4*)bp; b1 = *(const float4*)(bp + 4); }
      _Pragma("unroll") for (int ai = 0; ai < 2; ++ai) {
        if (u.pm * 256 + 128 * ai >= MTOT) continue;
        _Pragma("unroll") for (int m = 0; m < 4; ++m) {
          const int row = rbase + 128 * ai + 16 * m;
          pf4 x = acc[ai][bj][m][0], y = acc[ai][bj][m][1];
          if (op == 1) { _Pragma("unroll") for (int j = 0; j < 4; ++j) { x[j] = siluf_(x[j]); y[j] = siluf_(y[j]); } }
          else if (op == 2) {
            x[0] = sigmoidf_(x[0] + b0.x); x[1] = sigmoidf_(x[1] + b0.y); x[2] = sigmoidf_(x[2] + b0.z); x[3] = sigmoidf_(x[3] + b0.w);
            y[0] = sigmoidf_(y[0] + b1.x); y[1] = sigmoidf_(y[1] + b1.y); y[2] = sigmoidf_(y[2] + b1.z); y[3] = sigmoidf_(y[3] + b1.w);
          }
          u32x4 o; o[0] = pk2(x[0], x[1]); o[1] = pk2(x[2], x[3]); o[2] = pk2(y[0], y[1]); o[3] = pk2(y[2], y[3]);
          *(u32x4*)(dst + (size_t)row * ld + col + 128 * bj + cw) = o;
        }
      }
    }
  }
};

template <int PASS> struct EpiMerge {
  static constexpr bool PERM = true, AFTER_DRAIN = false;
  const Params& p;
  DI void operator()(const pf4 (&acc)[2][2][4][2], const pg8::Unit& u, int wr, int wc, int fr, int fq) const {
    const int rbase = u.pm * 256 + wr * 64 + fr, cbase = u.pn * 256 + 32 * wc + 8 * fq;
    const bfr* G = PASS == 0 ? p.GA : p.GB;
    _Pragma("unroll") for (int ai = 0; ai < 2; ++ai) _Pragma("unroll") for (int m = 0; m < 4; ++m) _Pragma("unroll") for (int bj = 0; bj < 2; ++bj) {
      const size_t off = (size_t)(rbase + 128 * ai + 16 * m) * 1024 + cbase + 128 * bj;
      const u32x4 g = *(const u32x4*)(G + off);
      const pf4 x = acc[ai][bj][m][0], y = acc[ai][bj][m][1];
      float r[8] = {bflo(g[0]) * x[0], bfhi(g[0]) * x[1], bflo(g[1]) * x[2], bfhi(g[1]) * x[3], bflo(g[2]) * y[0], bfhi(g[2]) * y[1], bflo(g[3]) * y[2], bfhi(g[3]) * y[3]};
      if (PASS == 1) {
        const u32x4 t = *(const u32x4*)(p.Y + off);
        r[0] += bflo(t[0]); r[1] += bfhi(t[0]); r[2] += bflo(t[1]); r[3] += bfhi(t[1]); r[4] += bflo(t[2]); r[5] += bfhi(t[2]); r[6] += bflo(t[3]); r[7] += bfhi(t[3]);
      }
      u32x4 o; o[0] = pk2(r[0], r[1]); o[1] = pk2(r[2], r[3]); o[2] = pk2(r[4], r[5]); o[3] = pk2(r[6], r[7]);
      *(u32x4*)(p.Y + off) = o;
    }
  }
};

struct EpiOut {
  static constexpr bool PERM = false, AFTER_DRAIN = false;
  const Params& p;
  DI void operator()(const pf4 (&acc)[2][2][4][2], const pg8::Unit& u, int wr, int wc, int fr, int fq) const {
    const int rbase = u.pm * 256 + wr * 64 + fr, cbase = u.pn * 256 + 32 * wc + 4 * fq;
    const float* gr = p.mod + (size_t)128 * 3072 + 2048;
    _Pragma("unroll") for (int bj = 0; bj < 2; ++bj) _Pragma("unroll") for (int n = 0; n < 2; ++n) {
      const int c = cbase + 128 * bj + 16 * n;
      const pf4 gt = *(const pf4*)(gr + c);
      _Pragma("unroll") for (int ai = 0; ai < 2; ++ai) _Pragma("unroll") for (int m = 0; m < 4; ++m) {
        const size_t off = (size_t)(rbase + 128 * ai + 16 * m) * DM + c;
        const pf4 xv = *(const pf4*)(p.x_prompt + off);
        *(pf4*)(p.out_yp + off) = xv + gt * acc[ai][bj][m][n];
      }
    }
  }
};

DI f32x16 wave_gemm32(const bfr* __restrict__ A, int lda, const bfr* __restrict__ W, int ldw, int K, int lane) {
  const int r = lane & 31, h = lane >> 5;
  const bfr* ap = A + (size_t)r * lda + 8 * h;
  const bfr* wp = W + (size_t)r * ldw + 8 * h;
  f32x16 acc = zero16();
  for (int k0 = 0; k0 < K; k0 += 128) {
    bf16x8 a[8], b[8];
    _Pragma("unroll") for (int q = 0; q < 8; ++q) { a[q] = *(const bf16x8*)(ap + k0 + 16 * q); b[q] = *(const bf16x8*)(wp + k0 + 16 * q); }
    _Pragma("unroll") for (int q = 0; q < 8; ++q) acc = mfma(b[q], a[q], acc);
  }
  return acc;
}

DI void sample_chain_wave(const Params& p, int wt, int lane) {
  const int mt = wt >> 5, nt = wt & 31, r = lane & 31, h = lane >> 5;
  const int m = 32 * mt + r;
  unsigned* cnt = p.bar + PANEL_CNT_WORD + 64 * mt;
  {
    const f32x16 a1 = wave_gemm32(p.YA + (size_t)(SEQ + 32 * mt) * 512, 512, p.Wt_pa + (size_t)(32 * nt) * 512, 512, 512, lane);
    const f32x16 a2 = wave_gemm32(p.YB + (size_t)(SEQ + 32 * mt) * 512, 512, p.Wt_pb + (size_t)(32 * nt) * 512, 512, 512, lane);
    _Pragma("unroll") for (int g = 0; g < 4; ++g) {
      const int n = 32 * nt + 8 * g + 4 * h;
      const u32x2 ga = *(const u32x2*)(p.GA + (size_t)(SEQ + m) * 1024 + n), gb = *(const u32x2*)(p.GB + (size_t)(SEQ + m) * 1024 + n);
      *(u32x2*)(p.Ys + (size_t)m * 1024 + n) = pack4(bflo(ga[0]) * a1[4 * g] + bflo(gb[0]) * a2[4 * g], bfhi(ga[0]) * a1[4 * g + 1] + bfhi(gb[0]) * a2[4 * g + 1],
                                                     bflo(ga[1]) * a1[4 * g + 2] + bflo(gb[1]) * a2[4 * g + 2], bfhi(ga[1]) * a1[4 * g + 3] + bfhi(gb[1]) * a2[4 * g + 3]);
    }
    __builtin_amdgcn_fence(__ATOMIC_RELEASE, "agent");
    asm volatile("s_waitcnt vmcnt(0)" ::: "memory");
    if (lane == 0) __hip_atomic_fetch_add(cnt, 1u, __ATOMIC_RELAXED, __HIP_MEMORY_SCOPE_AGENT);
  }
  {
    unsigned sp = 0;
    while (__hip_atomic_load(cnt, __ATOMIC_RELAXED, __HIP_MEMORY_SCOPE_AGENT) < 32u) { __builtin_amdgcn_s_sleep(2); if (++sp > (1u << 22)) break; }
    __builtin_amdgcn_fence(__ATOMIC_ACQUIRE, "agent");
    asm volatile("s_waitcnt vmcnt(0)" ::: "memory");
  }
  const f32x16 acc = wave_gemm32(p.Ys + (size_t)(32 * mt) * 1024, 1024, p.Wt_out + (size_t)(32 * nt) * 1024, 1024, 1024, lane);
  _Pragma("unroll") for (int g = 0; g < 4; ++g) {
    const int n = 32 * nt + 8 * g + 4 * h;
    const float4 xv = *(const float4*)(p.x_sample + (size_t)m * DM + n), gt = *(const float4*)(p.mod + (size_t)m * 3072 + 2048 + n);
    float4 o;
    o.x = xv.x + gt.x * acc[4 * g]; o.y = xv.y + gt.y * acc[4 * g + 1]; o.z = xv.z + gt.z * acc[4 * g + 2]; o.w = xv.w + gt.w * acc[4 * g + 3];
    *(float4*)(p.out_ys + (size_t)m * DM + n) = o;
  }
}

DI void attn_prompt_item(const Params& p, int qb, int hd, bfr* sVt  ) {
  const int t = TID, lane = t & 63, w = t >> 6, r = lane & 31, h = lane >> 5;
  const int j = hd >> 2, kb0 = qb * 128 - 128;
  __syncthreads();
  _Pragma("unroll") for (int it = 0; it < 8; ++it) {
    int kl = it * 32 + (t & 31), dg = t >> 5, kpos = kb0 + kl;
    u32x4 v = {0u, 0u, 0u, 0u};
    if (kpos >= 0) v = *(const u32x4*)(p.Vb + (size_t)kpos * 128 + j * 64 + dg * 8);
    _Pragma("unroll") for (int e = 0; e < 8; ++e) sVt[(dg * 8 + e) * 264 + kl] = (bfr)((v[e >> 1] >> ((e & 1) * 16)) & 0xffffu);
  }
  __syncthreads();
  const int q0 = qb * 128 + 32 * w, q = q0 + r;
  bf16x8 qf[4];
  _Pragma("unroll") for (int s = 0; s < 4; ++s) qf[s] = *(const bf16x8*)(p.Q + (size_t)q * 512 + hd * 64 + 16 * s + 8 * h);
  f32x16 sacc[5];
  _Pragma("unroll") for (int kt = 0; kt < 5; ++kt) {
    sacc[kt] = zero16();
    int kr = q0 - 128 + 32 * kt + r; kr = kr < 0 ? 0 : kr;
    _Pragma("unroll") for (int s = 0; s < 4; ++s) {
      bf16x8 kf = *(const bf16x8*)(p.Kb + (size_t)kr * 128 + j * 64 + 16 * s + 8 * h);
      sacc[kt] = mfma(kf, qf[s], sacc[kt]);
    }
  }
  const float sink = p.sinks[hd];
  float mx = sink;
  _Pragma("unroll") for (int kt = 0; kt < 5; ++kt) _Pragma("unroll") for (int i = 0; i < 16; ++i) {
    int key = q0 - 128 + 32 * kt + crow(i, h), rel = q - key;
    bool valid = (rel >= 0) && (rel < 128) && (key >= 0);
    float sv = valid ? sacc[kt][i] : -INFINITY;
    sacc[kt][i] = sv; mx = fmaxf(mx, sv);
  }
  mx = fmaxf(mx, __shfl_xor(mx, 32));
  float l = 0.f;
  _Pragma("unroll") for (int kt = 0; kt < 5; ++kt) _Pragma("unroll") for (int i = 0; i < 16; ++i) {
    float pv = __expf(sacc[kt][i] - mx); sacc[kt][i] = pv; l += pv;
  }
  l += __shfl_xor(l, 32);
  l += __expf(sink - mx);
  f32x16 oacc[2]; oacc[0] = zero16(); oacc[1] = zero16();
  _Pragma("unroll") for (int kt = 0; kt < 5; ++kt) _Pragma("unroll") for (int s2 = 0; s2 < 2; ++s2) {
    u32x4 pp;
    _Pragma("unroll") for (int e = 0; e < 4; ++e) pp[e] = pk2(sacc[kt][8 * s2 + 2 * e], sacc[kt][8 * s2 + 2 * e + 1]);
    bf16x8 pf = __builtin_bit_cast(bf16x8, pp);
    _Pragma("unroll") for (int dt = 0; dt < 2; ++dt) {
      const bfr* vp = sVt + (dt * 32 + r) * 264 + 32 * w + 32 * kt + 16 * s2 + 4 * h;
      u32x2 lo = *(const u32x2*)vp, hi = *(const u32x2*)(vp + 8);
      u32x4 vv; vv[0] = lo[0]; vv[1] = lo[1]; vv[2] = hi[0]; vv[3] = hi[1];
      oacc[dt] = mfma(__builtin_bit_cast(bf16x8, vv), pf, oacc[dt]);
    }
  }
  const float il = 1.f / l;
  _Pragma("unroll") for (int dt = 0; dt < 2; ++dt) _Pragma("unroll") for (int g = 0; g < 4; ++g) {
    int d = dt * 32 + 8 * g + 4 * h;
    size_t off = (size_t)q * 512 + hd * 64 + d;
    u32x2 za = *(const u32x2*)(p.ZA + off);
    *(u32x2*)(p.YA + off) = pack4(oacc[dt][4 * g] * il * bflo(za[0]), oacc[dt][4 * g + 1] * il * bfhi(za[0]),
                                  oacc[dt][4 * g + 2] * il * bflo(za[1]), oacc[dt][4 * g + 3] * il * bfhi(za[1]));
  }
}

DI void attn_sample_wave(const Params& p, int b, int hd) {
  const int lane = TID & 63, j = hd >> 2, m = SEQ + b;
  u32x4 qv[8];
  _Pragma("unroll") for (int i = 0; i < 8; ++i) qv[i] = *(const u32x4*)(p.Q + (size_t)m * 512 + hd * 64 + 8 * i);
  float dn = 0.f;
  _Pragma("unroll") for (int i = 0; i < 8; ++i) {
    u32x4 kv = *(const u32x4*)(p.Kb + (size_t)m * 128 + j * 64 + 8 * i);
    _Pragma("unroll") for (int e = 0; e < 4; ++e) dn += bflo(qv[i][e]) * bflo(kv[e]) + bfhi(qv[i][e]) * bfhi(kv[e]);
  }
  float s[2];
  _Pragma("unroll") for (int u = 0; u < 2; ++u) {
    int idx = lane + 1 + 64 * u;
    int ic = idx < 128 ? idx : 127;
    const float* kp = p.cache_k + ((size_t)(b * 128 + ic) * 2 + j) * 64;
    float d = 0.f;
    _Pragma("unroll") for (int i = 0; i < 8; ++i) {
      float4 k0 = *(const float4*)(kp + 8 * i), k1 = *(const float4*)(kp + 8 * i + 4);
      d += bflo(qv[i][0]) * k0.x + bfhi(qv[i][0]) * k0.y + bflo(qv[i][1]) * k0.z + bfhi(qv[i][1]) * k0.w;
      d += bflo(qv[i][2]) * k1.x + bfhi(qv[i][2]) * k1.y + bflo(qv[i][3]) * k1.z + bfhi(qv[i][3]) * k1.w;
    }
    s[u] = idx < 128 ? d : dn;
  }
  const float sink = p.sinks[hd];
  float mx = fmaxf(fmaxf(s[0], s[1]), sink);
  _Pragma("unroll") for (int o = 32; o >= 1; o >>= 1) mx = fmaxf(mx, __shfl_xor(mx, o));
  float p0 = __expf(s[0] - mx), p1 = __expf(s[1] - mx);
  float l = p0 + p1;
  _Pragma("unroll") for (int o = 32; o >= 1; o >>= 1) l += __shfl_xor(l, o);
  l += __expf(sink - mx);
  float o = 0.f;
  const float* vb = p.cache_v + ((size_t)(b * 128) * 2 + j) * 64 + lane;
  _Pragma("unroll 32") for (int idx = 1; idx < 128; ++idx) {
    float pv = __shfl(idx <= 64 ? p0 : p1, (idx - 1) & 63);
    o += pv * vb[(size_t)idx * 128];
  }
  o += __shfl(p1, 63) * bf2f(p.Vb[(size_t)m * 128 + j * 64 + lane]);
  size_t off = (size_t)m * 512 + hd * 64 + lane;
  p.YA[off] = (bfr)f2bf(o / l * bf2f(p.ZA[off]));
}

DI void hgrn_gates(const Params& p, int row0, int hh, float* sTot, float (&L)[32], float (&kin)[32], float& t0, float& lc) {
  const int t = TID, c = t & 127, half = t >> 7, ch = hh * 128 + c;
  const float lbv = 1.f / (1.f + __expf(p.lb_logits[512 + ch] - p.lb_logits[ch]));
  const float* zp = p.ZF + (size_t)(row0 + half * 32) * 512 + ch;
  float run = 0.f;
  _Pragma("unroll") for (int jj = 0; jj < 32; ++jj) {
    float z = zp[(size_t)jj * 512];
    z = fminf(fmaxf(z, -30.f), 30.f);
    float em = __expf(-z), sg = 1.f / (1.f + em);
    float f = lbv + (1.f - lbv) * sg;
    kin[jj] = (1.f - lbv) * em * sg;
    run += __logf(f);
    L[jj] = run;
  }
  sTot[half * 128 + c] = run;
  __syncthreads();
  t0 = sTot[c]; lc = t0 + sTot[128 + c];
  if (half) { _Pragma("unroll") for (int jj = 0; jj < 32; ++jj) L[jj] += t0; }
}

DI void hgrn_local_item(const Params& p, int n, int hh, char* smem) {
  bfr* sKt = (bfr*)smem; bfr* sVt = sKt + 128 * LDT; float* sTot = (float*)(sVt + 128 * LDT);
  const int t = TID, lane = t & 63, w = t >> 6, r = lane & 31, h = lane >> 5, c = t & 127, half = t >> 7;
  const int row0 = n * 64;
  __syncthreads();
  float L[32], kin[32], t0, lc;
  hgrn_gates(p, row0, hh, sTot, L, kin, t0, lc);
  _Pragma("unroll") for (int q4 = 0; q4 < 4; ++q4) {
    u32x4 o;
    _Pragma("unroll") for (int e = 0; e < 4; ++e) {
      int jj = q4 * 8 + 2 * e;
      o[e] = pk2(kin[jj] * __expf(lc - L[jj]), kin[jj + 1] * __expf(lc - L[jj + 1]));
    }
    *(u32x4*)(sKt + c * LDT + half * 32 + q4 * 8) = o;
  }
  const bfr* ip = p.IB + (size_t)(row0 + half * 32) * 512 + hh * 128 + c;
  _Pragma("unroll") for (int q4 = 0; q4 < 4; ++q4) {
    u32x4 o;
    _Pragma("unroll") for (int e = 0; e < 4; ++e) {
      int jj = q4 * 8 + 2 * e;
      o[e] = (unsigned)ip[(size_t)jj * 512] | ((unsigned)ip[(size_t)(jj + 1) * 512] << 16);
    }
    *(u32x4*)(sVt + c * LDT + half * 32 + q4 * 8) = o;
  }
  if (half == 0) p.dec[(n * 4 + hh) * 128 + c] = __expf(lc);
  __syncthreads();
  const int wv = w >> 1, wk = w & 1;
  f32x16 acc[2][2];
  _Pragma("unroll") for (int a = 0; a < 2; ++a) _Pragma("unroll") for (int b = 0; b < 2; ++b) acc[a][b] = zero16();
  _Pragma("unroll") for (int s = 0; s < 4; ++s) {
    bf16x8 af[2], bf[2];
    _Pragma("unroll") for (int x = 0; x < 2; ++x) {
      af[x] = *(const bf16x8*)(sVt + (wv * 64 + x * 32 + r) * LDT + 16 * s + 8 * h);
      bf[x] = *(const bf16x8*)(sKt + (wk * 64 + x * 32 + r) * LDT + 16 * s + 8 * h);
    }
    _Pragma("unroll") for (int a = 0; a < 2; ++a) _Pragma("unroll") for (int b = 0; b < 2; ++b) acc[a][b] = mfma(af[a], bf[b], acc[a][b]);
  }
  float* up = p.Ust + (size_t)(n * 4 + hh) * 16384;
  _Pragma("unroll") for (int a = 0; a < 2; ++a) _Pragma("unroll") for (int b = 0; b < 2; ++b) _Pragma("unroll") for (int i = 0; i < 16; ++i) {
    int v = wv * 64 + a * 32 + crow(i, h), k = wk * 64 + b * 32 + r;
    up[v * 128 + k] = acc[a][b][i];
  }
}

DI void hgrn_sample_item(const Params& p, int b, int hh, char* smem) {
  float* sf = (float*)smem; float* skin = sf + 128; float* sq = skin + 128; float* sv = sq + 128; float* sred = sv + 128; float* s2 = sred + 8 * 128;
  const int t = TID, m = SEQ + b;
  __syncthreads();
  if (t < 128) {
    int ch = hh * 128 + t;
    float lbv = 1.f / (1.f + __expf(p.lb_logits[512 + ch] - p.lb_logits[ch]));
    float z = p.ZF[(size_t)m * 512 + ch];
    z = fminf(fmaxf(z, -30.f), 30.f);
    float em = __expf(-z), sg = 1.f / (1.f + em);
    sf[t] = lbv + (1.f - lbv) * sg; skin[t] = (1.f - lbv) * em * sg;
    sq[t] = bf2f(p.QB[(size_t)m * 512 + ch]); sv[t] = bf2f(p.IB[(size_t)m * 512 + ch]);
  }
  __syncthreads();
  const int v4 = (t & 31) * 4, kg = t >> 5;
  float4 vv = *(const float4*)(sv + v4);
  float4 o = {0.f, 0.f, 0.f, 0.f};
  const size_t sb = (size_t)(b * 4 + hh) * 16384;
  _Pragma("unroll 8") for (int kk = 0; kk < 16; ++kk) {
    int k = kg * 16 + kk;
    float4 S = *(const float4*)(p.state + sb + k * 128 + v4);
    float f = sf[k], ki = skin[k], qq = sq[k];
    float4 Sn; Sn.x = f * S.x + ki * vv.x; Sn.y = f * S.y + ki * vv.y; Sn.z = f * S.z + ki * vv.z; Sn.w = f * S.w + ki * vv.w;
    *(float4*)(p.out_ss + sb + k * 128 + v4) = Sn;
    o.x += qq * Sn.x; o.y += qq * Sn.y; o.z += qq * Sn.z; o.w += qq * Sn.w;
  }
  *(float4*)(sred + kg * 128 + v4) = o;
  __syncthreads();
  float ov = 0.f;
  if (t < 128) {
    _Pragma("unroll") for (int g = 0; g < 8; ++g) ov += sred[g * 128 + t];
    float ss = ov * ov;
    _Pragma("unroll") for (int of = 32; of >= 1; of >>= 1) ss += __shfl_xor(ss, of);
    if ((t & 63) == 0) s2[t >> 6] = ss;
  }
  __syncthreads();
  if (t < 128) {
    float sc = rsqrtf((s2[0] + s2[1]) * (1.f / 128.f) + EPS);
    size_t off = (size_t)m * 512 + hh * 128 + t;
    p.YB[off] = (bfr)f2bf(ov * sc * p.og[t] * bf2f(p.ZB[off]));
  }
}

DI void phase_mix(const Params& p, char* smem) {
  for (int it = VBID; it < 1024; it += VGRID) attn_prompt_item(p, it >> 3, it & 7, (bfr*)smem);
  for (int it = VBID; it < 1024; it += VGRID) hgrn_local_item(p, it >> 2, it & 3, smem);
  for (int it = VBID; it < 512; it += VGRID) hgrn_sample_item(p, it >> 2, it & 3, smem);
  for (int it = VBID * 4 + (TID >> 6); it < 1024; it += VGRID * 4) attn_sample_wave(p, it >> 3, it & 7);
  for (int idx = VBID * 256 + TID; idx < 128 * 4064; idx += VGRID * 256) {
    int b = idx / 4064, i4 = idx - b * 4064;
    size_t so = (size_t)b * 16384 + 128 + i4 * 4, dof = (size_t)b * 16384 + i4 * 4;
    *(float4*)(p.out_ks + dof) = *(const float4*)(p.cache_k + so);
    *(float4*)(p.out_vs + dof) = *(const float4*)(p.cache_v + so);
  }
}

#define SCAN_LOAD(U, Dd, N0) _Pragma("unroll") for (int i = 0; i < 32; ++i) { U[i] = up[(size_t)((N0) + i) * 65536]; Dd[i] = dp[((N0) + i) * 512]; }
#define SCAN_STEP(U, Dd, N0) _Pragma("unroll") for (int i = 0; i < 32; ++i) { up[(size_t)((N0) + i) * 65536] = S; S = Dd[i] * S + U[i]; }
DI void phase_scan(const Params& p, int eb) {
  const int e = eb * 256 + threadIdx.x;
  const int hh = e >> 14, k = e & 127, v = (e >> 7) & 127;
  float* up = p.Ust + e;
  const float* dp = p.dec + hh * 128 + k;
  float S = 0.f;
  float ua[32], da[32], ub[32], db[32];
  SCAN_LOAD(ua, da, 0)
  for (int n0 = 0; n0 < NCH; n0 += 64) {
    SCAN_LOAD(ub, db, n0 + 32)
    SCAN_STEP(ua, da, n0)
    if (n0 + 64 < NCH) { SCAN_LOAD(ua, da, n0 + 64) }
    SCAN_STEP(ub, db, n0 + 32)
  }
  p.out_sp[(hh * 128 + k) * 128 + v] = S;
}

DI void hgrn_out_item(const Params& p, int n, int hh, char* smem) {
  bfr* sQh = (bfr*)smem;
  bfr* sKh = sQh + 64 * 136;
  bfr* sVt = sKh + 64 * 136;
  bfr* sAm = sVt + 128 * LDT;
  float* sTot = (float*)(sAm + 64 * LDT);
  float* sEm = sTot + 256;
  float* sRed = sEm + 128;
  const int t = TID, lane = t & 63, w = t >> 6, r = lane & 31, h = lane >> 5, c = t & 127, half = t >> 7;
  const int row0 = n * 64;
  __syncthreads();
  {
    float L[32], kin[32], t0, lc;
    hgrn_gates(p, row0, hh, sTot, L, kin, t0, lc);
    const bfr* qp = p.QB + (size_t)(row0 + half * 32) * 512 + hh * 128 + c;
    _Pragma("unroll") for (int jj = 0; jj < 32; ++jj) {
      float dl = L[jj] - t0;
      float eq = __expf(fminf(dl, 80.f)), ek = __expf(fminf(-dl, 80.f));
      float qv = bf2f(qp[(size_t)jj * 512]);
      sQh[(half * 32 + jj) * 136 + c] = (bfr)f2bf(qv * eq);
      sKh[(half * 32 + jj) * 136 + c] = (bfr)f2bf(kin[jj] * ek);
    }
    if (half == 0) sEm[c] = __expf(t0);
  }
  const bfr* ip = p.IB + (size_t)(row0 + half * 32) * 512 + hh * 128 + c;
  _Pragma("unroll") for (int q4 = 0; q4 < 4; ++q4) {
    u32x4 o;
    _Pragma("unroll") for (int e = 0; e < 4; ++e) {
      int jj = q4 * 8 + 2 * e;
      o[e] = (unsigned)ip[(size_t)jj * 512] | ((unsigned)ip[(size_t)(jj + 1) * 512] << 16);
    }
    *(u32x4*)(sVt + c * LDT + half * 32 + q4 * 8) = o;
  }
  __syncthreads();
  {
    const int jt = w >> 1, it = w & 1;
    f32x16 a = zero16();
    if (jt <= it) {
      _Pragma("unroll") for (int s = 0; s < 8; ++s) {
        bf16x8 kf = *(const bf16x8*)(sKh + (jt * 32 + r) * 136 + 16 * s + 8 * h);
        bf16x8 qf = *(const bf16x8*)(sQh + (it * 32 + r) * 136 + 16 * s + 8 * h);
        a = mfma(kf, qf, a);
      }
    }
    const int i = it * 32 + r;
    _Pragma("unroll") for (int g = 0; g < 4; ++g) {
      int j0 = jt * 32 + 8 * g + 4 * h;
      float x0 = (j0 <= i) ? a[4 * g] : 0.f, x1 = (j0 + 1 <= i) ? a[4 * g + 1] : 0.f;
      float x2 = (j0 + 2 <= i) ? a[4 * g + 2] : 0.f, x3 = (j0 + 3 <= i) ? a[4 * g + 3] : 0.f;
      *(u32x2*)(sAm + i * LDT + j0) = pack4(x0, x1, x2, x3);
    }
  }
  __syncthreads();
  f32x16 oacc[2]; oacc[0] = zero16(); oacc[1] = zero16();
  {
    const float* sp = p.Ust + (size_t)(n * 4 + hh) * 16384 + (size_t)(32 * w + r) * 128;
    _Pragma("unroll") for (int s = 0; s < 8; ++s) {
      float4 a0 = *(const float4*)(sp + 16 * s + 8 * h), a1 = *(const float4*)(sp + 16 * s + 8 * h + 4);
      float4 e0 = *(const float4*)(sEm + 16 * s + 8 * h), e1 = *(const float4*)(sEm + 16 * s + 8 * h + 4);
      u32x4 pa; pa[0] = pk2(a0.x * e0.x, a0.y * e0.y); pa[1] = pk2(a0.z * e0.z, a0.w * e0.w);
      pa[2] = pk2(a1.x * e1.x, a1.y * e1.y); pa[3] = pk2(a1.z * e1.z, a1.w * e1.w);
      bf16x8 af = __builtin_bit_cast(bf16x8, pa);
      _Pragma("unroll") for (int it = 0; it < 2; ++it) {
        bf16x8 qf = *(const bf16x8*)(sQh + (it * 32 + r) * 136 + 16 * s + 8 * h);
        oacc[it] = mfma(af, qf, oacc[it]);
      }
    }
    _Pragma("unroll") for (int s = 0; s < 4; ++s) {
      bf16x8 vf = *(const bf16x8*)(sVt + (32 * w + r) * LDT + 16 * s + 8 * h);
      _Pragma("unroll") for (int it = 0; it < 2; ++it) {
        bf16x8 af2 = *(const bf16x8*)(sAm + (it * 32 + r) * LDT + 16 * s + 8 * h);
        oacc[it] = mfma(vf, af2, oacc[it]);
      }
    }
  }
  _Pragma("unroll") for (int it = 0; it < 2; ++it) {
    float ss = 0.f;
    _Pragma("unroll") for (int i = 0; i < 16; ++i) ss += oacc[it][i] * oacc[it][i];
    ss += __shfl_xor(ss, 32);
    if (h == 0) sRed[w * 64 + it * 32 + r] = ss;
  }
  __syncthreads();
  _Pragma("unroll") for (int it = 0; it < 2; ++it) {
    const int i = it * 32 + r;
    float tot = sRed[i] + sRed[64 + i] + sRed[128 + i] + sRed[192 + i];
    float sc = rsqrtf(tot * (1.f / 128.f) + EPS);
    _Pragma("unroll") for (int g = 0; g < 4; ++g) {
      int v = 32 * w + 8 * g + 4 * h;
      size_t off = (size_t)(row0 + i) * 512 + hh * 128 + v;
      float4 og = *(const float4*)(p.og + v);
      u32x2 zb = *(const u32x2*)(p.ZB + off);
      *(u32x2*)(p.YB + off) = pack4(oacc[it][4 * g] * sc * og.x * bflo(zb[0]), oacc[it][4 * g + 1] * sc * og.y * bfhi(zb[0]),
                                    oacc[it][4 * g + 2] * sc * og.z * bflo(zb[1]), oacc[it][4 * g + 3] * sc * og.w * bfhi(zb[1]));
    }
  }
}

#define XB_TMO      128
#define XB_XCNT(j)  (256  + 64 * (j))
#define XB_XSUB(j)  (1280 + 64 * (j))
#define XB_XGEN(j)  (2304 + 64 * (j))
#define XB_TOP      3328
#define XB_TOPGEN   3392
#define XCD_BAR_WORDS 3456
#define XB_SPIN_CAP (1u << 18)
#define LAS __attribute__((address_space(3)))

__device__ __forceinline__ unsigned xb_ld(unsigned* p)              { return __hip_atomic_load(p, __ATOMIC_RELAXED, __HIP_MEMORY_SCOPE_AGENT); }
__device__ __forceinline__ unsigned xb_add(unsigned* p, unsigned v) { return __hip_atomic_fetch_add(p, v, __ATOMIC_RELAXED, __HIP_MEMORY_SCOPE_AGENT); }
__device__ __forceinline__ unsigned xb_xcc_id() { return (unsigned)__builtin_amdgcn_s_getreg((3 << 11) | 20) & 0xFu; }
#define XB_SPIN(cond, bar) do { unsigned _sp = 0; while (cond) { __builtin_amdgcn_s_sleep(1); \
    if ((++_sp & 255u) == 0u) { if (xb_ld(&(bar)[XB_TMO])) break; if (_sp > XB_SPIN_CAP) { atomicAdd(&(bar)[XB_TMO], 1u); break; } } } } while (0)

struct XcdBarrier {
    unsigned* bar; unsigned x;
    volatile LAS unsigned* st;
};

__device__ __forceinline__ XcdBarrier xcd_barrier_post(unsigned* bar, volatile LAS unsigned* st) {
    XcdBarrier b; b.bar = bar; b.x = xb_xcc_id(); b.st = st;
    if (threadIdx.x == 0) (void)xb_add(&bar[XB_XCNT(b.x)], 1u);
    return b;
}
__device__ __forceinline__ void xcd_barrier_complete(unsigned* bar, unsigned x, unsigned& nloc, unsigned& nx) {
    const unsigned G = gridDim.x * gridDim.y * gridDim.z;
    unsigned sum, cnt, mine, sp = 0u;
    for (;;) {
        sum = 0u; cnt = 0u; mine = 0u;
#pragma unroll
        for (unsigned j = 0; j < 16; ++j) { const unsigned c = xb_ld(&bar[XB_XCNT(j)]); sum += c; cnt += (c > 0u) ? 1u : 0u; mine = (j == x) ? c : mine; }
        if (sum == G) break;
        __builtin_amdgcn_s_sleep(1);
        if ((++sp & 255u) == 0u) { if (xb_ld(&bar[XB_TMO])) break; if (sp > XB_SPIN_CAP) { atomicAdd(&bar[XB_TMO], 1u); break; } }
    }
    nloc = mine > 0u ? mine : 1u; nx = cnt > 0u ? cnt : 1u;
}

__device__ __forceinline__ void xcd_barrier(const XcdBarrier& b) {
    asm volatile("s_waitcnt vmcnt(0)" ::: "memory");
    __syncthreads();
    if (threadIdx.x == 0) {
        unsigned* bar = b.bar;
        __builtin_amdgcn_s_waitcnt(0);
        unsigned nloc = b.st[0], nx = b.st[1];
        if (nloc == 0u) { xcd_barrier_complete(bar, b.x, nloc, nx); b.st[0] = nloc; b.st[1] = nx; }
        const unsigned old = xb_add(&bar[XB_XSUB(b.x)], 1u);
        const unsigned gen = old / nloc;
        if (old + 1u == (gen + 1u) * nloc) {
            __builtin_amdgcn_fence(__ATOMIC_RELEASE, "agent");
            asm volatile("s_waitcnt vmcnt(0)" ::: "memory");
            const unsigned og = xb_add(&bar[XB_TOP], 1u);
            const unsigned tg = og / nx;
            if (og + 1u == (tg + 1u) * nx) xb_add(&bar[XB_TOPGEN], 1u);
            else XB_SPIN(xb_ld(&bar[XB_TOPGEN]) == tg, bar);
            __builtin_amdgcn_fence(__ATOMIC_ACQUIRE, "agent");
            xb_add(&bar[XB_XGEN(b.x)], 1u);
            asm volatile("s_waitcnt vmcnt(0)" ::: "memory");
        } else {
            XB_SPIN(xb_ld(&bar[XB_XGEN(b.x)]) == gen, bar);
            __builtin_amdgcn_fence(__ATOMIC_ACQUIRE, "agent");
            asm volatile("s_waitcnt vmcnt(0)" ::: "memory");
        }
    }
    __syncthreads();
}

static_assert(PANEL_CNT_WORD == XCD_BAR_WORDS, "panel counters follow the barrier words");
__global__ void __launch_bounds__(512, 2) hybrid_megakernel(Params p) {
  extern __shared__ __attribute__((aligned(16))) char smem_all[];
  __shared__ uint4 xb_words;
  if (threadIdx.x == 0) xb_words = make_uint4(0u, 0u, 0u, 0u);
  __syncthreads();
  const XcdBarrier xb = xcd_barrier_post(p.bar, (volatile LAS unsigned*)&xb_words);
  char* smem = smem_all + (threadIdx.x >> 8) * 65536;
#ifndef REPMASK
#define REPMASK 0
#endif
#define RUN_PHASE(n, ...) if (p.phase_lo <= n && n <= p.phase_hi) { if (n != p.phase_lo) xcd_barrier(xb); __VA_ARGS__; if ((REPMASK >> n) & 1) { xcd_barrier(xb); __VA_ARGS__; } }
  RUN_PHASE(0, phase_prep(p, smem))
  RUN_PHASE(1, { if (VBID < 48) phase_mod(p, smem); else phase_prep2(p, smem, VBID - 48, VGRID - 48); })
  RUN_PHASE(2, phase_h(p))
  RUN_PHASE(3, {
    pg8::Gemm g{p.H, p.Wt_all, MPAD, NALL, 1024};
    pg8::StaticOrder S; S.init(MPAD, NALL, (int)gridDim.x, (int)blockIdx.x);
    EpiMain E{p};
    pg8::gemm_phase<EpiMain, pg8::StaticOrder, false>((PG8_LAS unsigned char*)smem_all, g, S, E, nullptr);
  })
  RUN_PHASE(4, phase_mix(p, smem))
  RUN_PHASE(5, {
    if (threadIdx.x < 256) { for (int eb = blockIdx.x; eb < 256; eb += gridDim.x) phase_scan(p, eb); }
    else { const int wt = blockIdx.x * 4 + ((threadIdx.x >> 6) - 4); if (wt < 128) sample_chain_wave(p, wt, threadIdx.x & 63); }
  })
  RUN_PHASE(6, {
    for (int it = VBID; it < 1024; it += VGRID) hgrn_out_item(p, it >> 2, it & 3, smem);
  })
  RUN_PHASE(7, {
    pg8::StaticOrder S; S.init(SEQ, 1024, (int)gridDim.x, (int)blockIdx.x);
    { pg8::Gemm g{p.YA, p.Wt_pa, SEQ, 1024, 512}; EpiMerge<0> E{p};
      pg8::gemm_phase<EpiMerge<0>, pg8::StaticOrder, false>((PG8_LAS unsigned char*)smem_all, g, S, E, nullptr); }
    { pg8::Gemm g{p.YB, p.Wt_pb, SEQ, 1024, 512}; EpiMerge<1> E{p};
      pg8::gemm_phase<EpiMerge<1>, pg8::StaticOrder, false>((PG8_LAS unsigned char*)smem_all, g, S, E, nullptr); }
  })
  RUN_PHASE(8, {
    pg8::Gemm g{p.Y, p.Wt_out, SEQ, 1024, 1024};
    pg8::StaticOrder S; S.init(SEQ, 1024, (int)gridDim.x, (int)blockIdx.x);
    EpiOut E{p};
    pg8::gemm_phase<EpiOut, pg8::StaticOrder, false>((PG8_LAS unsigned char*)smem_all, g, S, E, nullptr);
  })
}

#ifndef ONE_LAUNCH
#define ONE_LAUNCH 1
#endif
constexpr size_t kDynLds = 131072;

extern "C" void kernel_launch(void* const* d_in, const int* in_sizes, int n_in, void* d_out, int out_size, void* d_ws, size_t ws_size,
                              hipStream_t stream) {
  static int grid_blocks = 0;
  if (!grid_blocks) {
    int dev = 0, cus = 0, per_cu = 0;
    (void)hipGetDevice(&dev);
    (void)hipDeviceGetAttribute(&cus, hipDeviceAttributeMultiprocessorCount, dev);
    (void)hipFuncSetAttribute((const void*)hybrid_megakernel, hipFuncAttributeMaxDynamicSharedMemorySize, (int)kDynLds);
    (void)hipOccupancyMaxActiveBlocksPerMultiprocessor(&per_cu, hybrid_megakernel, 512, kDynLds);
    if (per_cu > 1) per_cu = 1;
    if (per_cu < 1) per_cu = 1;
    grid_blocks = cus * per_cu;
  }
  Params p{};
  const float* const* in = (const float* const*)d_in;
  p.x_prompt = in[0]; p.x_sample = in[1]; p.cache_k = in[2]; p.cache_v = in[3]; p.state = in[4]; p.c_prompt = in[5]; p.c_sample = in[6];
  p.w_ada = in[7]; p.b_ada = in[8]; p.norm_g = in[9]; p.w_in = in[10]; p.qg = in[11]; p.kg = in[12]; p.sinks = in[13]; p.lb_logits = in[14];
  p.og = in[15]; p.w_merge = in[16]; p.b_merge = in[17]; p.w_pa = in[18]; p.w_pb = in[19]; p.w_out = in[20];
  float* o = (float*)d_out;
  p.out_yp = o; o += (size_t)SEQ * DM;
  p.out_ys = o; o += (size_t)NBT * DM;
  p.out_kp = o; o += 128 * 128;
  p.out_vp = o; o += 128 * 128;
  p.out_sp = o; o += 4 * 128 * 128;
  p.out_ks = o; o += (size_t)NBT * 128 * 128;
  p.out_vs = o; o += (size_t)NBT * 128 * 128;
  p.out_ss = o;
  char* wsp = (char*)d_ws;
  auto take = [&](size_t bytes) { char* r = wsp; wsp += (bytes + 255) & ~(size_t)255; return r; };
  p.bar = (unsigned*)take((size_t)(XCD_BAR_WORDS + 256) * 4);
  p.Wt_all = (bfr*)take((size_t)NALL * 1024 * 2);
  p.Wt_pa = (bfr*)take((size_t)1024 * 512 * 2);
  p.Wt_pb = (bfr*)take((size_t)1024 * 512 * 2);
  p.Wt_out = (bfr*)take((size_t)1024 * 1024 * 2);
  p.Wt_ada = (bfr*)take((size_t)3072 * 1024 * 2);
  p.Cb = (bfr*)take((size_t)256 * 1024 * 2);
  p.mod = (float*)take((size_t)256 * 3072 * 4);
  p.Ys = (bfr*)take((size_t)128 * 1024 * 2);
  p.H = (bfr*)take((size_t)MPAD * 1024 * 2);
  p.YA = p.H; p.YB = p.H + (size_t)MTOT * 512;
  p.Q = (bfr*)take((size_t)MTOT * 512 * 2);
  p.QB = (bfr*)take((size_t)MTOT * 512 * 2);
  p.Y = p.Q;
  p.Kb = (bfr*)take((size_t)MTOT * 128 * 2);
  p.Vb = (bfr*)take((size_t)MTOT * 128 * 2);
  p.ZA = (bfr*)take((size_t)MTOT * 512 * 2);
  p.IB = (bfr*)take((size_t)MTOT * 512 * 2);
  p.ZB = (bfr*)take((size_t)MTOT * 512 * 2);
  p.ZF = (float*)take((size_t)MTOT * 512 * 4);
  p.GA = (bfr*)take((size_t)MTOT * 1024 * 2);
  p.GB = (bfr*)take((size_t)MTOT * 1024 * 2);
  p.dec = (float*)take((size_t)NCH * 4 * 128 * 4);
  p.Ust = p.out_yp;
  if ((size_t)(wsp - (char*)d_ws) > ws_size) { fprintf(stderr, "workspace too small\n"); return; }
  (void)hipMemsetAsync(p.bar, 0, (size_t)(XCD_BAR_WORDS + 256) * 4, stream);
#if ONE_LAUNCH
  p.phase_lo = 0; p.phase_hi = 8;
  void* args[] = {&p};
  hipError_t e = hipLaunchCooperativeKernel((void*)hybrid_megakernel, dim3(grid_blocks), dim3(512), args, kDynLds, stream);
  if (e != hipSuccess) fprintf(stderr, "cooperative launch failed: %s (grid %d)\n", hipGetErrorString(e), grid_blocks);
#else
  for (int ph = 0; ph <= 8; ++ph) {
    p.phase_lo = ph; p.phase_hi = ph;
    hipLaunchKernelGGL(hybrid_megakernel, dim3(grid_blocks), dim3(512), kDynLds, stream, p);
  }
#endif
}
```

```cpp
#include <hip/hip_runtime.h>
#include <cstdio>

#define DI __device__ __forceinline__
typedef unsigned short bfr;
using bf16x8 = __attribute__((ext_vector_type(8))) short;
using f32x16 = __attribute__((ext_vector_type(16))) float;
using u32x4 = __attribute__((ext_vector_type(4))) unsigned;
using u32x2 = __attribute__((ext_vector_type(2))) unsigned;

constexpr int DM = 1024, SEQ = 16384, NBT = 128, MTOT = SEQ + NBT;
constexpr int NALL = 5376;
constexpr int NCH = 256;
constexpr float EPS = 1e-6f;
constexpr int PANEL_CNT_WORD = 3456;
constexpr int LDT = 72;
constexpr int MPAD = 16640;
#define TID ((int)(threadIdx.x & 255))
#define VBID ((int)(blockIdx.x * 2 + (threadIdx.x >> 8)))
#define VGRID ((int)(gridDim.x * 2))

struct Params {
  const float *x_prompt, *x_sample, *cache_k, *cache_v, *state, *c_prompt, *c_sample;
  const float *w_ada, *b_ada, *norm_g, *w_in, *qg, *kg, *sinks, *lb_logits, *og, *w_merge, *b_merge, *w_pa, *w_pb, *w_out;
  float *out_yp, *out_ys, *out_kp, *out_vp, *out_sp, *out_ks, *out_vs, *out_ss;
  bfr *Wt_all, *Wt_pab, *Wt_out, *Wt_ada, *Cb, *H, *Q, *QB, *Kb, *Vb, *ZA, *IB, *ZB, *GA, *GB, *YA, *YB, *Y;
  float *mod, *dec, *Ust;
  bfr* ZF;
  bfr* S16;
  bfr* Ys;
  unsigned* bar;
  int phase_lo, phase_hi;
};

DI unsigned f2bf(float x) { unsigned u = __float_as_uint(x); u += 0x7fffu + ((u >> 16) & 1u); return u >> 16; }
typedef __bf16 hbf2 __attribute__((ext_vector_type(2)));
typedef float hf2 __attribute__((ext_vector_type(2)));
DI unsigned pk2(float a, float b) { hf2 v = {a, b}; return __builtin_bit_cast(unsigned, __builtin_convertvector(v, hbf2)); }
DI float bf2f(unsigned b) { return __uint_as_float(b << 16); }
DI float bflo(unsigned u) { return __uint_as_float(u << 16); }
DI float bfhi(unsigned u) { return __uint_as_float(u & 0xffff0000u); }
DI int crow(int i, int h) { return (i & 3) + 8 * (i >> 2) + 4 * h; }
DI f32x16 mfma(bf16x8 a, bf16x8 b, f32x16 c) { return __builtin_amdgcn_mfma_f32_32x32x16_bf16(a, b, c, 0, 0, 0); }
DI f32x16 zero16() { f32x16 z; _Pragma("unroll") for (int i = 0; i < 16; ++i) z[i] = 0.f; return z; }
DI float sigmoidf_(float x) { return 1.f / (1.f + __expf(-x)); }
DI float siluf_(float x) { return x / (1.f + __expf(-x)); }
DI u32x2 pack4(float a, float b, float c, float d) { u32x2 r; r[0] = pk2(a, b); r[1] = pk2(c, d); return r; }

DI int wt_row_of_col(int c) {
  const int pn = c >> 8, cl = c & 255;
  int slot;
  if (pn < 3) {
    const int g = cl >> 6, d = cl & 63;
    if (d >= 32) { const int x = d - 32; slot = 128 + 32 * g + 16 * ((x >> 2) & 1) + 4 * (x >> 3) + (x & 3); }
    else { const int fq = 2 * (d >> 4) + ((d >> 2) & 1), n = (d >> 3) & 1, j = d & 3; slot = 32 * g + 16 * n + 4 * fq + j; }
  } else {
    const int bj = cl >> 7, g = (cl >> 5) & 3, x = cl & 31;
    slot = 128 * bj + 32 * g + 16 * ((x >> 2) & 1) + 4 * (x >> 3) + (x & 3);
  }
  return (pn << 8) + slot;
}

DI void gemm_mainloop(const bfr* __restrict__ A, int lda, int m0, const bfr* __restrict__ W, int ldw, int n0, int K,
                      bfr* sA, bfr* sW, f32x16 (&acc)[2][2]) {
  const int t = TID, lane = t & 63, w = t >> 6, wn = w >> 1, wm = w & 1, r = lane & 31, h = lane >> 5;
  const int lrow = t >> 3, lk = (t & 7) * 8;
  const bfr* ap = A + (size_t)(m0 + lrow) * lda + lk;
  const bfr* wp = W + (size_t)(n0 + lrow) * ldw + lk;
  u32x4 ra[4], rw[4];
  _Pragma("unroll") for (int i = 0; i < 4; ++i) {
    ra[i] = *(const u32x4*)(ap + (size_t)(32 * i) * lda);
    rw[i] = *(const u32x4*)(wp + (size_t)(32 * i) * ldw);
  }
  const int nk = K >> 6;
  for (int kt = 0; kt < nk; ++kt) {
    __syncthreads();
    _Pragma("unroll") for (int i = 0; i < 4; ++i) {
      *(u32x4*)(sA + (lrow + 32 * i) * LDT + lk) = ra[i];
      *(u32x4*)(sW + (lrow + 32 * i) * LDT + lk) = rw[i];
    }
    __syncthreads();
    if (kt + 1 < nk) {
      ap += 64; wp += 64;
      _Pragma("unroll") for (int i = 0; i < 4; ++i) {
        ra[i] = *(const u32x4*)(ap + (size_t)(32 * i) * lda);
        rw[i] = *(const u32x4*)(wp + (size_t)(32 * i) * ldw);
      }
    }
    _Pragma("unroll") for (int kk = 0; kk < 4; ++kk) {
      bf16x8 af[2], bf[2];
      _Pragma("unroll") for (int x = 0; x < 2; ++x) {
        af[x] = *(const bf16x8*)(sW + (wn * 64 + x * 32 + r) * LDT + kk * 16 + 8 * h);
        bf[x] = *(const bf16x8*)(sA + (wm * 64 + x * 32 + r) * LDT + kk * 16 + 8 * h);
      }
      _Pragma("unroll") for (int nt = 0; nt < 2; ++nt)
        _Pragma("unroll") for (int mt = 0; mt < 2; ++mt) acc[nt][mt] = mfma(af[nt], bf[mt], acc[nt][mt]);
    }
  }
}

template <int PERMBASE> DI void transpose_tile(const float* __restrict__ src, int N, bfr* __restrict__ dst, int K, int kt, int nt, float* sm) {
  const int t = TID, k0 = kt * 64, n0 = nt * 64;
  __syncthreads();
  _Pragma("unroll") for (int i = 0; i < 16; ++i) {
    int idx = i * 256 + t, kk = idx >> 6, nn = idx & 63;
    sm[kk * 65 + nn] = src[(size_t)(k0 + kk) * N + n0 + nn];
  }
  __syncthreads();
  _Pragma("unroll") for (int i = 0; i < 8; ++i) {
    int idx = i * 256 + t, nn = idx >> 5, kk = (idx & 31) * 2;
    const int drow = PERMBASE >= 0 ? wt_row_of_col(PERMBASE + n0 + nn) : n0 + nn;
    *(unsigned*)(dst + (size_t)drow * K + k0 + kk) = pk2(sm[kk * 65 + nn], sm[(kk + 1) * 65 + nn]);
  }
}

DI void phase_prep(const Params& p, char* smem) {
  float* sm = (float*)smem;
  for (int it = VBID; it < 768; it += VGRID) transpose_tile<-1>(p.w_ada, 3072, p.Wt_ada, 1024, it / 48, it % 48, sm);
  for (int idx = VBID * 256 + TID; idx < 256 * 1024; idx += VGRID * 256) {
    int row = idx >> 10, col = idx & 1023;
    float v = row < 128 ? p.c_sample[row * 1024 + col] : (row == 128 ? p.c_prompt[col] : 0.f);
    p.Cb[idx] = (bfr)f2bf(v);
  }
}
DI void phase_prep2(const Params& p, char* smem, int vb0, int nvb) {
  float* sm = (float*)smem;
  for (int it = vb0; it < 1856; it += nvb) {
    int i = it;
    if (i < 832) { transpose_tile<0>(p.w_in, 3328, p.Wt_all, 1024, i / 52, i % 52, sm); continue; }
    i -= 832;
    if (i < 512) { transpose_tile<3328>(p.w_merge, 2048, p.Wt_all, 1024, i / 32, i % 32, sm); continue; }
    i -= 512;
    if (i < 128) { transpose_tile<-1>(p.w_pa, 1024, p.Wt_pab, 1024, i / 16, i % 16, sm); continue; }
    i -= 128;
    if (i < 128) { transpose_tile<-1>(p.w_pb, 1024, p.Wt_pab + 512, 1024, i / 16, i % 16, sm); continue; }
    i -= 128;
    transpose_tile<-1>(p.w_out, 1024, p.Wt_out, 1024, i / 16, i % 16, sm);
  }
}

DI void phase_mod(const Params& p, char* smem) {
  bfr* sA = (bfr*)smem; bfr* sW = sA + 128 * LDT;
  const int t = TID, lane = t & 63, w = t >> 6, wn = w >> 1, wm = w & 1, r = lane & 31, h = lane >> 5;
  for (int tile = VBID; tile < 48; tile += VGRID) {
    int m0 = (tile / 24) * 128, n0 = (tile % 24) * 128;
    f32x16 acc[2][2];
    _Pragma("unroll") for (int a = 0; a < 2; ++a) _Pragma("unroll") for (int b = 0; b < 2; ++b) acc[a][b] = zero16();
    gemm_mainloop(p.Cb, 1024, m0, p.Wt_ada, 1024, n0, 1024, sA, sW, acc);
    _Pragma("unroll") for (int nt = 0; nt < 2; ++nt) _Pragma("unroll") for (int mt = 0; mt < 2; ++mt) {
      int m = m0 + wm * 64 + mt * 32 + r;
      _Pragma("unroll") for (int g = 0; g < 4; ++g) {
        int n = n0 + wn * 64 + nt * 32 + 8 * g + 4 * h;
        float4 b = *(const float4*)(p.b_ada + n);
        float4 o; o.x = acc[nt][mt][4 * g] + b.x; o.y = acc[nt][mt][4 * g + 1] + b.y; o.z = acc[nt][mt][4 * g + 2] + b.z; o.w = acc[nt][mt][4 * g + 3] + b.w;
        *(float4*)(p.mod + (size_t)m * 3072 + n) = o;
      }
    }
  }
}

DI void phase_h(const Params& p) {
  const int lane = TID & 63, w = TID >> 6;
  for (int row = VBID * 4 + w; row < MTOT; row += VGRID * 4) {
    const float* xr = row < SEQ ? p.x_prompt + (size_t)row * DM : p.x_sample + (size_t)(row - SEQ) * DM;
    const float* mr = p.mod + (size_t)(row < SEQ ? 128 : row - SEQ) * 3072;
    float4 xv[4]; float ss = 0.f;
    _Pragma("unroll") for (int j = 0; j < 4; ++j) {
      xv[j] = *(const float4*)(xr + j * 256 + lane * 4);
      ss += xv[j].x * xv[j].x + xv[j].y * xv[j].y + xv[j].z * xv[j].z + xv[j].w * xv[j].w;
    }
    _Pragma("unroll") for (int o = 32; o >= 1; o >>= 1) ss += __shfl_xor(ss, o);
    float rs = rsqrtf(ss * (1.f / DM) + EPS);
    _Pragma("unroll") for (int j = 0; j < 4; ++j) {
      int col = j * 256 + lane * 4;
      float4 g = *(const float4*)(p.norm_g + col);
      float4 sh = *(const float4*)(mr + col);
      float4 sc = *(const float4*)(mr + 1024 + col);
      float a = xv[j].x * rs * g.x * (1.f + sc.x) + sh.x;
      float b = xv[j].y * rs * g.y * (1.f + sc.y) + sh.y;
      float c = xv[j].z * rs * g.z * (1.f + sc.z) + sh.z;
      float d = xv[j].w * rs * g.w * (1.f + sc.w) + sh.w;
      *(u32x2*)(p.H + (size_t)row * DM + col) = pack4(a, b, c, d);
    }
  }
}

DI void sincos_red(float a, float& s, float& c) {
  float n = rintf(a * 0.15915494309189535f);
  float rr = fmaf(-n, 6.2831854820251465f, a);
  rr = fmaf(-n, -1.7484555e-7f, rr);
  s = __sinf(rr); c = __cosf(rr);
}

namespace pg8 {
#define PG8_LAS __attribute__((address_space(3)))
typedef unsigned short bf16_t;
typedef short bf16x8 __attribute__((ext_vector_type(8)));
typedef float f32x4 __attribute__((ext_vector_type(4)));
typedef unsigned u32x4 __attribute__((ext_vector_type(4)));
constexpr int BM = 256, BK = 64, HALF = 128, HTB = HALF * BK * 2  , STAGE_BYTES = 8 * HTB, NXCD = 8, WGM = 8;

__host__ __device__ __forceinline__ int lds_byte(int r, int c) { const int st = (r >> 4) * 2 + (c >> 5), rr = r & 15, cc = c & 31, ob = rr * 64 + cc * 2; return st * 1024 + (ob ^ (((ob >> 9) & 1) << 5)); }
__host__ __device__ __forceinline__ void stage_rc(int b, int& R, int& C) { const int st = b / 1024, sb = b % 1024, swz = sb ^ (((sb >> 9) & 1) << 5); R = (st >> 1) * 16 + swz / 64; C = (st & 1) * 32 + (swz % 64) / 2; }
__host__ __device__ __forceinline__ int perm32(int rho) { const int n = rho >> 4, i = rho & 15; return 8 * (i >> 2) + 4 * n + (i & 3); }

struct Unit { int pm, pn; };
struct Gemm { const bf16_t* A; const bf16_t* Bt; int M, N, K; };

struct StaticOrder {
    int nM, nN, nwg, G, c;
    __host__ __device__ void init(int M, int N, int G_, int c_) { nM = M / BM; nN = N / BM; nwg = nM * nN; G = G_; c = c_; }
    __host__ __device__ bool next(int i, Unit& u) const {
        const long L = (long)i * G + c; if (L >= nwg) return false;
        int wgid = (int)L; { const int q = nwg / NXCD, r = nwg % NXCD, xcd = wgid % NXCD, off = wgid / NXCD; wgid = (xcd < r ? xcd * (q + 1) : r * (q + 1) + (xcd - r) * q) + off; }
        const int nig = WGM * nN, gid = wgid / nig, fm = gid * WGM, gsz = (nM - fm) < WGM ? (nM - fm) : WGM;
        u.pm = fm + ((wgid % nig) % gsz); u.pn = (wgid % nig) / gsz; return true;
    }
    __device__ __forceinline__ void a_ready(const Unit&) const {}
    __device__ __forceinline__ void done(const Unit&) const {}
};
template <class Epi, class Sched, bool STAMP = false>
__device__ __forceinline__ void gemm_phase(PG8_LAS unsigned char* lds, const Gemm g, const Sched& S, const Epi& E, unsigned long long* stamps) {
    const int tid = threadIdx.x, wid = __builtin_amdgcn_readfirstlane(tid >> 6), lane = tid & 63, wr = wid >> 2, wc = wid & 3, fr = lane & 15, fq = lane >> 4;
    const int K = g.K, nt = K / BK;
    int ts_lo = 0, ts_hi = 0, nts = 0; const unsigned long long rt_entry = STAMP ? (unsigned long long)wall_clock64() : 0ull;
#define PG8_STAMP() do { if (STAMP && wid == 0 && nts < 64) { const unsigned long long _c = (unsigned long long)clock64(); \
        ts_lo = (lane == nts) ? (int)(unsigned)_c : ts_lo; ts_hi = (lane == nts) ? (int)(unsigned)(_c >> 32) : ts_hi; ++nts; } } while (0)
    PG8_STAMP();
    unsigned voffA[2], voffB[2];
#pragma unroll
    for (int i = 0; i < 2; ++i) { int R, C; stage_rc(tid * 16 + i * 8192, R, C); const int Rb = Epi::PERM ? ((R & ~31) + perm32(R & 31)) : R;
        voffA[i] = (unsigned)(R * K + C) * 2u; voffB[i] = (unsigned)(Rb * K + C) * 2u; }
    const size_t kstep = (size_t)(BK * 2);
    const size_t hstep = (size_t)HALF * K * 2;
    const size_t tstep = 2 * hstep;
    const unsigned ldsw = (unsigned)wid * 1024u;
    const int aoff = lds_byte(wr * 64 + fr, fq * 8), boff = lds_byte(wc * 32 + fr, fq * 8);
#define PG8_SA(b, h) (((b) * 2 + (h)) * HTB)
#define PG8_SB(b, h) ((4 + (b) * 2 + (h)) * HTB)
#define PG8_STAGE(bufoff, gbase, voff) do { _Pragma("unroll") for (int _i = 0; _i < 2; ++_i) \
        __builtin_amdgcn_global_load_lds((const unsigned*)((const char*)(gbase) + (voff)[_i]), (PG8_LAS unsigned*)(lds + (bufoff) + ldsw + _i * 8192), 16, 0, 0); } while (0)
#define PG8_LDA(dst, b, h) do { _Pragma("unroll") for (int m = 0; m < 4; ++m) _Pragma("unroll") for (int k = 0; k < 2; ++k) dst[m][k] = *(const PG8_LAS bf16x8*)(lds + PG8_SA(b, h) + aoff + m * 2048 + k * 1024); } while (0)
#define PG8_LDB(dst, b, h) do { _Pragma("unroll") for (int n = 0; n < 2; ++n) _Pragma("unroll") for (int k = 0; k < 2; ++k) dst[n][k] = *(const PG8_LAS bf16x8*)(lds + PG8_SB(b, h) + boff + n * 2048 + k * 1024); } while (0)
#define PG8_MMA(ai, bj, At, Bt) do { __builtin_amdgcn_s_setprio(1); _Pragma("unroll") for (int m = 0; m < 4; ++m) _Pragma("unroll") for (int n = 0; n < 2; ++n) _Pragma("unroll") for (int k = 0; k < 2; ++k) \
        acc[ai][bj][m][n] = __builtin_amdgcn_mfma_f32_16x16x32_bf16(Bt[n][k], At[m][k], acc[ai][bj][m][n], 0, 0, 0); __builtin_amdgcn_s_setprio(0); } while (0)
#define PG8_WAIT_V(n) asm volatile("s_waitcnt vmcnt(" #n ")" ::: "memory")
#define PG8_WAIT_L(n) asm volatile("s_waitcnt lgkmcnt(" #n ")" ::: "memory")
#define PG8_BAR __builtin_amdgcn_s_barrier()
#define PG8_SCHED __builtin_amdgcn_sched_barrier(0)
    Unit cur, nxt; int ui = 0;
    if (!S.next(0, cur)) return;
    f32x4 acc[2][2][4][2];
#pragma unroll
    for (int a = 0; a < 2; ++a)
#pragma unroll
        for (int b = 0; b < 2; ++b)
#pragma unroll
            for (int m = 0; m < 4; ++m)
#pragma unroll
                for (int n = 0; n < 2; ++n) acc[a][b][m][n] = (f32x4){0.f, 0.f, 0.f, 0.f};
    bf16x8 At[4][2], B0[2][2], B1[2][2];
    const char* cA = (const char*)g.A + (size_t)cur.pm * tstep; const char* cB = (const char*)g.Bt + (size_t)cur.pn * tstep;
    S.a_ready(cur);
    PG8_STAGE(PG8_SB(0, 0), cB, voffB); PG8_STAGE(PG8_SA(0, 0), cA, voffA); PG8_STAGE(PG8_SB(0, 1), cB + hstep, voffB); PG8_STAGE(PG8_SA(0, 1), cA + hstep, voffA);
    if (wr == 1) PG8_BAR;
    PG8_WAIT_V(4); PG8_BAR;
    PG8_STAGE(PG8_SB(1, 0), cB + kstep, voffB); PG8_STAGE(PG8_SA(1, 0), cA + kstep, voffA); PG8_STAGE(PG8_SB(1, 1), cB + hstep + kstep, voffB);
    PG8_WAIT_V(6); PG8_BAR;
    PG8_STAMP();
    for (;;) {
        const bool has_next = S.next(ui + 1, nxt);
        const char* nA = has_next ? (const char*)g.A + (size_t)nxt.pm * tstep : cA; const char* nB = has_next ? (const char*)g.Bt + (size_t)nxt.pn * tstep : cB;
        for (int t = 0; t < nt; t += 2) {
            const bool last = (t == nt - 2);
            const char* a1 = cA + (size_t)(t + 1) * kstep;
            const char* a2 = last ? nA : cA + (size_t)(t + 2) * kstep; const char* b2 = last ? nB : cB + (size_t)(t + 2) * kstep;
            const char* a3 = a2 + kstep; const char* b3 = b2 + kstep;
            if (last && has_next) S.a_ready(nxt);
            if constexpr (Epi::MID_T > 0) { if (t == Epi::MID_T) E.mid(acc, cur, wr, wc, fr, fq); }
            PG8_LDB(B0, 0, 0); PG8_SCHED; PG8_LDA(At, 0, 0); PG8_STAGE(PG8_SA(1, 1), a1 + hstep, voffA);
            PG8_WAIT_L(8); PG8_BAR; PG8_WAIT_L(0); PG8_MMA(0, 0, At, B0); PG8_BAR; PG8_SCHED;
            PG8_LDB(B1, 0, 1); PG8_STAGE(PG8_SB(0, 0), b2, voffB);
            PG8_BAR; PG8_WAIT_L(0); PG8_MMA(0, 1, At, B1); PG8_BAR;
            PG8_LDA(At, 0, 1); PG8_STAGE(PG8_SA(0, 0), a2, voffA);
            PG8_BAR; PG8_WAIT_L(0); PG8_MMA(1, 0, At, B0); PG8_BAR; PG8_SCHED;
            PG8_STAGE(PG8_SB(0, 1), b2 + hstep, voffB);
            PG8_WAIT_V(6); PG8_BAR; PG8_MMA(1, 1, At, B1); PG8_BAR;
            PG8_LDB(B0, 1, 0); PG8_SCHED; PG8_LDA(At, 1, 0); PG8_STAGE(PG8_SA(0, 1), a2 + hstep, voffA);
            PG8_WAIT_L(8); PG8_BAR; PG8_WAIT_L(0); PG8_MMA(0, 0, At, B0); PG8_BAR; PG8_SCHED;
            PG8_LDB(B1, 1, 1); PG8_STAGE(PG8_SB(1, 0), b3, voffB);
            PG8_BAR; PG8_WAIT_L(0); PG8_MMA(0, 1, At, B1); PG8_BAR;
            PG8_LDA(At, 1, 1); PG8_STAGE(PG8_SA(1, 0), a3, voffA);
            PG8_BAR; PG8_WAIT_L(0); PG8_MMA(1, 0, At, B0); PG8_BAR; PG8_SCHED;
            PG8_STAGE(PG8_SB(1, 1), b3 + hstep, voffB);
            PG8_WAIT_V(6); PG8_BAR; PG8_MMA(1, 1, At, B1); PG8_BAR;
        }
        PG8_STAMP();
        if constexpr (!Epi::AFTER_DRAIN) { E(acc, cur, wr, wc, fr, fq); S.done(cur); }
        PG8_STAMP();
        if (!has_next) break;
#pragma unroll
        for (int a = 0; a < 2; ++a)
#pragma unroll
            for (int b = 0; b < 2; ++b)
#pragma unroll
                for (int m = 0; m < 4; ++m)
#pragma unroll
                    for (int n = 0; n < 2; ++n) acc[a][b][m][n] = (f32x4){0.f, 0.f, 0.f, 0.f};
        cur = nxt; cA = nA; cB = nB; ++ui;
    }
    PG8_WAIT_V(0);
    if (wr == 0) PG8_BAR;
    PG8_BAR;
    if constexpr (Epi::AFTER_DRAIN) { E.fused(acc, cur, wr, wc, fr, fq, lds, wid, lane); S.done(cur); }
    PG8_STAMP();
    if (STAMP && wid == 0) { stamps[lane] = lane < nts ? (((unsigned long long)(unsigned)ts_hi << 32) | (unsigned)ts_lo) : 0ull;
        if (lane == 62) stamps[62] = rt_entry; if (lane == 63) stamps[63] = (unsigned long long)wall_clock64(); }
#undef PG8_STAMP
#undef PG8_SA
#undef PG8_SB
#undef PG8_STAGE
#undef PG8_LDA
#undef PG8_LDB
#undef PG8_MMA
#undef PG8_WAIT_V
#undef PG8_WAIT_L
#undef PG8_BAR
#undef PG8_SCHED
}
}
using pf4 = pg8::f32x4;

struct EpiMain {
  static constexpr bool PERM = false, AFTER_DRAIN = false;
  static constexpr int MID_T = 0;
  const Params& p;
  DI void operator()(const pf4 (&acc)[2][2][4][2], const pg8::Unit& u, int wr, int wc, int fr, int fq) const {
    const int pn = u.pn;
    const int rbase = u.pm * 256 + wr * 64 + fr;
    if (pn < 3) {
      const bool isq = pn < 2, isv = (pn == 2) && (wc >= 2);
      const float* gp = isq ? p.qg : p.kg;
      const int d0 = 16 * (fq >> 1) + 4 * (fq & 1), d1 = 32 + 8 * fq;
      float4 g00 = {1.f, 1.f, 1.f, 1.f}, g01 = g00, g10 = g00, g11 = g00;
      if (!isv) { g00 = *(const float4*)(gp + d0); g01 = *(const float4*)(gp + d0 + 8); g10 = *(const float4*)(gp + d1); g11 = *(const float4*)(gp + d1 + 4); }
      _Pragma("unroll") for (int ai = 0; ai < 2; ++ai) {
        if (u.pm * 256 + 128 * ai >= MTOT) continue;
        _Pragma("unroll") for (int m = 0; m < 4; ++m) {
          const int row = rbase + 128 * ai + 16 * m;
          pf4 a00 = acc[ai][0][m][0], a01 = acc[ai][0][m][1], a10 = acc[ai][1][m][0], a11 = acc[ai][1][m][1];
          if (!isv) {
            float ss = 0.f;
            _Pragma("unroll") for (int j = 0; j < 4; ++j) ss += a00[j] * a00[j] + a01[j] * a01[j] + a10[j] * a10[j] + a11[j] * a11[j];
            ss += __shfl_xor(ss, 16); ss += __shfl_xor(ss, 32);
            const float sc = rsqrtf(ss * (1.f / 64.f) + EPS);
            a00[0] *= sc * g00.x; a00[1] *= sc * g00.y; a00[2] *= sc * g00.z; a00[3] *= sc * g00.w;
            a01[0] *= sc * g01.x; a01[1] *= sc * g01.y; a01[2] *= sc * g01.z; a01[3] *= sc * g01.w;
            a10[0] *= sc * g10.x; a10[1] *= sc * g10.y; a10[2] *= sc * g10.z; a10[3] *= sc * g10.w;
            a11[0] *= sc * g11.x; a11[1] *= sc * g11.y; a11[2] *= sc * g11.z; a11[3] *= sc * g11.w;
            if (fq < 2) {
              const float pos = (float)(row < SEQ ? row : SEQ);
              const float invlo[4] = {1.0f, 0.19392274f, 0.03760603f, 0.0072926646f};
              const float invhi[4] = {0.0014142136f, 0.0002742482f, 5.3182957e-05f, 1.0313385e-05f};
              _Pragma("unroll") for (int j = 0; j < 4; ++j) {
                const float inv = (fq & 1) ? invhi[j] : invlo[j];
                float s_, c_; sincos_red(pos * inv, s_, c_);
                const float x1 = a00[j], x2 = a01[j];
                a00[j] = x1 * c_ - x2 * s_; a01[j] = x2 * c_ + x1 * s_;
              }
            }
          }
          if (isq) {
            bfr* qp = p.Q + (size_t)row * 512 + (4 * pn + wc) * 64;
            *(u32x2*)(qp + d0) = pack4(a00[0] * 0.125f, a00[1] * 0.125f, a00[2] * 0.125f, a00[3] * 0.125f);
            *(u32x2*)(qp + d0 + 8) = pack4(a01[0] * 0.125f, a01[1] * 0.125f, a01[2] * 0.125f, a01[3] * 0.125f);
            u32x4 o; o[0] = pk2(a10[0] * 0.125f, a10[1] * 0.125f); o[1] = pk2(a10[2] * 0.125f, a10[3] * 0.125f);
            o[2] = pk2(a11[0] * 0.125f, a11[1] * 0.125f); o[3] = pk2(a11[2] * 0.125f, a11[3] * 0.125f);
            *(u32x4*)(qp + d1) = o;
          } else {
            const int jh = wc & 1;
            bfr* kp = (isv ? p.Vb : p.Kb) + (size_t)row * 128 + jh * 64;
            *(u32x2*)(kp + d0) = pack4(a00[0], a00[1], a00[2], a00[3]);
            *(u32x2*)(kp + d0 + 8) = pack4(a01[0], a01[1], a01[2], a01[3]);
            u32x4 o; o[0] = pk2(a10[0], a10[1]); o[1] = pk2(a10[2], a10[3]); o[2] = pk2(a11[0], a11[1]); o[3] = pk2(a11[2], a11[3]);
            *(u32x4*)(kp + d1) = o;
            float* op = nullptr;
            if (row >= SEQ) op = (isv ? p.out_vs : p.out_ks) + ((size_t)((row - SEQ) * 128 + 127) * 2 + jh) * 64;
            else if (row >= SEQ - 128) op = (isv ? p.out_vp : p.out_kp) + ((size_t)(row - (SEQ - 128)) * 2 + jh) * 64;
            if (op) {
              *(pf4*)(op + d0) = a00; *(pf4*)(op + d0 + 8) = a01; *(pf4*)(op + d1) = a10; *(pf4*)(op + d1 + 4) = a11;
            }
          }
        }
      }
      return;
    }
    const int cw = 32 * wc + 8 * fq;
    bfr* dst; int ld, col, op;
    if (pn < 5) { dst = p.ZA; ld = 512; col = (pn - 3) * 256; op = 1; }
    else if (pn < 7) { dst = p.QB; ld = 512; col = (pn - 5) * 256; op = 0; }
    else if (pn < 9) { dst = p.ZF; ld = 512; col = (pn - 7) * 256; op = 0; }
    else if (pn < 11) { dst = p.IB; ld = 512; col = (pn - 9) * 256; op = 0; }
    else if (pn < 13) { dst = p.ZB; ld = 512; col = (pn - 11) * 256; op = 1; }
    else if (pn < 17) { dst = p.GA; ld = 1024; col = (pn - 13) * 256; op = 2; }
    else { dst = p.GB; ld = 1024; col = (pn - 17) * 256; op = 2; }
    _Pragma("unroll") for (int bj = 0; bj < 2; ++bj) {
      float4 b0 = {0.f, 0.f, 0.f, 0.f}, b1 = b0;
      if (op == 2) { const float* bp = p.b_merge + (pn - 13) * 256 + 128 * bj + cw; b0 = *(const float4*)bp; b1 = *(const float4*)(bp + 4); }
      _Pragma("unroll") for (int ai = 0; ai < 2; ++ai) {
        if (u.pm * 256 + 128 * ai >= MTOT) continue;
        _Pragma("unroll") for (int m = 0; m < 4; ++m) {
          const int row = rbase + 128 * ai + 16 * m;
          pf4 x = acc[ai][bj][m][0], y = acc[ai][bj][m][1];
          if (op == 1) { _Pragma("unroll") for (int j = 0; j < 4; ++j) { x[j] = siluf_(x[j]); y[j] = siluf_(y[j]); } }
          else if (op == 2) {
            x[0] = sigmoidf_(x[0] + b0.x); x[1] = sigmoidf_(x[1] + b0.y); x[2] = sigmoidf_(x[2] + b0.z); x[3] = sigmoidf_(x[3] + b0.w);
            y[0] = sigmoidf_(y[0] + b1.x); y[1] = sigmoidf_(y[1] + b1.y); y[2] = sigmoidf_(y[2] + b1.z); y[3] = sigmoidf_(y[3] + b1.w);
          }
          u32x4 o; o[0] = pk2(x[0], x[1]); o[1] = pk2(x[2], x[3]); o[2] = pk2(y[0], y[1]); o[3] = pk2(y[2], y[3]);
          *(u32x4*)(dst + (size_t)row * ld + col + 128 * bj + cw) = o;
        }
      }
    }
  }
};

struct EpiMerge {
  static constexpr bool PERM = true, AFTER_DRAIN = false;
  static constexpr int MID_T = 8;
  const Params& p;
  DI void mid(pf4 (&acc)[2][2][4][2], const pg8::Unit& u, int wr, int wc, int fr, int fq) const {
    int rbase = u.pm * 256 + wr * 64 + fr; const int cbase = u.pn * 256 + 32 * wc + 8 * fq;
    asm volatile("" : "+v"(rbase));
    _Pragma("unroll") for (int ai = 0; ai < 2; ++ai) _Pragma("unroll") for (int m = 0; m < 4; ++m) _Pragma("unroll") for (int bj = 0; bj < 2; ++bj) {
      __builtin_amdgcn_sched_barrier(0);
      const size_t off = (size_t)(rbase + 128 * ai + 16 * m) * 1024 + cbase + 128 * bj;
      const u32x4 ga = *(const u32x4*)(p.GA + off), gb = *(const u32x4*)(p.GB + off);
      _Pragma("unroll") for (int e = 0; e < 2; ++e) {
        acc[ai][bj][m][0][2 * e] *= bflo(ga[e]) * __builtin_amdgcn_rcpf(bflo(gb[e]));
        acc[ai][bj][m][0][2 * e + 1] *= bfhi(ga[e]) * __builtin_amdgcn_rcpf(bfhi(gb[e]));
        acc[ai][bj][m][1][2 * e] *= bflo(ga[2 + e]) * __builtin_amdgcn_rcpf(bflo(gb[2 + e]));
        acc[ai][bj][m][1][2 * e + 1] *= bfhi(ga[2 + e]) * __builtin_amdgcn_rcpf(bfhi(gb[2 + e]));
      }
    }
  }
  DI void operator()(const pf4 (&acc)[2][2][4][2], const pg8::Unit& u, int wr, int wc, int fr, int fq) const {
    const int rbase = u.pm * 256 + wr * 64 + fr, cbase = u.pn * 256 + 32 * wc + 8 * fq;
    _Pragma("unroll") for (int ai = 0; ai < 2; ++ai) _Pragma("unroll") for (int m = 0; m < 4; ++m) _Pragma("unroll") for (int bj = 0; bj < 2; ++bj) {
      const size_t off = (size_t)(rbase + 128 * ai + 16 * m) * 1024 + cbase + 128 * bj;
      const u32x4 g = *(const u32x4*)(p.GB + off);
      const pf4 x = acc[ai][bj][m][0], y = acc[ai][bj][m][1];
      u32x4 o; o[0] = pk2(bflo(g[0]) * x[0], bfhi(g[0]) * x[1]); o[1] = pk2(bflo(g[1]) * x[2], bfhi(g[1]) * x[3]);
      o[2] = pk2(bflo(g[2]) * y[0], bfhi(g[2]) * y[1]); o[3] = pk2(bflo(g[3]) * y[2], bfhi(g[3]) * y[3]);
      *(u32x4*)(p.Y + off) = o;
    }
  }
};

struct EpiOut {
  static constexpr bool PERM = false, AFTER_DRAIN = false;
  static constexpr int MID_T = 0;
  const Params& p;
  DI void operator()(const pf4 (&acc)[2][2][4][2], const pg8::Unit& u, int wr, int wc, int fr, int fq) const {
    const int rbase = u.pm * 256 + wr * 64 + fr, cbase = u.pn * 256 + 32 * wc + 4 * fq;
    const float* gr = p.mod + (size_t)128 * 3072 + 2048;
    _Pragma("unroll") for (int bj = 0; bj < 2; ++bj) _Pragma("unroll") for (int n = 0; n < 2; ++n) {
      const int c = cbase + 128 * bj + 16 * n;
      const pf4 gt = *(const pf4*)(gr + c);
      _Pragma("unroll") for (int ai = 0; ai < 2; ++ai) _Pragma("unroll") for (int m = 0; m < 4; ++m) {
        const size_t off = (size_t)(rbase + 128 * ai + 16 * m) * DM + c;
        const pf4 xv = *(const pf4*)(p.x_prompt + off);
        *(pf4*)(p.out_yp + off) = xv + gt * acc[ai][bj][m][n];
      }
    }
  }
};

DI f32x16 wave_gemm32(const bfr* __restrict__ A, int lda, const bfr* __restrict__ W, int ldw, int K, int lane) {
  const int r = lane & 31, h = lane >> 5;
  const bfr* ap = A + (size_t)r * lda + 8 * h;
  const bfr* wp = W + (size_t)r * ldw + 8 * h;
  f32x16 acc = zero16();
  for (int k0 = 0; k0 < K; k0 += 128) {
    bf16x8 a[8], b[8];
    _Pragma("unroll") for (int q = 0; q < 8; ++q) { a[q] = *(const bf16x8*)(ap + k0 + 16 * q); b[q] = *(const bf16x8*)(wp + k0 + 16 * q); }
    _Pragma("unroll") for (int q = 0; q < 8; ++q) acc = mfma(b[q], a[q], acc);
  }
  return acc;
}

DI void sample_chain_wave(const Params& p, int wt, int lane) {
  const int mt = wt >> 5, nt = wt & 31, r = lane & 31, h = lane >> 5;
  const int m = 32 * mt + r;
  unsigned* cnt = p.bar + PANEL_CNT_WORD + 64 * mt;
  {
    const f32x16 a1 = wave_gemm32(p.YA + (size_t)(SEQ + 32 * mt) * 1024, 1024, p.Wt_pab + (size_t)(32 * nt) * 1024, 1024, 512, lane);
    const f32x16 a2 = wave_gemm32(p.YB + (size_t)(SEQ + 32 * mt) * 1024, 1024, p.Wt_pab + (size_t)(32 * nt) * 1024 + 512, 1024, 512, lane);
    _Pragma("unroll") for (int g = 0; g < 4; ++g) {
      const int n = 32 * nt + 8 * g + 4 * h;
      const u32x2 ga = *(const u32x2*)(p.GA + (size_t)(SEQ + m) * 1024 + n), gb = *(const u32x2*)(p.GB + (size_t)(SEQ + m) * 1024 + n);
      *(u32x2*)(p.Ys + (size_t)m * 1024 + n) = pack4(bflo(ga[0]) * a1[4 * g] + bflo(gb[0]) * a2[4 * g], bfhi(ga[0]) * a1[4 * g + 1] + bfhi(gb[0]) * a2[4 * g + 1],
                                                     bflo(ga[1]) * a1[4 * g + 2] + bflo(gb[1]) * a2[4 * g + 2], bfhi(ga[1]) * a1[4 * g + 3] + bfhi(gb[1]) * a2[4 * g + 3]);
    }
    __builtin_amdgcn_fence(__ATOMIC_RELEASE, "agent");
    asm volatile("s_waitcnt vmcnt(0)" ::: "memory");
    if (lane == 0) __hip_atomic_fetch_add(cnt, 1u, __ATOMIC_RELAXED, __HIP_MEMORY_SCOPE_AGENT);
  }
  {
    unsigned sp = 0;
    while (__hip_atomic_load(cnt, __ATOMIC_RELAXED, __HIP_MEMORY_SCOPE_AGENT) < 32u) { __builtin_amdgcn_s_sleep(2); if (++sp > (1u << 22)) break; }
    __builtin_amdgcn_fence(__ATOMIC_ACQUIRE, "agent");
    asm volatile("s_waitcnt vmcnt(0)" ::: "memory");
  }
  const f32x16 acc = wave_gemm32(p.Ys + (size_t)(32 * mt) * 1024, 1024, p.Wt_out + (size_t)(32 * nt) * 1024, 1024, 1024, lane);
  _Pragma("unroll") for (int g = 0; g < 4; ++g) {
    const int n = 32 * nt + 8 * g + 4 * h;
    const float4 xv = *(const float4*)(p.x_sample + (size_t)m * DM + n), gt = *(const float4*)(p.mod + (size_t)m * 3072 + 2048 + n);
    float4 o;
    o.x = xv.x + gt.x * acc[4 * g]; o.y = xv.y + gt.y * acc[4 * g + 1]; o.z = xv.z + gt.z * acc[4 * g + 2]; o.w = xv.w + gt.w * acc[4 * g + 3];
    *(float4*)(p.out_ys + (size_t)m * DM + n) = o;
  }
}

DI void attn_prompt_item(const Params& p, int qb, int hd, bfr* sVt  ) {
  const int t = TID, lane = t & 63, w = t >> 6, r = lane & 31, h = lane >> 5;
  const int j = hd >> 2, kb0 = qb * 128 - 128;
  __syncthreads();
  _Pragma("unroll") for (int it = 0; it < 8; ++it) {
    int kl = it * 32 + (t & 31), dg = t >> 5, kpos = kb0 + kl;
    u32x4 v = {0u, 0u, 0u, 0u};
    if (kpos >= 0) v = *(const u32x4*)(p.Vb + (size_t)kpos * 128 + j * 64 + dg * 8);
    _Pragma("unroll") for (int e = 0; e < 8; ++e) sVt[(dg * 8 + e) * 264 + kl] = (bfr)((v[e >> 1] >> ((e & 1) * 16)) & 0xffffu);
  }
  __syncthreads();
  const int q0 = qb * 128 + 32 * w, q = q0 + r;
  bf16x8 qf[4];
  _Pragma("unroll") for (int s = 0; s < 4; ++s) qf[s] = *(const bf16x8*)(p.Q + (size_t)q * 512 + hd * 64 + 16 * s + 8 * h);
  f32x16 sacc[5];
  _Pragma("unroll") for (int kt = 0; kt < 5; ++kt) {
    sacc[kt] = zero16();
    int kr = q0 - 128 + 32 * kt + r; kr = kr < 0 ? 0 : kr;
    _Pragma("unroll") for (int s = 0; s < 4; ++s) {
      bf16x8 kf = *(const bf16x8*)(p.Kb + (size_t)kr * 128 + j * 64 + 16 * s + 8 * h);
      sacc[kt] = mfma(kf, qf[s], sacc[kt]);
    }
  }
  const float sink = p.sinks[hd];
  float mx = sink;
  _Pragma("unroll") for (int kt = 0; kt < 5; ++kt) _Pragma("unroll") for (int i = 0; i < 16; ++i) {
    int key = q0 - 128 + 32 * kt + crow(i, h), rel = q - key;
    bool valid = (rel >= 0) && (rel < 128) && (key >= 0);
    float sv = valid ? sacc[kt][i] : -INFINITY;
    sacc[kt][i] = sv; mx = fmaxf(mx, sv);
  }
  mx = fmaxf(mx, __shfl_xor(mx, 32));
  float l = 0.f;
  _Pragma("unroll") for (int kt = 0; kt < 5; ++kt) _Pragma("unroll") for (int i = 0; i < 16; ++i) {
    float pv = __expf(sacc[kt][i] - mx); sacc[kt][i] = pv; l += pv;
  }
  l += __shfl_xor(l, 32);
  l += __expf(sink - mx);
  f32x16 oacc[2]; oacc[0] = zero16(); oacc[1] = zero16();
  _Pragma("unroll") for (int kt = 0; kt < 5; ++kt) _Pragma("unroll") for (int s2 = 0; s2 < 2; ++s2) {
    u32x4 pp;
    _Pragma("unroll") for (int e = 0; e < 4; ++e) pp[e] = pk2(sacc[kt][8 * s2 + 2 * e], sacc[kt][8 * s2 + 2 * e + 1]);
    bf16x8 pf = __builtin_bit_cast(bf16x8, pp);
    _Pragma("unroll") for (int dt = 0; dt < 2; ++dt) {
      const bfr* vp = sVt + (dt * 32 + r) * 264 + 32 * w + 32 * kt + 16 * s2 + 4 * h;
      u32x2 lo = *(const u32x2*)vp, hi = *(const u32x2*)(vp + 8);
      u32x4 vv; vv[0] = lo[0]; vv[1] = lo[1]; vv[2] = hi[0]; vv[3] = hi[1];
      oacc[dt] = mfma(__builtin_bit_cast(bf16x8, vv), pf, oacc[dt]);
    }
  }
  const float il = 1.f / l;
  _Pragma("unroll") for (int dt = 0; dt < 2; ++dt) _Pragma("unroll") for (int g = 0; g < 4; ++g) {
    int d = dt * 32 + 8 * g + 4 * h;
    size_t off = (size_t)q * 512 + hd * 64 + d;
    u32x2 za = *(const u32x2*)(p.ZA + off);
    *(u32x2*)(p.YA + (size_t)q * 1024 + hd * 64 + d) = pack4(oacc[dt][4 * g] * il * bflo(za[0]), oacc[dt][4 * g + 1] * il * bfhi(za[0]),
                                  oacc[dt][4 * g + 2] * il * bflo(za[1]), oacc[dt][4 * g + 3] * il * bfhi(za[1]));
  }
}

DI void attn_prompt_wave(const Params& p, int qt, int hd, int lane) {
  const int r = lane & 31, h = lane >> 5, j = hd >> 2;
  const int q0 = qt * 32, q = q0 + r, kb = q0 - 128;
  bf16x8 qf[4];
  _Pragma("unroll") for (int s = 0; s < 4; ++s) qf[s] = *(const bf16x8*)(p.Q + (size_t)q * 512 + hd * 64 + 16 * s + 8 * h);
  f32x16 sacc[5];
  _Pragma("unroll") for (int kt = 0; kt < 5; ++kt) {
    sacc[kt] = zero16();
    int kr = kb + 32 * kt + r; kr = kr < 0 ? 0 : kr;
    _Pragma("unroll") for (int s = 0; s < 4; ++s) {
      bf16x8 kf = *(const bf16x8*)(p.Kb + (size_t)kr * 128 + j * 64 + 16 * s + 8 * h);
      sacc[kt] = mfma(kf, qf[s], sacc[kt]);
    }
  }
  const float sink = p.sinks[hd];
  float mx = sink;
  _Pragma("unroll") for (int kt = 0; kt < 5; ++kt) _Pragma("unroll") for (int i = 0; i < 16; ++i) {
    int key = kb + 32 * kt + crow(i, h), rel = q - key;
    bool valid = (rel >= 0) && (rel < 128) && (key >= 0);
    float sv = valid ? sacc[kt][i] : -INFINITY;
    sacc[kt][i] = sv; mx = fmaxf(mx, sv);
  }
  mx = fmaxf(mx, __shfl_xor(mx, 32));
  float l = 0.f;
  _Pragma("unroll") for (int kt = 0; kt < 5; ++kt) _Pragma("unroll") for (int i = 0; i < 16; ++i) {
    float pv = __expf(sacc[kt][i] - mx); sacc[kt][i] = pv; l += pv;
  }
  l += __shfl_xor(l, 32);
  l += __expf(sink - mx);
  f32x16 oacc[2]; oacc[0] = zero16(); oacc[1] = zero16();
  const bfr* vbase = p.Vb + j * 64 + 2 * r;
  _Pragma("unroll") for (int kt = 0; kt < 5; ++kt) _Pragma("unroll") for (int s2 = 0; s2 < 2; ++s2) {
    u32x4 pp;
    _Pragma("unroll") for (int e = 0; e < 4; ++e) pp[e] = pk2(sacc[kt][8 * s2 + 2 * e], sacc[kt][8 * s2 + 2 * e + 1]);
    unsigned wv[8];
    _Pragma("unroll") for (int jj = 0; jj < 8; ++jj) {
      int key = kb + 32 * kt + 16 * s2 + 8 * (jj >> 2) + 4 * h + (jj & 3); key = key < 0 ? 0 : key;
      wv[jj] = *(const unsigned*)(vbase + (size_t)key * 128);
    }
    u32x4 v0, v1;
    _Pragma("unroll") for (int e = 0; e < 4; ++e) {
      v0[e] = (wv[2 * e] & 0xffffu) | (wv[2 * e + 1] << 16);
      v1[e] = (wv[2 * e] >> 16) | (wv[2 * e + 1] & 0xffff0000u);
    }
    const bf16x8 pa = __builtin_bit_cast(bf16x8, pp);
    oacc[0] = mfma(pa, __builtin_bit_cast(bf16x8, v0), oacc[0]);
    oacc[1] = mfma(pa, __builtin_bit_cast(bf16x8, v1), oacc[1]);
  }
  const float il = 1.f / l;
  _Pragma("unroll") for (int i = 0; i < 16; ++i) {
    const int qi = crow(i, h);
    const float ili = __shfl(il, qi);
    const size_t row = (size_t)(q0 + qi);
    const unsigned za = *(const unsigned*)(p.ZA + row * 512 + hd * 64 + 2 * r);
    *(unsigned*)(p.YA + row * 1024 + hd * 64 + 2 * r) = pk2(oacc[0][i] * ili * bflo(za), oacc[1][i] * ili * bfhi(za));
  }
}

DI void attn_sample_wave(const Params& p, int b, int hd) {
  const int lane = TID & 63, j = hd >> 2, m = SEQ + b;
  u32x4 qv[8];
  _Pragma("unroll") for (int i = 0; i < 8; ++i) qv[i] = *(const u32x4*)(p.Q + (size_t)m * 512 + hd * 64 + 8 * i);
  float dn = 0.f;
  _Pragma("unroll") for (int i = 0; i < 8; ++i) {
    u32x4 kv = *(const u32x4*)(p.Kb + (size_t)m * 128 + j * 64 + 8 * i);
    _Pragma("unroll") for (int e = 0; e < 4; ++e) dn += bflo(qv[i][e]) * bflo(kv[e]) + bfhi(qv[i][e]) * bfhi(kv[e]);
  }
  float s[2];
  _Pragma("unroll") for (int u = 0; u < 2; ++u) {
    int idx = lane + 1 + 64 * u;
    int ic = idx < 128 ? idx : 127;
    const float* kp = p.cache_k + ((size_t)(b * 128 + ic) * 2 + j) * 64;
    float d = 0.f;
    _Pragma("unroll") for (int i = 0; i < 8; ++i) {
      float4 k0 = *(const float4*)(kp + 8 * i), k1 = *(const float4*)(kp + 8 * i + 4);
      d += bflo(qv[i][0]) * k0.x + bfhi(qv[i][0]) * k0.y + bflo(qv[i][1]) * k0.z + bfhi(qv[i][1]) * k0.w;
      d += bflo(qv[i][2]) * k1.x + bfhi(qv[i][2]) * k1.y + bflo(qv[i][3]) * k1.z + bfhi(qv[i][3]) * k1.w;
    }
    s[u] = idx < 128 ? d : dn;
  }
  const float sink = p.sinks[hd];
  float mx = fmaxf(fmaxf(s[0], s[1]), sink);
  _Pragma("unroll") for (int o = 32; o >= 1; o >>= 1) mx = fmaxf(mx, __shfl_xor(mx, o));
  float p0 = __expf(s[0] - mx), p1 = __expf(s[1] - mx);
  float l = p0 + p1;
  _Pragma("unroll") for (int o = 32; o >= 1; o >>= 1) l += __shfl_xor(l, o);
  l += __expf(sink - mx);
  float o = 0.f;
  const float* vb = p.cache_v + ((size_t)(b * 128) * 2 + j) * 64 + lane;
  _Pragma("unroll 32") for (int idx = 1; idx < 128; ++idx) {
    float pv = __shfl(idx <= 64 ? p0 : p1, (idx - 1) & 63);
    o += pv * vb[(size_t)idx * 128];
  }
  o += __shfl(p1, 63) * bf2f(p.Vb[(size_t)m * 128 + j * 64 + lane]);
  size_t off = (size_t)m * 512 + hd * 64 + lane;
  p.YA[(size_t)m * 1024 + hd * 64 + lane] = (bfr)f2bf(o / l * bf2f(p.ZA[off]));
}

DI void hgrn_gates(const Params& p, int row0, int hh, float* sTot, float (&L)[32], float (&kin)[32], float& t0, float& lc) {
  const int t = TID, c = t & 127, half = t >> 7, ch = hh * 128 + c;
  const float lbv = 1.f / (1.f + __expf(p.lb_logits[512 + ch] - p.lb_logits[ch]));
  const bfr* zp = p.ZF + (size_t)(row0 + half * 32) * 512 + ch;
  float run = 0.f;
  _Pragma("unroll") for (int jj = 0; jj < 32; ++jj) {
    float z = bf2f(zp[(size_t)jj * 512]);
    z = fminf(fmaxf(z, -30.f), 30.f);
    float em = __expf(-z), sg = 1.f / (1.f + em);
    float f = lbv + (1.f - lbv) * sg;
    kin[jj] = (1.f - lbv) * em * sg;
    run += __logf(f);
    L[jj] = run;
  }
  sTot[half * 128 + c] = run;
  __syncthreads();
  t0 = sTot[c]; lc = t0 + sTot[128 + c];
  if (half) { _Pragma("unroll") for (int jj = 0; jj < 32; ++jj) L[jj] += t0; }
}

DI void hgrn_fused_item(const Params& p, int n, int hh, char* smem) {
  bfr* sVt = (bfr*)smem;
  bfr* sKt = sVt + 128 * LDT;
  bfr* sQh = sKt + 128 * LDT;
  bfr* sKh = sQh + 64 * 136;
  bfr* sAm = sKt;
  float* sTot = (float*)(sKh + 64 * 136);
  const int t = TID, lane = t & 63, w = t >> 6, h = lane >> 5, c = t & 127, half = t >> 7;
  const int row0 = n * 64;
  __syncthreads();
  {
    const bfr* ip = p.IB + (size_t)(row0 + half * 32) * 512 + hh * 128 + c;
    _Pragma("unroll") for (int q4 = 0; q4 < 4; ++q4) {
      u32x4 o;
      _Pragma("unroll") for (int e = 0; e < 4; ++e) {
        int jj = q4 * 8 + 2 * e;
        o[e] = (unsigned)ip[(size_t)jj * 512] | ((unsigned)ip[(size_t)(jj + 1) * 512] << 16);
      }
      *(u32x4*)(sVt + c * LDT + half * 32 + q4 * 8) = o;
    }
  }
  {
    float L[32], kin[32], t0, lc;
    hgrn_gates(p, row0, hh, sTot, L, kin, t0, lc);
    _Pragma("unroll") for (int q4 = 0; q4 < 4; ++q4) {
      u32x4 o;
      _Pragma("unroll") for (int e = 0; e < 4; ++e) {
        int jj = q4 * 8 + 2 * e;
        o[e] = pk2(kin[jj] * __expf(lc - L[jj]), kin[jj + 1] * __expf(lc - L[jj + 1]));
      }
      *(u32x4*)(sKt + c * LDT + half * 32 + q4 * 8) = o;
    }
    if (half == 0) p.dec[(n * 4 + hh) * 128 + c] = __expf(lc);
    bfr* qp = p.QB + (size_t)(row0 + half * 32) * 512 + hh * 128 + c;
    _Pragma("unroll") for (int jj = 0; jj < 32; ++jj) {
      const float qv = bf2f(qp[(size_t)jj * 512]);
      qp[(size_t)jj * 512] = (bfr)(pk2(qv * __expf(L[jj]), 0.f) & 0xffffu);
      const float dl = L[jj] - t0;
      sQh[(half * 32 + jj) * 136 + c] = (bfr)(pk2(qv * __expf(fminf(dl, 80.f)), 0.f) & 0xffffu);
      sKh[(half * 32 + jj) * 136 + c] = (bfr)(pk2(kin[jj] * __expf(fminf(-dl, 80.f)), 0.f) & 0xffffu);
    }
  }
  __syncthreads();
  {
    int r = lane & 31; asm volatile("" : "+v"(r));
    const int wv = w >> 1, wk = w & 1;
    f32x16 acc[2][2];
    _Pragma("unroll") for (int a = 0; a < 2; ++a) _Pragma("unroll") for (int b = 0; b < 2; ++b) acc[a][b] = zero16();
    _Pragma("unroll") for (int s = 0; s < 4; ++s) {
      bf16x8 af[2], bf[2];
      _Pragma("unroll") for (int x = 0; x < 2; ++x) {
        af[x] = *(const bf16x8*)(sVt + (wv * 64 + x * 32 + r) * LDT + 16 * s + 8 * h);
        bf[x] = *(const bf16x8*)(sKt + (wk * 64 + x * 32 + r) * LDT + 16 * s + 8 * h);
      }
      _Pragma("unroll") for (int a = 0; a < 2; ++a) _Pragma("unroll") for (int b = 0; b < 2; ++b) acc[a][b] = mfma(af[a], bf[b], acc[a][b]);
    }
    float* up = p.Ust + (size_t)(n * 4 + hh) * 16384;
    _Pragma("unroll") for (int a = 0; a < 2; ++a) _Pragma("unroll") for (int b = 0; b < 2; ++b) _Pragma("unroll") for (int i = 0; i < 16; ++i) {
      int v = wv * 64 + a * 32 + crow(i, h), k = wk * 64 + b * 32 + r;
      up[v * 128 + k] = acc[a][b][i];
    }
  }
  const int jt = w >> 1, it = w & 1;
  int r2 = lane & 31; asm volatile("" : "+v"(r2));
  f32x16 am = zero16();
  if (jt <= it) {
    _Pragma("unroll") for (int s = 0; s < 8; ++s) {
      bf16x8 kf = *(const bf16x8*)(sKh + (jt * 32 + r2) * 136 + 16 * s + 8 * h);
      bf16x8 qf = *(const bf16x8*)(sQh + (it * 32 + r2) * 136 + 16 * s + 8 * h);
      am = mfma(kf, qf, am);
    }
  }
  __syncthreads();
  {
    int r3 = lane & 31; asm volatile("" : "+v"(r3));
    const int i = it * 32 + r3;
    _Pragma("unroll") for (int g = 0; g < 4; ++g) {
      int j0 = jt * 32 + 8 * g + 4 * h;
      float x0 = (j0 <= i) ? am[4 * g] : 0.f, x1 = (j0 + 1 <= i) ? am[4 * g + 1] : 0.f;
      float x2 = (j0 + 2 <= i) ? am[4 * g + 2] : 0.f, x3 = (j0 + 3 <= i) ? am[4 * g + 3] : 0.f;
      *(u32x2*)(sAm + i * LDT + j0) = pack4(x0, x1, x2, x3);
    }
  }
  __syncthreads();
  {
    int r = lane & 31; asm volatile("" : "+v"(r));
    f32x16 oacc[2]; oacc[0] = zero16(); oacc[1] = zero16();
    _Pragma("unroll") for (int s = 0; s < 4; ++s) {
      bf16x8 vf = *(const bf16x8*)(sVt + (32 * w + r) * LDT + 16 * s + 8 * h);
      _Pragma("unroll") for (int i2 = 0; i2 < 2; ++i2) {
        bf16x8 af2 = *(const bf16x8*)(sAm + (i2 * 32 + r) * LDT + 16 * s + 8 * h);
        oacc[i2] = mfma(vf, af2, oacc[i2]);
      }
    }
    _Pragma("unroll") for (int i2 = 0; i2 < 2; ++i2) _Pragma("unroll") for (int g = 0; g < 4; ++g)
      *(u32x2*)(p.YB + (size_t)(row0 + i2 * 32 + r) * 1024 + hh * 128 + 32 * w + 8 * g + 4 * h) =
          pack4(oacc[i2][4 * g], oacc[i2][4 * g + 1], oacc[i2][4 * g + 2], oacc[i2][4 * g + 3]);
  }
}

DI void hgrn_sample_item(const Params& p, int b, int hh, char* smem) {
  float* sf = (float*)smem; float* skin = sf + 128; float* sq = skin + 128; float* sv = sq + 128; float* sred = sv + 128; float* s2 = sred + 8 * 128;
  const int t = TID, m = SEQ + b;
  __syncthreads();
  if (t < 128) {
    int ch = hh * 128 + t;
    float lbv = 1.f / (1.f + __expf(p.lb_logits[512 + ch] - p.lb_logits[ch]));
    float z = bf2f(p.ZF[(size_t)m * 512 + ch]);
    z = fminf(fmaxf(z, -30.f), 30.f);
    float em = __expf(-z), sg = 1.f / (1.f + em);
    sf[t] = lbv + (1.f - lbv) * sg; skin[t] = (1.f - lbv) * em * sg;
    sq[t] = bf2f(p.QB[(size_t)m * 512 + ch]); sv[t] = bf2f(p.IB[(size_t)m * 512 + ch]);
  }
  __syncthreads();
  const int v4 = (t & 31) * 4, kg = t >> 5;
  float4 vv = *(const float4*)(sv + v4);
  float4 o = {0.f, 0.f, 0.f, 0.f};
  const size_t sb = (size_t)(b * 4 + hh) * 16384;
  _Pragma("unroll 8") for (int kk = 0; kk < 16; ++kk) {
    int k = kg * 16 + kk;
    float4 S = *(const float4*)(p.state + sb + k * 128 + v4);
    float f = sf[k], ki = skin[k], qq = sq[k];
    float4 Sn; Sn.x = f * S.x + ki * vv.x; Sn.y = f * S.y + ki * vv.y; Sn.z = f * S.z + ki * vv.z; Sn.w = f * S.w + ki * vv.w;
    *(float4*)(p.out_ss + sb + k * 128 + v4) = Sn;
    o.x += qq * Sn.x; o.y += qq * Sn.y; o.z += qq * Sn.z; o.w += qq * Sn.w;
  }
  *(float4*)(sred + kg * 128 + v4) = o;
  __syncthreads();
  float ov = 0.f;
  if (t < 128) {
    _Pragma("unroll") for (int g = 0; g < 8; ++g) ov += sred[g * 128 + t];
    float ss = ov * ov;
    _Pragma("unroll") for (int of = 32; of >= 1; of >>= 1) ss += __shfl_xor(ss, of);
    if ((t & 63) == 0) s2[t >> 6] = ss;
  }
  __syncthreads();
  if (t < 128) {
    float sc = rsqrtf((s2[0] + s2[1]) * (1.f / 128.f) + EPS);
    size_t off = (size_t)m * 512 + hh * 128 + t;
    p.YB[(size_t)m * 1024 + hh * 128 + t] = (bfr)f2bf(ov * sc * p.og[t] * bf2f(p.ZB[off]));
  }
}

DI void phase_mix(const Params& p, char* smem) {
  for (int it = blockIdx.x * 8 + (threadIdx.x >> 6); it < 4096; it += gridDim.x * 8) attn_prompt_wave(p, it >> 3, it & 7, threadIdx.x & 63);
  for (int it = VBID; it < 1024; it += VGRID) hgrn_fused_item(p, it >> 2, it & 3, smem);
  for (int it = VBID; it < 512; it += VGRID) hgrn_sample_item(p, it >> 2, it & 3, smem);
  for (int it = VBID * 4 + (TID >> 6); it < 1024; it += VGRID * 4) attn_sample_wave(p, it >> 3, it & 7);
  for (int idx = VBID * 256 + TID; idx < 128 * 4064; idx += VGRID * 256) {
    int b = idx / 4064, i4 = idx - b * 4064;
    size_t so = (size_t)b * 16384 + 128 + i4 * 4, dof = (size_t)b * 16384 + i4 * 4;
    *(float4*)(p.out_ks + dof) = *(const float4*)(p.cache_k + so);
    *(float4*)(p.out_vs + dof) = *(const float4*)(p.cache_v + so);
  }
}

#define SCAN_LOAD(U, Dd, N0) _Pragma("unroll") for (int i = 0; i < 32; ++i) { U[i] = up[(size_t)((N0) + i) * 65536]; Dd[i] = dp[((N0) + i) * 512]; }
#define SCAN_STEP(U, Dd, N0) _Pragma("unroll") for (int i = 0; i < 32; ++i) { sp[(size_t)((N0) + i) * 65536] = (bfr)(pk2(S, 0.f) & 0xffffu); S = Dd[i] * S + U[i]; }
DI void phase_scan(const Params& p, int eb) {
  const int e = eb * 256 + threadIdx.x;
  const int hh = e >> 14, k = e & 127, v = (e >> 7) & 127;
  const float* up = p.Ust + e;
  bfr* sp = p.S16 + e;
  const float* dp = p.dec + hh * 128 + k;
  float S = 0.f;
  float ua[32], da[32], ub[32], db[32];
  SCAN_LOAD(ua, da, 0)
  for (int n0 = 0; n0 < NCH; n0 += 64) {
    SCAN_LOAD(ub, db, n0 + 32)
    SCAN_STEP(ua, da, n0)
    if (n0 + 64 < NCH) { SCAN_LOAD(ua, da, n0 + 64) }
    SCAN_STEP(ub, db, n0 + 32)
  }
  p.out_sp[(hh * 128 + k) * 128 + v] = S;
}

DI void hgrn_out_wave(const Params& p, int n, int hh, int it, int lane) {
  const int r = lane & 31, h = lane >> 5;
  const size_t row = (size_t)(n * 64 + it * 32 + r);
  bf16x8 qf[8];
  _Pragma("unroll") for (int s = 0; s < 8; ++s) qf[s] = *(const bf16x8*)(p.QB + row * 512 + hh * 128 + 16 * s + 8 * h);
  const bfr* sb = p.S16 + (size_t)(n * 4 + hh) * 16384 + (size_t)r * 128 + 8 * h;
  f32x16 acc[4];
  _Pragma("unroll") for (int vt = 0; vt < 4; ++vt) {
    acc[vt] = zero16();
    _Pragma("unroll") for (int s = 0; s < 8; ++s) {
      bf16x8 sf = *(const bf16x8*)(sb + vt * 32 * 128 + 16 * s);
      acc[vt] = mfma(sf, qf[s], acc[vt]);
    }
  }
  float ss = 0.f;
  _Pragma("unroll") for (int vt = 0; vt < 4; ++vt) _Pragma("unroll") for (int g = 0; g < 4; ++g) {
    const u32x2 oi = *(const u32x2*)(p.YB + row * 1024 + hh * 128 + 32 * vt + 8 * g + 4 * h);
    acc[vt][4 * g] += bflo(oi[0]); acc[vt][4 * g + 1] += bfhi(oi[0]); acc[vt][4 * g + 2] += bflo(oi[1]); acc[vt][4 * g + 3] += bfhi(oi[1]);
    ss += acc[vt][4 * g] * acc[vt][4 * g] + acc[vt][4 * g + 1] * acc[vt][4 * g + 1] + acc[vt][4 * g + 2] * acc[vt][4 * g + 2] + acc[vt][4 * g + 3] * acc[vt][4 * g + 3];
  }
  ss += __shfl_xor(ss, 32);
  const float sc = rsqrtf(ss * (1.f / 128.f) + EPS);
  _Pragma("unroll") for (int vt = 0; vt < 4; ++vt) _Pragma("unroll") for (int g = 0; g < 4; ++g) {
    const int v = 32 * vt + 8 * g + 4 * h;
    const float4 og = *(const float4*)(p.og + v);
    const u32x2 zb = *(const u32x2*)(p.ZB + row * 512 + hh * 128 + v);
    *(u32x2*)(p.YB + row * 1024 + hh * 128 + v) = pack4(acc[vt][4 * g] * sc * og.x * bflo(zb[0]), acc[vt][4 * g + 1] * sc * og.y * bfhi(zb[0]),
                                                        acc[vt][4 * g + 2] * sc * og.z * bflo(zb[1]), acc[vt][4 * g + 3] * sc * og.w * bfhi(zb[1]));
  }
}

#define XB_TMO      128
#define XB_XCNT(j)  (256  + 64 * (j))
#define XB_XSUB(j)  (1280 + 64 * (j))
#define XB_XGEN(j)  (2304 + 64 * (j))
#define XB_TOP      3328
#define XB_TOPGEN   3392
#define XCD_BAR_WORDS 3456
#define XB_SPIN_CAP (1u << 18)
#define LAS __attribute__((address_space(3)))

__device__ __forceinline__ unsigned xb_ld(unsigned* p)              { return __hip_atomic_load(p, __ATOMIC_RELAXED, __HIP_MEMORY_SCOPE_AGENT); }
__device__ __forceinline__ unsigned xb_add(unsigned* p, unsigned v) { return __hip_atomic_fetch_add(p, v, __ATOMIC_RELAXED, __HIP_MEMORY_SCOPE_AGENT); }
__device__ __forceinline__ unsigned xb_xcc_id() { return (unsigned)__builtin_amdgcn_s_getreg((3 << 11) | 20) & 0xFu; }
#define XB_SPIN(cond, bar) do { unsigned _sp = 0; while (cond) { __builtin_amdgcn_s_sleep(1); \
    if ((++_sp & 255u) == 0u) { if (xb_ld(&(bar)[XB_TMO])) break; if (_sp > XB_SPIN_CAP) { atomicAdd(&(bar)[XB_TMO], 1u); break; } } } } while (0)

struct XcdBarrier {
    unsigned* bar; unsigned x;
    volatile LAS unsigned* st;
};

__device__ __forceinline__ XcdBarrier xcd_barrier_post(unsigned* bar, volatile LAS unsigned* st) {
    XcdBarrier b; b.bar = bar; b.x = xb_xcc_id(); b.st = st;
    if (threadIdx.x == 0) (void)xb_add(&bar[XB_XCNT(b.x)], 1u);
    return b;
}
__device__ __forceinline__ void xcd_barrier_complete(unsigned* bar, unsigned x, unsigned& nloc, unsigned& nx) {
    const unsigned G = gridDim.x * gridDim.y * gridDim.z;
    unsigned sum, cnt, mine, sp = 0u;
    for (;;) {
        sum = 0u; cnt = 0u; mine = 0u;
#pragma unroll
        for (unsigned j = 0; j < 16; ++j) { const unsigned c = xb_ld(&bar[XB_XCNT(j)]); sum += c; cnt += (c > 0u) ? 1u : 0u; mine = (j == x) ? c : mine; }
        if (sum == G) break;
        __builtin_amdgcn_s_sleep(1);
        if ((++sp & 255u) == 0u) { if (xb_ld(&bar[XB_TMO])) break; if (sp > XB_SPIN_CAP) { atomicAdd(&bar[XB_TMO], 1u); break; } }
    }
    nloc = mine > 0u ? mine : 1u; nx = cnt > 0u ? cnt : 1u;
}

__device__ __forceinline__ void xcd_barrier(const XcdBarrier& b) {
    asm volatile("s_waitcnt vmcnt(0)" ::: "memory");
    __syncthreads();
    if (threadIdx.x == 0) {
        unsigned* bar = b.bar;
        __builtin_amdgcn_s_waitcnt(0);
        unsigned nloc = b.st[0], nx = b.st[1];
        if (nloc == 0u) { xcd_barrier_complete(bar, b.x, nloc, nx); b.st[0] = nloc; b.st[1] = nx; }
        const unsigned old = xb_add(&bar[XB_XSUB(b.x)], 1u);
        const unsigned gen = old / nloc;
        if (old + 1u == (gen + 1u) * nloc) {
            __builtin_amdgcn_fence(__ATOMIC_RELEASE, "agent");
            asm volatile("s_waitcnt vmcnt(0)" ::: "memory");
            const unsigned og = xb_add(&bar[XB_TOP], 1u);
            const unsigned tg = og / nx;
            if (og + 1u == (tg + 1u) * nx) xb_add(&bar[XB_TOPGEN], 1u);
            else XB_SPIN(xb_ld(&bar[XB_TOPGEN]) == tg, bar);
            __builtin_amdgcn_fence(__ATOMIC_ACQUIRE, "agent");
            xb_add(&bar[XB_XGEN(b.x)], 1u);
            asm volatile("s_waitcnt vmcnt(0)" ::: "memory");
        } else {
            XB_SPIN(xb_ld(&bar[XB_XGEN(b.x)]) == gen, bar);
            __builtin_amdgcn_fence(__ATOMIC_ACQUIRE, "agent");
            asm volatile("s_waitcnt vmcnt(0)" ::: "memory");
        }
    }
    __syncthreads();
}

static_assert(PANEL_CNT_WORD == XCD_BAR_WORDS, "panel counters follow the barrier words");
__global__ void __launch_bounds__(512, 2) hybrid_megakernel(Params p) {
  extern __shared__ __attribute__((aligned(16))) char smem_all[];
  __shared__ uint4 xb_words;
  if (threadIdx.x == 0) xb_words = make_uint4(0u, 0u, 0u, 0u);
  __syncthreads();
  const XcdBarrier xb = xcd_barrier_post(p.bar, (volatile LAS unsigned*)&xb_words);
  char* smem = smem_all + (threadIdx.x >> 8) * 73728;
#ifndef REPMASK
#define REPMASK 0
#endif
#define RUN_PHASE(n, ...) if (p.phase_lo <= n && n <= p.phase_hi) { if (n != p.phase_lo) xcd_barrier(xb); __VA_ARGS__; if ((REPMASK >> n) & 1) { xcd_barrier(xb); __VA_ARGS__; } }
  RUN_PHASE(0, phase_prep(p, smem))
  RUN_PHASE(1, { if (VBID < 48) phase_mod(p, smem); else phase_prep2(p, smem, VBID - 48, VGRID - 48); })
  RUN_PHASE(2, phase_h(p))
  RUN_PHASE(3, {
    pg8::Gemm g{p.H, p.Wt_all, MPAD, NALL, 1024};
    pg8::StaticOrder S; S.init(MPAD, NALL, (int)gridDim.x, (int)blockIdx.x);
    EpiMain E{p};
    pg8::gemm_phase<EpiMain, pg8::StaticOrder, false>((PG8_LAS unsigned char*)smem_all, g, S, E, nullptr);
  })
  RUN_PHASE(4, phase_mix(p, smem))
  RUN_PHASE(5, {
    if (threadIdx.x < 256) { for (int eb = blockIdx.x; eb < 256; eb += gridDim.x) phase_scan(p, eb); }
    else { const int wt = blockIdx.x * 4 + ((threadIdx.x >> 6) - 4); if (wt < 128) sample_chain_wave(p, wt, threadIdx.x & 63); }
  })
  RUN_PHASE(6, {
    for (int wi = blockIdx.x * 8 + (threadIdx.x >> 6); wi < 2048; wi += gridDim.x * 8) hgrn_out_wave(p, wi >> 3, (wi >> 1) & 3, wi & 1, threadIdx.x & 63);
  })
  RUN_PHASE(7, {
    pg8::Gemm g{p.YA, p.Wt_pab, SEQ, 1024, 1024};
    pg8::StaticOrder S; S.init(SEQ, 1024, (int)gridDim.x, (int)blockIdx.x);
    EpiMerge E{p};
    pg8::gemm_phase<EpiMerge, pg8::StaticOrder, false>((PG8_LAS unsigned char*)smem_all, g, S, E, nullptr);
  })
  RUN_PHASE(8, {
    pg8::Gemm g{p.Y, p.Wt_out, SEQ, 1024, 1024};
    pg8::StaticOrder S; S.init(SEQ, 1024, (int)gridDim.x, (int)blockIdx.x);
    EpiOut E{p};
    pg8::gemm_phase<EpiOut, pg8::StaticOrder, false>((PG8_LAS unsigned char*)smem_all, g, S, E, nullptr);
  })
}

#ifndef ONE_LAUNCH
#define ONE_LAUNCH 1
#endif
constexpr size_t kDynLds = 147456;

extern "C" void kernel_launch(void* const* d_in, const int* in_sizes, int n_in, void* d_out, int out_size, void* d_ws, size_t ws_size,
                              hipStream_t stream) {
  static int grid_blocks = 0;
  if (!grid_blocks) {
    int dev = 0, cus = 0, per_cu = 0;
    (void)hipGetDevice(&dev);
    (void)hipDeviceGetAttribute(&cus, hipDeviceAttributeMultiprocessorCount, dev);
    (void)hipFuncSetAttribute((const void*)hybrid_megakernel, hipFuncAttributeMaxDynamicSharedMemorySize, (int)kDynLds);
    (void)hipOccupancyMaxActiveBlocksPerMultiprocessor(&per_cu, hybrid_megakernel, 512, kDynLds);
    if (per_cu > 1) per_cu = 1;
    if (per_cu < 1) per_cu = 1;
    grid_blocks = cus * per_cu;
  }
  Params p{};
  const float* const* in = (const float* const*)d_in;
  p.x_prompt = in[0]; p.x_sample = in[1]; p.cache_k = in[2]; p.cache_v = in[3]; p.state = in[4]; p.c_prompt = in[5]; p.c_sample = in[6];
  p.w_ada = in[7]; p.b_ada = in[8]; p.norm_g = in[9]; p.w_in = in[10]; p.qg = in[11]; p.kg = in[12]; p.sinks = in[13]; p.lb_logits = in[14];
  p.og = in[15]; p.w_merge = in[16]; p.b_merge = in[17]; p.w_pa = in[18]; p.w_pb = in[19]; p.w_out = in[20];
  float* o = (float*)d_out;
  p.out_yp = o; o += (size_t)SEQ * DM;
  p.out_ys = o; o += (size_t)NBT * DM;
  p.out_kp = o; o += 128 * 128;
  p.out_vp = o; o += 128 * 128;
  p.out_sp = o; o += 4 * 128 * 128;
  p.out_ks = o; o += (size_t)NBT * 128 * 128;
  p.out_vs = o; o += (size_t)NBT * 128 * 128;
  p.out_ss = o;
  char* wsp = (char*)d_ws;
  auto take = [&](size_t bytes) { char* r = wsp; wsp += (bytes + 255) & ~(size_t)255; return r; };
  p.bar = (unsigned*)take((size_t)(XCD_BAR_WORDS + 256) * 4);
  p.Wt_all = (bfr*)take((size_t)NALL * 1024 * 2);
  p.Wt_pab = (bfr*)take((size_t)1024 * 1024 * 2);
  p.Wt_out = (bfr*)take((size_t)1024 * 1024 * 2);
  p.Wt_ada = (bfr*)take((size_t)3072 * 1024 * 2);
  p.Cb = (bfr*)take((size_t)256 * 1024 * 2);
  p.mod = (float*)take((size_t)256 * 3072 * 4);
  p.Ys = (bfr*)take((size_t)128 * 1024 * 2);
  p.H = (bfr*)take((size_t)MPAD * 1024 * 2);
  p.YA = p.H; p.YB = p.H + 512;
  p.ZA = (bfr*)take((size_t)MTOT * 512 * 2);
  p.S16 = p.ZA;
  p.Q = (bfr*)take((size_t)MTOT * 512 * 2);
  p.QB = (bfr*)take((size_t)MTOT * 512 * 2);
  p.Y = p.Q;
  p.Kb = (bfr*)take((size_t)MTOT * 128 * 2);
  p.Vb = (bfr*)take((size_t)MTOT * 128 * 2);
  p.IB = (bfr*)take((size_t)MTOT * 512 * 2);
  p.ZB = (bfr*)take((size_t)MTOT * 512 * 2);
  p.ZF = (bfr*)take((size_t)MTOT * 512 * 2);
  p.GA = (bfr*)take((size_t)MTOT * 1024 * 2);
  p.GB = (bfr*)take((size_t)MTOT * 1024 * 2);
  p.dec = (float*)take((size_t)NCH * 4 * 128 * 4);
  p.Ust = p.out_yp;
  if ((size_t)(wsp - (char*)d_ws) > ws_size) { fprintf(stderr, "workspace too small\n"); return; }
  (void)hipMemsetAsync(p.bar, 0, (size_t)(XCD_BAR_WORDS + 256) * 4, stream);
#if ONE_LAUNCH
  p.phase_lo = 0; p.phase_hi = 8;
  void* args[] = {&p};
  hipError_t e = hipLaunchCooperativeKernel((void*)hybrid_megakernel, dim3(grid_blocks), dim3(512), args, kDynLds, stream);
  if (e != hipSuccess) fprintf(stderr, "cooperative launch failed: %s (grid %d)\n", hipGetErrorString(e), grid_blocks);
#else
  for (int ph = 0; ph <= 8; ++ph) {
    p.phase_lo = ph; p.phase_hi = ph;
    hipLaunchKernelGGL(hybrid_megakernel, dim3(grid_blocks), dim3(512), kDynLds, stream, p);
  }
#endif
}
```

```cpp
#include <hip/hip_runtime.h>
#include <cstdio>

#define DI __device__ __forceinline__
typedef unsigned short bfr;
using bf16x8 = __attribute__((ext_vector_type(8))) short;
using f32x16 = __attribute__((ext_vector_type(16))) float;
using u32x4 = __attribute__((ext_vector_type(4))) unsigned;
using u32x2 = __attribute__((ext_vector_type(2))) unsigned;

constexpr int DM = 1024, SEQ = 16384, NBT = 128, MTOT = SEQ + NBT;
constexpr int NALL = 5376;
constexpr int NCH = 256;
constexpr float EPS = 1e-6f;
constexpr int PANEL_CNT_WORD = 3456;
constexpr int LDT = 72;
constexpr int MPAD = 16640;
#define TID ((int)(threadIdx.x & 255))
#define VBID ((int)(blockIdx.x * 2 + (threadIdx.x >> 8)))
#define VGRID ((int)(gridDim.x * 2))

struct Params {
  const float *x_prompt, *x_sample, *cache_k, *cache_v, *state, *c_prompt, *c_sample;
  const float *w_ada, *b_ada, *norm_g, *w_in, *qg, *kg, *sinks, *lb_logits, *og, *w_merge, *b_merge, *w_pa, *w_pb, *w_out;
  float *out_yp, *out_ys, *out_kp, *out_vp, *out_sp, *out_ks, *out_vs, *out_ss;
  bfr *Wt_all, *Wt_pab, *Wt_out, *Wt_ada, *Cb, *H, *Q, *QB, *Kb, *Vb, *ZA, *IB, *ZB, *GA, *GB, *YA, *YB, *Y;
  float *mod, *dec, *Ust;
  bfr* ZF;
  bfr* S16;
  bfr* Ys;
  unsigned* bar;
  int phase_lo, phase_hi;
};

DI unsigned f2bf(float x) { unsigned u = __float_as_uint(x); u += 0x7fffu + ((u >> 16) & 1u); return u >> 16; }
typedef __bf16 hbf2 __attribute__((ext_vector_type(2)));
typedef float hf2 __attribute__((ext_vector_type(2)));
DI unsigned pk2(float a, float b) { hf2 v = {a, b}; return __builtin_bit_cast(unsigned, __builtin_convertvector(v, hbf2)); }
DI float bf2f(unsigned b) { return __uint_as_float(b << 16); }
DI float bflo(unsigned u) { return __uint_as_float(u << 16); }
DI float bfhi(unsigned u) { return __uint_as_float(u & 0xffff0000u); }
DI int crow(int i, int h) { return (i & 3) + 8 * (i >> 2) + 4 * h; }
DI f32x16 mfma(bf16x8 a, bf16x8 b, f32x16 c) { return __builtin_amdgcn_mfma_f32_32x32x16_bf16(a, b, c, 0, 0, 0); }
DI f32x16 zero16() { f32x16 z; _Pragma("unroll") for (int i = 0; i < 16; ++i) z[i] = 0.f; return z; }
DI float frcp(float x) { return __builtin_amdgcn_rcpf(x); }
DI float fexp(float x) { return __builtin_amdgcn_exp2f(x * 1.4426950408889634f); }
DI float sigmoidf_(float x) { return frcp(1.f + fexp(-x)); }
DI float siluf_(float x) { return x * frcp(1.f + fexp(-x)); }
DI u32x2 pack4(float a, float b, float c, float d) { u32x2 r; r[0] = pk2(a, b); r[1] = pk2(c, d); return r; }

DI int wt_row_of_col(int c) {
  const int pn = c >> 8, cl = c & 255;
  int slot;
  if (pn < 3) {
    const int g = cl >> 6, d = cl & 63;
    if (d >= 32) { const int x = d - 32; slot = 128 + 32 * g + 16 * ((x >> 2) & 1) + 4 * (x >> 3) + (x & 3); }
    else { const int fq = 2 * (d >> 4) + ((d >> 2) & 1), n = (d >> 3) & 1, j = d & 3; slot = 32 * g + 16 * n + 4 * fq + j; }
  } else {
    const int bj = cl >> 7, g = (cl >> 5) & 3, x = cl & 31;
    slot = 128 * bj + 32 * g + 16 * ((x >> 2) & 1) + 4 * (x >> 3) + (x & 3);
  }
  return (pn << 8) + slot;
}

DI void gemm_mainloop(const bfr* __restrict__ A, int lda, int m0, const bfr* __restrict__ W, int ldw, int n0, int K,
                      bfr* sA, bfr* sW, f32x16 (&acc)[2][2]) {
  const int t = TID, lane = t & 63, w = t >> 6, wn = w >> 1, wm = w & 1, r = lane & 31, h = lane >> 5;
  const int lrow = t >> 3, lk = (t & 7) * 8;
  const bfr* ap = A + (size_t)(m0 + lrow) * lda + lk;
  const bfr* wp = W + (size_t)(n0 + lrow) * ldw + lk;
  u32x4 ra[4], rw[4];
  _Pragma("unroll") for (int i = 0; i < 4; ++i) {
    ra[i] = *(const u32x4*)(ap + (size_t)(32 * i) * lda);
    rw[i] = *(const u32x4*)(wp + (size_t)(32 * i) * ldw);
  }
  const int nk = K >> 6;
  for (int kt = 0; kt < nk; ++kt) {
    __syncthreads();
    _Pragma("unroll") for (int i = 0; i < 4; ++i) {
      *(u32x4*)(sA + (lrow + 32 * i) * LDT + lk) = ra[i];
      *(u32x4*)(sW + (lrow + 32 * i) * LDT + lk) = rw[i];
    }
    __syncthreads();
    if (kt + 1 < nk) {
      ap += 64; wp += 64;
      _Pragma("unroll") for (int i = 0; i < 4; ++i) {
        ra[i] = *(const u32x4*)(ap + (size_t)(32 * i) * lda);
        rw[i] = *(const u32x4*)(wp + (size_t)(32 * i) * ldw);
      }
    }
    _Pragma("unroll") for (int kk = 0; kk < 4; ++kk) {
      bf16x8 af[2], bf[2];
      _Pragma("unroll") for (int x = 0; x < 2; ++x) {
        af[x] = *(const bf16x8*)(sW + (wn * 64 + x * 32 + r) * LDT + kk * 16 + 8 * h);
        bf[x] = *(const bf16x8*)(sA + (wm * 64 + x * 32 + r) * LDT + kk * 16 + 8 * h);
      }
      _Pragma("unroll") for (int nt = 0; nt < 2; ++nt)
        _Pragma("unroll") for (int mt = 0; mt < 2; ++mt) acc[nt][mt] = mfma(af[nt], bf[mt], acc[nt][mt]);
    }
  }
}

template <int PERMBASE> DI void transpose_tile(const float* __restrict__ src, int N, bfr* __restrict__ dst, int K, int kt, int nt, float* sm) {
  const int t = TID, k0 = kt * 64, n0 = nt * 64;
  __syncthreads();
  _Pragma("unroll") for (int i = 0; i < 16; ++i) {
    int idx = i * 256 + t, kk = idx >> 6, nn = idx & 63;
    sm[kk * 65 + nn] = src[(size_t)(k0 + kk) * N + n0 + nn];
  }
  __syncthreads();
  _Pragma("unroll") for (int i = 0; i < 8; ++i) {
    int idx = i * 256 + t, nn = idx >> 5, kk = (idx & 31) * 2;
    const int drow = PERMBASE >= 0 ? wt_row_of_col(PERMBASE + n0 + nn) : n0 + nn;
    *(unsigned*)(dst + (size_t)drow * K + k0 + kk) = pk2(sm[kk * 65 + nn], sm[(kk + 1) * 65 + nn]);
  }
}

DI void phase_prep(const Params& p, char* smem) {
  float* sm = (float*)smem;
  for (int it = VBID; it < 768; it += VGRID) transpose_tile<-1>(p.w_ada, 3072, p.Wt_ada, 1024, it / 48, it % 48, sm);
  for (int idx = VBID * 256 + TID; idx < 256 * 1024; idx += VGRID * 256) {
    int row = idx >> 10, col = idx & 1023;
    float v = row < 128 ? p.c_sample[row * 1024 + col] : (row == 128 ? p.c_prompt[col] : 0.f);
    p.Cb[idx] = (bfr)f2bf(v);
  }
}
DI void phase_prep2(const Params& p, char* smem, int vb0, int nvb) {
  float* sm = (float*)smem;
  for (int it = vb0; it < 1856; it += nvb) {
    int i = it;
    if (i < 832) { transpose_tile<0>(p.w_in, 3328, p.Wt_all, 1024, i / 52, i % 52, sm); continue; }
    i -= 832;
    if (i < 512) { transpose_tile<3328>(p.w_merge, 2048, p.Wt_all, 1024, i / 32, i % 32, sm); continue; }
    i -= 512;
    if (i < 128) { transpose_tile<-1>(p.w_pa, 1024, p.Wt_pab, 1024, i / 16, i % 16, sm); continue; }
    i -= 128;
    if (i < 128) { transpose_tile<-1>(p.w_pb, 1024, p.Wt_pab + 512, 1024, i / 16, i % 16, sm); continue; }
    i -= 128;
    transpose_tile<-1>(p.w_out, 1024, p.Wt_out, 1024, i / 16, i % 16, sm);
  }
}

DI void phase_mod(const Params& p, char* smem) {
  bfr* sA = (bfr*)smem; bfr* sW = sA + 128 * LDT;
  const int t = TID, lane = t & 63, w = t >> 6, wn = w >> 1, wm = w & 1, r = lane & 31, h = lane >> 5;
  for (int tile = VBID; tile < 48; tile += VGRID) {
    int m0 = (tile / 24) * 128, n0 = (tile % 24) * 128;
    f32x16 acc[2][2];
    _Pragma("unroll") for (int a = 0; a < 2; ++a) _Pragma("unroll") for (int b = 0; b < 2; ++b) acc[a][b] = zero16();
    gemm_mainloop(p.Cb, 1024, m0, p.Wt_ada, 1024, n0, 1024, sA, sW, acc);
    _Pragma("unroll") for (int nt = 0; nt < 2; ++nt) _Pragma("unroll") for (int mt = 0; mt < 2; ++mt) {
      int m = m0 + wm * 64 + mt * 32 + r;
      _Pragma("unroll") for (int g = 0; g < 4; ++g) {
        int n = n0 + wn * 64 + nt * 32 + 8 * g + 4 * h;
        float4 b = *(const float4*)(p.b_ada + n);
        float4 o; o.x = acc[nt][mt][4 * g] + b.x; o.y = acc[nt][mt][4 * g + 1] + b.y; o.z = acc[nt][mt][4 * g + 2] + b.z; o.w = acc[nt][mt][4 * g + 3] + b.w;
        *(float4*)(p.mod + (size_t)m * 3072 + n) = o;
      }
    }
  }
}

DI void phase_h(const Params& p) {
  const int lane = TID & 63, w = TID >> 6;
  for (int row = VBID * 4 + w; row < MTOT; row += VGRID * 4) {
    const float* xr = row < SEQ ? p.x_prompt + (size_t)row * DM : p.x_sample + (size_t)(row - SEQ) * DM;
    const float* mr = p.mod + (size_t)(row < SEQ ? 128 : row - SEQ) * 3072;
    float4 xv[4]; float ss = 0.f;
    _Pragma("unroll") for (int j = 0; j < 4; ++j) {
      xv[j] = *(const float4*)(xr + j * 256 + lane * 4);
      ss += xv[j].x * xv[j].x + xv[j].y * xv[j].y + xv[j].z * xv[j].z + xv[j].w * xv[j].w;
    }
    _Pragma("unroll") for (int o = 32; o >= 1; o >>= 1) ss += __shfl_xor(ss, o);
    float rs = rsqrtf(ss * (1.f / DM) + EPS);
    _Pragma("unroll") for (int j = 0; j < 4; ++j) {
      int col = j * 256 + lane * 4;
      float4 g = *(const float4*)(p.norm_g + col);
      float4 sh = *(const float4*)(mr + col);
      float4 sc = *(const float4*)(mr + 1024 + col);
      float a = xv[j].x * rs * g.x * (1.f + sc.x) + sh.x;
      float b = xv[j].y * rs * g.y * (1.f + sc.y) + sh.y;
      float c = xv[j].z * rs * g.z * (1.f + sc.z) + sh.z;
      float d = xv[j].w * rs * g.w * (1.f + sc.w) + sh.w;
      *(u32x2*)(p.H + (size_t)row * DM + col) = pack4(a, b, c, d);
    }
  }
}

DI void sincos_red(float a, float& s, float& c) {
  float n = rintf(a * 0.15915494309189535f);
  float rr = fmaf(-n, 6.2831854820251465f, a);
  rr = fmaf(-n, -1.7484555e-7f, rr);
  s = __sinf(rr); c = __cosf(rr);
}

namespace pg8 {
#define PG8_LAS __attribute__((address_space(3)))
typedef unsigned short bf16_t;
typedef short bf16x8 __attribute__((ext_vector_type(8)));
typedef float f32x4 __attribute__((ext_vector_type(4)));
typedef unsigned u32x4 __attribute__((ext_vector_type(4)));
constexpr int BM = 256, BK = 64, HALF = 128, HTB = HALF * BK * 2  , STAGE_BYTES = 8 * HTB, NXCD = 8, WGM = 8;

__host__ __device__ __forceinline__ int lds_byte(int r, int c) { const int st = (r >> 4) * 2 + (c >> 5), rr = r & 15, cc = c & 31, ob = rr * 64 + cc * 2; return st * 1024 + (ob ^ (((ob >> 9) & 1) << 5)); }
__host__ __device__ __forceinline__ void stage_rc(int b, int& R, int& C) { const int st = b / 1024, sb = b % 1024, swz = sb ^ (((sb >> 9) & 1) << 5); R = (st >> 1) * 16 + swz / 64; C = (st & 1) * 32 + (swz % 64) / 2; }
__host__ __device__ __forceinline__ int perm32(int rho) { const int n = rho >> 4, i = rho & 15; return 8 * (i >> 2) + 4 * n + (i & 3); }

struct Unit { int pm, pn; };
struct Gemm { const bf16_t* A; const bf16_t* Bt; int M, N, K; };

struct StaticOrder {
    int nM, nN, nwg, G, c;
    __host__ __device__ void init(int M, int N, int G_, int c_) { nM = M / BM; nN = N / BM; nwg = nM * nN; G = G_; c = c_; }
    __host__ __device__ bool next(int i, Unit& u) const {
        const long L = (long)i * G + c; if (L >= nwg) return false;
        int wgid = (int)L; { const int q = nwg / NXCD, r = nwg % NXCD, xcd = wgid % NXCD, off = wgid / NXCD; wgid = (xcd < r ? xcd * (q + 1) : r * (q + 1) + (xcd - r) * q) + off; }
        const int nig = WGM * nN, gid = wgid / nig, fm = gid * WGM, gsz = (nM - fm) < WGM ? (nM - fm) : WGM;
        u.pm = fm + ((wgid % nig) % gsz); u.pn = (wgid % nig) / gsz; return true;
    }
    __device__ __forceinline__ void a_ready(const Unit&) const {}
    __device__ __forceinline__ void done(const Unit&) const {}
};
template <class Epi, class Sched, bool STAMP = false>
__device__ __forceinline__ void gemm_phase(PG8_LAS unsigned char* lds, const Gemm g, const Sched& S, const Epi& E, unsigned long long* stamps) {
    const int tid = threadIdx.x, wid = __builtin_amdgcn_readfirstlane(tid >> 6), lane = tid & 63, wr = wid >> 2, wc = wid & 3, fr = lane & 15, fq = lane >> 4;
    const int K = g.K, nt = K / BK;
    int ts_lo = 0, ts_hi = 0, nts = 0; const unsigned long long rt_entry = STAMP ? (unsigned long long)wall_clock64() : 0ull;
#define PG8_STAMP() do { if (STAMP && wid == 0 && nts < 64) { const unsigned long long _c = (unsigned long long)clock64(); \
        ts_lo = (lane == nts) ? (int)(unsigned)_c : ts_lo; ts_hi = (lane == nts) ? (int)(unsigned)(_c >> 32) : ts_hi; ++nts; } } while (0)
    PG8_STAMP();
    unsigned voffA[2], voffB[2];
#pragma unroll
    for (int i = 0; i < 2; ++i) { int R, C; stage_rc(tid * 16 + i * 8192, R, C); const int Rb = Epi::PERM ? ((R & ~31) + perm32(R & 31)) : R;
        voffA[i] = (unsigned)(R * K + C) * 2u; voffB[i] = (unsigned)(Rb * K + C) * 2u; }
    const size_t kstep = (size_t)(BK * 2);
    const size_t hstep = (size_t)HALF * K * 2;
    const size_t tstep = 2 * hstep;
    const unsigned ldsw = (unsigned)wid * 1024u;
    const int aoff = lds_byte(wr * 64 + fr, fq * 8), boff = lds_byte(wc * 32 + fr, fq * 8);
#define PG8_SA(b, h) (((b) * 2 + (h)) * HTB)
#define PG8_SB(b, h) ((4 + (b) * 2 + (h)) * HTB)
#define PG8_STAGE(bufoff, gbase, voff) do { _Pragma("unroll") for (int _i = 0; _i < 2; ++_i) \
        __builtin_amdgcn_global_load_lds((const unsigned*)((const char*)(gbase) + (voff)[_i]), (PG8_LAS unsigned*)(lds + (bufoff) + ldsw + _i * 8192), 16, 0, 0); } while (0)
#define PG8_LDA(dst, b, h) do { _Pragma("unroll") for (int m = 0; m < 4; ++m) _Pragma("unroll") for (int k = 0; k < 2; ++k) dst[m][k] = *(const PG8_LAS bf16x8*)(lds + PG8_SA(b, h) + aoff + m * 2048 + k * 1024); } while (0)
#define PG8_LDB(dst, b, h) do { _Pragma("unroll") for (int n = 0; n < 2; ++n) _Pragma("unroll") for (int k = 0; k < 2; ++k) dst[n][k] = *(const PG8_LAS bf16x8*)(lds + PG8_SB(b, h) + boff + n * 2048 + k * 1024); } while (0)
#define PG8_MMA(ai, bj, At, Bt) do { __builtin_amdgcn_s_setprio(1); _Pragma("unroll") for (int m = 0; m < 4; ++m) _Pragma("unroll") for (int n = 0; n < 2; ++n) _Pragma("unroll") for (int k = 0; k < 2; ++k) \
        acc[ai][bj][m][n] = __builtin_amdgcn_mfma_f32_16x16x32_bf16(Bt[n][k], At[m][k], acc[ai][bj][m][n], 0, 0, 0); __builtin_amdgcn_s_setprio(0); } while (0)
#define PG8_WAIT_V(n) asm volatile("s_waitcnt vmcnt(" #n ")" ::: "memory")
#define PG8_WAIT_L(n) asm volatile("s_waitcnt lgkmcnt(" #n ")" ::: "memory")
#define PG8_BAR __builtin_amdgcn_s_barrier()
#define PG8_SCHED __builtin_amdgcn_sched_barrier(0)
    Unit cur, nxt; int ui = 0;
    if (!S.next(0, cur)) return;
    f32x4 acc[2][2][4][2];
#pragma unroll
    for (int a = 0; a < 2; ++a)
#pragma unroll
        for (int b = 0; b < 2; ++b)
#pragma unroll
            for (int m = 0; m < 4; ++m)
#pragma unroll
                for (int n = 0; n < 2; ++n) acc[a][b][m][n] = (f32x4){0.f, 0.f, 0.f, 0.f};
    bf16x8 At[4][2], B0[2][2], B1[2][2];
    const char* cA = (const char*)g.A + (size_t)cur.pm * tstep; const char* cB = (const char*)g.Bt + (size_t)cur.pn * tstep;
    S.a_ready(cur);
    PG8_STAGE(PG8_SB(0, 0), cB, voffB); PG8_STAGE(PG8_SA(0, 0), cA, voffA); PG8_STAGE(PG8_SB(0, 1), cB + hstep, voffB); PG8_STAGE(PG8_SA(0, 1), cA + hstep, voffA);
    if (wr == 1) PG8_BAR;
    PG8_WAIT_V(4); PG8_BAR;
    PG8_STAGE(PG8_SB(1, 0), cB + kstep, voffB); PG8_STAGE(PG8_SA(1, 0), cA + kstep, voffA); PG8_STAGE(PG8_SB(1, 1), cB + hstep + kstep, voffB);
    PG8_WAIT_V(6); PG8_BAR;
    PG8_STAMP();
    for (;;) {
        const bool has_next = S.next(ui + 1, nxt);
        const char* nA = has_next ? (const char*)g.A + (size_t)nxt.pm * tstep : cA; const char* nB = has_next ? (const char*)g.Bt + (size_t)nxt.pn * tstep : cB;
        for (int t = 0; t < nt; t += 2) {
            const bool last = (t == nt - 2);
            const char* a1 = cA + (size_t)(t + 1) * kstep;
            const char* a2 = last ? nA : cA + (size_t)(t + 2) * kstep; const char* b2 = last ? nB : cB + (size_t)(t + 2) * kstep;
            const char* a3 = a2 + kstep; const char* b3 = b2 + kstep;
            if (last && has_next) S.a_ready(nxt);
            if constexpr (Epi::MID_T > 0) { if (t == Epi::MID_T) E.mid(acc, cur, wr, wc, fr, fq); }
            PG8_LDB(B0, 0, 0); PG8_SCHED; PG8_LDA(At, 0, 0); PG8_STAGE(PG8_SA(1, 1), a1 + hstep, voffA);
            PG8_WAIT_L(8); PG8_BAR; PG8_WAIT_L(0); PG8_MMA(0, 0, At, B0); PG8_BAR; PG8_SCHED;
            PG8_LDB(B1, 0, 1); PG8_STAGE(PG8_SB(0, 0), b2, voffB);
            PG8_BAR; PG8_WAIT_L(0); PG8_MMA(0, 1, At, B1); PG8_BAR;
            PG8_LDA(At, 0, 1); PG8_STAGE(PG8_SA(0, 0), a2, voffA);
            PG8_BAR; PG8_WAIT_L(0); PG8_MMA(1, 0, At, B0); PG8_BAR; PG8_SCHED;
            PG8_STAGE(PG8_SB(0, 1), b2 + hstep, voffB);
            PG8_WAIT_V(6); PG8_BAR; PG8_MMA(1, 1, At, B1); PG8_BAR;
            PG8_LDB(B0, 1, 0); PG8_SCHED; PG8_LDA(At, 1, 0); PG8_STAGE(PG8_SA(0, 1), a2 + hstep, voffA);
            PG8_WAIT_L(8); PG8_BAR; PG8_WAIT_L(0); PG8_MMA(0, 0, At, B0); PG8_BAR; PG8_SCHED;
            PG8_LDB(B1, 1, 1); PG8_STAGE(PG8_SB(1, 0), b3, voffB);
            PG8_BAR; PG8_WAIT_L(0); PG8_MMA(0, 1, At, B1); PG8_BAR;
            PG8_LDA(At, 1, 1); PG8_STAGE(PG8_SA(1, 0), a3, voffA);
            PG8_BAR; PG8_WAIT_L(0); PG8_MMA(1, 0, At, B0); PG8_BAR; PG8_SCHED;
            PG8_STAGE(PG8_SB(1, 1), b3 + hstep, voffB);
            PG8_WAIT_V(6); PG8_BAR; PG8_MMA(1, 1, At, B1); PG8_BAR;
        }
        PG8_STAMP();
        if constexpr (!Epi::AFTER_DRAIN) { E(acc, cur, wr, wc, fr, fq); S.done(cur); }
        PG8_STAMP();
        if (!has_next) break;
#pragma unroll
        for (int a = 0; a < 2; ++a)
#pragma unroll
            for (int b = 0; b < 2; ++b)
#pragma unroll
                for (int m = 0; m < 4; ++m)
#pragma unroll
                    for (int n = 0; n < 2; ++n) acc[a][b][m][n] = (f32x4){0.f, 0.f, 0.f, 0.f};
        cur = nxt; cA = nA; cB = nB; ++ui;
    }
    PG8_WAIT_V(0);
    if (wr == 0) PG8_BAR;
    PG8_BAR;
    if constexpr (Epi::AFTER_DRAIN) { E.fused(acc, cur, wr, wc, fr, fq, lds, wid, lane); S.done(cur); }
    PG8_STAMP();
    if (STAMP && wid == 0) { stamps[lane] = lane < nts ? (((unsigned long long)(unsigned)ts_hi << 32) | (unsigned)ts_lo) : 0ull;
        if (lane == 62) stamps[62] = rt_entry; if (lane == 63) stamps[63] = (unsigned long long)wall_clock64(); }
#undef PG8_STAMP
#undef PG8_SA
#undef PG8_SB
#undef PG8_STAGE
#undef PG8_LDA
#undef PG8_LDB
#undef PG8_MMA
#undef PG8_WAIT_V
#undef PG8_WAIT_L
#undef PG8_BAR
#undef PG8_SCHED
}
}
using pf4 = pg8::f32x4;

struct EpiMain {
  static constexpr bool PERM = false, AFTER_DRAIN = false;
  static constexpr int MID_T = 0;
  const Params& p;
  DI void operator()(const pf4 (&acc)[2][2][4][2], const pg8::Unit& u, int wr, int wc, int fr, int fq) const {
    const int pn = u.pn;
    const int rbase = u.pm * 256 + wr * 64 + fr;
    if (pn < 3) {
      const bool isq = pn < 2, isv = (pn == 2) && (wc >= 2);
      const float* gp = isq ? p.qg : p.kg;
      const int d0 = 16 * (fq >> 1) + 4 * (fq & 1), d1 = 32 + 8 * fq;
      float4 g00 = {1.f, 1.f, 1.f, 1.f}, g01 = g00, g10 = g00, g11 = g00;
      if (!isv) { g00 = *(const float4*)(gp + d0); g01 = *(const float4*)(gp + d0 + 8); g10 = *(const float4*)(gp + d1); g11 = *(const float4*)(gp + d1 + 4); }
      _Pragma("unroll") for (int ai = 0; ai < 2; ++ai) {
        if (u.pm * 256 + 128 * ai >= MTOT) continue;
        _Pragma("unroll") for (int m = 0; m < 4; ++m) {
          const int row = rbase + 128 * ai + 16 * m;
          pf4 a00 = acc[ai][0][m][0], a01 = acc[ai][0][m][1], a10 = acc[ai][1][m][0], a11 = acc[ai][1][m][1];
          if (!isv) {
            float ss = 0.f;
            _Pragma("unroll") for (int j = 0; j < 4; ++j) ss += a00[j] * a00[j] + a01[j] * a01[j] + a10[j] * a10[j] + a11[j] * a11[j];
            ss += __shfl_xor(ss, 16); ss += __shfl_xor(ss, 32);
            const float sc = rsqrtf(ss * (1.f / 64.f) + EPS);
            a00[0] *= sc * g00.x; a00[1] *= sc * g00.y; a00[2] *= sc * g00.z; a00[3] *= sc * g00.w;
            a01[0] *= sc * g01.x; a01[1] *= sc * g01.y; a01[2] *= sc * g01.z; a01[3] *= sc * g01.w;
            a10[0] *= sc * g10.x; a10[1] *= sc * g10.y; a10[2] *= sc * g10.z; a10[3] *= sc * g10.w;
            a11[0] *= sc * g11.x; a11[1] *= sc * g11.y; a11[2] *= sc * g11.z; a11[3] *= sc * g11.w;
            if (fq < 2) {
              const float pos = (float)(row < SEQ ? row : SEQ);
              const float invlo[4] = {1.0f, 0.19392274f, 0.03760603f, 0.0072926646f};
              const float invhi[4] = {0.0014142136f, 0.0002742482f, 5.3182957e-05f, 1.0313385e-05f};
              _Pragma("unroll") for (int j = 0; j < 4; ++j) {
                const float inv = (fq & 1) ? invhi[j] : invlo[j];
                float s_, c_; sincos_red(pos * inv, s_, c_);
                const float x1 = a00[j], x2 = a01[j];
                a00[j] = x1 * c_ - x2 * s_; a01[j] = x2 * c_ + x1 * s_;
              }
            }
          }
          if (isq) {
            bfr* qp = p.Q + (size_t)row * 512 + (4 * pn + wc) * 64;
            *(u32x2*)(qp + d0) = pack4(a00[0] * 0.125f, a00[1] * 0.125f, a00[2] * 0.125f, a00[3] * 0.125f);
            *(u32x2*)(qp + d0 + 8) = pack4(a01[0] * 0.125f, a01[1] * 0.125f, a01[2] * 0.125f, a01[3] * 0.125f);
            u32x4 o; o[0] = pk2(a10[0] * 0.125f, a10[1] * 0.125f); o[1] = pk2(a10[2] * 0.125f, a10[3] * 0.125f);
            o[2] = pk2(a11[0] * 0.125f, a11[1] * 0.125f); o[3] = pk2(a11[2] * 0.125f, a11[3] * 0.125f);
            *(u32x4*)(qp + d1) = o;
          } else {
            const int jh = wc & 1;
            bfr* kp = (isv ? p.Vb : p.Kb) + (size_t)row * 128 + jh * 64;
            *(u32x2*)(kp + d0) = pack4(a00[0], a00[1], a00[2], a00[3]);
            *(u32x2*)(kp + d0 + 8) = pack4(a01[0], a01[1], a01[2], a01[3]);
            u32x4 o; o[0] = pk2(a10[0], a10[1]); o[1] = pk2(a10[2], a10[3]); o[2] = pk2(a11[0], a11[1]); o[3] = pk2(a11[2], a11[3]);
            *(u32x4*)(kp + d1) = o;
            float* op = nullptr;
            if (row >= SEQ) op = (isv ? p.out_vs : p.out_ks) + ((size_t)((row - SEQ) * 128 + 127) * 2 + jh) * 64;
            else if (row >= SEQ - 128) op = (isv ? p.out_vp : p.out_kp) + ((size_t)(row - (SEQ - 128)) * 2 + jh) * 64;
            if (op) {
              *(pf4*)(op + d0) = a00; *(pf4*)(op + d0 + 8) = a01; *(pf4*)(op + d1) = a10; *(pf4*)(op + d1 + 4) = a11;
            }
          }
        }
      }
      return;
    }
    const int cw = 32 * wc + 8 * fq;
    bfr* dst; int ld, col, op;
    if (pn < 5) { dst = p.ZA; ld = 512; col = (pn - 3) * 256; op = 1; }
    else if (pn < 7) { dst = p.QB; ld = 512; col = (pn - 5) * 256; op = 0; }
    else if (pn < 9) { dst = p.ZF; ld = 512; col = (pn - 7) * 256; op = 0; }
    else if (pn < 11) { dst = p.IB; ld = 512; col = (pn - 9) * 256; op = 0; }
    else if (pn < 13) { dst = p.ZB; ld = 512; col = (pn - 11) * 256; op = 1; }
    else if (pn < 17) { dst = p.GA; ld = 1024; col = (pn - 13) * 256; op = 2; }
    else { dst = p.GB; ld = 1024; col = (pn - 17) * 256; op = 2; }
    _Pragma("unroll") for (int bj = 0; bj < 2; ++bj) {
      float4 b0 = {0.f, 0.f, 0.f, 0.f}, b1 = b0;
      if (op == 2) { const float* bp = p.b_merge + (pn - 13) * 256 + 128 * bj + cw; b0 = *(const float4*)bp; b1 = *(const float4*)(bp + 4); }
      _Pragma("unroll") for (int ai = 0; ai < 2; ++ai) {
        if (u.pm * 256 + 128 * ai >= MTOT) continue;
        _Pragma("unroll") for (int m = 0; m < 4; ++m) {
          const int row = rbase + 128 * ai + 16 * m;
          pf4 x = acc[ai][bj][m][0], y = acc[ai][bj][m][1];
          if (op == 1) { _Pragma("unroll") for (int j = 0; j < 4; ++j) { x[j] = siluf_(x[j]); y[j] = siluf_(y[j]); } }
          else if (op == 2) {
            x[0] = sigmoidf_(x[0] + b0.x); x[1] = sigmoidf_(x[1] + b0.y); x[2] = sigmoidf_(x[2] + b0.z); x[3] = sigmoidf_(x[3] + b0.w);
            y[0] = sigmoidf_(y[0] + b1.x); y[1] = sigmoidf_(y[1] + b1.y); y[2] = sigmoidf_(y[2] + b1.z); y[3] = sigmoidf_(y[3] + b1.w);
          }
          u32x4 o; o[0] = pk2(x[0], x[1]); o[1] = pk2(x[2], x[3]); o[2] = pk2(y[0], y[1]); o[3] = pk2(y[2], y[3]);
          *(u32x4*)(dst + (size_t)row * ld + col + 128 * bj + cw) = o;
        }
      }
    }
  }
};

struct EpiMerge {
  static constexpr bool PERM = true, AFTER_DRAIN = false;
  static constexpr int MID_T = 8;
  const Params& p;
  DI void mid(pf4 (&acc)[2][2][4][2], const pg8::Unit& u, int wr, int wc, int fr, int fq) const {
    int rbase = u.pm * 256 + wr * 64 + fr; const int cbase = u.pn * 256 + 32 * wc + 8 * fq;
    asm volatile("" : "+v"(rbase));
    _Pragma("unroll") for (int ai = 0; ai < 2; ++ai) _Pragma("unroll") for (int m = 0; m < 4; ++m) _Pragma("unroll") for (int bj = 0; bj < 2; ++bj) {
      __builtin_amdgcn_sched_barrier(0);
      const size_t off = (size_t)(rbase + 128 * ai + 16 * m) * 1024 + cbase + 128 * bj;
      const u32x4 ga = *(const u32x4*)(p.GA + off), gb = *(const u32x4*)(p.GB + off);
      _Pragma("unroll") for (int e = 0; e < 2; ++e) {
        acc[ai][bj][m][0][2 * e] *= bflo(ga[e]) * __builtin_amdgcn_rcpf(bflo(gb[e]));
        acc[ai][bj][m][0][2 * e + 1] *= bfhi(ga[e]) * __builtin_amdgcn_rcpf(bfhi(gb[e]));
        acc[ai][bj][m][1][2 * e] *= bflo(ga[2 + e]) * __builtin_amdgcn_rcpf(bflo(gb[2 + e]));
        acc[ai][bj][m][1][2 * e + 1] *= bfhi(ga[2 + e]) * __builtin_amdgcn_rcpf(bfhi(gb[2 + e]));
      }
    }
  }
  DI void operator()(const pf4 (&acc)[2][2][4][2], const pg8::Unit& u, int wr, int wc, int fr, int fq) const {
    const int rbase = u.pm * 256 + wr * 64 + fr, cbase = u.pn * 256 + 32 * wc + 8 * fq;
    _Pragma("unroll") for (int ai = 0; ai < 2; ++ai) _Pragma("unroll") for (int m = 0; m < 4; ++m) _Pragma("unroll") for (int bj = 0; bj < 2; ++bj) {
      const size_t off = (size_t)(rbase + 128 * ai + 16 * m) * 1024 + cbase + 128 * bj;
      const u32x4 g = *(const u32x4*)(p.GB + off);
      const pf4 x = acc[ai][bj][m][0], y = acc[ai][bj][m][1];
      u32x4 o; o[0] = pk2(bflo(g[0]) * x[0], bfhi(g[0]) * x[1]); o[1] = pk2(bflo(g[1]) * x[2], bfhi(g[1]) * x[3]);
      o[2] = pk2(bflo(g[2]) * y[0], bfhi(g[2]) * y[1]); o[3] = pk2(bflo(g[3]) * y[2], bfhi(g[3]) * y[3]);
      *(u32x4*)(p.Y + off) = o;
    }
  }
};

struct EpiOut {
  static constexpr bool PERM = false, AFTER_DRAIN = false;
  static constexpr int MID_T = 0;
  const Params& p;
  DI void operator()(const pf4 (&acc)[2][2][4][2], const pg8::Unit& u, int wr, int wc, int fr, int fq) const {
    const int rbase = u.pm * 256 + wr * 64 + fr, cbase = u.pn * 256 + 32 * wc + 4 * fq;
    const float* gr = p.mod + (size_t)128 * 3072 + 2048;
    _Pragma("unroll") for (int bj = 0; bj < 2; ++bj) _Pragma("unroll") for (int n = 0; n < 2; ++n) {
      const int c = cbase + 128 * bj + 16 * n;
      const pf4 gt = *(const pf4*)(gr + c);
      _Pragma("unroll") for (int ai = 0; ai < 2; ++ai) _Pragma("unroll") for (int m = 0; m < 4; ++m) {
        const size_t off = (size_t)(rbase + 128 * ai + 16 * m) * DM + c;
        const pf4 xv = *(const pf4*)(p.x_prompt + off);
        *(pf4*)(p.out_yp + off) = xv + gt * acc[ai][bj][m][n];
      }
    }
  }
};

DI f32x16 wave_gemm32(const bfr* __restrict__ A, int lda, const bfr* __restrict__ W, int ldw, int K, int lane) {
  const int r = lane & 31, h = lane >> 5;
  const bfr* ap = A + (size_t)r * lda + 8 * h;
  const bfr* wp = W + (size_t)r * ldw + 8 * h;
  f32x16 acc = zero16();
  for (int k0 = 0; k0 < K; k0 += 128) {
    bf16x8 a[8], b[8];
    _Pragma("unroll") for (int q = 0; q < 8; ++q) { a[q] = *(const bf16x8*)(ap + k0 + 16 * q); b[q] = *(const bf16x8*)(wp + k0 + 16 * q); }
    _Pragma("unroll") for (int q = 0; q < 8; ++q) acc = mfma(b[q], a[q], acc);
  }
  return acc;
}

DI void sample_chain_wave(const Params& p, int wt, int lane) {
  const int mt = wt >> 5, nt = wt & 31, r = lane & 31, h = lane >> 5;
  const int m = 32 * mt + r;
  unsigned* cnt = p.bar + PANEL_CNT_WORD + 64 * mt;
  {
    const f32x16 a1 = wave_gemm32(p.YA + (size_t)(SEQ + 32 * mt) * 1024, 1024, p.Wt_pab + (size_t)(32 * nt) * 1024, 1024, 512, lane);
    const f32x16 a2 = wave_gemm32(p.YB + (size_t)(SEQ + 32 * mt) * 1024, 1024, p.Wt_pab + (size_t)(32 * nt) * 1024 + 512, 1024, 512, lane);
    _Pragma("unroll") for (int g = 0; g < 4; ++g) {
      const int n = 32 * nt + 8 * g + 4 * h;
      const u32x2 ga = *(const u32x2*)(p.GA + (size_t)(SEQ + m) * 1024 + n), gb = *(const u32x2*)(p.GB + (size_t)(SEQ + m) * 1024 + n);
      *(u32x2*)(p.Ys + (size_t)m * 1024 + n) = pack4(bflo(ga[0]) * a1[4 * g] + bflo(gb[0]) * a2[4 * g], bfhi(ga[0]) * a1[4 * g + 1] + bfhi(gb[0]) * a2[4 * g + 1],
                                                     bflo(ga[1]) * a1[4 * g + 2] + bflo(gb[1]) * a2[4 * g + 2], bfhi(ga[1]) * a1[4 * g + 3] + bfhi(gb[1]) * a2[4 * g + 3]);
    }
    __builtin_amdgcn_fence(__ATOMIC_RELEASE, "agent");
    asm volatile("s_waitcnt vmcnt(0)" ::: "memory");
    if (lane == 0) __hip_atomic_fetch_add(cnt, 1u, __ATOMIC_RELAXED, __HIP_MEMORY_SCOPE_AGENT);
  }
  {
    unsigned sp = 0;
    while (__hip_atomic_load(cnt, __ATOMIC_RELAXED, __HIP_MEMORY_SCOPE_AGENT) < 32u) { __builtin_amdgcn_s_sleep(2); if (++sp > (1u << 22)) break; }
    __builtin_amdgcn_fence(__ATOMIC_ACQUIRE, "agent");
    asm volatile("s_waitcnt vmcnt(0)" ::: "memory");
  }
  const f32x16 acc = wave_gemm32(p.Ys + (size_t)(32 * mt) * 1024, 1024, p.Wt_out + (size_t)(32 * nt) * 1024, 1024, 1024, lane);
  _Pragma("unroll") for (int g = 0; g < 4; ++g) {
    const int n = 32 * nt + 8 * g + 4 * h;
    const float4 xv = *(const float4*)(p.x_sample + (size_t)m * DM + n), gt = *(const float4*)(p.mod + (size_t)m * 3072 + 2048 + n);
    float4 o;
    o.x = xv.x + gt.x * acc[4 * g]; o.y = xv.y + gt.y * acc[4 * g + 1]; o.z = xv.z + gt.z * acc[4 * g + 2]; o.w = xv.w + gt.w * acc[4 * g + 3];
    *(float4*)(p.out_ys + (size_t)m * DM + n) = o;
  }
}

DI void attn_prompt_item(const Params& p, int qb, int hd, bfr* sVt  ) {
  const int t = TID, lane = t & 63, w = t >> 6, r = lane & 31, h = lane >> 5;
  const int j = hd >> 2, kb0 = qb * 128 - 128;
  __syncthreads();
  _Pragma("unroll") for (int it = 0; it < 8; ++it) {
    int kl = it * 32 + (t & 31), dg = t >> 5, kpos = kb0 + kl;
    u32x4 v = {0u, 0u, 0u, 0u};
    if (kpos >= 0) v = *(const u32x4*)(p.Vb + (size_t)kpos * 128 + j * 64 + dg * 8);
    _Pragma("unroll") for (int e = 0; e < 8; ++e) sVt[(dg * 8 + e) * 264 + kl] = (bfr)((v[e >> 1] >> ((e & 1) * 16)) & 0xffffu);
  }
  __syncthreads();
  const int q0 = qb * 128 + 32 * w, q = q0 + r;
  bf16x8 qf[4];
  _Pragma("unroll") for (int s = 0; s < 4; ++s) qf[s] = *(const bf16x8*)(p.Q + (size_t)q * 512 + hd * 64 + 16 * s + 8 * h);
  f32x16 sacc[5];
  _Pragma("unroll") for (int kt = 0; kt < 5; ++kt) {
    sacc[kt] = zero16();
    int kr = q0 - 128 + 32 * kt + r; kr = kr < 0 ? 0 : kr;
    _Pragma("unroll") for (int s = 0; s < 4; ++s) {
      bf16x8 kf = *(const bf16x8*)(p.Kb + (size_t)kr * 128 + j * 64 + 16 * s + 8 * h);
      sacc[kt] = mfma(kf, qf[s], sacc[kt]);
    }
  }
  const float sink = p.sinks[hd];
  float mx = sink;
  _Pragma("unroll") for (int kt = 0; kt < 5; ++kt) _Pragma("unroll") for (int i = 0; i < 16; ++i) {
    int key = q0 - 128 + 32 * kt + crow(i, h), rel = q - key;
    bool valid = (rel >= 0) && (rel < 128) && (key >= 0);
    float sv = valid ? sacc[kt][i] : -INFINITY;
    sacc[kt][i] = sv; mx = fmaxf(mx, sv);
  }
  mx = fmaxf(mx, __shfl_xor(mx, 32));
  float l = 0.f;
  _Pragma("unroll") for (int kt = 0; kt < 5; ++kt) _Pragma("unroll") for (int i = 0; i < 16; ++i) {
    float pv = __expf(sacc[kt][i] - mx); sacc[kt][i] = pv; l += pv;
  }
  l += __shfl_xor(l, 32);
  l += __expf(sink - mx);
  f32x16 oacc[2]; oacc[0] = zero16(); oacc[1] = zero16();
  _Pragma("unroll") for (int kt = 0; kt < 5; ++kt) _Pragma("unroll") for (int s2 = 0; s2 < 2; ++s2) {
    u32x4 pp;
    _Pragma("unroll") for (int e = 0; e < 4; ++e) pp[e] = pk2(sacc[kt][8 * s2 + 2 * e], sacc[kt][8 * s2 + 2 * e + 1]);
    bf16x8 pf = __builtin_bit_cast(bf16x8, pp);
    _Pragma("unroll") for (int dt = 0; dt < 2; ++dt) {
      const bfr* vp = sVt + (dt * 32 + r) * 264 + 32 * w + 32 * kt + 16 * s2 + 4 * h;
      u32x2 lo = *(const u32x2*)vp, hi = *(const u32x2*)(vp + 8);
      u32x4 vv; vv[0] = lo[0]; vv[1] = lo[1]; vv[2] = hi[0]; vv[3] = hi[1];
      oacc[dt] = mfma(__builtin_bit_cast(bf16x8, vv), pf, oacc[dt]);
    }
  }
  const float il = frcp(l);
  _Pragma("unroll") for (int dt = 0; dt < 2; ++dt) _Pragma("unroll") for (int g = 0; g < 4; ++g) {
    int d = dt * 32 + 8 * g + 4 * h;
    size_t off = (size_t)q * 512 + hd * 64 + d;
    u32x2 za = *(const u32x2*)(p.ZA + off);
    *(u32x2*)(p.YA + (size_t)q * 1024 + hd * 64 + d) = pack4(oacc[dt][4 * g] * il * bflo(za[0]), oacc[dt][4 * g + 1] * il * bfhi(za[0]),
                                  oacc[dt][4 * g + 2] * il * bflo(za[1]), oacc[dt][4 * g + 3] * il * bfhi(za[1]));
  }
}

DI void attn_prompt_wave(const Params& p, int qt, int hd, int lane) {
  const int r = lane & 31, h = lane >> 5, j = hd >> 2;
  const int q0 = qt * 32, q = q0 + r, kb = q0 - 128;
  bf16x8 qf[4];
  _Pragma("unroll") for (int s = 0; s < 4; ++s) qf[s] = *(const bf16x8*)(p.Q + (size_t)q * 512 + hd * 64 + 16 * s + 8 * h);
  f32x16 sacc[5];
  _Pragma("unroll") for (int kt = 0; kt < 5; ++kt) {
    sacc[kt] = zero16();
    int kr = kb + 32 * kt + r; kr = kr < 0 ? 0 : kr;
    _Pragma("unroll") for (int s = 0; s < 4; ++s) {
      bf16x8 kf = *(const bf16x8*)(p.Kb + (size_t)kr * 128 + j * 64 + 16 * s + 8 * h);
      sacc[kt] = mfma(kf, qf[s], sacc[kt]);
    }
  }
  const float sink = p.sinks[hd];
  float mx = sink;
  _Pragma("unroll") for (int kt = 0; kt < 5; ++kt) _Pragma("unroll") for (int i = 0; i < 16; ++i) {
    int key = kb + 32 * kt + crow(i, h), rel = q - key;
    bool valid = (rel >= 0) && (rel < 128) && (key >= 0);
    float sv = valid ? sacc[kt][i] : -INFINITY;
    sacc[kt][i] = sv; mx = fmaxf(mx, sv);
  }
  mx = fmaxf(mx, __shfl_xor(mx, 32));
  float l = 0.f;
  _Pragma("unroll") for (int kt = 0; kt < 5; ++kt) _Pragma("unroll") for (int i = 0; i < 16; ++i) {
    float pv = __expf(sacc[kt][i] - mx); sacc[kt][i] = pv; l += pv;
  }
  l += __shfl_xor(l, 32);
  l += __expf(sink - mx);
  f32x16 oacc[2]; oacc[0] = zero16(); oacc[1] = zero16();
  const bfr* vbase = p.Vb + j * 64 + 2 * r;
  _Pragma("unroll") for (int kt = 0; kt < 5; ++kt) _Pragma("unroll") for (int s2 = 0; s2 < 2; ++s2) {
    u32x4 pp;
    _Pragma("unroll") for (int e = 0; e < 4; ++e) pp[e] = pk2(sacc[kt][8 * s2 + 2 * e], sacc[kt][8 * s2 + 2 * e + 1]);
    unsigned wv[8];
    _Pragma("unroll") for (int jj = 0; jj < 8; ++jj) {
      int key = kb + 32 * kt + 16 * s2 + 8 * (jj >> 2) + 4 * h + (jj & 3); key = key < 0 ? 0 : key;
      wv[jj] = *(const unsigned*)(vbase + (size_t)key * 128);
    }
    u32x4 v0, v1;
    _Pragma("unroll") for (int e = 0; e < 4; ++e) {
      v0[e] = (wv[2 * e] & 0xffffu) | (wv[2 * e + 1] << 16);
      v1[e] = (wv[2 * e] >> 16) | (wv[2 * e + 1] & 0xffff0000u);
    }
    const bf16x8 pa = __builtin_bit_cast(bf16x8, pp);
    oacc[0] = mfma(pa, __builtin_bit_cast(bf16x8, v0), oacc[0]);
    oacc[1] = mfma(pa, __builtin_bit_cast(bf16x8, v1), oacc[1]);
  }
  const float il = frcp(l);
  _Pragma("unroll") for (int i = 0; i < 16; ++i) {
    const int qi = crow(i, h);
    const float ili = __shfl(il, qi);
    const size_t row = (size_t)(q0 + qi);
    const unsigned za = *(const unsigned*)(p.ZA + row * 512 + hd * 64 + 2 * r);
    *(unsigned*)(p.YA + row * 1024 + hd * 64 + 2 * r) = pk2(oacc[0][i] * ili * bflo(za), oacc[1][i] * ili * bfhi(za));
  }
}

DI void attn_sample_wave(const Params& p, int b, int hd) {
  const int lane = TID & 63, j = hd >> 2, m = SEQ + b;
  u32x4 qv[8];
  _Pragma("unroll") for (int i = 0; i < 8; ++i) qv[i] = *(const u32x4*)(p.Q + (size_t)m * 512 + hd * 64 + 8 * i);
  float dn = 0.f;
  _Pragma("unroll") for (int i = 0; i < 8; ++i) {
    u32x4 kv = *(const u32x4*)(p.Kb + (size_t)m * 128 + j * 64 + 8 * i);
    _Pragma("unroll") for (int e = 0; e < 4; ++e) dn += bflo(qv[i][e]) * bflo(kv[e]) + bfhi(qv[i][e]) * bfhi(kv[e]);
  }
  float s[2];
  _Pragma("unroll") for (int u = 0; u < 2; ++u) {
    int idx = lane + 1 + 64 * u;
    int ic = idx < 128 ? idx : 127;
    const float* kp = p.cache_k + ((size_t)(b * 128 + ic) * 2 + j) * 64;
    float d = 0.f;
    _Pragma("unroll") for (int i = 0; i < 8; ++i) {
      float4 k0 = *(const float4*)(kp + 8 * i), k1 = *(const float4*)(kp + 8 * i + 4);
      d += bflo(qv[i][0]) * k0.x + bfhi(qv[i][0]) * k0.y + bflo(qv[i][1]) * k0.z + bfhi(qv[i][1]) * k0.w;
      d += bflo(qv[i][2]) * k1.x + bfhi(qv[i][2]) * k1.y + bflo(qv[i][3]) * k1.z + bfhi(qv[i][3]) * k1.w;
    }
    s[u] = idx < 128 ? d : dn;
  }
  const float sink = p.sinks[hd];
  float mx = fmaxf(fmaxf(s[0], s[1]), sink);
  _Pragma("unroll") for (int o = 32; o >= 1; o >>= 1) mx = fmaxf(mx, __shfl_xor(mx, o));
  float p0 = __expf(s[0] - mx), p1 = __expf(s[1] - mx);
  float l = p0 + p1;
  _Pragma("unroll") for (int o = 32; o >= 1; o >>= 1) l += __shfl_xor(l, o);
  l += __expf(sink - mx);
  float o = 0.f;
  const float* vb = p.cache_v + ((size_t)(b * 128) * 2 + j) * 64 + lane;
  _Pragma("unroll 32") for (int idx = 1; idx < 128; ++idx) {
    float pv = __shfl(idx <= 64 ? p0 : p1, (idx - 1) & 63);
    o += pv * vb[(size_t)idx * 128];
  }
  o += __shfl(p1, 63) * bf2f(p.Vb[(size_t)m * 128 + j * 64 + lane]);
  size_t off = (size_t)m * 512 + hd * 64 + lane;
  p.YA[(size_t)m * 1024 + hd * 64 + lane] = (bfr)f2bf(o * frcp(l) * bf2f(p.ZA[off]));
}

DI void hgrn_gates(const Params& p, int row0, int hh, float* sTot, float (&L)[32], float (&kin)[32], float& t0, float& lc) {
  const int t = TID, c = t & 127, half = t >> 7, ch = hh * 128 + c;
  const float lbv = frcp(1.f + __expf(p.lb_logits[512 + ch] - p.lb_logits[ch]));
  const bfr* zp = p.ZF + (size_t)(row0 + half * 32) * 512 + ch;
  float run = 0.f;
  _Pragma("unroll") for (int jj = 0; jj < 32; ++jj) {
    float z = bf2f(zp[(size_t)jj * 512]);
    z = fminf(fmaxf(z, -30.f), 30.f);
    float em = __expf(-z), sg = frcp(1.f + em);
    float f = lbv + (1.f - lbv) * sg;
    kin[jj] = (1.f - lbv) * em * sg;
    run += __logf(f);
    L[jj] = run;
  }
  sTot[half * 128 + c] = run;
  __syncthreads();
  t0 = sTot[c]; lc = t0 + sTot[128 + c];
  if (half) { _Pragma("unroll") for (int jj = 0; jj < 32; ++jj) L[jj] += t0; }
}

DI void hgrn_fused_item(const Params& p, int n, int hh, char* smem) {
  bfr* sVt = (bfr*)smem;
  bfr* sKt = sVt + 128 * LDT;
  bfr* sQh = sKt + 128 * LDT;
  bfr* sKh = sQh + 64 * 136;
  bfr* sAm = sKt;
  float* sTot = (float*)(sKh + 64 * 136);
  const int t = TID, lane = t & 63, w = t >> 6, h = lane >> 5, c = t & 127, half = t >> 7;
  const int row0 = n * 64;
  __syncthreads();
  {
    const bfr* ip = p.IB + (size_t)(row0 + half * 32) * 512 + hh * 128 + c;
    _Pragma("unroll") for (int q4 = 0; q4 < 4; ++q4) {
      u32x4 o;
      _Pragma("unroll") for (int e = 0; e < 4; ++e) {
        int jj = q4 * 8 + 2 * e;
        o[e] = (unsigned)ip[(size_t)jj * 512] | ((unsigned)ip[(size_t)(jj + 1) * 512] << 16);
      }
      *(u32x4*)(sVt + c * LDT + half * 32 + q4 * 8) = o;
    }
  }
  {
    float L[32], kin[32], t0, lc;
    hgrn_gates(p, row0, hh, sTot, L, kin, t0, lc);
    _Pragma("unroll") for (int q4 = 0; q4 < 4; ++q4) {
      u32x4 o;
      _Pragma("unroll") for (int e = 0; e < 4; ++e) {
        int jj = q4 * 8 + 2 * e;
        o[e] = pk2(kin[jj] * __expf(lc - L[jj]), kin[jj + 1] * __expf(lc - L[jj + 1]));
      }
      *(u32x4*)(sKt + c * LDT + half * 32 + q4 * 8) = o;
    }
    if (half == 0) p.dec[(n * 4 + hh) * 128 + c] = __expf(lc);
    bfr* qp = p.QB + (size_t)(row0 + half * 32) * 512 + hh * 128 + c;
    _Pragma("unroll") for (int jj = 0; jj < 32; ++jj) {
      const float qv = bf2f(qp[(size_t)jj * 512]);
      qp[(size_t)jj * 512] = (bfr)(pk2(qv * __expf(L[jj]), 0.f) & 0xffffu);
      const float dl = L[jj] - t0;
      sQh[(half * 32 + jj) * 136 + c] = (bfr)(pk2(qv * __expf(fminf(dl, 80.f)), 0.f) & 0xffffu);
      sKh[(half * 32 + jj) * 136 + c] = (bfr)(pk2(kin[jj] * __expf(fminf(-dl, 80.f)), 0.f) & 0xffffu);
    }
  }
  __syncthreads();
  {
    int r = lane & 31; asm volatile("" : "+v"(r));
    const int wv = w >> 1, wk = w & 1;
    f32x16 acc[2][2];
    _Pragma("unroll") for (int a = 0; a < 2; ++a) _Pragma("unroll") for (int b = 0; b < 2; ++b) acc[a][b] = zero16();
    _Pragma("unroll") for (int s = 0; s < 4; ++s) {
      bf16x8 af[2], bf[2];
      _Pragma("unroll") for (int x = 0; x < 2; ++x) {
        af[x] = *(const bf16x8*)(sVt + (wv * 64 + x * 32 + r) * LDT + 16 * s + 8 * h);
        bf[x] = *(const bf16x8*)(sKt + (wk * 64 + x * 32 + r) * LDT + 16 * s + 8 * h);
      }
      _Pragma("unroll") for (int a = 0; a < 2; ++a) _Pragma("unroll") for (int b = 0; b < 2; ++b) acc[a][b] = mfma(af[a], bf[b], acc[a][b]);
    }
    float* up = p.Ust + (size_t)(n * 4 + hh) * 16384;
    _Pragma("unroll") for (int a = 0; a < 2; ++a) _Pragma("unroll") for (int b = 0; b < 2; ++b) _Pragma("unroll") for (int i = 0; i < 16; ++i) {
      int v = wv * 64 + a * 32 + crow(i, h), k = wk * 64 + b * 32 + r;
      up[v * 128 + k] = acc[a][b][i];
    }
  }
  const int jt = w >> 1, it = w & 1;
  int r2 = lane & 31; asm volatile("" : "+v"(r2));
  f32x16 am = zero16();
  if (jt <= it) {
    _Pragma("unroll") for (int s = 0; s < 8; ++s) {
      bf16x8 kf = *(const bf16x8*)(sKh + (jt * 32 + r2) * 136 + 16 * s + 8 * h);
      bf16x8 qf = *(const bf16x8*)(sQh + (it * 32 + r2) * 136 + 16 * s + 8 * h);
      am = mfma(kf, qf, am);
    }
  }
  __syncthreads();
  {
    int r3 = lane & 31; asm volatile("" : "+v"(r3));
    const int i = it * 32 + r3;
    _Pragma("unroll") for (int g = 0; g < 4; ++g) {
      int j0 = jt * 32 + 8 * g + 4 * h;
      float x0 = (j0 <= i) ? am[4 * g] : 0.f, x1 = (j0 + 1 <= i) ? am[4 * g + 1] : 0.f;
      float x2 = (j0 + 2 <= i) ? am[4 * g + 2] : 0.f, x3 = (j0 + 3 <= i) ? am[4 * g + 3] : 0.f;
      *(u32x2*)(sAm + i * LDT + j0) = pack4(x0, x1, x2, x3);
    }
  }
  __syncthreads();
  {
    int r = lane & 31; asm volatile("" : "+v"(r));
    f32x16 oacc[2]; oacc[0] = zero16(); oacc[1] = zero16();
    _Pragma("unroll") for (int s = 0; s < 4; ++s) {
      bf16x8 vf = *(const bf16x8*)(sVt + (32 * w + r) * LDT + 16 * s + 8 * h);
      _Pragma("unroll") for (int i2 = 0; i2 < 2; ++i2) {
        bf16x8 af2 = *(const bf16x8*)(sAm + (i2 * 32 + r) * LDT + 16 * s + 8 * h);
        oacc[i2] = mfma(vf, af2, oacc[i2]);
      }
    }
    _Pragma("unroll") for (int i2 = 0; i2 < 2; ++i2) _Pragma("unroll") for (int g = 0; g < 4; ++g)
      *(u32x2*)(p.YB + (size_t)(row0 + i2 * 32 + r) * 1024 + hh * 128 + 32 * w + 8 * g + 4 * h) =
          pack4(oacc[i2][4 * g], oacc[i2][4 * g + 1], oacc[i2][4 * g + 2], oacc[i2][4 * g + 3]);
  }
}

DI void hgrn_sample_item(const Params& p, int b, int hh, char* smem) {
  float* sf = (float*)smem; float* skin = sf + 128; float* sq = skin + 128; float* sv = sq + 128; float* sred = sv + 128; float* s2 = sred + 8 * 128;
  const int t = TID, m = SEQ + b;
  __syncthreads();
  if (t < 128) {
    int ch = hh * 128 + t;
    float lbv = frcp(1.f + __expf(p.lb_logits[512 + ch] - p.lb_logits[ch]));
    float z = bf2f(p.ZF[(size_t)m * 512 + ch]);
    z = fminf(fmaxf(z, -30.f), 30.f);
    float em = __expf(-z), sg = frcp(1.f + em);
    sf[t] = lbv + (1.f - lbv) * sg; skin[t] = (1.f - lbv) * em * sg;
    sq[t] = bf2f(p.QB[(size_t)m * 512 + ch]); sv[t] = bf2f(p.IB[(size_t)m * 512 + ch]);
  }
  __syncthreads();
  const int v4 = (t & 31) * 4, kg = t >> 5;
  float4 vv = *(const float4*)(sv + v4);
  float4 o = {0.f, 0.f, 0.f, 0.f};
  const size_t sb = (size_t)(b * 4 + hh) * 16384;
  _Pragma("unroll 8") for (int kk = 0; kk < 16; ++kk) {
    int k = kg * 16 + kk;
    float4 S = *(const float4*)(p.state + sb + k * 128 + v4);
    float f = sf[k], ki = skin[k], qq = sq[k];
    float4 Sn; Sn.x = f * S.x + ki * vv.x; Sn.y = f * S.y + ki * vv.y; Sn.z = f * S.z + ki * vv.z; Sn.w = f * S.w + ki * vv.w;
    *(float4*)(p.out_ss + sb + k * 128 + v4) = Sn;
    o.x += qq * Sn.x; o.y += qq * Sn.y; o.z += qq * Sn.z; o.w += qq * Sn.w;
  }
  *(float4*)(sred + kg * 128 + v4) = o;
  __syncthreads();
  float ov = 0.f;
  if (t < 128) {
    _Pragma("unroll") for (int g = 0; g < 8; ++g) ov += sred[g * 128 + t];
    float ss = ov * ov;
    _Pragma("unroll") for (int of = 32; of >= 1; of >>= 1) ss += __shfl_xor(ss, of);
    if ((t & 63) == 0) s2[t >> 6] = ss;
  }
  __syncthreads();
  if (t < 128) {
    float sc = rsqrtf((s2[0] + s2[1]) * (1.f / 128.f) + EPS);
    size_t off = (size_t)m * 512 + hh * 128 + t;
    p.YB[(size_t)m * 1024 + hh * 128 + t] = (bfr)f2bf(ov * sc * p.og[t] * bf2f(p.ZB[off]));
  }
}

DI void hgrn_sample_wave(const Params& p, int b, int hh, int lane, float* sw  ) {
  const int m = SEQ + b;
  _Pragma("unroll") for (int u = 0; u < 2; ++u) {
    const int k = lane + 64 * u, ch = hh * 128 + k;
    const float lbv = frcp(1.f + __expf(p.lb_logits[512 + ch] - p.lb_logits[ch]));
    float z = bf2f(p.ZF[(size_t)m * 512 + ch]);
    z = fminf(fmaxf(z, -30.f), 30.f);
    const float em = __expf(-z), sg = frcp(1.f + em);
    sw[k] = lbv + (1.f - lbv) * sg; sw[128 + k] = (1.f - lbv) * em * sg; sw[256 + k] = bf2f(p.QB[(size_t)m * 512 + ch]);
  }
  const int v4 = (lane & 31) * 4, kg = lane >> 5;
  const u32x2 vraw = *(const u32x2*)(p.IB + (size_t)m * 512 + hh * 128 + v4);
  const float4 vv = {bflo(vraw[0]), bfhi(vraw[0]), bflo(vraw[1]), bfhi(vraw[1])};
  __builtin_amdgcn_s_waitcnt(0xc07f);
  __builtin_amdgcn_wave_barrier();
  float4 o = {0.f, 0.f, 0.f, 0.f};
  const size_t sb = (size_t)(b * 4 + hh) * 16384 + (size_t)(kg * 64) * 128 + v4;
  const volatile float* swv = sw;
  _Pragma("unroll 16") for (int kk = 0; kk < 64; ++kk) {
    const int k = kg * 64 + kk;
    const float4 S = *(const float4*)(p.state + sb + kk * 128);
    const float f = swv[k], ki = swv[128 + k], qq = swv[256 + k];
    float4 Sn; Sn.x = f * S.x + ki * vv.x; Sn.y = f * S.y + ki * vv.y; Sn.z = f * S.z + ki * vv.z; Sn.w = f * S.w + ki * vv.w;
    *(float4*)(p.out_ss + sb + kk * 128) = Sn;
    o.x += qq * Sn.x; o.y += qq * Sn.y; o.z += qq * Sn.z; o.w += qq * Sn.w;
  }
  o.x += __shfl_xor(o.x, 32); o.y += __shfl_xor(o.y, 32); o.z += __shfl_xor(o.z, 32); o.w += __shfl_xor(o.w, 32);
  float ss = o.x * o.x + o.y * o.y + o.z * o.z + o.w * o.w;
  _Pragma("unroll") for (int of = 16; of >= 1; of >>= 1) ss += __shfl_xor(ss, of);
  const float sc = rsqrtf(ss * (1.f / 128.f) + EPS);
  if (kg == 0) {
    const float4 og = *(const float4*)(p.og + v4);
    const u32x2 zb = *(const u32x2*)(p.ZB + (size_t)m * 512 + hh * 128 + v4);
    *(u32x2*)(p.YB + (size_t)m * 1024 + hh * 128 + v4) = pack4(o.x * sc * og.x * bflo(zb[0]), o.y * sc * og.y * bfhi(zb[0]), o.z * sc * og.z * bflo(zb[1]), o.w * sc * og.w * bfhi(zb[1]));
  }
  __builtin_amdgcn_wave_barrier();
}

DI void cache_shift_copy(const Params& p, int gw, int nw, int lane, int part) {
  const int lo = part * (64 * 4064), hi = lo + 64 * 4064;
  for (int idx = lo + gw * 64 + lane; idx < hi; idx += nw * 64) {
    int b = idx / 4064, i4 = idx - b * 4064;
    size_t so = (size_t)b * 16384 + 128 + i4 * 4, dof = (size_t)b * 16384 + i4 * 4;
    *(float4*)(p.out_ks + dof) = *(const float4*)(p.cache_k + so);
    *(float4*)(p.out_vs + dof) = *(const float4*)(p.cache_v + so);
  }
}

DI void phase_mix(const Params& p, char* smem, char* smem_all) {
  const int wave = threadIdx.x >> 6, lane = threadIdx.x & 63, gw = blockIdx.x * 8 + wave, nw = gridDim.x * 8;
  float* sw = (float*)(smem_all + wave * 2048);
  if (gw & 1) {
    for (int it = gw >> 1; it < 1024; it += nw >> 1) attn_sample_wave(p, it >> 3, it & 7);
    cache_shift_copy(p, gw >> 1, nw >> 1, lane, 0);
    for (int it = gw; it < 4096; it += nw) attn_prompt_wave(p, it >> 3, it & 7, lane);
  } else {
    int it = gw;
    if (it < 4096) { attn_prompt_wave(p, it >> 3, it & 7, lane); it += nw; }
    if ((gw & 3) == 0) { for (int hs = gw >> 2; hs < 512; hs += nw >> 2) hgrn_sample_wave(p, hs >> 2, hs & 3, lane, sw); }
    cache_shift_copy(p, gw >> 1, nw >> 1, lane, 1);
    for (; it < 4096; it += nw) attn_prompt_wave(p, it >> 3, it & 7, lane);
  }
  for (int it = VBID; it < 1024; it += VGRID) hgrn_fused_item(p, it >> 2, it & 3, smem);
}

#define SCAN_LOAD(U, Dd, N0) _Pragma("unroll") for (int i = 0; i < 32; ++i) { U[i] = up[(size_t)((N0) + i) * 65536]; Dd[i] = dp[((N0) + i) * 512]; }
#define SCAN_STEP(U, Dd, N0) _Pragma("unroll") for (int i = 0; i < 32; ++i) { sp[(size_t)((N0) + i) * 65536] = (bfr)(pk2(S, 0.f) & 0xffffu); S = Dd[i] * S + U[i]; }
DI void phase_scan(const Params& p, int eb) {
  const int e = eb * 256 + threadIdx.x;
  const int hh = e >> 14, k = e & 127, v = (e >> 7) & 127;
  const float* up = p.Ust + e;
  bfr* sp = p.S16 + e;
  const float* dp = p.dec + hh * 128 + k;
  float S = 0.f;
  float ua[32], da[32], ub[32], db[32];
  SCAN_LOAD(ua, da, 0)
  for (int n0 = 0; n0 < NCH; n0 += 64) {
    SCAN_LOAD(ub, db, n0 + 32)
    SCAN_STEP(ua, da, n0)
    if (n0 + 64 < NCH) { SCAN_LOAD(ua, da, n0 + 64) }
    SCAN_STEP(ub, db, n0 + 32)
  }
  p.out_sp[(hh * 128 + k) * 128 + v] = S;
}

DI void hgrn_out_wave(const Params& p, int n, int hh, int it, int lane) {
  const int r = lane & 31, h = lane >> 5;
  const size_t row = (size_t)(n * 64 + it * 32 + r);
  bf16x8 qf[8];
  _Pragma("unroll") for (int s = 0; s < 8; ++s) qf[s] = *(const bf16x8*)(p.QB + row * 512 + hh * 128 + 16 * s + 8 * h);
  const bfr* sb = p.S16 + (size_t)(n * 4 + hh) * 16384 + (size_t)r * 128 + 8 * h;
  f32x16 acc[4];
  _Pragma("unroll") for (int vt = 0; vt < 4; ++vt) {
    acc[vt] = zero16();
    _Pragma("unroll") for (int s = 0; s < 8; ++s) {
      bf16x8 sf = *(const bf16x8*)(sb + vt * 32 * 128 + 16 * s);
      acc[vt] = mfma(sf, qf[s], acc[vt]);
    }
  }
  float ss = 0.f;
  _Pragma("unroll") for (int vt = 0; vt < 4; ++vt) _Pragma("unroll") for (int g = 0; g < 4; ++g) {
    const u32x2 oi = *(const u32x2*)(p.YB + row * 1024 + hh * 128 + 32 * vt + 8 * g + 4 * h);
    acc[vt][4 * g] += bflo(oi[0]); acc[vt][4 * g + 1] += bfhi(oi[0]); acc[vt][4 * g + 2] += bflo(oi[1]); acc[vt][4 * g + 3] += bfhi(oi[1]);
    ss += acc[vt][4 * g] * acc[vt][4 * g] + acc[vt][4 * g + 1] * acc[vt][4 * g + 1] + acc[vt][4 * g + 2] * acc[vt][4 * g + 2] + acc[vt][4 * g + 3] * acc[vt][4 * g + 3];
  }
  ss += __shfl_xor(ss, 32);
  const float sc = rsqrtf(ss * (1.f / 128.f) + EPS);
  _Pragma("unroll") for (int vt = 0; vt < 4; ++vt) _Pragma("unroll") for (int g = 0; g < 4; ++g) {
    const int v = 32 * vt + 8 * g + 4 * h;
    const float4 og = *(const float4*)(p.og + v);
    const u32x2 zb = *(const u32x2*)(p.ZB + row * 512 + hh * 128 + v);
    *(u32x2*)(p.YB + row * 1024 + hh * 128 + v) = pack4(acc[vt][4 * g] * sc * og.x * bflo(zb[0]), acc[vt][4 * g + 1] * sc * og.y * bfhi(zb[0]),
                                                        acc[vt][4 * g + 2] * sc * og.z * bflo(zb[1]), acc[vt][4 * g + 3] * sc * og.w * bfhi(zb[1]));
  }
}

#define XB_TMO      128
#define XB_XCNT(j)  (256  + 64 * (j))
#define XB_XSUB(j)  (1280 + 64 * (j))
#define XB_XGEN(j)  (2304 + 64 * (j))
#define XB_TOP      3328
#define XB_TOPGEN   3392
#define XCD_BAR_WORDS 3456
#define XB_SPIN_CAP (1u << 18)
#define LAS __attribute__((address_space(3)))

__device__ __forceinline__ unsigned xb_ld(unsigned* p)              { return __hip_atomic_load(p, __ATOMIC_RELAXED, __HIP_MEMORY_SCOPE_AGENT); }
__device__ __forceinline__ unsigned xb_add(unsigned* p, unsigned v) { return __hip_atomic_fetch_add(p, v, __ATOMIC_RELAXED, __HIP_MEMORY_SCOPE_AGENT); }
__device__ __forceinline__ unsigned xb_xcc_id() { return (unsigned)__builtin_amdgcn_s_getreg((3 << 11) | 20) & 0xFu; }
#define XB_SPIN(cond, bar) do { unsigned _sp = 0; while (cond) { __builtin_amdgcn_s_sleep(1); \
    if ((++_sp & 255u) == 0u) { if (xb_ld(&(bar)[XB_TMO])) break; if (_sp > XB_SPIN_CAP) { atomicAdd(&(bar)[XB_TMO], 1u); break; } } } } while (0)

struct XcdBarrier {
    unsigned* bar; unsigned x;
    volatile LAS unsigned* st;
};

__device__ __forceinline__ XcdBarrier xcd_barrier_post(unsigned* bar, volatile LAS unsigned* st) {
    XcdBarrier b; b.bar = bar; b.x = xb_xcc_id(); b.st = st;
    if (threadIdx.x == 0) (void)xb_add(&bar[XB_XCNT(b.x)], 1u);
    return b;
}
__device__ __forceinline__ void xcd_barrier_complete(unsigned* bar, unsigned x, unsigned& nloc, unsigned& nx) {
    const unsigned G = gridDim.x * gridDim.y * gridDim.z;
    unsigned sum, cnt, mine, sp = 0u;
    for (;;) {
        sum = 0u; cnt = 0u; mine = 0u;
#pragma unroll
        for (unsigned j = 0; j < 16; ++j) { const unsigned c = xb_ld(&bar[XB_XCNT(j)]); sum += c; cnt += (c > 0u) ? 1u : 0u; mine = (j == x) ? c : mine; }
        if (sum == G) break;
        __builtin_amdgcn_s_sleep(1);
        if ((++sp & 255u) == 0u) { if (xb_ld(&bar[XB_TMO])) break; if (sp > XB_SPIN_CAP) { atomicAdd(&bar[XB_TMO], 1u); break; } }
    }
    nloc = mine > 0u ? mine : 1u; nx = cnt > 0u ? cnt : 1u;
}

__device__ __forceinline__ void xcd_barrier(const XcdBarrier& b) {
    asm volatile("s_waitcnt vmcnt(0)" ::: "memory");
    __syncthreads();
    if (threadIdx.x == 0) {
        unsigned* bar = b.bar;
        __builtin_amdgcn_s_waitcnt(0);
        unsigned nloc = b.st[0], nx = b.st[1];
        if (nloc == 0u) { xcd_barrier_complete(bar, b.x, nloc, nx); b.st[0] = nloc; b.st[1] = nx; }
        const unsigned old = xb_add(&bar[XB_XSUB(b.x)], 1u);
        const unsigned gen = old / nloc;
        if (old + 1u == (gen + 1u) * nloc) {
            __builtin_amdgcn_fence(__ATOMIC_RELEASE, "agent");
            asm volatile("s_waitcnt vmcnt(0)" ::: "memory");
            const unsigned og = xb_add(&bar[XB_TOP], 1u);
            const unsigned tg = og / nx;
            if (og + 1u == (tg + 1u) * nx) xb_add(&bar[XB_TOPGEN], 1u);
            else XB_SPIN(xb_ld(&bar[XB_TOPGEN]) == tg, bar);
            __builtin_amdgcn_fence(__ATOMIC_ACQUIRE, "agent");
            xb_add(&bar[XB_XGEN(b.x)], 1u);
            asm volatile("s_waitcnt vmcnt(0)" ::: "memory");
        } else {
            XB_SPIN(xb_ld(&bar[XB_XGEN(b.x)]) == gen, bar);
            __builtin_amdgcn_fence(__ATOMIC_ACQUIRE, "agent");
            asm volatile("s_waitcnt vmcnt(0)" ::: "memory");
        }
    }
    __syncthreads();
}

static_assert(PANEL_CNT_WORD == XCD_BAR_WORDS, "panel counters follow the barrier words");
__global__ void __launch_bounds__(512, 2) hybrid_megakernel(Params p) {
  extern __shared__ __attribute__((aligned(16))) char smem_all[];
  __shared__ uint4 xb_words;
  if (threadIdx.x == 0) xb_words = make_uint4(0u, 0u, 0u, 0u);
  __syncthreads();
  const XcdBarrier xb = xcd_barrier_post(p.bar, (volatile LAS unsigned*)&xb_words);
  char* smem = smem_all + (threadIdx.x >> 8) * 73728;
#ifndef REPMASK
#define REPMASK 0
#endif
#define RUN_PHASE(n, ...) if (p.phase_lo <= n && n <= p.phase_hi) { if (n != p.phase_lo) xcd_barrier(xb); __VA_ARGS__; if ((REPMASK >> n) & 1) { xcd_barrier(xb); __VA_ARGS__; } }
  RUN_PHASE(0, phase_prep(p, smem))
  RUN_PHASE(1, { if (VBID < 48) phase_mod(p, smem); else phase_prep2(p, smem, VBID - 48, VGRID - 48); })
  RUN_PHASE(2, phase_h(p))
  RUN_PHASE(3, {
    pg8::Gemm g{p.H, p.Wt_all, MPAD, NALL, 1024};
    pg8::StaticOrder S; S.init(MPAD, NALL, (int)gridDim.x, (int)blockIdx.x);
    EpiMain E{p};
    pg8::gemm_phase<EpiMain, pg8::StaticOrder, false>((PG8_LAS unsigned char*)smem_all, g, S, E, nullptr);
  })
  RUN_PHASE(4, phase_mix(p, smem, smem_all))
  RUN_PHASE(5, {
    if (threadIdx.x < 256) { for (int eb = blockIdx.x; eb < 256; eb += gridDim.x) phase_scan(p, eb); }
    else { const int wt = blockIdx.x * 4 + ((threadIdx.x >> 6) - 4); if (wt < 128) sample_chain_wave(p, wt, threadIdx.x & 63); }
  })
  RUN_PHASE(6, {
    for (int wi = blockIdx.x * 8 + (threadIdx.x >> 6); wi < 2048; wi += gridDim.x * 8) hgrn_out_wave(p, wi >> 3, (wi >> 1) & 3, wi & 1, threadIdx.x & 63);
  })
  RUN_PHASE(7, {
    pg8::Gemm g{p.YA, p.Wt_pab, SEQ, 1024, 1024};
    pg8::StaticOrder S; S.init(SEQ, 1024, (int)gridDim.x, (int)blockIdx.x);
    EpiMerge E{p};
    pg8::gemm_phase<EpiMerge, pg8::StaticOrder, false>((PG8_LAS unsigned char*)smem_all, g, S, E, nullptr);
  })
  RUN_PHASE(8, {
    pg8::Gemm g{p.Y, p.Wt_out, SEQ, 1024, 1024};
    pg8::StaticOrder S; S.init(SEQ, 1024, (int)gridDim.x, (int)blockIdx.x);
    EpiOut E{p};
    pg8::gemm_phase<EpiOut, pg8::StaticOrder, false>((PG8_LAS unsigned char*)smem_all, g, S, E, nullptr);
  })
}

#ifndef ONE_LAUNCH
#define ONE_LAUNCH 1
#endif
constexpr size_t kDynLds = 147456;

extern "C" void kernel_launch(void* const* d_in, const int* in_sizes, int n_in, void* d_out, int out_size, void* d_ws, size_t ws_size,
                              hipStream_t stream) {
  static int grid_blocks = 0;
  if (!grid_blocks) {
    int dev = 0, cus = 0, per_cu = 0;
    (void)hipGetDevice(&dev);
    (void)hipDeviceGetAttribute(&cus, hipDeviceAttributeMultiprocessorCount, dev);
    (void)hipFuncSetAttribute((const void*)hybrid_megakernel, hipFuncAttributeMaxDynamicSharedMemorySize, (int)kDynLds);
    (void)hipOccupancyMaxActiveBlocksPerMultiprocessor(&per_cu, hybrid_megakernel, 512, kDynLds);
    if (per_cu > 1) per_cu = 1;
    if (per_cu < 1) per_cu = 1;
    grid_blocks = cus * per_cu;
  }
  Params p{};
  const float* const* in = (const float* const*)d_in;
  p.x_prompt = in[0]; p.x_sample = in[1]; p.cache_k = in[2]; p.cache_v = in[3]; p.state = in[4]; p.c_prompt = in[5]; p.c_sample = in[6];
  p.w_ada = in[7]; p.b_ada = in[8]; p.norm_g = in[9]; p.w_in = in[10]; p.qg = in[11]; p.kg = in[12]; p.sinks = in[13]; p.lb_logits = in[14];
  p.og = in[15]; p.w_merge = in[16]; p.b_merge = in[17]; p.w_pa = in[18]; p.w_pb = in[19]; p.w_out = in[20];
  float* o = (float*)d_out;
  p.out_yp = o; o += (size_t)SEQ * DM;
  p.out_ys = o; o += (size_t)NBT * DM;
  p.out_kp = o; o += 128 * 128;
  p.out_vp = o; o += 128 * 128;
  p.out_sp = o; o += 4 * 128 * 128;
  p.out_ks = o; o += (size_t)NBT * 128 * 128;
  p.out_vs = o; o += (size_t)NBT * 128 * 128;
  p.out_ss = o;
  char* wsp = (char*)d_ws;
  auto take = [&](size_t bytes) { char* r = wsp; wsp += (bytes + 255) & ~(size_t)255; return r; };
  p.bar = (unsigned*)take((size_t)(XCD_BAR_WORDS + 256) * 4);
  p.Wt_all = (bfr*)take((size_t)NALL * 1024 * 2);
  p.Wt_pab = (bfr*)take((size_t)1024 * 1024 * 2);
  p.Wt_out = (bfr*)take((size_t)1024 * 1024 * 2);
  p.Wt_ada = (bfr*)take((size_t)3072 * 1024 * 2);
  p.Cb = (bfr*)take((size_t)256 * 1024 * 2);
  p.mod = (float*)take((size_t)256 * 3072 * 4);
  p.Ys = (bfr*)take((size_t)128 * 1024 * 2);
  p.H = (bfr*)take((size_t)MPAD * 1024 * 2);
  p.YA = p.H; p.YB = p.H + 512;
  p.ZA = (bfr*)take((size_t)MTOT * 512 * 2);
  p.S16 = p.ZA;
  p.Q = (bfr*)take((size_t)MTOT * 512 * 2);
  p.QB = (bfr*)take((size_t)MTOT * 512 * 2);
  p.Y = p.Q;
  p.Kb = (bfr*)take((size_t)MTOT * 128 * 2);
  p.Vb = (bfr*)take((size_t)MTOT * 128 * 2);
  p.IB = (bfr*)take((size_t)MTOT * 512 * 2);
  p.ZB = (bfr*)take((size_t)MTOT * 512 * 2);
  p.ZF = (bfr*)take((size_t)MTOT * 512 * 2);
  p.GA = (bfr*)take((size_t)MTOT * 1024 * 2);
  p.GB = (bfr*)take((size_t)MTOT * 1024 * 2);
  p.dec = (float*)take((size_t)NCH * 4 * 128 * 4);
  p.Ust = p.out_yp;
  if ((size_t)(wsp - (char*)d_ws) > ws_size) { fprintf(stderr, "workspace too small\n"); return; }
  (void)hipMemsetAsync(p.bar, 0, (size_t)(XCD_BAR_WORDS + 256) * 4, stream);
#if ONE_LAUNCH
  p.phase_lo = 0; p.phase_hi = 8;
  void* args[] = {&p};
  hipError_t e = hipLaunchCooperativeKernel((void*)hybrid_megakernel, dim3(grid_blocks), dim3(512), args, kDynLds, stream);
  if (e != hipSuccess) fprintf(stderr, "cooperative launch failed: %s (grid %d)\n", hipGetErrorString(e), grid_blocks);
#else
  for (int ph = 0; ph <= 8; ++ph) {
    p.phase_lo = ph; p.phase_hi = ph;
    hipLaunchKernelGGL(hybrid_megakernel, dim3(grid_blocks), dim3(512), kDynLds, stream, p);
  }
#endif
}
```

```cpp
#include <hip/hip_runtime.h>
#include <cstdio>

#define DI __device__ __forceinline__
typedef unsigned short bfr;
using bf16x8 = __attribute__((ext_vector_type(8))) short;
using f32x16 = __attribute__((ext_vector_type(16))) float;
using u32x4 = __attribute__((ext_vector_type(4))) unsigned;
using u32x2 = __attribute__((ext_vector_type(2))) unsigned;

constexpr int DM = 1024, SEQ = 16384, NBT = 128, MTOT = SEQ + NBT;
constexpr int NALL = 5376;
constexpr int NCH = 256;
constexpr float EPS = 1e-6f;
constexpr int PANEL_CNT_WORD = 3456;
constexpr int LDT = 72;
constexpr int MPAD = 16640;
#define TID ((int)(threadIdx.x & 255))
#define VBID ((int)(blockIdx.x * 2 + (threadIdx.x >> 8)))
#define VGRID ((int)(gridDim.x * 2))

struct Params {
  const float *x_prompt, *x_sample, *cache_k, *cache_v, *state, *c_prompt, *c_sample;
  const float *w_ada, *b_ada, *norm_g, *w_in, *qg, *kg, *sinks, *lb_logits, *og, *w_merge, *b_merge, *w_pa, *w_pb, *w_out;
  float *out_yp, *out_ys, *out_kp, *out_vp, *out_sp, *out_ks, *out_vs, *out_ss;
  bfr *Wt_all, *Wt_pab, *Wt_out, *Wt_ada, *Cb, *H, *Q, *QB, *Kb, *Vb, *ZA, *IB, *ZB, *GA, *GB, *YA, *YB, *Y;
  float *mod, *dec, *Ust;
  bfr* ZF;
  bfr* S16;
  bfr* Ys;
  unsigned* bar;
  int phase_lo, phase_hi;
};

DI unsigned f2bf(float x) { unsigned u = __float_as_uint(x); u += 0x7fffu + ((u >> 16) & 1u); return u >> 16; }
typedef __bf16 hbf2 __attribute__((ext_vector_type(2)));
typedef float hf2 __attribute__((ext_vector_type(2)));
DI unsigned pk2(float a, float b) { hf2 v = {a, b}; return __builtin_bit_cast(unsigned, __builtin_convertvector(v, hbf2)); }
DI float bf2f(unsigned b) { return __uint_as_float(b << 16); }
DI float bflo(unsigned u) { return __uint_as_float(u << 16); }
DI float bfhi(unsigned u) { return __uint_as_float(u & 0xffff0000u); }
DI int crow(int i, int h) { return (i & 3) + 8 * (i >> 2) + 4 * h; }
DI f32x16 mfma(bf16x8 a, bf16x8 b, f32x16 c) { return __builtin_amdgcn_mfma_f32_32x32x16_bf16(a, b, c, 0, 0, 0); }
DI f32x16 zero16() { f32x16 z; _Pragma("unroll") for (int i = 0; i < 16; ++i) z[i] = 0.f; return z; }
DI float frcp(float x) { return __builtin_amdgcn_rcpf(x); }
DI float fexp(float x) { return __builtin_amdgcn_exp2f(x * 1.4426950408889634f); }
DI float sigmoidf_(float x) { return frcp(1.f + fexp(-x)); }
DI float siluf_(float x) { return x * frcp(1.f + fexp(-x)); }
DI u32x2 pack4(float a, float b, float c, float d) { u32x2 r; r[0] = pk2(a, b); r[1] = pk2(c, d); return r; }

DI int wt_row_of_col(int c) {
  const int pn = c >> 8, cl = c & 255;
  int slot;
  if (pn < 3) {
    const int g = cl >> 6, d = cl & 63;
    if (d >= 32) { const int x = d - 32; slot = 128 + 32 * g + 16 * ((x >> 2) & 1) + 4 * (x >> 3) + (x & 3); }
    else { const int fq = 2 * (d >> 4) + ((d >> 2) & 1), n = (d >> 3) & 1, j = d & 3; slot = 32 * g + 16 * n + 4 * fq + j; }
  } else {
    const int bj = cl >> 7, g = (cl >> 5) & 3, x = cl & 31;
    slot = 128 * bj + 32 * g + 16 * ((x >> 2) & 1) + 4 * (x >> 3) + (x & 3);
  }
  return (pn << 8) + slot;
}

DI void gemm_mainloop(const bfr* __restrict__ A, int lda, int m0, const bfr* __restrict__ W, int ldw, int n0, int K,
                      bfr* sA, bfr* sW, f32x16 (&acc)[2][2]) {
  const int t = TID, lane = t & 63, w = t >> 6, wn = w >> 1, wm = w & 1, r = lane & 31, h = lane >> 5;
  const int lrow = t >> 3, lk = (t & 7) * 8;
  const bfr* ap = A + (size_t)(m0 + lrow) * lda + lk;
  const bfr* wp = W + (size_t)(n0 + lrow) * ldw + lk;
  u32x4 ra[4], rw[4];
  _Pragma("unroll") for (int i = 0; i < 4; ++i) {
    ra[i] = *(const u32x4*)(ap + (size_t)(32 * i) * lda);
    rw[i] = *(const u32x4*)(wp + (size_t)(32 * i) * ldw);
  }
  const int nk = K >> 6;
  for (int kt = 0; kt < nk; ++kt) {
    __syncthreads();
    _Pragma("unroll") for (int i = 0; i < 4; ++i) {
      *(u32x4*)(sA + (lrow + 32 * i) * LDT + lk) = ra[i];
      *(u32x4*)(sW + (lrow + 32 * i) * LDT + lk) = rw[i];
    }
    __syncthreads();
    if (kt + 1 < nk) {
      ap += 64; wp += 64;
      _Pragma("unroll") for (int i = 0; i < 4; ++i) {
        ra[i] = *(const u32x4*)(ap + (size_t)(32 * i) * lda);
        rw[i] = *(const u32x4*)(wp + (size_t)(32 * i) * ldw);
      }
    }
    _Pragma("unroll") for (int kk = 0; kk < 4; ++kk) {
      bf16x8 af[2], bf[2];
      _Pragma("unroll") for (int x = 0; x < 2; ++x) {
        af[x] = *(const bf16x8*)(sW + (wn * 64 + x * 32 + r) * LDT + kk * 16 + 8 * h);
        bf[x] = *(const bf16x8*)(sA + (wm * 64 + x * 32 + r) * LDT + kk * 16 + 8 * h);
      }
      _Pragma("unroll") for (int nt = 0; nt < 2; ++nt)
        _Pragma("unroll") for (int mt = 0; mt < 2; ++mt) acc[nt][mt] = mfma(af[nt], bf[mt], acc[nt][mt]);
    }
  }
}

template <int PERMBASE> DI void transpose_tile(const float* __restrict__ src, int N, bfr* __restrict__ dst, int K, int kt, int nt, float* sm) {
  const int t = TID, k0 = kt * 64, n0 = nt * 64;
  __syncthreads();
  _Pragma("unroll") for (int i = 0; i < 16; ++i) {
    int idx = i * 256 + t, kk = idx >> 6, nn = idx & 63;
    sm[kk * 65 + nn] = src[(size_t)(k0 + kk) * N + n0 + nn];
  }
  __syncthreads();
  _Pragma("unroll") for (int i = 0; i < 8; ++i) {
    int idx = i * 256 + t, nn = idx >> 5, kk = (idx & 31) * 2;
    const int drow = PERMBASE >= 0 ? wt_row_of_col(PERMBASE + n0 + nn) : n0 + nn;
    *(unsigned*)(dst + (size_t)drow * K + k0 + kk) = pk2(sm[kk * 65 + nn], sm[(kk + 1) * 65 + nn]);
  }
}

DI void phase_prep(const Params& p, char* smem) {
  float* sm = (float*)smem;
  for (int it = VBID; it < 768; it += VGRID) transpose_tile<-1>(p.w_ada, 3072, p.Wt_ada, 1024, it / 48, it % 48, sm);
  for (int idx = VBID * 256 + TID; idx < 256 * 1024; idx += VGRID * 256) {
    int row = idx >> 10, col = idx & 1023;
    float v = row < 128 ? p.c_sample[row * 1024 + col] : (row == 128 ? p.c_prompt[col] : 0.f);
    p.Cb[idx] = (bfr)f2bf(v);
  }
}
DI void phase_prep2(const Params& p, char* smem, int vb0, int nvb) {
  float* sm = (float*)smem;
  for (int it = vb0; it < 1856; it += nvb) {
    int i = it;
    if (i < 832) { transpose_tile<0>(p.w_in, 3328, p.Wt_all, 1024, i / 52, i % 52, sm); continue; }
    i -= 832;
    if (i < 512) { transpose_tile<3328>(p.w_merge, 2048, p.Wt_all, 1024, i / 32, i % 32, sm); continue; }
    i -= 512;
    if (i < 128) { transpose_tile<-1>(p.w_pa, 1024, p.Wt_pab, 1024, i / 16, i % 16, sm); continue; }
    i -= 128;
    if (i < 128) { transpose_tile<-1>(p.w_pb, 1024, p.Wt_pab + 512, 1024, i / 16, i % 16, sm); continue; }
    i -= 128;
    transpose_tile<-1>(p.w_out, 1024, p.Wt_out, 1024, i / 16, i % 16, sm);
  }
}

DI void phase_mod(const Params& p, char* smem) {
  bfr* sA = (bfr*)smem; bfr* sW = sA + 128 * LDT;
  const int t = TID, lane = t & 63, w = t >> 6, wn = w >> 1, wm = w & 1, r = lane & 31, h = lane >> 5;
  for (int tile = VBID; tile < 48; tile += VGRID) {
    int m0 = (tile / 24) * 128, n0 = (tile % 24) * 128;
    f32x16 acc[2][2];
    _Pragma("unroll") for (int a = 0; a < 2; ++a) _Pragma("unroll") for (int b = 0; b < 2; ++b) acc[a][b] = zero16();
    gemm_mainloop(p.Cb, 1024, m0, p.Wt_ada, 1024, n0, 1024, sA, sW, acc);
    _Pragma("unroll") for (int nt = 0; nt < 2; ++nt) _Pragma("unroll") for (int mt = 0; mt < 2; ++mt) {
      int m = m0 + wm * 64 + mt * 32 + r;
      _Pragma("unroll") for (int g = 0; g < 4; ++g) {
        int n = n0 + wn * 64 + nt * 32 + 8 * g + 4 * h;
        float4 b = *(const float4*)(p.b_ada + n);
        float4 o; o.x = acc[nt][mt][4 * g] + b.x; o.y = acc[nt][mt][4 * g + 1] + b.y; o.z = acc[nt][mt][4 * g + 2] + b.z; o.w = acc[nt][mt][4 * g + 3] + b.w;
        *(float4*)(p.mod + (size_t)m * 3072 + n) = o;
      }
    }
  }
}

DI void phase_h(const Params& p) {
  const int lane = TID & 63, w = TID >> 6;
  for (int row = VBID * 4 + w; row < MTOT; row += VGRID * 4) {
    const float* xr = row < SEQ ? p.x_prompt + (size_t)row * DM : p.x_sample + (size_t)(row - SEQ) * DM;
    const float* mr = p.mod + (size_t)(row < SEQ ? 128 : row - SEQ) * 3072;
    float4 xv[4]; float ss = 0.f;
    _Pragma("unroll") for (int j = 0; j < 4; ++j) {
      xv[j] = *(const float4*)(xr + j * 256 + lane * 4);
      ss += xv[j].x * xv[j].x + xv[j].y * xv[j].y + xv[j].z * xv[j].z + xv[j].w * xv[j].w;
    }
    _Pragma("unroll") for (int o = 32; o >= 1; o >>= 1) ss += __shfl_xor(ss, o);
    float rs = rsqrtf(ss * (1.f / DM) + EPS);
    _Pragma("unroll") for (int j = 0; j < 4; ++j) {
      int col = j * 256 + lane * 4;
      float4 g = *(const float4*)(p.norm_g + col);
      float4 sh = *(const float4*)(mr + col);
      float4 sc = *(const float4*)(mr + 1024 + col);
      float a = xv[j].x * rs * g.x * (1.f + sc.x) + sh.x;
      float b = xv[j].y * rs * g.y * (1.f + sc.y) + sh.y;
      float c = xv[j].z * rs * g.z * (1.f + sc.z) + sh.z;
      float d = xv[j].w * rs * g.w * (1.f + sc.w) + sh.w;
      *(u32x2*)(p.H + (size_t)row * DM + col) = pack4(a, b, c, d);
    }
  }
}

DI void sincos_red(float a, float& s, float& c) {
  float n = rintf(a * 0.15915494309189535f);
  float rr = fmaf(-n, 6.2831854820251465f, a);
  rr = fmaf(-n, -1.7484555e-7f, rr);
  s = __sinf(rr); c = __cosf(rr);
}

namespace pg8 {
#define PG8_LAS __attribute__((address_space(3)))
typedef unsigned short bf16_t;
typedef short bf16x8 __attribute__((ext_vector_type(8)));
typedef float f32x4 __attribute__((ext_vector_type(4)));
typedef unsigned u32x4 __attribute__((ext_vector_type(4)));
constexpr int BM = 256, BK = 64, HALF = 128, HTB = HALF * BK * 2  , STAGE_BYTES = 8 * HTB, NXCD = 8, WGM = 8;

__host__ __device__ __forceinline__ int lds_byte(int r, int c) { const int st = (r >> 4) * 2 + (c >> 5), rr = r & 15, cc = c & 31, ob = rr * 64 + cc * 2; return st * 1024 + (ob ^ (((ob >> 9) & 1) << 5)); }
__host__ __device__ __forceinline__ void stage_rc(int b, int& R, int& C) { const int st = b / 1024, sb = b % 1024, swz = sb ^ (((sb >> 9) & 1) << 5); R = (st >> 1) * 16 + swz / 64; C = (st & 1) * 32 + (swz % 64) / 2; }
__host__ __device__ __forceinline__ int perm32(int rho) { const int n = rho >> 4, i = rho & 15; return 8 * (i >> 2) + 4 * n + (i & 3); }

struct Unit { int pm, pn; };
struct Gemm { const bf16_t* A; const bf16_t* Bt; int M, N, K; };

struct StaticOrder {
    int nM, nN, nwg, G, c;
    __host__ __device__ void init(int M, int N, int G_, int c_) { nM = M / BM; nN = N / BM; nwg = nM * nN; G = G_; c = c_; }
    __host__ __device__ bool next(int i, Unit& u) const {
        const long L = (long)i * G + c; if (L >= nwg) return false;
        int wgid = (int)L; { const int q = nwg / NXCD, r = nwg % NXCD, xcd = wgid % NXCD, off = wgid / NXCD; wgid = (xcd < r ? xcd * (q + 1) : r * (q + 1) + (xcd - r) * q) + off; }
        const int nig = WGM * nN, gid = wgid / nig, fm = gid * WGM, gsz = (nM - fm) < WGM ? (nM - fm) : WGM;
        u.pm = fm + ((wgid % nig) % gsz); u.pn = (wgid % nig) / gsz; return true;
    }
    __device__ __forceinline__ void a_ready(const Unit&) const {}
    __device__ __forceinline__ void done(const Unit&) const {}
};
template <class Epi, class Sched, bool STAMP = false>
__device__ __forceinline__ void gemm_phase(PG8_LAS unsigned char* lds, const Gemm g, const Sched& S, const Epi& E, unsigned long long* stamps) {
    const int tid = threadIdx.x, wid = __builtin_amdgcn_readfirstlane(tid >> 6), lane = tid & 63, wr = wid >> 2, wc = wid & 3, fr = lane & 15, fq = lane >> 4;
    const int K = g.K, nt = K / BK;
    int ts_lo = 0, ts_hi = 0, nts = 0; const unsigned long long rt_entry = STAMP ? (unsigned long long)wall_clock64() : 0ull;
#define PG8_STAMP() do { if (STAMP && wid == 0 && nts < 64) { const unsigned long long _c = (unsigned long long)clock64(); \
        ts_lo = (lane == nts) ? (int)(unsigned)_c : ts_lo; ts_hi = (lane == nts) ? (int)(unsigned)(_c >> 32) : ts_hi; ++nts; } } while (0)
    PG8_STAMP();
    unsigned voffA[2], voffB[2];
#pragma unroll
    for (int i = 0; i < 2; ++i) { int R, C; stage_rc(tid * 16 + i * 8192, R, C); const int Rb = Epi::PERM ? ((R & ~31) + perm32(R & 31)) : R;
        voffA[i] = (unsigned)(R * K + C) * 2u; voffB[i] = (unsigned)(Rb * K + C) * 2u; }
    const size_t kstep = (size_t)(BK * 2);
    const size_t hstep = (size_t)HALF * K * 2;
    const size_t tstep = 2 * hstep;
    const unsigned ldsw = (unsigned)wid * 1024u;
    const int aoff = lds_byte(wr * 64 + fr, fq * 8), boff = lds_byte(wc * 32 + fr, fq * 8);
#define PG8_SA(b, h) (((b) * 2 + (h)) * HTB)
#define PG8_SB(b, h) ((4 + (b) * 2 + (h)) * HTB)
#define PG8_STAGE(bufoff, gbase, voff) do { _Pragma("unroll") for (int _i = 0; _i < 2; ++_i) \
        __builtin_amdgcn_global_load_lds((const unsigned*)((const char*)(gbase) + (voff)[_i]), (PG8_LAS unsigned*)(lds + (bufoff) + ldsw + _i * 8192), 16, 0, 0); } while (0)
#define PG8_LDA(dst, b, h) do { _Pragma("unroll") for (int m = 0; m < 4; ++m) _Pragma("unroll") for (int k = 0; k < 2; ++k) dst[m][k] = *(const PG8_LAS bf16x8*)(lds + PG8_SA(b, h) + aoff + m * 2048 + k * 1024); } while (0)
#define PG8_LDB(dst, b, h) do { _Pragma("unroll") for (int n = 0; n < 2; ++n) _Pragma("unroll") for (int k = 0; k < 2; ++k) dst[n][k] = *(const PG8_LAS bf16x8*)(lds + PG8_SB(b, h) + boff + n * 2048 + k * 1024); } while (0)
#define PG8_MMA(ai, bj, At, Bt) do { __builtin_amdgcn_s_setprio(1); _Pragma("unroll") for (int m = 0; m < 4; ++m) _Pragma("unroll") for (int n = 0; n < 2; ++n) _Pragma("unroll") for (int k = 0; k < 2; ++k) \
        acc[ai][bj][m][n] = __builtin_amdgcn_mfma_f32_16x16x32_bf16(Bt[n][k], At[m][k], acc[ai][bj][m][n], 0, 0, 0); __builtin_amdgcn_s_setprio(0); } while (0)
#define PG8_WAIT_V(n) asm volatile("s_waitcnt vmcnt(" #n ")" ::: "memory")
#define PG8_WAIT_L(n) asm volatile("s_waitcnt lgkmcnt(" #n ")" ::: "memory")
#define PG8_BAR __builtin_amdgcn_s_barrier()
#define PG8_SCHED __builtin_amdgcn_sched_barrier(0)
    Unit cur, nxt; int ui = 0;
    if (!S.next(0, cur)) return;
    f32x4 acc[2][2][4][2];
#pragma unroll
    for (int a = 0; a < 2; ++a)
#pragma unroll
        for (int b = 0; b < 2; ++b)
#pragma unroll
            for (int m = 0; m < 4; ++m)
#pragma unroll
                for (int n = 0; n < 2; ++n) acc[a][b][m][n] = (f32x4){0.f, 0.f, 0.f, 0.f};
    bf16x8 At[4][2], B0[2][2], B1[2][2];
    const char* cA = (const char*)g.A + (size_t)cur.pm * tstep; const char* cB = (const char*)g.Bt + (size_t)cur.pn * tstep;
    S.a_ready(cur);
    PG8_STAGE(PG8_SB(0, 0), cB, voffB); PG8_STAGE(PG8_SA(0, 0), cA, voffA); PG8_STAGE(PG8_SB(0, 1), cB + hstep, voffB); PG8_STAGE(PG8_SA(0, 1), cA + hstep, voffA);
    if (wr == 1) PG8_BAR;
    PG8_WAIT_V(4); PG8_BAR;
    PG8_STAGE(PG8_SB(1, 0), cB + kstep, voffB); PG8_STAGE(PG8_SA(1, 0), cA + kstep, voffA); PG8_STAGE(PG8_SB(1, 1), cB + hstep + kstep, voffB);
    PG8_WAIT_V(6); PG8_BAR;
    PG8_STAMP();
    for (;;) {
        const bool has_next = S.next(ui + 1, nxt);
        const char* nA = has_next ? (const char*)g.A + (size_t)nxt.pm * tstep : cA; const char* nB = has_next ? (const char*)g.Bt + (size_t)nxt.pn * tstep : cB;
        for (int t = 0; t < nt; t += 2) {
            const bool last = (t == nt - 2);
            const char* a1 = cA + (size_t)(t + 1) * kstep;
            const char* a2 = last ? nA : cA + (size_t)(t + 2) * kstep; const char* b2 = last ? nB : cB + (size_t)(t + 2) * kstep;
            const char* a3 = a2 + kstep; const char* b3 = b2 + kstep;
            if (last && has_next) S.a_ready(nxt);
            if constexpr (Epi::MID_T > 0) { if (t == Epi::MID_T) E.mid(acc, cur, wr, wc, fr, fq); }
            PG8_LDB(B0, 0, 0); PG8_SCHED; PG8_LDA(At, 0, 0); PG8_STAGE(PG8_SA(1, 1), a1 + hstep, voffA);
            PG8_WAIT_L(8); PG8_BAR; PG8_WAIT_L(0); PG8_MMA(0, 0, At, B0); PG8_BAR; PG8_SCHED;
            PG8_LDB(B1, 0, 1); PG8_STAGE(PG8_SB(0, 0), b2, voffB);
            PG8_BAR; PG8_WAIT_L(0); PG8_MMA(0, 1, At, B1); PG8_BAR;
            PG8_LDA(At, 0, 1); PG8_STAGE(PG8_SA(0, 0), a2, voffA);
            PG8_BAR; PG8_WAIT_L(0); PG8_MMA(1, 0, At, B0); PG8_BAR; PG8_SCHED;
            PG8_STAGE(PG8_SB(0, 1), b2 + hstep, voffB);
            PG8_WAIT_V(6); PG8_BAR; PG8_MMA(1, 1, At, B1); PG8_BAR;
            PG8_LDB(B0, 1, 0); PG8_SCHED; PG8_LDA(At, 1, 0); PG8_STAGE(PG8_SA(0, 1), a2 + hstep, voffA);
            PG8_WAIT_L(8); PG8_BAR; PG8_WAIT_L(0); PG8_MMA(0, 0, At, B0); PG8_BAR; PG8_SCHED;
            PG8_LDB(B1, 1, 1); PG8_STAGE(PG8_SB(1, 0), b3, voffB);
            PG8_BAR; PG8_WAIT_L(0); PG8_MMA(0, 1, At, B1); PG8_BAR;
            PG8_LDA(At, 1, 1); PG8_STAGE(PG8_SA(1, 0), a3, voffA);
            PG8_BAR; PG8_WAIT_L(0); PG8_MMA(1, 0, At, B0); PG8_BAR; PG8_SCHED;
            PG8_STAGE(PG8_SB(1, 1), b3 + hstep, voffB);
            PG8_WAIT_V(6); PG8_BAR; PG8_MMA(1, 1, At, B1); PG8_BAR;
        }
        PG8_STAMP();
        if constexpr (!Epi::AFTER_DRAIN) { E(acc, cur, wr, wc, fr, fq); S.done(cur); }
        PG8_STAMP();
        if (!has_next) break;
#pragma unroll
        for (int a = 0; a < 2; ++a)
#pragma unroll
            for (int b = 0; b < 2; ++b)
#pragma unroll
                for (int m = 0; m < 4; ++m)
#pragma unroll
                    for (int n = 0; n < 2; ++n) acc[a][b][m][n] = (f32x4){0.f, 0.f, 0.f, 0.f};
        cur = nxt; cA = nA; cB = nB; ++ui;
    }
    PG8_WAIT_V(0);
    if (wr == 0) PG8_BAR;
    PG8_BAR;
    if constexpr (Epi::AFTER_DRAIN) { E.fused(acc, cur, wr, wc, fr, fq, lds, wid, lane); S.done(cur); }
    PG8_STAMP();
    if (STAMP && wid == 0) { stamps[lane] = lane < nts ? (((unsigned long long)(unsigned)ts_hi << 32) | (unsigned)ts_lo) : 0ull;
        if (lane == 62) stamps[62] = rt_entry; if (lane == 63) stamps[63] = (unsigned long long)wall_clock64(); }
#undef PG8_STAMP
#undef PG8_SA
#undef PG8_SB
#undef PG8_STAGE
#undef PG8_LDA
#undef PG8_LDB
#undef PG8_MMA
#undef PG8_WAIT_V
#undef PG8_WAIT_L
#undef PG8_BAR
#undef PG8_SCHED
}
}
using pf4 = pg8::f32x4;

struct EpiMain {
  static constexpr bool PERM = false, AFTER_DRAIN = false;
  static constexpr int MID_T = 0;
  const Params& p;
  DI void operator()(const pf4 (&acc)[2][2][4][2], const pg8::Unit& u, int wr, int wc, int fr, int fq) const {
    const int pn = u.pn;
    const int rbase = u.pm * 256 + wr * 64 + fr;
    if (pn < 3) {
      const bool isq = pn < 2, isv = (pn == 2) && (wc >= 2);
      const float* gp = isq ? p.qg : p.kg;
      const int d0 = 16 * (fq >> 1) + 4 * (fq & 1), d1 = 32 + 8 * fq;
      float4 g00 = {1.f, 1.f, 1.f, 1.f}, g01 = g00, g10 = g00, g11 = g00;
      if (!isv) { g00 = *(const float4*)(gp + d0); g01 = *(const float4*)(gp + d0 + 8); g10 = *(const float4*)(gp + d1); g11 = *(const float4*)(gp + d1 + 4); }
      _Pragma("unroll") for (int ai = 0; ai < 2; ++ai) {
        if (u.pm * 256 + 128 * ai >= MTOT) continue;
        _Pragma("unroll") for (int m = 0; m < 4; ++m) {
          const int row = rbase + 128 * ai + 16 * m;
          pf4 a00 = acc[ai][0][m][0], a01 = acc[ai][0][m][1], a10 = acc[ai][1][m][0], a11 = acc[ai][1][m][1];
          if (!isv) {
            float ss = 0.f;
            _Pragma("unroll") for (int j = 0; j < 4; ++j) ss += a00[j] * a00[j] + a01[j] * a01[j] + a10[j] * a10[j] + a11[j] * a11[j];
            ss += __shfl_xor(ss, 16); ss += __shfl_xor(ss, 32);
            const float sc = rsqrtf(ss * (1.f / 64.f) + EPS);
            a00[0] *= sc * g00.x; a00[1] *= sc * g00.y; a00[2] *= sc * g00.z; a00[3] *= sc * g00.w;
            a01[0] *= sc * g01.x; a01[1] *= sc * g01.y; a01[2] *= sc * g01.z; a01[3] *= sc * g01.w;
            a10[0] *= sc * g10.x; a10[1] *= sc * g10.y; a10[2] *= sc * g10.z; a10[3] *= sc * g10.w;
            a11[0] *= sc * g11.x; a11[1] *= sc * g11.y; a11[2] *= sc * g11.z; a11[3] *= sc * g11.w;
            if (fq < 2) {
              const float pos = (float)(row < SEQ ? row : SEQ);
              const float invlo[4] = {1.0f, 0.19392274f, 0.03760603f, 0.0072926646f};
              const float invhi[4] = {0.0014142136f, 0.0002742482f, 5.3182957e-05f, 1.0313385e-05f};
              _Pragma("unroll") for (int j = 0; j < 4; ++j) {
                const float inv = (fq & 1) ? invhi[j] : invlo[j];
                float s_, c_; sincos_red(pos * inv, s_, c_);
                const float x1 = a00[j], x2 = a01[j];
                a00[j] = x1 * c_ - x2 * s_; a01[j] = x2 * c_ + x1 * s_;
              }
            }
          }
          if (isq) {
            bfr* qp = p.Q + (size_t)row * 512 + (4 * pn + wc) * 64;
            *(u32x2*)(qp + d0) = pack4(a00[0] * 0.125f, a00[1] * 0.125f, a00[2] * 0.125f, a00[3] * 0.125f);
            *(u32x2*)(qp + d0 + 8) = pack4(a01[0] * 0.125f, a01[1] * 0.125f, a01[2] * 0.125f, a01[3] * 0.125f);
            u32x4 o; o[0] = pk2(a10[0] * 0.125f, a10[1] * 0.125f); o[1] = pk2(a10[2] * 0.125f, a10[3] * 0.125f);
            o[2] = pk2(a11[0] * 0.125f, a11[1] * 0.125f); o[3] = pk2(a11[2] * 0.125f, a11[3] * 0.125f);
            *(u32x4*)(qp + d1) = o;
          } else {
            const int jh = wc & 1;
            bfr* kp = (isv ? p.Vb : p.Kb) + (size_t)row * 128 + jh * 64;
            *(u32x2*)(kp + d0) = pack4(a00[0], a00[1], a00[2], a00[3]);
            *(u32x2*)(kp + d0 + 8) = pack4(a01[0], a01[1], a01[2], a01[3]);
            u32x4 o; o[0] = pk2(a10[0], a10[1]); o[1] = pk2(a10[2], a10[3]); o[2] = pk2(a11[0], a11[1]); o[3] = pk2(a11[2], a11[3]);
            *(u32x4*)(kp + d1) = o;
            float* op = nullptr;
            if (row >= SEQ) op = (isv ? p.out_vs : p.out_ks) + ((size_t)((row - SEQ) * 128 + 127) * 2 + jh) * 64;
            else if (row >= SEQ - 128) op = (isv ? p.out_vp : p.out_kp) + ((size_t)(row - (SEQ - 128)) * 2 + jh) * 64;
            if (op) {
              *(pf4*)(op + d0) = a00; *(pf4*)(op + d0 + 8) = a01; *(pf4*)(op + d1) = a10; *(pf4*)(op + d1 + 4) = a11;
            }
          }
        }
      }
      return;
    }
    const int cw = 32 * wc + 8 * fq;
    bfr* dst; int ld, col, op;
    if (pn < 5) { dst = p.ZA; ld = 512; col = (pn - 3) * 256; op = 1; }
    else if (pn < 7) { dst = p.QB; ld = 512; col = (pn - 5) * 256; op = 0; }
    else if (pn < 9) { dst = p.ZF; ld = 512; col = (pn - 7) * 256; op = 0; }
    else if (pn < 11) { dst = p.IB; ld = 512; col = (pn - 9) * 256; op = 0; }
    else if (pn < 13) { dst = p.ZB; ld = 512; col = (pn - 11) * 256; op = 1; }
    else if (pn < 17) { dst = p.GA; ld = 1024; col = (pn - 13) * 256; op = 2; }
    else { dst = p.GB; ld = 1024; col = (pn - 17) * 256; op = 2; }
    _Pragma("unroll") for (int bj = 0; bj < 2; ++bj) {
      float4 b0 = {0.f, 0.f, 0.f, 0.f}, b1 = b0;
      if (op == 2) { const float* bp = p.b_merge + (pn - 13) * 256 + 128 * bj + cw; b0 = *(const float4*)bp; b1 = *(const float4*)(bp + 4); }
      _Pragma("unroll") for (int ai = 0; ai < 2; ++ai) {
        if (u.pm * 256 + 128 * ai >= MTOT) continue;
        _Pragma("unroll") for (int m = 0; m < 4; ++m) {
          const int row = rbase + 128 * ai + 16 * m;
          pf4 x = acc[ai][bj][m][0], y = acc[ai][bj][m][1];
          if (op == 1) { _Pragma("unroll") for (int j = 0; j < 4; ++j) { x[j] = siluf_(x[j]); y[j] = siluf_(y[j]); } }
          else if (op == 2) {
            x[0] = sigmoidf_(x[0] + b0.x); x[1] = sigmoidf_(x[1] + b0.y); x[2] = sigmoidf_(x[2] + b0.z); x[3] = sigmoidf_(x[3] + b0.w);
            y[0] = sigmoidf_(y[0] + b1.x); y[1] = sigmoidf_(y[1] + b1.y); y[2] = sigmoidf_(y[2] + b1.z); y[3] = sigmoidf_(y[3] + b1.w);
          }
          u32x4 o; o[0] = pk2(x[0], x[1]); o[1] = pk2(x[2], x[3]); o[2] = pk2(y[0], y[1]); o[3] = pk2(y[2], y[3]);
          __builtin_nontemporal_store(o, (u32x4*)(dst + (size_t)row * ld + col + 128 * bj + cw));
        }
      }
    }
  }
};

struct EpiMerge {
  static constexpr bool PERM = true, AFTER_DRAIN = false;
  static constexpr int MID_T = 8;
  const Params& p;
  DI void mid(pf4 (&acc)[2][2][4][2], const pg8::Unit& u, int wr, int wc, int fr, int fq) const {
    int rbase = u.pm * 256 + wr * 64 + fr; const int cbase = u.pn * 256 + 32 * wc + 8 * fq;
    asm volatile("" : "+v"(rbase));
    _Pragma("unroll") for (int ai = 0; ai < 2; ++ai) _Pragma("unroll") for (int m = 0; m < 4; ++m) _Pragma("unroll") for (int bj = 0; bj < 2; ++bj) {
      if (bj == 0 && m == 0) __builtin_amdgcn_sched_barrier(0);
      const size_t off = (size_t)(rbase + 128 * ai + 16 * m) * 1024 + cbase + 128 * bj;
      const u32x4 ga = *(const u32x4*)(p.GA + off), gb = *(const u32x4*)(p.GB + off);
      _Pragma("unroll") for (int e = 0; e < 2; ++e) {
        acc[ai][bj][m][0][2 * e] *= bflo(ga[e]) * __builtin_amdgcn_rcpf(fmaxf(bflo(gb[e]), 1e-30f));
        acc[ai][bj][m][0][2 * e + 1] *= bfhi(ga[e]) * __builtin_amdgcn_rcpf(fmaxf(bfhi(gb[e]), 1e-30f));
        acc[ai][bj][m][1][2 * e] *= bflo(ga[2 + e]) * __builtin_amdgcn_rcpf(fmaxf(bflo(gb[2 + e]), 1e-30f));
        acc[ai][bj][m][1][2 * e + 1] *= bfhi(ga[2 + e]) * __builtin_amdgcn_rcpf(fmaxf(bfhi(gb[2 + e]), 1e-30f));
      }
    }
  }
  DI void operator()(const pf4 (&acc)[2][2][4][2], const pg8::Unit& u, int wr, int wc, int fr, int fq) const {
    const int rbase = u.pm * 256 + wr * 64 + fr, cbase = u.pn * 256 + 32 * wc + 8 * fq;
    _Pragma("unroll") for (int ai = 0; ai < 2; ++ai) _Pragma("unroll") for (int m = 0; m < 4; ++m) _Pragma("unroll") for (int bj = 0; bj < 2; ++bj) {
      const size_t off = (size_t)(rbase + 128 * ai + 16 * m) * 1024 + cbase + 128 * bj;
      const u32x4 g = *(const u32x4*)(p.GB + off);
      const pf4 x = acc[ai][bj][m][0], y = acc[ai][bj][m][1];
      u32x4 o; o[0] = pk2(bflo(g[0]) * x[0], bfhi(g[0]) * x[1]); o[1] = pk2(bflo(g[1]) * x[2], bfhi(g[1]) * x[3]);
      o[2] = pk2(bflo(g[2]) * y[0], bfhi(g[2]) * y[1]); o[3] = pk2(bflo(g[3]) * y[2], bfhi(g[3]) * y[3]);
      *(u32x4*)(p.Y + off) = o;
    }
  }
};

struct EpiOut {
  static constexpr bool PERM = false, AFTER_DRAIN = false;
  static constexpr int MID_T = 0;
  const Params& p;
  DI void operator()(const pf4 (&acc)[2][2][4][2], const pg8::Unit& u, int wr, int wc, int fr, int fq) const {
    const int rbase = u.pm * 256 + wr * 64 + fr, cbase = u.pn * 256 + 32 * wc + 4 * fq;
    const float* gr = p.mod + (size_t)128 * 3072 + 2048;
    _Pragma("unroll") for (int bj = 0; bj < 2; ++bj) _Pragma("unroll") for (int n = 0; n < 2; ++n) {
      const int c = cbase + 128 * bj + 16 * n;
      const pf4 gt = *(const pf4*)(gr + c);
      pf4 xv[8];
      _Pragma("unroll") for (int q = 0; q < 8; ++q) xv[q] = __builtin_nontemporal_load((const pf4*)(p.x_prompt + (size_t)(rbase + 128 * (q >> 2) + 16 * (q & 3)) * DM + c));
      __builtin_amdgcn_sched_barrier(0);
      _Pragma("unroll") for (int q = 0; q < 8; ++q)
        __builtin_nontemporal_store(xv[q] + gt * acc[q >> 2][bj][q & 3][n], (pf4*)(p.out_yp + (size_t)(rbase + 128 * (q >> 2) + 16 * (q & 3)) * DM + c));
      __builtin_amdgcn_sched_barrier(0);
    }
  }
};

DI f32x16 wave_gemm32(const bfr* __restrict__ A, int lda, const bfr* __restrict__ W, int ldw, int K, int lane) {
  const int r = lane & 31, h = lane >> 5;
  const bfr* ap = A + (size_t)r * lda + 8 * h;
  const bfr* wp = W + (size_t)r * ldw + 8 * h;
  f32x16 acc = zero16();
  for (int k0 = 0; k0 < K; k0 += 128) {
    bf16x8 a[8], b[8];
    _Pragma("unroll") for (int q = 0; q < 8; ++q) { a[q] = *(const bf16x8*)(ap + k0 + 16 * q); b[q] = *(const bf16x8*)(wp + k0 + 16 * q); }
    _Pragma("unroll") for (int q = 0; q < 8; ++q) acc = mfma(b[q], a[q], acc);
  }
  return acc;
}

DI void sample_chain_wave(const Params& p, int wt, int lane) {
  const int mt = wt >> 5, nt = wt & 31, r = lane & 31, h = lane >> 5;
  const int m = 32 * mt + r;
  unsigned* cnt = p.bar + PANEL_CNT_WORD + 64 * mt;
  {
    const f32x16 a1 = wave_gemm32(p.YA + (size_t)(SEQ + 32 * mt) * 1024, 1024, p.Wt_pab + (size_t)(32 * nt) * 1024, 1024, 512, lane);
    const f32x16 a2 = wave_gemm32(p.YB + (size_t)(SEQ + 32 * mt) * 1024, 1024, p.Wt_pab + (size_t)(32 * nt) * 1024 + 512, 1024, 512, lane);
    _Pragma("unroll") for (int g = 0; g < 4; ++g) {
      const int n = 32 * nt + 8 * g + 4 * h;
      const u32x2 ga = *(const u32x2*)(p.GA + (size_t)(SEQ + m) * 1024 + n), gb = *(const u32x2*)(p.GB + (size_t)(SEQ + m) * 1024 + n);
      *(u32x2*)(p.Ys + (size_t)m * 1024 + n) = pack4(bflo(ga[0]) * a1[4 * g] + bflo(gb[0]) * a2[4 * g], bfhi(ga[0]) * a1[4 * g + 1] + bfhi(gb[0]) * a2[4 * g + 1],
                                                     bflo(ga[1]) * a1[4 * g + 2] + bflo(gb[1]) * a2[4 * g + 2], bfhi(ga[1]) * a1[4 * g + 3] + bfhi(gb[1]) * a2[4 * g + 3]);
    }
    __builtin_amdgcn_fence(__ATOMIC_RELEASE, "agent");
    asm volatile("s_waitcnt vmcnt(0)" ::: "memory");
    if (lane == 0) __hip_atomic_fetch_add(cnt, 1u, __ATOMIC_RELAXED, __HIP_MEMORY_SCOPE_AGENT);
  }
  {
    unsigned sp = 0;
    while (__hip_atomic_load(cnt, __ATOMIC_RELAXED, __HIP_MEMORY_SCOPE_AGENT) < 32u) { __builtin_amdgcn_s_sleep(2); if (++sp > (1u << 22)) break; }
    __builtin_amdgcn_fence(__ATOMIC_ACQUIRE, "agent");
    asm volatile("s_waitcnt vmcnt(0)" ::: "memory");
  }
  const f32x16 acc = wave_gemm32(p.Ys + (size_t)(32 * mt) * 1024, 1024, p.Wt_out + (size_t)(32 * nt) * 1024, 1024, 1024, lane);
  _Pragma("unroll") for (int g = 0; g < 4; ++g) {
    const int n = 32 * nt + 8 * g + 4 * h;
    const float4 xv = *(const float4*)(p.x_sample + (size_t)m * DM + n), gt = *(const float4*)(p.mod + (size_t)m * 3072 + 2048 + n);
    float4 o;
    o.x = xv.x + gt.x * acc[4 * g]; o.y = xv.y + gt.y * acc[4 * g + 1]; o.z = xv.z + gt.z * acc[4 * g + 2]; o.w = xv.w + gt.w * acc[4 * g + 3];
    *(float4*)(p.out_ys + (size_t)m * DM + n) = o;
  }
}

DI void attn_prompt_item(const Params& p, int qb, int hd, bfr* sVt  ) {
  const int t = TID, lane = t & 63, w = t >> 6, r = lane & 31, h = lane >> 5;
  const int j = hd >> 2, kb0 = qb * 128 - 128;
  __syncthreads();
  _Pragma("unroll") for (int it = 0; it < 8; ++it) {
    int kl = it * 32 + (t & 31), dg = t >> 5, kpos = kb0 + kl;
    u32x4 v = {0u, 0u, 0u, 0u};
    if (kpos >= 0) v = *(const u32x4*)(p.Vb + (size_t)kpos * 128 + j * 64 + dg * 8);
    _Pragma("unroll") for (int e = 0; e < 8; ++e) sVt[(dg * 8 + e) * 264 + kl] = (bfr)((v[e >> 1] >> ((e & 1) * 16)) & 0xffffu);
  }
  __syncthreads();
  const int q0 = qb * 128 + 32 * w, q = q0 + r;
  bf16x8 qf[4];
  _Pragma("unroll") for (int s = 0; s < 4; ++s) qf[s] = *(const bf16x8*)(p.Q + (size_t)q * 512 + hd * 64 + 16 * s + 8 * h);
  f32x16 sacc[5];
  _Pragma("unroll") for (int kt = 0; kt < 5; ++kt) {
    sacc[kt] = zero16();
    int kr = q0 - 128 + 32 * kt + r; kr = kr < 0 ? 0 : kr;
    _Pragma("unroll") for (int s = 0; s < 4; ++s) {
      bf16x8 kf = *(const bf16x8*)(p.Kb + (size_t)kr * 128 + j * 64 + 16 * s + 8 * h);
      sacc[kt] = mfma(kf, qf[s], sacc[kt]);
    }
  }
  const float sink = p.sinks[hd];
  float mx = sink;
  _Pragma("unroll") for (int kt = 0; kt < 5; ++kt) _Pragma("unroll") for (int i = 0; i < 16; ++i) {
    int key = q0 - 128 + 32 * kt + crow(i, h), rel = q - key;
    bool valid = (rel >= 0) && (rel < 128) && (key >= 0);
    float sv = valid ? sacc[kt][i] : -INFINITY;
    sacc[kt][i] = sv; mx = fmaxf(mx, sv);
  }
  mx = fmaxf(mx, __shfl_xor(mx, 32));
  float l = 0.f;
  _Pragma("unroll") for (int kt = 0; kt < 5; ++kt) _Pragma("unroll") for (int i = 0; i < 16; ++i) {
    float pv = __expf(sacc[kt][i] - mx); sacc[kt][i] = pv; l += pv;
  }
  l += __shfl_xor(l, 32);
  l += __expf(sink - mx);
  f32x16 oacc[2]; oacc[0] = zero16(); oacc[1] = zero16();
  _Pragma("unroll") for (int kt = 0; kt < 5; ++kt) _Pragma("unroll") for (int s2 = 0; s2 < 2; ++s2) {
    u32x4 pp;
    _Pragma("unroll") for (int e = 0; e < 4; ++e) pp[e] = pk2(sacc[kt][8 * s2 + 2 * e], sacc[kt][8 * s2 + 2 * e + 1]);
    bf16x8 pf = __builtin_bit_cast(bf16x8, pp);
    _Pragma("unroll") for (int dt = 0; dt < 2; ++dt) {
      const bfr* vp = sVt + (dt * 32 + r) * 264 + 32 * w + 32 * kt + 16 * s2 + 4 * h;
      u32x2 lo = *(const u32x2*)vp, hi = *(const u32x2*)(vp + 8);
      u32x4 vv; vv[0] = lo[0]; vv[1] = lo[1]; vv[2] = hi[0]; vv[3] = hi[1];
      oacc[dt] = mfma(__builtin_bit_cast(bf16x8, vv), pf, oacc[dt]);
    }
  }
  const float il = frcp(l);
  _Pragma("unroll") for (int dt = 0; dt < 2; ++dt) _Pragma("unroll") for (int g = 0; g < 4; ++g) {
    int d = dt * 32 + 8 * g + 4 * h;
    size_t off = (size_t)q * 512 + hd * 64 + d;
    u32x2 za = *(const u32x2*)(p.ZA + off);
    *(u32x2*)(p.YA + (size_t)q * 1024 + hd * 64 + d) = pack4(oacc[dt][4 * g] * il * bflo(za[0]), oacc[dt][4 * g + 1] * il * bfhi(za[0]),
                                  oacc[dt][4 * g + 2] * il * bflo(za[1]), oacc[dt][4 * g + 3] * il * bfhi(za[1]));
  }
}

DI void attn_prompt_wave(const Params& p, int qt, int hd, int lane) {
  const int r = lane & 31, h = lane >> 5, j = hd >> 2;
  const int q0 = qt * 32, q = q0 + r, kb = q0 - 128;
  bf16x8 qf[4];
  _Pragma("unroll") for (int s = 0; s < 4; ++s) qf[s] = *(const bf16x8*)(p.Q + (size_t)q * 512 + hd * 64 + 16 * s + 8 * h);
  f32x16 sacc[5];
  _Pragma("unroll") for (int kt = 0; kt < 5; ++kt) {
    sacc[kt] = zero16();
    int kr = kb + 32 * kt + r; kr = kr < 0 ? 0 : kr;
    _Pragma("unroll") for (int s = 0; s < 4; ++s) {
      bf16x8 kf = *(const bf16x8*)(p.Kb + (size_t)kr * 128 + j * 64 + 16 * s + 8 * h);
      sacc[kt] = mfma(kf, qf[s], sacc[kt]);
    }
  }
  const float sink = p.sinks[hd];
  float mx = sink;
  _Pragma("unroll") for (int kt = 0; kt < 5; ++kt) _Pragma("unroll") for (int i = 0; i < 16; ++i) {
    int key = kb + 32 * kt + crow(i, h), rel = q - key;
    bool valid = (rel >= 0) && (rel < 128) && (key >= 0);
    float sv = valid ? sacc[kt][i] : -INFINITY;
    sacc[kt][i] = sv; mx = fmaxf(mx, sv);
  }
  mx = fmaxf(mx, __shfl_xor(mx, 32));
  float l = 0.f;
  _Pragma("unroll") for (int kt = 0; kt < 5; ++kt) _Pragma("unroll") for (int i = 0; i < 16; ++i) {
    float pv = __expf(sacc[kt][i] - mx); sacc[kt][i] = pv; l += pv;
  }
  l += __shfl_xor(l, 32);
  l += __expf(sink - mx);
  f32x16 oacc[2]; oacc[0] = zero16(); oacc[1] = zero16();
  const bfr* vbase = p.Vb + j * 64 + 2 * r;
  _Pragma("unroll") for (int kt = 0; kt < 5; ++kt) _Pragma("unroll") for (int s2 = 0; s2 < 2; ++s2) {
    u32x4 pp;
    _Pragma("unroll") for (int e = 0; e < 4; ++e) pp[e] = pk2(sacc[kt][8 * s2 + 2 * e], sacc[kt][8 * s2 + 2 * e + 1]);
    unsigned wv[8];
    _Pragma("unroll") for (int jj = 0; jj < 8; ++jj) {
      int key = kb + 32 * kt + 16 * s2 + 8 * (jj >> 2) + 4 * h + (jj & 3); key = key < 0 ? 0 : key;
      wv[jj] = *(const unsigned*)(vbase + (size_t)key * 128);
    }
    u32x4 v0, v1;
    _Pragma("unroll") for (int e = 0; e < 4; ++e) {
      v0[e] = (wv[2 * e] & 0xffffu) | (wv[2 * e + 1] << 16);
      v1[e] = (wv[2 * e] >> 16) | (wv[2 * e + 1] & 0xffff0000u);
    }
    const bf16x8 pa = __builtin_bit_cast(bf16x8, pp);
    oacc[0] = mfma(pa, __builtin_bit_cast(bf16x8, v0), oacc[0]);
    oacc[1] = mfma(pa, __builtin_bit_cast(bf16x8, v1), oacc[1]);
  }
  const float il = frcp(l);
  _Pragma("unroll") for (int i = 0; i < 16; ++i) {
    const int qi = crow(i, h);
    const float ili = __shfl(il, qi);
    const size_t row = (size_t)(q0 + qi);
    const unsigned za = *(const unsigned*)(p.ZA + row * 512 + hd * 64 + 2 * r);
    *(unsigned*)(p.YA + row * 1024 + hd * 64 + 2 * r) = pk2(oacc[0][i] * ili * bflo(za), oacc[1][i] * ili * bfhi(za));
  }
}

DI void attn_sample_wave(const Params& p, int b, int hd) {
  const int lane = TID & 63, j = hd >> 2, m = SEQ + b;
  u32x4 qv[8];
  _Pragma("unroll") for (int i = 0; i < 8; ++i) qv[i] = *(const u32x4*)(p.Q + (size_t)m * 512 + hd * 64 + 8 * i);
  float dn = 0.f;
  _Pragma("unroll") for (int i = 0; i < 8; ++i) {
    u32x4 kv = *(const u32x4*)(p.Kb + (size_t)m * 128 + j * 64 + 8 * i);
    _Pragma("unroll") for (int e = 0; e < 4; ++e) dn += bflo(qv[i][e]) * bflo(kv[e]) + bfhi(qv[i][e]) * bfhi(kv[e]);
  }
  float s[2];
  _Pragma("unroll") for (int u = 0; u < 2; ++u) {
    int idx = lane + 1 + 64 * u;
    int ic = idx < 128 ? idx : 127;
    const float* kp = p.cache_k + ((size_t)(b * 128 + ic) * 2 + j) * 64;
    float d = 0.f;
    _Pragma("unroll") for (int i = 0; i < 8; ++i) {
      float4 k0 = *(const float4*)(kp + 8 * i), k1 = *(const float4*)(kp + 8 * i + 4);
      d += bflo(qv[i][0]) * k0.x + bfhi(qv[i][0]) * k0.y + bflo(qv[i][1]) * k0.z + bfhi(qv[i][1]) * k0.w;
      d += bflo(qv[i][2]) * k1.x + bfhi(qv[i][2]) * k1.y + bflo(qv[i][3]) * k1.z + bfhi(qv[i][3]) * k1.w;
    }
    s[u] = idx < 128 ? d : dn;
  }
  const float sink = p.sinks[hd];
  float mx = fmaxf(fmaxf(s[0], s[1]), sink);
  _Pragma("unroll") for (int o = 32; o >= 1; o >>= 1) mx = fmaxf(mx, __shfl_xor(mx, o));
  float p0 = __expf(s[0] - mx), p1 = __expf(s[1] - mx);
  float l = p0 + p1;
  _Pragma("unroll") for (int o = 32; o >= 1; o >>= 1) l += __shfl_xor(l, o);
  l += __expf(sink - mx);
  float o = 0.f;
  const float* vb = p.cache_v + ((size_t)(b * 128) * 2 + j) * 64 + lane;
  _Pragma("unroll 32") for (int idx = 1; idx < 128; ++idx) {
    float pv = __shfl(idx <= 64 ? p0 : p1, (idx - 1) & 63);
    o += pv * vb[(size_t)idx * 128];
  }
  o += __shfl(p1, 63) * bf2f(p.Vb[(size_t)m * 128 + j * 64 + lane]);
  size_t off = (size_t)m * 512 + hd * 64 + lane;
  p.YA[(size_t)m * 1024 + hd * 64 + lane] = (bfr)f2bf(o * frcp(l) * bf2f(p.ZA[off]));
}

DI void hgrn_gates(const Params& p, int row0, int hh, float* sTot, float (&L)[32], float (&kin)[32], float& t0, float& lc) {
  const int t = TID, c = t & 127, half = t >> 7, ch = hh * 128 + c;
  const float lbv = frcp(1.f + __expf(p.lb_logits[512 + ch] - p.lb_logits[ch]));
  const bfr* zp = p.ZF + (size_t)(row0 + half * 32) * 512 + ch;
  float run = 0.f;
  _Pragma("unroll") for (int jj = 0; jj < 32; ++jj) {
    float z = bf2f(zp[(size_t)jj * 512]);
    z = fminf(fmaxf(z, -30.f), 30.f);
    float em = __expf(-z), sg = frcp(1.f + em);
    float f = lbv + (1.f - lbv) * sg;
    kin[jj] = (1.f - lbv) * em * sg;
    run += __logf(f);
    L[jj] = run;
  }
  sTot[half * 128 + c] = run;
  __syncthreads();
  t0 = sTot[c]; lc = t0 + sTot[128 + c];
  if (half) { _Pragma("unroll") for (int jj = 0; jj < 32; ++jj) L[jj] += t0; }
}

DI void hgrn_fused_item(const Params& p, int n, int hh, char* smem) {
  bfr* sVt = (bfr*)smem;
  bfr* sKt = sVt + 128 * LDT;
  bfr* sQh = sKt + 128 * LDT;
  bfr* sKh = sQh + 64 * 136;
  bfr* sAm = sKt;
  float* sTot = (float*)(sKh + 64 * 136);
  const int t = TID, lane = t & 63, w = t >> 6, h = lane >> 5, c = t & 127, half = t >> 7;
  const int row0 = n * 64;
  __syncthreads();
  {
    const bfr* ip = p.IB + (size_t)(row0 + half * 32) * 512 + hh * 128 + c;
    _Pragma("unroll") for (int q4 = 0; q4 < 4; ++q4) {
      u32x4 o;
      _Pragma("unroll") for (int e = 0; e < 4; ++e) {
        int jj = q4 * 8 + 2 * e;
        o[e] = (unsigned)ip[(size_t)jj * 512] | ((unsigned)ip[(size_t)(jj + 1) * 512] << 16);
      }
      *(u32x4*)(sVt + c * LDT + half * 32 + q4 * 8) = o;
    }
  }
  {
    float L[32], kin[32], t0, lc;
    hgrn_gates(p, row0, hh, sTot, L, kin, t0, lc);
    _Pragma("unroll") for (int q4 = 0; q4 < 4; ++q4) {
      u32x4 o;
      _Pragma("unroll") for (int e = 0; e < 4; ++e) {
        int jj = q4 * 8 + 2 * e;
        o[e] = pk2(kin[jj] * __expf(lc - L[jj]), kin[jj + 1] * __expf(lc - L[jj + 1]));
      }
      *(u32x4*)(sKt + c * LDT + half * 32 + q4 * 8) = o;
    }
    if (half == 0) p.dec[(n * 4 + hh) * 128 + c] = __expf(lc);
    bfr* qp = p.QB + (size_t)(row0 + half * 32) * 512 + hh * 128 + c;
    _Pragma("unroll") for (int jj = 0; jj < 32; ++jj) {
      const float qv = bf2f(qp[(size_t)jj * 512]);
      qp[(size_t)jj * 512] = (bfr)(pk2(qv * __expf(L[jj]), 0.f) & 0xffffu);
      const float dl = L[jj] - t0;
      sQh[(half * 32 + jj) * 136 + c] = (bfr)(pk2(qv * __expf(fminf(dl, 80.f)), 0.f) & 0xffffu);
      sKh[(half * 32 + jj) * 136 + c] = (bfr)(pk2(kin[jj] * __expf(fminf(-dl, 80.f)), 0.f) & 0xffffu);
    }
  }
  __syncthreads();
  {
    int r = lane & 31; asm volatile("" : "+v"(r));
    const int wv = w >> 1, wk = w & 1;
    f32x16 acc[2][2];
    _Pragma("unroll") for (int a = 0; a < 2; ++a) _Pragma("unroll") for (int b = 0; b < 2; ++b) acc[a][b] = zero16();
    _Pragma("unroll") for (int s = 0; s < 4; ++s) {
      bf16x8 af[2], bf[2];
      _Pragma("unroll") for (int x = 0; x < 2; ++x) {
        af[x] = *(const bf16x8*)(sVt + (wv * 64 + x * 32 + r) * LDT + 16 * s + 8 * h);
        bf[x] = *(const bf16x8*)(sKt + (wk * 64 + x * 32 + r) * LDT + 16 * s + 8 * h);
      }
      _Pragma("unroll") for (int a = 0; a < 2; ++a) _Pragma("unroll") for (int b = 0; b < 2; ++b) acc[a][b] = mfma(af[a], bf[b], acc[a][b]);
    }
    float* up = p.Ust + (size_t)(n * 4 + hh) * 16384;
    _Pragma("unroll") for (int a = 0; a < 2; ++a) _Pragma("unroll") for (int b = 0; b < 2; ++b) _Pragma("unroll") for (int i = 0; i < 16; ++i) {
      int v = wv * 64 + a * 32 + crow(i, h), k = wk * 64 + b * 32 + r;
      up[v * 128 + k] = acc[a][b][i];
    }
  }
  const int jt = w >> 1, it = w & 1;
  int r2 = lane & 31; asm volatile("" : "+v"(r2));
  f32x16 am = zero16();
  if (jt <= it) {
    _Pragma("unroll") for (int s = 0; s < 8; ++s) {
      bf16x8 kf = *(const bf16x8*)(sKh + (jt * 32 + r2) * 136 + 16 * s + 8 * h);
      bf16x8 qf = *(const bf16x8*)(sQh + (it * 32 + r2) * 136 + 16 * s + 8 * h);
      am = mfma(kf, qf, am);
    }
  }
  __syncthreads();
  {
    int r3 = lane & 31; asm volatile("" : "+v"(r3));
    const int i = it * 32 + r3;
    _Pragma("unroll") for (int g = 0; g < 4; ++g) {
      int j0 = jt * 32 + 8 * g + 4 * h;
      float x0 = (j0 <= i) ? am[4 * g] : 0.f, x1 = (j0 + 1 <= i) ? am[4 * g + 1] : 0.f;
      float x2 = (j0 + 2 <= i) ? am[4 * g + 2] : 0.f, x3 = (j0 + 3 <= i) ? am[4 * g + 3] : 0.f;
      *(u32x2*)(sAm + i * LDT + j0) = pack4(x0, x1, x2, x3);
    }
  }
  __syncthreads();
  {
    int r = lane & 31; asm volatile("" : "+v"(r));
    f32x16 oacc[2]; oacc[0] = zero16(); oacc[1] = zero16();
    _Pragma("unroll") for (int s = 0; s < 4; ++s) {
      bf16x8 vf = *(const bf16x8*)(sVt + (32 * w + r) * LDT + 16 * s + 8 * h);
      _Pragma("unroll") for (int i2 = 0; i2 < 2; ++i2) {
        bf16x8 af2 = *(const bf16x8*)(sAm + (i2 * 32 + r) * LDT + 16 * s + 8 * h);
        oacc[i2] = mfma(vf, af2, oacc[i2]);
      }
    }
    _Pragma("unroll") for (int i2 = 0; i2 < 2; ++i2) _Pragma("unroll") for (int g = 0; g < 4; ++g)
      *(u32x2*)(p.YB + (size_t)(row0 + i2 * 32 + r) * 1024 + hh * 128 + 32 * w + 8 * g + 4 * h) =
          pack4(oacc[i2][4 * g], oacc[i2][4 * g + 1], oacc[i2][4 * g + 2], oacc[i2][4 * g + 3]);
  }
}

DI void hgrn_sample_item(const Params& p, int b, int hh, char* smem) {
  float* sf = (float*)smem; float* skin = sf + 128; float* sq = skin + 128; float* sv = sq + 128; float* sred = sv + 128; float* s2 = sred + 8 * 128;
  const int t = TID, m = SEQ + b;
  __syncthreads();
  if (t < 128) {
    int ch = hh * 128 + t;
    float lbv = frcp(1.f + __expf(p.lb_logits[512 + ch] - p.lb_logits[ch]));
    float z = bf2f(p.ZF[(size_t)m * 512 + ch]);
    z = fminf(fmaxf(z, -30.f), 30.f);
    float em = __expf(-z), sg = frcp(1.f + em);
    sf[t] = lbv + (1.f - lbv) * sg; skin[t] = (1.f - lbv) * em * sg;
    sq[t] = bf2f(p.QB[(size_t)m * 512 + ch]); sv[t] = bf2f(p.IB[(size_t)m * 512 + ch]);
  }
  __syncthreads();
  const int v4 = (t & 31) * 4, kg = t >> 5;
  float4 vv = *(const float4*)(sv + v4);
  float4 o = {0.f, 0.f, 0.f, 0.f};
  const size_t sb = (size_t)(b * 4 + hh) * 16384;
  _Pragma("unroll 8") for (int kk = 0; kk < 16; ++kk) {
    int k = kg * 16 + kk;
    float4 S = *(const float4*)(p.state + sb + k * 128 + v4);
    float f = sf[k], ki = skin[k], qq = sq[k];
    float4 Sn; Sn.x = f * S.x + ki * vv.x; Sn.y = f * S.y + ki * vv.y; Sn.z = f * S.z + ki * vv.z; Sn.w = f * S.w + ki * vv.w;
    *(float4*)(p.out_ss + sb + k * 128 + v4) = Sn;
    o.x += qq * Sn.x; o.y += qq * Sn.y; o.z += qq * Sn.z; o.w += qq * Sn.w;
  }
  *(float4*)(sred + kg * 128 + v4) = o;
  __syncthreads();
  float ov = 0.f;
  if (t < 128) {
    _Pragma("unroll") for (int g = 0; g < 8; ++g) ov += sred[g * 128 + t];
    float ss = ov * ov;
    _Pragma("unroll") for (int of = 32; of >= 1; of >>= 1) ss += __shfl_xor(ss, of);
    if ((t & 63) == 0) s2[t >> 6] = ss;
  }
  __syncthreads();
  if (t < 128) {
    float sc = rsqrtf((s2[0] + s2[1]) * (1.f / 128.f) + EPS);
    size_t off = (size_t)m * 512 + hh * 128 + t;
    p.YB[(size_t)m * 1024 + hh * 128 + t] = (bfr)f2bf(ov * sc * p.og[t] * bf2f(p.ZB[off]));
  }
}

DI void hgrn_sample_wave(const Params& p, int b, int hh, int lane, float* sw  ) {
  const int m = SEQ + b;
  _Pragma("unroll") for (int u = 0; u < 2; ++u) {
    const int k = lane + 64 * u, ch = hh * 128 + k;
    const float lbv = frcp(1.f + __expf(p.lb_logits[512 + ch] - p.lb_logits[ch]));
    float z = bf2f(p.ZF[(size_t)m * 512 + ch]);
    z = fminf(fmaxf(z, -30.f), 30.f);
    const float em = __expf(-z), sg = frcp(1.f + em);
    sw[k] = lbv + (1.f - lbv) * sg; sw[128 + k] = (1.f - lbv) * em * sg; sw[256 + k] = bf2f(p.QB[(size_t)m * 512 + ch]);
  }
  const int v4 = (lane & 31) * 4, kg = lane >> 5;
  const u32x2 vraw = *(const u32x2*)(p.IB + (size_t)m * 512 + hh * 128 + v4);
  const float4 vv = {bflo(vraw[0]), bfhi(vraw[0]), bflo(vraw[1]), bfhi(vraw[1])};
  __builtin_amdgcn_s_waitcnt(0xc07f);
  __builtin_amdgcn_wave_barrier();
  float4 o = {0.f, 0.f, 0.f, 0.f};
  const size_t sb = (size_t)(b * 4 + hh) * 16384 + (size_t)(kg * 64) * 128 + v4;
  const volatile float* swv = sw;
  _Pragma("unroll 16") for (int kk = 0; kk < 64; ++kk) {
    const int k = kg * 64 + kk;
    const float4 S = *(const float4*)(p.state + sb + kk * 128);
    const float f = swv[k], ki = swv[128 + k], qq = swv[256 + k];
    float4 Sn; Sn.x = f * S.x + ki * vv.x; Sn.y = f * S.y + ki * vv.y; Sn.z = f * S.z + ki * vv.z; Sn.w = f * S.w + ki * vv.w;
    *(float4*)(p.out_ss + sb + kk * 128) = Sn;
    o.x += qq * Sn.x; o.y += qq * Sn.y; o.z += qq * Sn.z; o.w += qq * Sn.w;
  }
  o.x += __shfl_xor(o.x, 32); o.y += __shfl_xor(o.y, 32); o.z += __shfl_xor(o.z, 32); o.w += __shfl_xor(o.w, 32);
  float ss = o.x * o.x + o.y * o.y + o.z * o.z + o.w * o.w;
  _Pragma("unroll") for (int of = 16; of >= 1; of >>= 1) ss += __shfl_xor(ss, of);
  const float sc = rsqrtf(ss * (1.f / 128.f) + EPS);
  if (kg == 0) {
    const float4 og = *(const float4*)(p.og + v4);
    const u32x2 zb = *(const u32x2*)(p.ZB + (size_t)m * 512 + hh * 128 + v4);
    *(u32x2*)(p.YB + (size_t)m * 1024 + hh * 128 + v4) = pack4(o.x * sc * og.x * bflo(zb[0]), o.y * sc * og.y * bfhi(zb[0]), o.z * sc * og.z * bflo(zb[1]), o.w * sc * og.w * bfhi(zb[1]));
  }
  __builtin_amdgcn_wave_barrier();
}

DI void cache_shift_copy(const Params& p, int gw, int nw, int lane, int part) {
  const int lo = part * (64 * 4064), hi = lo + 64 * 4064;
  for (int idx = lo + gw * 64 + lane; idx < hi; idx += nw * 64) {
    int b = idx / 4064, i4 = idx - b * 4064;
    size_t so = (size_t)b * 16384 + 128 + i4 * 4, dof = (size_t)b * 16384 + i4 * 4;
    *(float4*)(p.out_ks + dof) = *(const float4*)(p.cache_k + so);
    *(float4*)(p.out_vs + dof) = *(const float4*)(p.cache_v + so);
  }
}

DI void phase_mix(const Params& p, char* smem, char* smem_all) {
  const int wave = threadIdx.x >> 6, lane = threadIdx.x & 63, gw = blockIdx.x * 8 + wave, nw = gridDim.x * 8;
  float* sw = (float*)(smem_all + wave * 2048);
  if (gw & 1) {
    for (int it = gw >> 1; it < 1024; it += nw >> 1) attn_sample_wave(p, it >> 3, it & 7);
    cache_shift_copy(p, gw >> 1, nw >> 1, lane, 0);
    for (int it = gw; it < 4096; it += nw) attn_prompt_wave(p, it >> 3, it & 7, lane);
  } else {
    int it = gw;
    if (it < 4096) { attn_prompt_wave(p, it >> 3, it & 7, lane); it += nw; }
    if ((gw & 3) == 0) { for (int hs = gw >> 2; hs < 512; hs += nw >> 2) hgrn_sample_wave(p, hs >> 2, hs & 3, lane, sw); }
    cache_shift_copy(p, gw >> 1, nw >> 1, lane, 1);
    for (; it < 4096; it += nw) attn_prompt_wave(p, it >> 3, it & 7, lane);
  }
  for (int it = VBID; it < 1024; it += VGRID) hgrn_fused_item(p, it >> 2, it & 3, smem);
}

#define SCAN_LOAD(U, Dd, N0) _Pragma("unroll") for (int i = 0; i < 32; ++i) { U[i] = up[(size_t)((N0) + i) * 65536]; Dd[i] = dp[((N0) + i) * 512]; }
#define SCAN_STEP(U, Dd, N0) _Pragma("unroll") for (int i = 0; i < 32; ++i) { sp[(size_t)((N0) + i) * 65536] = (bfr)(pk2(S, 0.f) & 0xffffu); S = Dd[i] * S + U[i]; }
DI void phase_scan(const Params& p, int eb) {
  const int e = eb * 256 + threadIdx.x;
  const int hh = e >> 14, k = e & 127, v = (e >> 7) & 127;
  const float* up = p.Ust + e;
  bfr* sp = p.S16 + e;
  const float* dp = p.dec + hh * 128 + k;
  float S = 0.f;
  float ua[32], da[32], ub[32], db[32];
  SCAN_LOAD(ua, da, 0)
  for (int n0 = 0; n0 < NCH; n0 += 64) {
    SCAN_LOAD(ub, db, n0 + 32)
    SCAN_STEP(ua, da, n0)
    if (n0 + 64 < NCH) { SCAN_LOAD(ua, da, n0 + 64) }
    SCAN_STEP(ub, db, n0 + 32)
  }
  p.out_sp[(hh * 128 + k) * 128 + v] = S;
}

DI void hgrn_out_wave(const Params& p, int n, int hh, int it, int lane) {
  const int r = lane & 31, h = lane >> 5;
  const size_t row = (size_t)(n * 64 + it * 32 + r);
  bf16x8 qf[8];
  _Pragma("unroll") for (int s = 0; s < 8; ++s) qf[s] = *(const bf16x8*)(p.QB + row * 512 + hh * 128 + 16 * s + 8 * h);
  const bfr* sb = p.S16 + (size_t)(n * 4 + hh) * 16384 + (size_t)r * 128 + 8 * h;
  f32x16 acc[4];
  _Pragma("unroll") for (int vt = 0; vt < 4; ++vt) {
    acc[vt] = zero16();
    _Pragma("unroll") for (int s = 0; s < 8; ++s) {
      bf16x8 sf = *(const bf16x8*)(sb + vt * 32 * 128 + 16 * s);
      acc[vt] = mfma(sf, qf[s], acc[vt]);
    }
  }
  float ss = 0.f;
  _Pragma("unroll") for (int vt = 0; vt < 4; ++vt) _Pragma("unroll") for (int g = 0; g < 4; ++g) {
    const u32x2 oi = *(const u32x2*)(p.YB + row * 1024 + hh * 128 + 32 * vt + 8 * g + 4 * h);
    acc[vt][4 * g] += bflo(oi[0]); acc[vt][4 * g + 1] += bfhi(oi[0]); acc[vt][4 * g + 2] += bflo(oi[1]); acc[vt][4 * g + 3] += bfhi(oi[1]);
    ss += acc[vt][4 * g] * acc[vt][4 * g] + acc[vt][4 * g + 1] * acc[vt][4 * g + 1] + acc[vt][4 * g + 2] * acc[vt][4 * g + 2] + acc[vt][4 * g + 3] * acc[vt][4 * g + 3];
  }
  ss += __shfl_xor(ss, 32);
  const float sc = rsqrtf(ss * (1.f / 128.f) + EPS);
  _Pragma("unroll") for (int vt = 0; vt < 4; ++vt) _Pragma("unroll") for (int g = 0; g < 4; ++g) {
    const int v = 32 * vt + 8 * g + 4 * h;
    const float4 og = *(const float4*)(p.og + v);
    const u32x2 zb = *(const u32x2*)(p.ZB + row * 512 + hh * 128 + v);
    *(u32x2*)(p.YB + row * 1024 + hh * 128 + v) = pack4(acc[vt][4 * g] * sc * og.x * bflo(zb[0]), acc[vt][4 * g + 1] * sc * og.y * bfhi(zb[0]),
                                                        acc[vt][4 * g + 2] * sc * og.z * bflo(zb[1]), acc[vt][4 * g + 3] * sc * og.w * bfhi(zb[1]));
  }
}

#define XB_TMO      128
#define XB_XCNT(j)  (256  + 64 * (j))
#define XB_XSUB(j)  (1280 + 64 * (j))
#define XB_XGEN(j)  (2304 + 64 * (j))
#define XB_TOP      3328
#define XB_TOPGEN   3392
#define XCD_BAR_WORDS 3456
#define XB_SPIN_CAP (1u << 18)
#define LAS __attribute__((address_space(3)))

__device__ __forceinline__ unsigned xb_ld(unsigned* p)              { return __hip_atomic_load(p, __ATOMIC_RELAXED, __HIP_MEMORY_SCOPE_AGENT); }
__device__ __forceinline__ unsigned xb_add(unsigned* p, unsigned v) { return __hip_atomic_fetch_add(p, v, __ATOMIC_RELAXED, __HIP_MEMORY_SCOPE_AGENT); }
__device__ __forceinline__ unsigned xb_xcc_id() { return (unsigned)__builtin_amdgcn_s_getreg((3 << 11) | 20) & 0xFu; }
#define XB_SPIN(cond, bar) do { unsigned _sp = 0; while (cond) { __builtin_amdgcn_s_sleep(1); \
    if ((++_sp & 255u) == 0u) { if (xb_ld(&(bar)[XB_TMO])) break; if (_sp > XB_SPIN_CAP) { atomicAdd(&(bar)[XB_TMO], 1u); break; } } } } while (0)

struct XcdBarrier {
    unsigned* bar; unsigned x;
    volatile LAS unsigned* st;
};

__device__ __forceinline__ XcdBarrier xcd_barrier_post(unsigned* bar, volatile LAS unsigned* st) {
    XcdBarrier b; b.bar = bar; b.x = xb_xcc_id(); b.st = st;
    if (threadIdx.x == 0) (void)xb_add(&bar[XB_XCNT(b.x)], 1u);
    return b;
}
__device__ __forceinline__ void xcd_barrier_complete(unsigned* bar, unsigned x, unsigned& nloc, unsigned& nx) {
    const unsigned G = gridDim.x * gridDim.y * gridDim.z;
    unsigned sum, cnt, mine, sp = 0u;
    for (;;) {
        sum = 0u; cnt = 0u; mine = 0u;
#pragma unroll
        for (unsigned j = 0; j < 16; ++j) { const unsigned c = xb_ld(&bar[XB_XCNT(j)]); sum += c; cnt += (c > 0u) ? 1u : 0u; mine = (j == x) ? c : mine; }
        if (sum == G) break;
        __builtin_amdgcn_s_sleep(1);
        if ((++sp & 255u) == 0u) { if (xb_ld(&bar[XB_TMO])) break; if (sp > XB_SPIN_CAP) { atomicAdd(&bar[XB_TMO], 1u); break; } }
    }
    nloc = mine > 0u ? mine : 1u; nx = cnt > 0u ? cnt : 1u;
}

__device__ __forceinline__ void xcd_barrier(const XcdBarrier& b) {
    asm volatile("s_waitcnt vmcnt(0)" ::: "memory");
    __syncthreads();
    if (threadIdx.x == 0) {
        unsigned* bar = b.bar;
        __builtin_amdgcn_s_waitcnt(0);
        unsigned nloc = b.st[0], nx = b.st[1];
        if (nloc == 0u) { xcd_barrier_complete(bar, b.x, nloc, nx); b.st[0] = nloc; b.st[1] = nx; }
        const unsigned old = xb_add(&bar[XB_XSUB(b.x)], 1u);
        const unsigned gen = old / nloc;
        if (old + 1u == (gen + 1u) * nloc) {
            __builtin_amdgcn_fence(__ATOMIC_RELEASE, "agent");
            asm volatile("s_waitcnt vmcnt(0)" ::: "memory");
            const unsigned og = xb_add(&bar[XB_TOP], 1u);
            const unsigned tg = og / nx;
            if (og + 1u == (tg + 1u) * nx) xb_add(&bar[XB_TOPGEN], 1u);
            else XB_SPIN(xb_ld(&bar[XB_TOPGEN]) == tg, bar);
            __builtin_amdgcn_fence(__ATOMIC_ACQUIRE, "agent");
            xb_add(&bar[XB_XGEN(b.x)], 1u);
            asm volatile("s_waitcnt vmcnt(0)" ::: "memory");
        } else {
            XB_SPIN(xb_ld(&bar[XB_XGEN(b.x)]) == gen, bar);
            __builtin_amdgcn_fence(__ATOMIC_ACQUIRE, "agent");
            asm volatile("s_waitcnt vmcnt(0)" ::: "memory");
        }
    }
    __syncthreads();
}

static_assert(PANEL_CNT_WORD == XCD_BAR_WORDS, "panel counters follow the barrier words");
__global__ void __launch_bounds__(512, 2) hybrid_megakernel(Params p) {
  extern __shared__ __attribute__((aligned(16))) char smem_all[];
  __shared__ uint4 xb_words;
  if (threadIdx.x == 0) xb_words = make_uint4(0u, 0u, 0u, 0u);
  __syncthreads();
  const XcdBarrier xb = xcd_barrier_post(p.bar, (volatile LAS unsigned*)&xb_words);
  char* smem = smem_all + (threadIdx.x >> 8) * 73728;
#ifndef REPMASK
#define REPMASK 0
#endif
#define RUN_PHASE(n, ...) if (p.phase_lo <= n && n <= p.phase_hi) { if (n != p.phase_lo) xcd_barrier(xb); __VA_ARGS__; if ((REPMASK >> n) & 1) { xcd_barrier(xb); __VA_ARGS__; } }
  RUN_PHASE(0, phase_prep(p, smem))
  RUN_PHASE(1, { if (VBID < 48) phase_mod(p, smem); else phase_prep2(p, smem, VBID - 48, VGRID - 48); })
  RUN_PHASE(2, phase_h(p))
  RUN_PHASE(3, {
    pg8::Gemm g{p.H, p.Wt_all, MPAD, NALL, 1024};
    pg8::StaticOrder S; S.init(MPAD, NALL, (int)gridDim.x, (int)blockIdx.x);
    EpiMain E{p};
    pg8::gemm_phase<EpiMain, pg8::StaticOrder, false>((PG8_LAS unsigned char*)smem_all, g, S, E, nullptr);
  })
  RUN_PHASE(4, phase_mix(p, smem, smem_all))
  RUN_PHASE(5, {
    if (threadIdx.x < 256) { for (int eb = blockIdx.x; eb < 256; eb += gridDim.x) phase_scan(p, eb); }
    else { const int wt = blockIdx.x * 4 + ((threadIdx.x >> 6) - 4); if (wt < 128) sample_chain_wave(p, wt, threadIdx.x & 63); }
  })
  RUN_PHASE(6, {
    for (int wi = blockIdx.x * 8 + (threadIdx.x >> 6); wi < 2048; wi += gridDim.x * 8) hgrn_out_wave(p, wi >> 3, (wi >> 1) & 3, wi & 1, threadIdx.x & 63);
  })
  RUN_PHASE(7, {
    pg8::Gemm g{p.YA, p.Wt_pab, SEQ, 1024, 1024};
    pg8::StaticOrder S; S.init(SEQ, 1024, (int)gridDim.x, (int)blockIdx.x);
    EpiMerge E{p};
    pg8::gemm_phase<EpiMerge, pg8::StaticOrder, false>((PG8_LAS unsigned char*)smem_all, g, S, E, nullptr);
  })
  RUN_PHASE(8, {
    pg8::Gemm g{p.Y, p.Wt_out, SEQ, 1024, 1024};
    pg8::StaticOrder S; S.init(SEQ, 1024, (int)gridDim.x, (int)blockIdx.x);
    EpiOut E{p};
    pg8::gemm_phase<EpiOut, pg8::StaticOrder, false>((PG8_LAS unsigned char*)smem_all, g, S, E, nullptr);
  })
}

#ifndef ONE_LAUNCH
#define ONE_LAUNCH 1
#endif
constexpr size_t kDynLds = 147456;

extern "C" void kernel_launch(void* const* d_in, const int* in_sizes, int n_in, void* d_out, int out_size, void* d_ws, size_t ws_size,
                              hipStream_t stream) {
  static int grid_blocks = 0;
  if (!grid_blocks) {
    int dev = 0, cus = 0, per_cu = 0;
    (void)hipGetDevice(&dev);
    (void)hipDeviceGetAttribute(&cus, hipDeviceAttributeMultiprocessorCount, dev);
    (void)hipFuncSetAttribute((const void*)hybrid_megakernel, hipFuncAttributeMaxDynamicSharedMemorySize, (int)kDynLds);
    (void)hipOccupancyMaxActiveBlocksPerMultiprocessor(&per_cu, hybrid_megakernel, 512, kDynLds);
    if (per_cu > 1) per_cu = 1;
    if (per_cu < 1) per_cu = 1;
    grid_blocks = cus * per_cu;
  }
  Params p{};
  const float* const* in = (const float* const*)d_in;
  p.x_prompt = in[0]; p.x_sample = in[1]; p.cache_k = in[2]; p.cache_v = in[3]; p.state = in[4]; p.c_prompt = in[5]; p.c_sample = in[6];
  p.w_ada = in[7]; p.b_ada = in[8]; p.norm_g = in[9]; p.w_in = in[10]; p.qg = in[11]; p.kg = in[12]; p.sinks = in[13]; p.lb_logits = in[14];
  p.og = in[15]; p.w_merge = in[16]; p.b_merge = in[17]; p.w_pa = in[18]; p.w_pb = in[19]; p.w_out = in[20];
  float* o = (float*)d_out;
  p.out_yp = o; o += (size_t)SEQ * DM;
  p.out_ys = o; o += (size_t)NBT * DM;
  p.out_kp = o; o += 128 * 128;
  p.out_vp = o; o += 128 * 128;
  p.out_sp = o; o += 4 * 128 * 128;
  p.out_ks = o; o += (size_t)NBT * 128 * 128;
  p.out_vs = o; o += (size_t)NBT * 128 * 128;
  p.out_ss = o;
  char* wsp = (char*)d_ws;
  auto take = [&](size_t bytes) { char* r = wsp; wsp += (bytes + 255) & ~(size_t)255; return r; };
  p.bar = (unsigned*)take((size_t)(XCD_BAR_WORDS + 256) * 4);
  p.Wt_all = (bfr*)take((size_t)NALL * 1024 * 2);
  p.Wt_pab = (bfr*)take((size_t)1024 * 1024 * 2);
  p.Wt_out = (bfr*)take((size_t)1024 * 1024 * 2);
  p.Wt_ada = (bfr*)take((size_t)3072 * 1024 * 2);
  p.Cb = (bfr*)take((size_t)256 * 1024 * 2);
  p.mod = (float*)take((size_t)256 * 3072 * 4);
  p.Ys = (bfr*)take((size_t)128 * 1024 * 2);
  p.H = (bfr*)take((size_t)MPAD * 1024 * 2);
  p.YA = p.H; p.YB = p.H + 512;
  p.ZA = (bfr*)take((size_t)MTOT * 512 * 2);
  p.S16 = p.ZA;
  p.Q = (bfr*)take((size_t)MTOT * 512 * 2);
  p.QB = (bfr*)take((size_t)MTOT * 512 * 2);
  p.Y = p.Q;
  p.Kb = (bfr*)take((size_t)MTOT * 128 * 2);
  p.Vb = (bfr*)take((size_t)MTOT * 128 * 2);
  p.IB = (bfr*)take((size_t)MTOT * 512 * 2);
  p.ZB = (bfr*)take((size_t)MTOT * 512 * 2);
  p.ZF = (bfr*)take((size_t)MTOT * 512 * 2);
  p.GA = (bfr*)take((size_t)MTOT * 1024 * 2);
  p.GB = (bfr*)take((size_t)MTOT * 1024 * 2);
  p.dec = (float*)take((size_t)NCH * 4 * 128 * 4);
  p.Ust = p.out_yp;
  if ((size_t)(wsp - (char*)d_ws) > ws_size) { fprintf(stderr, "workspace too small\n"); return; }
  (void)hipMemsetAsync(p.bar, 0, (size_t)(XCD_BAR_WORDS + 256) * 4, stream);
#if ONE_LAUNCH
  p.phase_lo = 0; p.phase_hi = 8;
  void* args[] = {&p};
  hipError_t e = hipLaunchCooperativeKernel((void*)hybrid_megakernel, dim3(grid_blocks), dim3(512), args, kDynLds, stream);
  if (e != hipSuccess) fprintf(stderr, "cooperative launch failed: %s (grid %d)\n", hipGetErrorString(e), grid_blocks);
#else
  for (int ph = 0; ph <= 8; ++ph) {
    p.phase_lo = ph; p.phase_hi = ph;
    hipLaunchKernelGGL(hybrid_megakernel, dim3(grid_blocks), dim3(512), kDynLds, stream, p);
  }
#endif
}
```

```cpp
#include <hip/hip_runtime.h>
#include <cstdio>

#define DI __device__ __forceinline__
typedef unsigned short bfr;
using bf16x8 = __attribute__((ext_vector_type(8))) short;
using f32x16 = __attribute__((ext_vector_type(16))) float;
using u32x4 = __attribute__((ext_vector_type(4))) unsigned;
using u32x2 = __attribute__((ext_vector_type(2))) unsigned;

constexpr int DM = 1024, SEQ = 16384, NBT = 128, MTOT = SEQ + NBT;
constexpr int NALL = 5376;
constexpr int NCH = 256;
constexpr float EPS = 1e-6f;
constexpr int PANEL_CNT_WORD = 3456;
constexpr int LDT = 72;
constexpr int MPAD = 16640;
#define TID ((int)(threadIdx.x & 255))
#define VBID ((int)(blockIdx.x * 2 + (threadIdx.x >> 8)))
#define VGRID ((int)(gridDim.x * 2))

struct Params {
  const float *x_prompt, *x_sample, *cache_k, *cache_v, *state, *c_prompt, *c_sample;
  const float *w_ada, *b_ada, *norm_g, *w_in, *qg, *kg, *sinks, *lb_logits, *og, *w_merge, *b_merge, *w_pa, *w_pb, *w_out;
  float *out_yp, *out_ys, *out_kp, *out_vp, *out_sp, *out_ks, *out_vs, *out_ss;
  bfr *Wt_all, *Wt_pab, *Wt_out, *Wt_ada, *Cb, *H, *Q, *QB, *Kb, *Vb, *ZA, *IB, *ZB, *GA, *GB, *YA, *YB, *Y;
  float *mod, *dec, *Ust;
  bfr* ZF;
  bfr* S16;
  bfr* Ys;
  unsigned* bar;
  int phase_lo, phase_hi;
};

DI unsigned f2bf(float x) { unsigned u = __float_as_uint(x); u += 0x7fffu + ((u >> 16) & 1u); return u >> 16; }
typedef __bf16 hbf2 __attribute__((ext_vector_type(2)));
typedef float hf2 __attribute__((ext_vector_type(2)));
DI unsigned pk2(float a, float b) { hf2 v = {a, b}; return __builtin_bit_cast(unsigned, __builtin_convertvector(v, hbf2)); }
DI float bf2f(unsigned b) { return __uint_as_float(b << 16); }
DI float bflo(unsigned u) { return __uint_as_float(u << 16); }
DI float bfhi(unsigned u) { return __uint_as_float(u & 0xffff0000u); }
DI int crow(int i, int h) { return (i & 3) + 8 * (i >> 2) + 4 * h; }
DI f32x16 mfma(bf16x8 a, bf16x8 b, f32x16 c) { return __builtin_amdgcn_mfma_f32_32x32x16_bf16(a, b, c, 0, 0, 0); }
DI f32x16 zero16() { f32x16 z; _Pragma("unroll") for (int i = 0; i < 16; ++i) z[i] = 0.f; return z; }
DI float frcp(float x) { return __builtin_amdgcn_rcpf(x); }
DI float fexp(float x) { return __builtin_amdgcn_exp2f(x * 1.4426950408889634f); }
DI float sigmoidf_(float x) { return frcp(1.f + fexp(-x)); }
DI float siluf_(float x) { return x * frcp(1.f + fexp(-x)); }
DI u32x2 pack4(float a, float b, float c, float d) { u32x2 r; r[0] = pk2(a, b); r[1] = pk2(c, d); return r; }

DI int wt_row_of_col(int c) {
  const int pn = c >> 8, cl = c & 255;
  int slot;
  if (pn < 3) {
    const int g = cl >> 6, d = cl & 63;
    if (d >= 32) { const int x = d - 32; slot = 128 + 32 * g + 16 * ((x >> 2) & 1) + 4 * (x >> 3) + (x & 3); }
    else { const int fq = 2 * (d >> 4) + ((d >> 2) & 1), n = (d >> 3) & 1, j = d & 3; slot = 32 * g + 16 * n + 4 * fq + j; }
  } else {
    const int bj = cl >> 7, g = (cl >> 5) & 3, x = cl & 31;
    slot = 128 * bj + 32 * g + 16 * ((x >> 2) & 1) + 4 * (x >> 3) + (x & 3);
  }
  return (pn << 8) + slot;
}

DI void gemm_mainloop(const bfr* __restrict__ A, int lda, int m0, const bfr* __restrict__ W, int ldw, int n0, int K,
                      bfr* sA, bfr* sW, f32x16 (&acc)[2][2]) {
  const int t = TID, lane = t & 63, w = t >> 6, wn = w >> 1, wm = w & 1, r = lane & 31, h = lane >> 5;
  const int lrow = t >> 3, lk = (t & 7) * 8;
  const bfr* ap = A + (size_t)(m0 + lrow) * lda + lk;
  const bfr* wp = W + (size_t)(n0 + lrow) * ldw + lk;
  u32x4 ra[4], rw[4];
  _Pragma("unroll") for (int i = 0; i < 4; ++i) {
    ra[i] = *(const u32x4*)(ap + (size_t)(32 * i) * lda);
    rw[i] = *(const u32x4*)(wp + (size_t)(32 * i) * ldw);
  }
  const int nk = K >> 6;
  for (int kt = 0; kt < nk; ++kt) {
    __syncthreads();
    _Pragma("unroll") for (int i = 0; i < 4; ++i) {
      *(u32x4*)(sA + (lrow + 32 * i) * LDT + lk) = ra[i];
      *(u32x4*)(sW + (lrow + 32 * i) * LDT + lk) = rw[i];
    }
    __syncthreads();
    if (kt + 1 < nk) {
      ap += 64; wp += 64;
      _Pragma("unroll") for (int i = 0; i < 4; ++i) {
        ra[i] = *(const u32x4*)(ap + (size_t)(32 * i) * lda);
        rw[i] = *(const u32x4*)(wp + (size_t)(32 * i) * ldw);
      }
    }
    _Pragma("unroll") for (int kk = 0; kk < 4; ++kk) {
      bf16x8 af[2], bf[2];
      _Pragma("unroll") for (int x = 0; x < 2; ++x) {
        af[x] = *(const bf16x8*)(sW + (wn * 64 + x * 32 + r) * LDT + kk * 16 + 8 * h);
        bf[x] = *(const bf16x8*)(sA + (wm * 64 + x * 32 + r) * LDT + kk * 16 + 8 * h);
      }
      _Pragma("unroll") for (int nt = 0; nt < 2; ++nt)
        _Pragma("unroll") for (int mt = 0; mt < 2; ++mt) acc[nt][mt] = mfma(af[nt], bf[mt], acc[nt][mt]);
    }
  }
}

template <int PERMBASE> DI void transpose_tile(const float* __restrict__ src, int N, bfr* __restrict__ dst, int K, int kt, int nt, float* sm) {
  const int t = TID, k0 = kt * 64, n0 = nt * 64;
  __syncthreads();
  _Pragma("unroll") for (int i = 0; i < 16; ++i) {
    int idx = i * 256 + t, kk = idx >> 6, nn = idx & 63;
    sm[kk * 65 + nn] = src[(size_t)(k0 + kk) * N + n0 + nn];
  }
  __syncthreads();
  _Pragma("unroll") for (int i = 0; i < 8; ++i) {
    int idx = i * 256 + t, nn = idx >> 5, kk = (idx & 31) * 2;
    const int drow = PERMBASE >= 0 ? wt_row_of_col(PERMBASE + n0 + nn) : n0 + nn;
    *(unsigned*)(dst + (size_t)drow * K + k0 + kk) = pk2(sm[kk * 65 + nn], sm[(kk + 1) * 65 + nn]);
  }
}

DI void phase_prep(const Params& p, char* smem) {
  float* sm = (float*)smem;
  for (int it = VBID; it < 768; it += VGRID) transpose_tile<-1>(p.w_ada, 3072, p.Wt_ada, 1024, it / 48, it % 48, sm);
  for (int idx = VBID * 256 + TID; idx < 256 * 1024; idx += VGRID * 256) {
    int row = idx >> 10, col = idx & 1023;
    float v = row < 128 ? p.c_sample[row * 1024 + col] : (row == 128 ? p.c_prompt[col] : 0.f);
    p.Cb[idx] = (bfr)f2bf(v);
  }
}
DI void phase_prep2(const Params& p, char* smem, int vb0, int nvb) {
  float* sm = (float*)smem;
  for (int it = vb0; it < 1856; it += nvb) {
    int i = it;
    if (i < 832) { transpose_tile<0>(p.w_in, 3328, p.Wt_all, 1024, i / 52, i % 52, sm); continue; }
    i -= 832;
    if (i < 512) { transpose_tile<3328>(p.w_merge, 2048, p.Wt_all, 1024, i / 32, i % 32, sm); continue; }
    i -= 512;
    if (i < 128) { transpose_tile<-1>(p.w_pa, 1024, p.Wt_pab, 1024, i / 16, i % 16, sm); continue; }
    i -= 128;
    if (i < 128) { transpose_tile<-1>(p.w_pb, 1024, p.Wt_pab + 512, 1024, i / 16, i % 16, sm); continue; }
    i -= 128;
    transpose_tile<-1>(p.w_out, 1024, p.Wt_out, 1024, i / 16, i % 16, sm);
  }
}

DI void phase_mod(const Params& p, char* smem) {
  bfr* sA = (bfr*)smem; bfr* sW = sA + 128 * LDT;
  const int t = TID, lane = t & 63, w = t >> 6, wn = w >> 1, wm = w & 1, r = lane & 31, h = lane >> 5;
  for (int tile = VBID; tile < 48; tile += VGRID) {
    int m0 = (tile / 24) * 128, n0 = (tile % 24) * 128;
    f32x16 acc[2][2];
    _Pragma("unroll") for (int a = 0; a < 2; ++a) _Pragma("unroll") for (int b = 0; b < 2; ++b) acc[a][b] = zero16();
    gemm_mainloop(p.Cb, 1024, m0, p.Wt_ada, 1024, n0, 1024, sA, sW, acc);
    _Pragma("unroll") for (int nt = 0; nt < 2; ++nt) _Pragma("unroll") for (int mt = 0; mt < 2; ++mt) {
      int m = m0 + wm * 64 + mt * 32 + r;
      _Pragma("unroll") for (int g = 0; g < 4; ++g) {
        int n = n0 + wn * 64 + nt * 32 + 8 * g + 4 * h;
        float4 b = *(const float4*)(p.b_ada + n);
        float4 o; o.x = acc[nt][mt][4 * g] + b.x; o.y = acc[nt][mt][4 * g + 1] + b.y; o.z = acc[nt][mt][4 * g + 2] + b.z; o.w = acc[nt][mt][4 * g + 3] + b.w;
        *(float4*)(p.mod + (size_t)m * 3072 + n) = o;
      }
    }
  }
}

DI void phase_h(const Params& p) {
  const int lane = TID & 63, w = TID >> 6;
  for (int row = VBID * 4 + w; row < MTOT; row += VGRID * 4) {
    const float* xr = row < SEQ ? p.x_prompt + (size_t)row * DM : p.x_sample + (size_t)(row - SEQ) * DM;
    const float* mr = p.mod + (size_t)(row < SEQ ? 128 : row - SEQ) * 3072;
    float4 xv[4]; float ss = 0.f;
    _Pragma("unroll") for (int j = 0; j < 4; ++j) {
      xv[j] = *(const float4*)(xr + j * 256 + lane * 4);
      ss += xv[j].x * xv[j].x + xv[j].y * xv[j].y + xv[j].z * xv[j].z + xv[j].w * xv[j].w;
    }
    _Pragma("unroll") for (int o = 32; o >= 1; o >>= 1) ss += __shfl_xor(ss, o);
    float rs = rsqrtf(ss * (1.f / DM) + EPS);
    _Pragma("unroll") for (int j = 0; j < 4; ++j) {
      int col = j * 256 + lane * 4;
      float4 g = *(const float4*)(p.norm_g + col);
      float4 sh = *(const float4*)(mr + col);
      float4 sc = *(const float4*)(mr + 1024 + col);
      float a = xv[j].x * rs * g.x * (1.f + sc.x) + sh.x;
      float b = xv[j].y * rs * g.y * (1.f + sc.y) + sh.y;
      float c = xv[j].z * rs * g.z * (1.f + sc.z) + sh.z;
      float d = xv[j].w * rs * g.w * (1.f + sc.w) + sh.w;
      *(u32x2*)(p.H + (size_t)row * DM + col) = pack4(a, b, c, d);
    }
  }
}

DI void sincos_red(float a, float& s, float& c) {
  float n = rintf(a * 0.15915494309189535f);
  float rr = fmaf(-n, 6.2831854820251465f, a);
  rr = fmaf(-n, -1.7484555e-7f, rr);
  s = __sinf(rr); c = __cosf(rr);
}

namespace pg8 {
#define PG8_LAS __attribute__((address_space(3)))
typedef unsigned short bf16_t;
typedef short bf16x8 __attribute__((ext_vector_type(8)));
typedef float f32x4 __attribute__((ext_vector_type(4)));
typedef unsigned u32x4 __attribute__((ext_vector_type(4)));
constexpr int BM = 256, BK = 64, HALF = 128, HTB = HALF * BK * 2  , STAGE_BYTES = 8 * HTB, NXCD = 8, WGM = 8;

__host__ __device__ __forceinline__ int lds_byte(int r, int c) { const int st = (r >> 4) * 2 + (c >> 5), rr = r & 15, cc = c & 31, ob = rr * 64 + cc * 2; return st * 1024 + (ob ^ (((ob >> 9) & 1) << 5)); }
__host__ __device__ __forceinline__ void stage_rc(int b, int& R, int& C) { const int st = b / 1024, sb = b % 1024, swz = sb ^ (((sb >> 9) & 1) << 5); R = (st >> 1) * 16 + swz / 64; C = (st & 1) * 32 + (swz % 64) / 2; }
__host__ __device__ __forceinline__ int perm32(int rho) { const int n = rho >> 4, i = rho & 15; return 8 * (i >> 2) + 4 * n + (i & 3); }

struct Unit { int pm, pn; };
struct Gemm { const bf16_t* A; const bf16_t* Bt; int M, N, K; };

struct StaticOrder {
    int nM, nN, nwg, G, c;
    __host__ __device__ void init(int M, int N, int G_, int c_) { nM = M / BM; nN = N / BM; nwg = nM * nN; G = G_; c = c_; }
    __host__ __device__ bool next(int i, Unit& u) const {
        const long L = (long)i * G + c; if (L >= nwg) return false;
        int wgid = (int)L; { const int q = nwg / NXCD, r = nwg % NXCD, xcd = wgid % NXCD, off = wgid / NXCD; wgid = (xcd < r ? xcd * (q + 1) : r * (q + 1) + (xcd - r) * q) + off; }
        const int nig = WGM * nN, gid = wgid / nig, fm = gid * WGM, gsz = (nM - fm) < WGM ? (nM - fm) : WGM;
        u.pm = fm + ((wgid % nig) % gsz); u.pn = (wgid % nig) / gsz; return true;
    }
    __device__ __forceinline__ void a_ready(const Unit&) const {}
    __device__ __forceinline__ void done(const Unit&) const {}
};
template <class Epi, class Sched, bool STAMP = false>
__device__ __forceinline__ void gemm_phase(PG8_LAS unsigned char* lds, const Gemm g, const Sched& S, const Epi& E, unsigned long long* stamps) {
    const int tid = threadIdx.x, wid = __builtin_amdgcn_readfirstlane(tid >> 6), lane = tid & 63, wr = wid >> 2, wc = wid & 3, fr = lane & 15, fq = lane >> 4;
    const int K = g.K, nt = K / BK;
    int ts_lo = 0, ts_hi = 0, nts = 0; const unsigned long long rt_entry = STAMP ? (unsigned long long)wall_clock64() : 0ull;
#define PG8_STAMP() do { if (STAMP && wid == 0 && nts < 64) { const unsigned long long _c = (unsigned long long)clock64(); \
        ts_lo = (lane == nts) ? (int)(unsigned)_c : ts_lo; ts_hi = (lane == nts) ? (int)(unsigned)(_c >> 32) : ts_hi; ++nts; } } while (0)
    PG8_STAMP();
    unsigned voffA[2], voffB[2];
#pragma unroll
    for (int i = 0; i < 2; ++i) { int R, C; stage_rc(tid * 16 + i * 8192, R, C); const int Rb = Epi::PERM ? ((R & ~31) + perm32(R & 31)) : R;
        voffA[i] = (unsigned)(R * K + C) * 2u; voffB[i] = (unsigned)(Rb * K + C) * 2u; }
    const size_t kstep = (size_t)(BK * 2);
    const size_t hstep = (size_t)HALF * K * 2;
    const size_t tstep = 2 * hstep;
    const unsigned ldsw = (unsigned)wid * 1024u;
    const int aoff = lds_byte(wr * 64 + fr, fq * 8), boff = lds_byte(wc * 32 + fr, fq * 8);
#define PG8_SA(b, h) (((b) * 2 + (h)) * HTB)
#define PG8_SB(b, h) ((4 + (b) * 2 + (h)) * HTB)
#define PG8_STAGE(bufoff, gbase, voff) do { _Pragma("unroll") for (int _i = 0; _i < 2; ++_i) \
        __builtin_amdgcn_global_load_lds((const unsigned*)((const char*)(gbase) + (voff)[_i]), (PG8_LAS unsigned*)(lds + (bufoff) + ldsw + _i * 8192), 16, 0, 0); } while (0)
#define PG8_LDA(dst, b, h) do { _Pragma("unroll") for (int m = 0; m < 4; ++m) _Pragma("unroll") for (int k = 0; k < 2; ++k) dst[m][k] = *(const PG8_LAS bf16x8*)(lds + PG8_SA(b, h) + aoff + m * 2048 + k * 1024); } while (0)
#define PG8_LDB(dst, b, h) do { _Pragma("unroll") for (int n = 0; n < 2; ++n) _Pragma("unroll") for (int k = 0; k < 2; ++k) dst[n][k] = *(const PG8_LAS bf16x8*)(lds + PG8_SB(b, h) + boff + n * 2048 + k * 1024); } while (0)
#define PG8_MMA(ai, bj, At, Bt) do { __builtin_amdgcn_s_setprio(1); _Pragma("unroll") for (int m = 0; m < 4; ++m) _Pragma("unroll") for (int n = 0; n < 2; ++n) _Pragma("unroll") for (int k = 0; k < 2; ++k) \
        acc[ai][bj][m][n] = __builtin_amdgcn_mfma_f32_16x16x32_bf16(Bt[n][k], At[m][k], acc[ai][bj][m][n], 0, 0, 0); __builtin_amdgcn_s_setprio(0); } while (0)
#define PG8_WAIT_V(n) asm volatile("s_waitcnt vmcnt(" #n ")" ::: "memory")
#define PG8_WAIT_L(n) asm volatile("s_waitcnt lgkmcnt(" #n ")" ::: "memory")
#define PG8_BAR __builtin_amdgcn_s_barrier()
#define PG8_SCHED __builtin_amdgcn_sched_barrier(0)
    Unit cur, nxt; int ui = 0;
    if (!S.next(0, cur)) return;
    f32x4 acc[2][2][4][2];
#pragma unroll
    for (int a = 0; a < 2; ++a)
#pragma unroll
        for (int b = 0; b < 2; ++b)
#pragma unroll
            for (int m = 0; m < 4; ++m)
#pragma unroll
                for (int n = 0; n < 2; ++n) acc[a][b][m][n] = (f32x4){0.f, 0.f, 0.f, 0.f};
    bf16x8 At[4][2], B0[2][2], B1[2][2];
    const char* cA = (const char*)g.A + (size_t)cur.pm * tstep; const char* cB = (const char*)g.Bt + (size_t)cur.pn * tstep;
    S.a_ready(cur);
    PG8_STAGE(PG8_SB(0, 0), cB, voffB); PG8_STAGE(PG8_SA(0, 0), cA, voffA); PG8_STAGE(PG8_SB(0, 1), cB + hstep, voffB); PG8_STAGE(PG8_SA(0, 1), cA + hstep, voffA);
    if (wr == 1) PG8_BAR;
    PG8_WAIT_V(4); PG8_BAR;
    PG8_STAGE(PG8_SB(1, 0), cB + kstep, voffB); PG8_STAGE(PG8_SA(1, 0), cA + kstep, voffA); PG8_STAGE(PG8_SB(1, 1), cB + hstep + kstep, voffB);
    PG8_WAIT_V(6); PG8_BAR;
    PG8_STAMP();
    for (;;) {
        const bool has_next = S.next(ui + 1, nxt);
        const char* nA = has_next ? (const char*)g.A + (size_t)nxt.pm * tstep : cA; const char* nB = has_next ? (const char*)g.Bt + (size_t)nxt.pn * tstep : cB;
        for (int t = 0; t < nt; t += 2) {
            const bool last = (t == nt - 2);
            const char* a1 = cA + (size_t)(t + 1) * kstep;
            const char* a2 = last ? nA : cA + (size_t)(t + 2) * kstep; const char* b2 = last ? nB : cB + (size_t)(t + 2) * kstep;
            const char* a3 = a2 + kstep; const char* b3 = b2 + kstep;
            if (last && has_next) S.a_ready(nxt);
            if constexpr (Epi::MID_T > 0) { if (t == Epi::MID_T) E.mid(acc, cur, wr, wc, fr, fq); }
            PG8_LDB(B0, 0, 0); PG8_SCHED; PG8_LDA(At, 0, 0); PG8_STAGE(PG8_SA(1, 1), a1 + hstep, voffA);
            PG8_WAIT_L(8); PG8_BAR; PG8_WAIT_L(0); PG8_MMA(0, 0, At, B0); PG8_BAR; PG8_SCHED;
            PG8_LDB(B1, 0, 1); PG8_STAGE(PG8_SB(0, 0), b2, voffB);
            PG8_BAR; PG8_WAIT_L(0); PG8_MMA(0, 1, At, B1); PG8_BAR;
            PG8_LDA(At, 0, 1); PG8_STAGE(PG8_SA(0, 0), a2, voffA);
            PG8_BAR; PG8_WAIT_L(0); PG8_MMA(1, 0, At, B0); PG8_BAR; PG8_SCHED;
            PG8_STAGE(PG8_SB(0, 1), b2 + hstep, voffB);
            PG8_WAIT_V(6); PG8_BAR; PG8_MMA(1, 1, At, B1); PG8_BAR;
            PG8_LDB(B0, 1, 0); PG8_SCHED; PG8_LDA(At, 1, 0); PG8_STAGE(PG8_SA(0, 1), a2 + hstep, voffA);
            PG8_WAIT_L(8); PG8_BAR; PG8_WAIT_L(0); PG8_MMA(0, 0, At, B0); PG8_BAR; PG8_SCHED;
            PG8_LDB(B1, 1, 1); PG8_STAGE(PG8_SB(1, 0), b3, voffB);
            PG8_BAR; PG8_WAIT_L(0); PG8_MMA(0, 1, At, B1); PG8_BAR;
            PG8_LDA(At, 1, 1); PG8_STAGE(PG8_SA(1, 0), a3, voffA);
            PG8_BAR; PG8_WAIT_L(0); PG8_MMA(1, 0, At, B0); PG8_BAR; PG8_SCHED;
            PG8_STAGE(PG8_SB(1, 1), b3 + hstep, voffB);
            PG8_WAIT_V(6); PG8_BAR; PG8_MMA(1, 1, At, B1); PG8_BAR;
        }
        PG8_STAMP();
        if constexpr (!Epi::AFTER_DRAIN) { E(acc, cur, wr, wc, fr, fq); S.done(cur); }
        PG8_STAMP();
        if (!has_next) break;
#pragma unroll
        for (int a = 0; a < 2; ++a)
#pragma unroll
            for (int b = 0; b < 2; ++b)
#pragma unroll
                for (int m = 0; m < 4; ++m)
#pragma unroll
                    for (int n = 0; n < 2; ++n) acc[a][b][m][n] = (f32x4){0.f, 0.f, 0.f, 0.f};
        cur = nxt; cA = nA; cB = nB; ++ui;
    }
    PG8_WAIT_V(0);
    if (wr == 0) PG8_BAR;
    PG8_BAR;
    if constexpr (Epi::AFTER_DRAIN) { E.fused(acc, cur, wr, wc, fr, fq, lds, wid, lane); S.done(cur); }
    PG8_STAMP();
    if (STAMP && wid == 0) { stamps[lane] = lane < nts ? (((unsigned long long)(unsigned)ts_hi << 32) | (unsigned)ts_lo) : 0ull;
        if (lane == 62) stamps[62] = rt_entry; if (lane == 63) stamps[63] = (unsigned long long)wall_clock64(); }
#undef PG8_STAMP
#undef PG8_SA
#undef PG8_SB
#undef PG8_STAGE
#undef PG8_LDA
#undef PG8_LDB
#undef PG8_MMA
#undef PG8_WAIT_V
#undef PG8_WAIT_L
#undef PG8_BAR
#undef PG8_SCHED
}
}
using pf4 = pg8::f32x4;

struct EpiMain {
  static constexpr bool PERM = false, AFTER_DRAIN = false;
  static constexpr int MID_T = 0;
  const Params& p;
  DI void operator()(const pf4 (&acc)[2][2][4][2], const pg8::Unit& u, int wr, int wc, int fr, int fq) const {
    const int pn = u.pn;
    const int rbase = u.pm * 256 + wr * 64 + fr;
    if (pn < 3) {
      const bool isq = pn < 2, isv = (pn == 2) && (wc >= 2);
      const float* gp = isq ? p.qg : p.kg;
      const int d0 = 16 * (fq >> 1) + 4 * (fq & 1), d1 = 32 + 8 * fq;
      float4 g00 = {1.f, 1.f, 1.f, 1.f}, g01 = g00, g10 = g00, g11 = g00;
      if (!isv) { g00 = *(const float4*)(gp + d0); g01 = *(const float4*)(gp + d0 + 8); g10 = *(const float4*)(gp + d1); g11 = *(const float4*)(gp + d1 + 4); }
      _Pragma("unroll") for (int ai = 0; ai < 2; ++ai) {
        if (u.pm * 256 + 128 * ai >= MTOT) continue;
        _Pragma("unroll") for (int m = 0; m < 4; ++m) {
          const int row = rbase + 128 * ai + 16 * m;
          pf4 a00 = acc[ai][0][m][0], a01 = acc[ai][0][m][1], a10 = acc[ai][1][m][0], a11 = acc[ai][1][m][1];
          if (!isv) {
            float ss = 0.f;
            _Pragma("unroll") for (int j = 0; j < 4; ++j) ss += a00[j] * a00[j] + a01[j] * a01[j] + a10[j] * a10[j] + a11[j] * a11[j];
            ss += __shfl_xor(ss, 16); ss += __shfl_xor(ss, 32);
            const float sc = rsqrtf(ss * (1.f / 64.f) + EPS);
            a00[0] *= sc * g00.x; a00[1] *= sc * g00.y; a00[2] *= sc * g00.z; a00[3] *= sc * g00.w;
            a01[0] *= sc * g01.x; a01[1] *= sc * g01.y; a01[2] *= sc * g01.z; a01[3] *= sc * g01.w;
            a10[0] *= sc * g10.x; a10[1] *= sc * g10.y; a10[2] *= sc * g10.z; a10[3] *= sc * g10.w;
            a11[0] *= sc * g11.x; a11[1] *= sc * g11.y; a11[2] *= sc * g11.z; a11[3] *= sc * g11.w;
            if (fq < 2) {
              const float pos = (float)(row < SEQ ? row : SEQ);
              const float invlo[4] = {1.0f, 0.19392274f, 0.03760603f, 0.0072926646f};
              const float invhi[4] = {0.0014142136f, 0.0002742482f, 5.3182957e-05f, 1.0313385e-05f};
              _Pragma("unroll") for (int j = 0; j < 4; ++j) {
                const float inv = (fq & 1) ? invhi[j] : invlo[j];
                float s_, c_; sincos_red(pos * inv, s_, c_);
                const float x1 = a00[j], x2 = a01[j];
                a00[j] = x1 * c_ - x2 * s_; a01[j] = x2 * c_ + x1 * s_;
              }
            }
          }
          if (isq) {
            bfr* qp = p.Q + (size_t)row * 512 + (4 * pn + wc) * 64;
            *(u32x2*)(qp + d0) = pack4(a00[0] * 0.125f, a00[1] * 0.125f, a00[2] * 0.125f, a00[3] * 0.125f);
            *(u32x2*)(qp + d0 + 8) = pack4(a01[0] * 0.125f, a01[1] * 0.125f, a01[2] * 0.125f, a01[3] * 0.125f);
            u32x4 o; o[0] = pk2(a10[0] * 0.125f, a10[1] * 0.125f); o[1] = pk2(a10[2] * 0.125f, a10[3] * 0.125f);
            o[2] = pk2(a11[0] * 0.125f, a11[1] * 0.125f); o[3] = pk2(a11[2] * 0.125f, a11[3] * 0.125f);
            *(u32x4*)(qp + d1) = o;
          } else {
            const int jh = wc & 1;
            bfr* kp = (isv ? p.Vb : p.Kb) + (size_t)row * 128 + jh * 64;
            *(u32x2*)(kp + d0) = pack4(a00[0], a00[1], a00[2], a00[3]);
            *(u32x2*)(kp + d0 + 8) = pack4(a01[0], a01[1], a01[2], a01[3]);
            u32x4 o; o[0] = pk2(a10[0], a10[1]); o[1] = pk2(a10[2], a10[3]); o[2] = pk2(a11[0], a11[1]); o[3] = pk2(a11[2], a11[3]);
            *(u32x4*)(kp + d1) = o;
            float* op = nullptr;
            if (row >= SEQ) op = (isv ? p.out_vs : p.out_ks) + ((size_t)((row - SEQ) * 128 + 127) * 2 + jh) * 64;
            else if (row >= SEQ - 128) op = (isv ? p.out_vp : p.out_kp) + ((size_t)(row - (SEQ - 128)) * 2 + jh) * 64;
            if (op) {
              *(pf4*)(op + d0) = a00; *(pf4*)(op + d0 + 8) = a01; *(pf4*)(op + d1) = a10; *(pf4*)(op + d1 + 4) = a11;
            }
          }
        }
      }
      return;
    }
    const int cw = 32 * wc + 8 * fq;
    bfr* dst; int ld, col, op;
    if (pn < 5) { dst = p.ZA; ld = 512; col = (pn - 3) * 256; op = 1; }
    else if (pn < 7) { dst = p.QB; ld = 512; col = (pn - 5) * 256; op = 0; }
    else if (pn < 9) { dst = p.ZF; ld = 512; col = (pn - 7) * 256; op = 0; }
    else if (pn < 11) { dst = p.IB; ld = 512; col = (pn - 9) * 256; op = 0; }
    else if (pn < 13) { dst = p.ZB; ld = 512; col = (pn - 11) * 256; op = 1; }
    else if (pn < 17) { dst = p.GA; ld = 1024; col = (pn - 13) * 256; op = 2; }
    else { dst = p.GB; ld = 1024; col = (pn - 17) * 256; op = 2; }
    bfr* const obase = dst + (size_t)rbase * ld + col + cw;
    _Pragma("unroll") for (int bj = 0; bj < 2; ++bj) {
      float4 b0 = {0.f, 0.f, 0.f, 0.f}, b1 = b0;
      if (op == 2) { const float* bp = p.b_merge + (pn - 13) * 256 + 128 * bj + cw; b0 = *(const float4*)bp; b1 = *(const float4*)(bp + 4); }
      _Pragma("unroll") for (int ai = 0; ai < 2; ++ai) {
        if (u.pm * 256 + 128 * ai >= MTOT) continue;
        _Pragma("unroll") for (int m = 0; m < 4; ++m) {
          const int row = rbase + 128 * ai + 16 * m;
          pf4 x = acc[ai][bj][m][0], y = acc[ai][bj][m][1];
          if (op == 1) { _Pragma("unroll") for (int j = 0; j < 4; ++j) { x[j] = siluf_(x[j]); y[j] = siluf_(y[j]); } }
          else if (op == 2) {
            x[0] = sigmoidf_(x[0] + b0.x); x[1] = sigmoidf_(x[1] + b0.y); x[2] = sigmoidf_(x[2] + b0.z); x[3] = sigmoidf_(x[3] + b0.w);
            y[0] = sigmoidf_(y[0] + b1.x); y[1] = sigmoidf_(y[1] + b1.y); y[2] = sigmoidf_(y[2] + b1.z); y[3] = sigmoidf_(y[3] + b1.w);
          }
          u32x4 o; o[0] = pk2(x[0], x[1]); o[1] = pk2(x[2], x[3]); o[2] = pk2(y[0], y[1]); o[3] = pk2(y[2], y[3]);
          __builtin_nontemporal_store(o, (u32x4*)(obase + (128 * ai + 16 * m) * ld + 128 * bj));
        }
      }
    }
  }
};

struct EpiMerge {
  static constexpr bool PERM = true, AFTER_DRAIN = false;
  static constexpr int MID_T = 8;
  const Params& p;
  DI void mid(pf4 (&acc)[2][2][4][2], const pg8::Unit& u, int wr, int wc, int fr, int fq) const {
    int rbase = u.pm * 256 + wr * 64 + fr; const int cbase = u.pn * 256 + 32 * wc + 8 * fq;
    asm volatile("" : "+v"(rbase));
    _Pragma("unroll") for (int ai = 0; ai < 2; ++ai) _Pragma("unroll") for (int m = 0; m < 4; ++m) _Pragma("unroll") for (int bj = 0; bj < 2; ++bj) {
      if (bj == 0 && m == 0) __builtin_amdgcn_sched_barrier(0);
      const size_t off = (size_t)(rbase + 128 * ai + 16 * m) * 1024 + cbase + 128 * bj;
      const u32x4 ga = *(const u32x4*)(p.GA + off), gb = *(const u32x4*)(p.GB + off);
      _Pragma("unroll") for (int e = 0; e < 2; ++e) {
        acc[ai][bj][m][0][2 * e] *= bflo(ga[e]) * __builtin_amdgcn_rcpf(fmaxf(bflo(gb[e]), 1e-30f));
        acc[ai][bj][m][0][2 * e + 1] *= bfhi(ga[e]) * __builtin_amdgcn_rcpf(fmaxf(bfhi(gb[e]), 1e-30f));
        acc[ai][bj][m][1][2 * e] *= bflo(ga[2 + e]) * __builtin_amdgcn_rcpf(fmaxf(bflo(gb[2 + e]), 1e-30f));
        acc[ai][bj][m][1][2 * e + 1] *= bfhi(ga[2 + e]) * __builtin_amdgcn_rcpf(fmaxf(bfhi(gb[2 + e]), 1e-30f));
      }
    }
  }
  DI void operator()(const pf4 (&acc)[2][2][4][2], const pg8::Unit& u, int wr, int wc, int fr, int fq) const {
    const int rbase = u.pm * 256 + wr * 64 + fr, cbase = u.pn * 256 + 32 * wc + 8 * fq;
    _Pragma("unroll") for (int ai = 0; ai < 2; ++ai) _Pragma("unroll") for (int m = 0; m < 4; ++m) _Pragma("unroll") for (int bj = 0; bj < 2; ++bj) {
      const size_t off = (size_t)(rbase + 128 * ai + 16 * m) * 1024 + cbase + 128 * bj;
      const u32x4 g = *(const u32x4*)(p.GB + off);
      const pf4 x = acc[ai][bj][m][0], y = acc[ai][bj][m][1];
      u32x4 o; o[0] = pk2(bflo(g[0]) * x[0], bfhi(g[0]) * x[1]); o[1] = pk2(bflo(g[1]) * x[2], bfhi(g[1]) * x[3]);
      o[2] = pk2(bflo(g[2]) * y[0], bfhi(g[2]) * y[1]); o[3] = pk2(bflo(g[3]) * y[2], bfhi(g[3]) * y[3]);
      *(u32x4*)(p.Y + off) = o;
    }
  }
};

struct EpiOut {
  static constexpr bool PERM = false, AFTER_DRAIN = false;
  static constexpr int MID_T = 0;
  const Params& p;
  DI void operator()(const pf4 (&acc)[2][2][4][2], const pg8::Unit& u, int wr, int wc, int fr, int fq) const {
    const int rbase = u.pm * 256 + wr * 64 + fr, cbase = u.pn * 256 + 32 * wc + 4 * fq;
    const float* gr = p.mod + (size_t)128 * 3072 + 2048;
    _Pragma("unroll") for (int bj = 0; bj < 2; ++bj) _Pragma("unroll") for (int n = 0; n < 2; ++n) {
      const int c = cbase + 128 * bj + 16 * n;
      const pf4 gt = *(const pf4*)(gr + c);
      pf4 xv[8];
      _Pragma("unroll") for (int q = 0; q < 8; ++q) xv[q] = __builtin_nontemporal_load((const pf4*)(p.x_prompt + (size_t)(rbase + 128 * (q >> 2) + 16 * (q & 3)) * DM + c));
      __builtin_amdgcn_sched_barrier(0);
      _Pragma("unroll") for (int q = 0; q < 8; ++q)
        __builtin_nontemporal_store(xv[q] + gt * acc[q >> 2][bj][q & 3][n], (pf4*)(p.out_yp + (size_t)(rbase + 128 * (q >> 2) + 16 * (q & 3)) * DM + c));
      __builtin_amdgcn_sched_barrier(0);
    }
  }
};

struct EpiOutLds {
  static constexpr bool PERM = false, AFTER_DRAIN = true;
  static constexpr int MID_T = 0;
  const Params& p;
  DI void operator()(const pf4 (&)[2][2][4][2], const pg8::Unit&, int, int, int, int) const {}
  DI void fused(const pf4 (&acc)[2][2][4][2], const pg8::Unit& u, int wr, int wc, int fr, int fq, PG8_LAS unsigned char* lds, int, int) const {
    const float* gr = p.mod + (size_t)128 * 3072 + 2048 + u.pn * 256;
    const int tid = threadIdx.x, c = tid & 63, rsub = tid >> 6;
    pf4 gt[2][2];
    _Pragma("unroll") for (int bj = 0; bj < 2; ++bj) _Pragma("unroll") for (int n = 0; n < 2; ++n) gt[bj][n] = *(const pf4*)(gr + 128 * bj + 32 * wc + 16 * n + 4 * fq);
    _Pragma("unroll") for (int ai = 0; ai < 2; ++ai) {
      _Pragma("unroll") for (int m = 0; m < 4; ++m) _Pragma("unroll") for (int bj = 0; bj < 2; ++bj) _Pragma("unroll") for (int n = 0; n < 2; ++n) {
        const int rl = 64 * wr + 16 * m + fr, chunk = 32 * bj + 8 * wc + 4 * n + fq;
        *(PG8_LAS pf4*)(lds + rl * 1024 + ((chunk ^ fr) << 4)) = gt[bj][n] * acc[ai][bj][m][n];
      }
      __syncthreads();
      const size_t g0 = (size_t)(u.pm * 256 + 128 * ai) * DM + u.pn * 256 + 4 * c;
      _Pragma("unroll") for (int s4 = 0; s4 < 4; ++s4) {
        pf4 xv[4];
        _Pragma("unroll") for (int q = 0; q < 4; ++q) xv[q] = __builtin_nontemporal_load((const pf4*)(p.x_prompt + g0 + (size_t)((s4 * 4 + q) * 8 + rsub) * DM));
        _Pragma("unroll") for (int q = 0; q < 4; ++q) {
          const int rl = (s4 * 4 + q) * 8 + rsub;
          const pf4 st = *(const PG8_LAS pf4*)(lds + rl * 1024 + ((c ^ (rl & 15)) << 4));
          __builtin_nontemporal_store(xv[q] + st, (pf4*)(p.out_yp + g0 + (size_t)rl * DM));
        }
      }
      __syncthreads();
    }
  }
};

DI f32x16 wave_gemm32(const bfr* __restrict__ A, int lda, const bfr* __restrict__ W, int ldw, int K, int lane) {
  const int r = lane & 31, h = lane >> 5;
  const bfr* ap = A + (size_t)r * lda + 8 * h;
  const bfr* wp = W + (size_t)r * ldw + 8 * h;
  f32x16 acc = zero16();
  for (int k0 = 0; k0 < K; k0 += 128) {
    bf16x8 a[8], b[8];
    _Pragma("unroll") for (int q = 0; q < 8; ++q) { a[q] = *(const bf16x8*)(ap + k0 + 16 * q); b[q] = *(const bf16x8*)(wp + k0 + 16 * q); }
    _Pragma("unroll") for (int q = 0; q < 8; ++q) acc = mfma(b[q], a[q], acc);
  }
  return acc;
}

DI void sample_chain_wave(const Params& p, int wt, int lane) {
  const int mt = wt >> 5, nt = wt & 31, r = lane & 31, h = lane >> 5;
  const int m = 32 * mt + r;
  unsigned* cnt = p.bar + PANEL_CNT_WORD + 64 * mt;
  {
    const f32x16 a1 = wave_gemm32(p.YA + (size_t)(SEQ + 32 * mt) * 1024, 1024, p.Wt_pab + (size_t)(32 * nt) * 1024, 1024, 512, lane);
    const f32x16 a2 = wave_gemm32(p.YB + (size_t)(SEQ + 32 * mt) * 1024, 1024, p.Wt_pab + (size_t)(32 * nt) * 1024 + 512, 1024, 512, lane);
    _Pragma("unroll") for (int g = 0; g < 4; ++g) {
      const int n = 32 * nt + 8 * g + 4 * h;
      const u32x2 ga = *(const u32x2*)(p.GA + (size_t)(SEQ + m) * 1024 + n), gb = *(const u32x2*)(p.GB + (size_t)(SEQ + m) * 1024 + n);
      *(u32x2*)(p.Ys + (size_t)m * 1024 + n) = pack4(bflo(ga[0]) * a1[4 * g] + bflo(gb[0]) * a2[4 * g], bfhi(ga[0]) * a1[4 * g + 1] + bfhi(gb[0]) * a2[4 * g + 1],
                                                     bflo(ga[1]) * a1[4 * g + 2] + bflo(gb[1]) * a2[4 * g + 2], bfhi(ga[1]) * a1[4 * g + 3] + bfhi(gb[1]) * a2[4 * g + 3]);
    }
    __builtin_amdgcn_fence(__ATOMIC_RELEASE, "agent");
    asm volatile("s_waitcnt vmcnt(0)" ::: "memory");
    if (lane == 0) __hip_atomic_fetch_add(cnt, 1u, __ATOMIC_RELAXED, __HIP_MEMORY_SCOPE_AGENT);
  }
  {
    unsigned sp = 0;
    while (__hip_atomic_load(cnt, __ATOMIC_RELAXED, __HIP_MEMORY_SCOPE_AGENT) < 32u) { __builtin_amdgcn_s_sleep(2); if (++sp > (1u << 22)) break; }
    __builtin_amdgcn_fence(__ATOMIC_ACQUIRE, "agent");
    asm volatile("s_waitcnt vmcnt(0)" ::: "memory");
  }
  const f32x16 acc = wave_gemm32(p.Ys + (size_t)(32 * mt) * 1024, 1024, p.Wt_out + (size_t)(32 * nt) * 1024, 1024, 1024, lane);
  _Pragma("unroll") for (int g = 0; g < 4; ++g) {
    const int n = 32 * nt + 8 * g + 4 * h;
    const float4 xv = *(const float4*)(p.x_sample + (size_t)m * DM + n), gt = *(const float4*)(p.mod + (size_t)m * 3072 + 2048 + n);
    float4 o;
    o.x = xv.x + gt.x * acc[4 * g]; o.y = xv.y + gt.y * acc[4 * g + 1]; o.z = xv.z + gt.z * acc[4 * g + 2]; o.w = xv.w + gt.w * acc[4 * g + 3];
    *(float4*)(p.out_ys + (size_t)m * DM + n) = o;
  }
}

DI void attn_prompt_wave(const Params& p, int qt, int hd, int lane) {
  const int r = lane & 31, h = lane >> 5, j = hd >> 2;
  const int q0 = qt * 32, q = q0 + r, kb = q0 - 128;
  bf16x8 qf[4];
  _Pragma("unroll") for (int s = 0; s < 4; ++s) qf[s] = *(const bf16x8*)(p.Q + (size_t)q * 512 + hd * 64 + 16 * s + 8 * h);
  f32x16 sacc[5];
  _Pragma("unroll") for (int kt = 0; kt < 5; ++kt) {
    sacc[kt] = zero16();
    int kr = kb + 32 * kt + r; kr = kr < 0 ? 0 : kr;
    _Pragma("unroll") for (int s = 0; s < 4; ++s) {
      bf16x8 kf = *(const bf16x8*)(p.Kb + (size_t)kr * 128 + j * 64 + 16 * s + 8 * h);
      sacc[kt] = mfma(kf, qf[s], sacc[kt]);
    }
  }
  const float sink = p.sinks[hd];
  float mx = sink;
  _Pragma("unroll") for (int kt = 0; kt < 5; ++kt) _Pragma("unroll") for (int i = 0; i < 16; ++i) {
    int key = kb + 32 * kt + crow(i, h), rel = q - key;
    bool valid = (rel >= 0) && (rel < 128) && (key >= 0);
    float sv = valid ? sacc[kt][i] : -INFINITY;
    sacc[kt][i] = sv; mx = fmaxf(mx, sv);
  }
  mx = fmaxf(mx, __shfl_xor(mx, 32));
  float l = 0.f;
  _Pragma("unroll") for (int kt = 0; kt < 5; ++kt) _Pragma("unroll") for (int i = 0; i < 16; ++i) {
    float pv = __expf(sacc[kt][i] - mx); sacc[kt][i] = pv; l += pv;
  }
  l += __shfl_xor(l, 32);
  l += __expf(sink - mx);
  f32x16 oacc[2]; oacc[0] = zero16(); oacc[1] = zero16();
  const bfr* vbase = p.Vb + j * 64 + 2 * r;
  _Pragma("unroll") for (int kt = 0; kt < 5; ++kt) _Pragma("unroll") for (int s2 = 0; s2 < 2; ++s2) {
    u32x4 pp;
    _Pragma("unroll") for (int e = 0; e < 4; ++e) pp[e] = pk2(sacc[kt][8 * s2 + 2 * e], sacc[kt][8 * s2 + 2 * e + 1]);
    unsigned wv[8];
    _Pragma("unroll") for (int jj = 0; jj < 8; ++jj) {
      int key = kb + 32 * kt + 16 * s2 + 8 * (jj >> 2) + 4 * h + (jj & 3); key = key < 0 ? 0 : key;
      wv[jj] = *(const unsigned*)(vbase + (size_t)key * 128);
    }
    u32x4 v0, v1;
    _Pragma("unroll") for (int e = 0; e < 4; ++e) {
      v0[e] = (wv[2 * e] & 0xffffu) | (wv[2 * e + 1] << 16);
      v1[e] = (wv[2 * e] >> 16) | (wv[2 * e + 1] & 0xffff0000u);
    }
    const bf16x8 pa = __builtin_bit_cast(bf16x8, pp);
    oacc[0] = mfma(pa, __builtin_bit_cast(bf16x8, v0), oacc[0]);
    oacc[1] = mfma(pa, __builtin_bit_cast(bf16x8, v1), oacc[1]);
  }
  const float il = frcp(l);
  _Pragma("unroll") for (int i = 0; i < 16; ++i) {
    const int qi = crow(i, h);
    const float ili = __shfl(il, qi);
    const size_t row = (size_t)(q0 + qi);
    const unsigned za = *(const unsigned*)(p.ZA + row * 512 + hd * 64 + 2 * r);
    *(unsigned*)(p.YA + row * 1024 + hd * 64 + 2 * r) = pk2(oacc[0][i] * ili * bflo(za), oacc[1][i] * ili * bfhi(za));
  }
}

DI void attn_sample_wave(const Params& p, int b, int hd) {
  const int lane = TID & 63, j = hd >> 2, m = SEQ + b;
  u32x4 qv[8];
  _Pragma("unroll") for (int i = 0; i < 8; ++i) qv[i] = *(const u32x4*)(p.Q + (size_t)m * 512 + hd * 64 + 8 * i);
  float dn = 0.f;
  _Pragma("unroll") for (int i = 0; i < 8; ++i) {
    u32x4 kv = *(const u32x4*)(p.Kb + (size_t)m * 128 + j * 64 + 8 * i);
    _Pragma("unroll") for (int e = 0; e < 4; ++e) dn += bflo(qv[i][e]) * bflo(kv[e]) + bfhi(qv[i][e]) * bfhi(kv[e]);
  }
  float s[2];
  _Pragma("unroll") for (int u = 0; u < 2; ++u) {
    int idx = lane + 1 + 64 * u;
    int ic = idx < 128 ? idx : 127;
    const float* kp = p.cache_k + ((size_t)(b * 128 + ic) * 2 + j) * 64;
    float d = 0.f;
    _Pragma("unroll") for (int i = 0; i < 8; ++i) {
      float4 k0 = *(const float4*)(kp + 8 * i), k1 = *(const float4*)(kp + 8 * i + 4);
      d += bflo(qv[i][0]) * k0.x + bfhi(qv[i][0]) * k0.y + bflo(qv[i][1]) * k0.z + bfhi(qv[i][1]) * k0.w;
      d += bflo(qv[i][2]) * k1.x + bfhi(qv[i][2]) * k1.y + bflo(qv[i][3]) * k1.z + bfhi(qv[i][3]) * k1.w;
    }
    s[u] = idx < 128 ? d : dn;
  }
  const float sink = p.sinks[hd];
  float mx = fmaxf(fmaxf(s[0], s[1]), sink);
  _Pragma("unroll") for (int o = 32; o >= 1; o >>= 1) mx = fmaxf(mx, __shfl_xor(mx, o));
  float p0 = __expf(s[0] - mx), p1 = __expf(s[1] - mx);
  float l = p0 + p1;
  _Pragma("unroll") for (int o = 32; o >= 1; o >>= 1) l += __shfl_xor(l, o);
  l += __expf(sink - mx);
  float o = 0.f;
  const float* vb = p.cache_v + ((size_t)(b * 128) * 2 + j) * 64 + lane;
  _Pragma("unroll 32") for (int idx = 1; idx < 128; ++idx) {
    float pv = __shfl(idx <= 64 ? p0 : p1, (idx - 1) & 63);
    o += pv * vb[(size_t)idx * 128];
  }
  o += __shfl(p1, 63) * bf2f(p.Vb[(size_t)m * 128 + j * 64 + lane]);
  size_t off = (size_t)m * 512 + hd * 64 + lane;
  p.YA[(size_t)m * 1024 + hd * 64 + lane] = (bfr)f2bf(o * frcp(l) * bf2f(p.ZA[off]));
}

DI void hgrn_gates(const Params& p, int row0, int hh, float* sTot, float (&L)[32], float (&kin)[32], float& t0, float& lc) {
  const int t = TID, c = t & 127, half = t >> 7, ch = hh * 128 + c;
  const float lbv = frcp(1.f + __expf(p.lb_logits[512 + ch] - p.lb_logits[ch]));
  const bfr* zp = p.ZF + (size_t)(row0 + half * 32) * 512 + ch;
  float run = 0.f;
  _Pragma("unroll") for (int jj = 0; jj < 32; ++jj) {
    float z = bf2f(zp[(size_t)jj * 512]);
    z = fminf(fmaxf(z, -30.f), 30.f);
    float em = __expf(-z), sg = frcp(1.f + em);
    float f = lbv + (1.f - lbv) * sg;
    kin[jj] = (1.f - lbv) * em * sg;
    run += __logf(f);
    L[jj] = run;
  }
  sTot[half * 128 + c] = run;
  __syncthreads();
  t0 = sTot[c]; lc = t0 + sTot[128 + c];
  if (half) { _Pragma("unroll") for (int jj = 0; jj < 32; ++jj) L[jj] += t0; }
}

DI void hgrn_fused_item(const Params& p, int n, int hh, char* smem) {
  bfr* sVt = (bfr*)smem;
  bfr* sKt = sVt + 128 * LDT;
  bfr* sQh = sKt + 128 * LDT;
  bfr* sKh = sQh + 64 * 136;
  bfr* sAm = sKt;
  float* sTot = (float*)(sKh + 64 * 136);
  const int t = TID, lane = t & 63, w = t >> 6, h = lane >> 5, c = t & 127, half = t >> 7;
  const int row0 = n * 64;
  __syncthreads();
  {
    const bfr* ip = p.IB + (size_t)(row0 + half * 32) * 512 + hh * 128 + c;
    _Pragma("unroll") for (int q4 = 0; q4 < 4; ++q4) {
      u32x4 o;
      _Pragma("unroll") for (int e = 0; e < 4; ++e) {
        int jj = q4 * 8 + 2 * e;
        o[e] = (unsigned)ip[(size_t)jj * 512] | ((unsigned)ip[(size_t)(jj + 1) * 512] << 16);
      }
      *(u32x4*)(sVt + c * LDT + half * 32 + q4 * 8) = o;
    }
  }
  {
    float L[32], kin[32], t0, lc;
    hgrn_gates(p, row0, hh, sTot, L, kin, t0, lc);
    _Pragma("unroll") for (int q4 = 0; q4 < 4; ++q4) {
      u32x4 o;
      _Pragma("unroll") for (int e = 0; e < 4; ++e) {
        int jj = q4 * 8 + 2 * e;
        o[e] = pk2(kin[jj] * __expf(lc - L[jj]), kin[jj + 1] * __expf(lc - L[jj + 1]));
      }
      *(u32x4*)(sKt + c * LDT + half * 32 + q4 * 8) = o;
    }
    if (half == 0) p.dec[(n * 4 + hh) * 128 + c] = __expf(lc);
    bfr* qp = p.QB + (size_t)(row0 + half * 32) * 512 + hh * 128 + c;
    _Pragma("unroll") for (int jj = 0; jj < 32; ++jj) {
      const float qv = bf2f(qp[(size_t)jj * 512]);
      qp[(size_t)jj * 512] = (bfr)(pk2(qv * __expf(L[jj]), 0.f) & 0xffffu);
      const float dl = L[jj] - t0;
      sQh[(half * 32 + jj) * 136 + c] = (bfr)(pk2(qv * __expf(fminf(dl, 80.f)), 0.f) & 0xffffu);
      sKh[(half * 32 + jj) * 136 + c] = (bfr)(pk2(kin[jj] * __expf(fminf(-dl, 80.f)), 0.f) & 0xffffu);
    }
  }
  __syncthreads();
  {
    int r = lane & 31; asm volatile("" : "+v"(r));
    const int wv = w >> 1, wk = w & 1;
    f32x16 acc[2][2];
    _Pragma("unroll") for (int a = 0; a < 2; ++a) _Pragma("unroll") for (int b = 0; b < 2; ++b) acc[a][b] = zero16();
    _Pragma("unroll") for (int s = 0; s < 4; ++s) {
      bf16x8 af[2], bf[2];
      _Pragma("unroll") for (int x = 0; x < 2; ++x) {
        af[x] = *(const bf16x8*)(sVt + (wv * 64 + x * 32 + r) * LDT + 16 * s + 8 * h);
        bf[x] = *(const bf16x8*)(sKt + (wk * 64 + x * 32 + r) * LDT + 16 * s + 8 * h);
      }
      _Pragma("unroll") for (int a = 0; a < 2; ++a) _Pragma("unroll") for (int b = 0; b < 2; ++b) acc[a][b] = mfma(af[a], bf[b], acc[a][b]);
    }
    float* up = p.Ust + (size_t)(n * 4 + hh) * 16384;
    _Pragma("unroll") for (int a = 0; a < 2; ++a) _Pragma("unroll") for (int b = 0; b < 2; ++b) _Pragma("unroll") for (int i = 0; i < 16; ++i) {
      int v = wv * 64 + a * 32 + crow(i, h), k = wk * 64 + b * 32 + r;
      up[v * 128 + k] = acc[a][b][i];
    }
  }
  const int jt = w >> 1, it = w & 1;
  int r2 = lane & 31; asm volatile("" : "+v"(r2));
  f32x16 am = zero16();
  if (jt <= it) {
    _Pragma("unroll") for (int s = 0; s < 8; ++s) {
      bf16x8 kf = *(const bf16x8*)(sKh + (jt * 32 + r2) * 136 + 16 * s + 8 * h);
      bf16x8 qf = *(const bf16x8*)(sQh + (it * 32 + r2) * 136 + 16 * s + 8 * h);
      am = mfma(kf, qf, am);
    }
  }
  __syncthreads();
  {
    int r3 = lane & 31; asm volatile("" : "+v"(r3));
    const int i = it * 32 + r3;
    _Pragma("unroll") for (int g = 0; g < 4; ++g) {
      int j0 = jt * 32 + 8 * g + 4 * h;
      float x0 = (j0 <= i) ? am[4 * g] : 0.f, x1 = (j0 + 1 <= i) ? am[4 * g + 1] : 0.f;
      float x2 = (j0 + 2 <= i) ? am[4 * g + 2] : 0.f, x3 = (j0 + 3 <= i) ? am[4 * g + 3] : 0.f;
      *(u32x2*)(sAm + i * LDT + j0) = pack4(x0, x1, x2, x3);
    }
  }
  __syncthreads();
  {
    int r = lane & 31; asm volatile("" : "+v"(r));
    f32x16 oacc[2]; oacc[0] = zero16(); oacc[1] = zero16();
    _Pragma("unroll") for (int s = 0; s < 4; ++s) {
      bf16x8 vf = *(const bf16x8*)(sVt + (32 * w + r) * LDT + 16 * s + 8 * h);
      _Pragma("unroll") for (int i2 = 0; i2 < 2; ++i2) {
        bf16x8 af2 = *(const bf16x8*)(sAm + (i2 * 32 + r) * LDT + 16 * s + 8 * h);
        oacc[i2] = mfma(vf, af2, oacc[i2]);
      }
    }
    _Pragma("unroll") for (int i2 = 0; i2 < 2; ++i2) _Pragma("unroll") for (int g = 0; g < 4; ++g)
      *(u32x2*)(p.YB + (size_t)(row0 + i2 * 32 + r) * 1024 + hh * 128 + 32 * w + 8 * g + 4 * h) =
          pack4(oacc[i2][4 * g], oacc[i2][4 * g + 1], oacc[i2][4 * g + 2], oacc[i2][4 * g + 3]);
  }
}

DI void hgrn_sample_wave(const Params& p, int b, int hh, int lane, float* sw  ) {
  const int m = SEQ + b;
  _Pragma("unroll") for (int u = 0; u < 2; ++u) {
    const int k = lane + 64 * u, ch = hh * 128 + k;
    const float lbv = frcp(1.f + __expf(p.lb_logits[512 + ch] - p.lb_logits[ch]));
    float z = bf2f(p.ZF[(size_t)m * 512 + ch]);
    z = fminf(fmaxf(z, -30.f), 30.f);
    const float em = __expf(-z), sg = frcp(1.f + em);
    sw[k] = lbv + (1.f - lbv) * sg; sw[128 + k] = (1.f - lbv) * em * sg; sw[256 + k] = bf2f(p.QB[(size_t)m * 512 + ch]);
  }
  const int v4 = (lane & 31) * 4, kg = lane >> 5;
  const u32x2 vraw = *(const u32x2*)(p.IB + (size_t)m * 512 + hh * 128 + v4);
  const float4 vv = {bflo(vraw[0]), bfhi(vraw[0]), bflo(vraw[1]), bfhi(vraw[1])};
  __builtin_amdgcn_s_waitcnt(0xc07f);
  __builtin_amdgcn_wave_barrier();
  float4 o = {0.f, 0.f, 0.f, 0.f};
  const size_t sb = (size_t)(b * 4 + hh) * 16384 + (size_t)(kg * 64) * 128 + v4;
  const volatile float* swv = sw;
  _Pragma("unroll 16") for (int kk = 0; kk < 64; ++kk) {
    const int k = kg * 64 + kk;
    const float4 S = *(const float4*)(p.state + sb + kk * 128);
    const float f = swv[k], ki = swv[128 + k], qq = swv[256 + k];
    float4 Sn; Sn.x = f * S.x + ki * vv.x; Sn.y = f * S.y + ki * vv.y; Sn.z = f * S.z + ki * vv.z; Sn.w = f * S.w + ki * vv.w;
    *(float4*)(p.out_ss + sb + kk * 128) = Sn;
    o.x += qq * Sn.x; o.y += qq * Sn.y; o.z += qq * Sn.z; o.w += qq * Sn.w;
  }
  o.x += __shfl_xor(o.x, 32); o.y += __shfl_xor(o.y, 32); o.z += __shfl_xor(o.z, 32); o.w += __shfl_xor(o.w, 32);
  float ss = o.x * o.x + o.y * o.y + o.z * o.z + o.w * o.w;
  _Pragma("unroll") for (int of = 16; of >= 1; of >>= 1) ss += __shfl_xor(ss, of);
  const float sc = rsqrtf(ss * (1.f / 128.f) + EPS);
  if (kg == 0) {
    const float4 og = *(const float4*)(p.og + v4);
    const u32x2 zb = *(const u32x2*)(p.ZB + (size_t)m * 512 + hh * 128 + v4);
    *(u32x2*)(p.YB + (size_t)m * 1024 + hh * 128 + v4) = pack4(o.x * sc * og.x * bflo(zb[0]), o.y * sc * og.y * bfhi(zb[0]), o.z * sc * og.z * bflo(zb[1]), o.w * sc * og.w * bfhi(zb[1]));
  }
  __builtin_amdgcn_wave_barrier();
}

DI void cache_shift_copy(const Params& p, int gw, int nw, int lane, int part) {
  const int lo = part * (64 * 4064), hi = lo + 64 * 4064;
  for (int idx = lo + gw * 64 + lane; idx < hi; idx += nw * 64) {
    int b = idx / 4064, i4 = idx - b * 4064;
    size_t so = (size_t)b * 16384 + 128 + i4 * 4, dof = (size_t)b * 16384 + i4 * 4;
    *(float4*)(p.out_ks + dof) = *(const float4*)(p.cache_k + so);
    *(float4*)(p.out_vs + dof) = *(const float4*)(p.cache_v + so);
  }
}

DI void phase_mix(const Params& p, char* smem, char* smem_all) {
  const int wave = threadIdx.x >> 6, lane = threadIdx.x & 63, gw = blockIdx.x * 8 + wave, nw = gridDim.x * 8;
  float* sw = (float*)(smem_all + wave * 2048);
  if (gw & 1) {
    for (int it = gw >> 1; it < 1024; it += nw >> 1) attn_sample_wave(p, it >> 3, it & 7);
    cache_shift_copy(p, gw >> 1, nw >> 1, lane, 0);
    for (int it = gw; it < 4096; it += nw) attn_prompt_wave(p, it >> 3, it & 7, lane);
  } else {
    int it = gw;
    if (it < 4096) { attn_prompt_wave(p, it >> 3, it & 7, lane); it += nw; }
    if ((gw & 3) == 0) { for (int hs = gw >> 2; hs < 512; hs += nw >> 2) hgrn_sample_wave(p, hs >> 2, hs & 3, lane, sw); }
    cache_shift_copy(p, gw >> 1, nw >> 1, lane, 1);
    for (; it < 4096; it += nw) attn_prompt_wave(p, it >> 3, it & 7, lane);
  }
  for (int it = VBID; it < 1024; it += VGRID) hgrn_fused_item(p, it >> 2, it & 3, smem);
}

#define SCAN_LOAD(U, Dd, N0) _Pragma("unroll") for (int i = 0; i < 32; ++i) { U[i] = up[(size_t)((N0) + i) * 65536]; Dd[i] = dp[((N0) + i) * 512]; }
#define SCAN_STEP(U, Dd, N0) _Pragma("unroll") for (int i = 0; i < 32; ++i) { sp[(size_t)((N0) + i) * 65536] = (bfr)(pk2(S, 0.f) & 0xffffu); S = Dd[i] * S + U[i]; }
DI void phase_scan(const Params& p, int eb) {
  const int e = eb * 256 + threadIdx.x;
  const int hh = e >> 14, k = e & 127, v = (e >> 7) & 127;
  const float* up = p.Ust + e;
  bfr* sp = p.S16 + e;
  const float* dp = p.dec + hh * 128 + k;
  float S = 0.f;
  float ua[32], da[32], ub[32], db[32];
  SCAN_LOAD(ua, da, 0)
  for (int n0 = 0; n0 < NCH; n0 += 64) {
    SCAN_LOAD(ub, db, n0 + 32)
    SCAN_STEP(ua, da, n0)
    if (n0 + 64 < NCH) { SCAN_LOAD(ua, da, n0 + 64) }
    SCAN_STEP(ub, db, n0 + 32)
  }
  p.out_sp[(hh * 128 + k) * 128 + v] = S;
}

DI void hgrn_out_wave(const Params& p, int n, int hh, int it, int lane) {
  const int r = lane & 31, h = lane >> 5;
  const size_t row = (size_t)(n * 64 + it * 32 + r);
  bf16x8 qf[8];
  _Pragma("unroll") for (int s = 0; s < 8; ++s) qf[s] = *(const bf16x8*)(p.QB + row * 512 + hh * 128 + 16 * s + 8 * h);
  const bfr* sb = p.S16 + (size_t)(n * 4 + hh) * 16384 + (size_t)r * 128 + 8 * h;
  f32x16 acc[4];
  _Pragma("unroll") for (int vt = 0; vt < 4; ++vt) {
    acc[vt] = zero16();
    _Pragma("unroll") for (int s = 0; s < 8; ++s) {
      bf16x8 sf = *(const bf16x8*)(sb + vt * 32 * 128 + 16 * s);
      acc[vt] = mfma(sf, qf[s], acc[vt]);
    }
  }
  float ss = 0.f;
  _Pragma("unroll") for (int vt = 0; vt < 4; ++vt) _Pragma("unroll") for (int g = 0; g < 4; ++g) {
    const u32x2 oi = *(const u32x2*)(p.YB + row * 1024 + hh * 128 + 32 * vt + 8 * g + 4 * h);
    acc[vt][4 * g] += bflo(oi[0]); acc[vt][4 * g + 1] += bfhi(oi[0]); acc[vt][4 * g + 2] += bflo(oi[1]); acc[vt][4 * g + 3] += bfhi(oi[1]);
    ss += acc[vt][4 * g] * acc[vt][4 * g] + acc[vt][4 * g + 1] * acc[vt][4 * g + 1] + acc[vt][4 * g + 2] * acc[vt][4 * g + 2] + acc[vt][4 * g + 3] * acc[vt][4 * g + 3];
  }
  ss += __shfl_xor(ss, 32);
  const float sc = rsqrtf(ss * (1.f / 128.f) + EPS);
  _Pragma("unroll") for (int vt = 0; vt < 4; ++vt) _Pragma("unroll") for (int g = 0; g < 4; ++g) {
    const int v = 32 * vt + 8 * g + 4 * h;
    const float4 og = *(const float4*)(p.og + v);
    const u32x2 zb = *(const u32x2*)(p.ZB + row * 512 + hh * 128 + v);
    *(u32x2*)(p.YB + row * 1024 + hh * 128 + v) = pack4(acc[vt][4 * g] * sc * og.x * bflo(zb[0]), acc[vt][4 * g + 1] * sc * og.y * bfhi(zb[0]),
                                                        acc[vt][4 * g + 2] * sc * og.z * bflo(zb[1]), acc[vt][4 * g + 3] * sc * og.w * bfhi(zb[1]));
  }
}

#define XB_TMO      128
#define XB_XCNT(j)  (256  + 64 * (j))
#define XB_XSUB(j)  (1280 + 64 * (j))
#define XB_XGEN(j)  (2304 + 64 * (j))
#define XB_TOP      3328
#define XB_TOPGEN   3392
#define XCD_BAR_WORDS 3456
#define XB_SPIN_CAP (1u << 18)
#define LAS __attribute__((address_space(3)))

__device__ __forceinline__ unsigned xb_ld(unsigned* p)              { return __hip_atomic_load(p, __ATOMIC_RELAXED, __HIP_MEMORY_SCOPE_AGENT); }
__device__ __forceinline__ unsigned xb_add(unsigned* p, unsigned v) { return __hip_atomic_fetch_add(p, v, __ATOMIC_RELAXED, __HIP_MEMORY_SCOPE_AGENT); }
__device__ __forceinline__ unsigned xb_xcc_id() { return (unsigned)__builtin_amdgcn_s_getreg((3 << 11) | 20) & 0xFu; }
#define XB_SPIN(cond, bar) do { unsigned _sp = 0; while (cond) { __builtin_amdgcn_s_sleep(1); \
    if ((++_sp & 255u) == 0u) { if (xb_ld(&(bar)[XB_TMO])) break; if (_sp > XB_SPIN_CAP) { atomicAdd(&(bar)[XB_TMO], 1u); break; } } } } while (0)

struct XcdBarrier {
    unsigned* bar; unsigned x;
    volatile LAS unsigned* st;
};

__device__ __forceinline__ XcdBarrier xcd_barrier_post(unsigned* bar, volatile LAS unsigned* st) {
    XcdBarrier b; b.bar = bar; b.x = xb_xcc_id(); b.st = st;
    if (threadIdx.x == 0) (void)xb_add(&bar[XB_XCNT(b.x)], 1u);
    return b;
}
__device__ __forceinline__ void xcd_barrier_complete(unsigned* bar, unsigned x, unsigned& nloc, unsigned& nx) {
    const unsigned G = gridDim.x * gridDim.y * gridDim.z;
    unsigned sum, cnt, mine, sp = 0u;
    for (;;) {
        sum = 0u; cnt = 0u; mine = 0u;
#pragma unroll
        for (unsigned j = 0; j < 16; ++j) { const unsigned c = xb_ld(&bar[XB_XCNT(j)]); sum += c; cnt += (c > 0u) ? 1u : 0u; mine = (j == x) ? c : mine; }
        if (sum == G) break;
        __builtin_amdgcn_s_sleep(1);
        if ((++sp & 255u) == 0u) { if (xb_ld(&bar[XB_TMO])) break; if (sp > XB_SPIN_CAP) { atomicAdd(&bar[XB_TMO], 1u); break; } }
    }
    nloc = mine > 0u ? mine : 1u; nx = cnt > 0u ? cnt : 1u;
}

__device__ __forceinline__ void xcd_barrier(const XcdBarrier& b) {
    asm volatile("s_waitcnt vmcnt(0)" ::: "memory");
    __syncthreads();
    if (threadIdx.x == 0) {
        unsigned* bar = b.bar;
        __builtin_amdgcn_s_waitcnt(0);
        unsigned nloc = b.st[0], nx = b.st[1];
        if (nloc == 0u) { xcd_barrier_complete(bar, b.x, nloc, nx); b.st[0] = nloc; b.st[1] = nx; }
        const unsigned old = xb_add(&bar[XB_XSUB(b.x)], 1u);
        const unsigned gen = old / nloc;
        if (old + 1u == (gen + 1u) * nloc) {
            __builtin_amdgcn_fence(__ATOMIC_RELEASE, "agent");
            asm volatile("s_waitcnt vmcnt(0)" ::: "memory");
            const unsigned og = xb_add(&bar[XB_TOP], 1u);
            const unsigned tg = og / nx;
            if (og + 1u == (tg + 1u) * nx) xb_add(&bar[XB_TOPGEN], 1u);
            else XB_SPIN(xb_ld(&bar[XB_TOPGEN]) == tg, bar);
            __builtin_amdgcn_fence(__ATOMIC_ACQUIRE, "agent");
            xb_add(&bar[XB_XGEN(b.x)], 1u);
            asm volatile("s_waitcnt vmcnt(0)" ::: "memory");
        } else {
            XB_SPIN(xb_ld(&bar[XB_XGEN(b.x)]) == gen, bar);
            __builtin_amdgcn_fence(__ATOMIC_ACQUIRE, "agent");
            asm volatile("s_waitcnt vmcnt(0)" ::: "memory");
        }
    }
    __syncthreads();
}

static_assert(PANEL_CNT_WORD == XCD_BAR_WORDS, "panel counters follow the barrier words");
__global__ void __launch_bounds__(512, 2) hybrid_megakernel(Params p) {
  extern __shared__ __attribute__((aligned(16))) char smem_all[];
  __shared__ uint4 xb_words;
  if (threadIdx.x == 0) xb_words = make_uint4(0u, 0u, 0u, 0u);
  __syncthreads();
  const XcdBarrier xb = xcd_barrier_post(p.bar, (volatile LAS unsigned*)&xb_words);
  char* smem = smem_all + (threadIdx.x >> 8) * 73728;
#ifndef REPMASK
#define REPMASK 0
#endif
#define RUN_PHASE(n, ...) if (p.phase_lo <= n && n <= p.phase_hi) { if (n != p.phase_lo) xcd_barrier(xb); __VA_ARGS__; if ((REPMASK >> n) & 1) { xcd_barrier(xb); __VA_ARGS__; } }
  RUN_PHASE(0, phase_prep(p, smem))
  RUN_PHASE(1, { if (VBID < 48) phase_mod(p, smem); else phase_prep2(p, smem, VBID - 48, VGRID - 48); })
  RUN_PHASE(2, phase_h(p))
  RUN_PHASE(3, {
    pg8::Gemm g{p.H, p.Wt_all, MPAD, NALL, 1024};
    pg8::StaticOrder S; S.init(MPAD, NALL, (int)gridDim.x, (int)blockIdx.x);
    EpiMain E{p};
    pg8::gemm_phase<EpiMain, pg8::StaticOrder, false>((PG8_LAS unsigned char*)smem_all, g, S, E, nullptr);
  })
  RUN_PHASE(4, phase_mix(p, smem, smem_all))
  RUN_PHASE(5, {
    if (threadIdx.x < 256) { for (int eb = blockIdx.x; eb < 256; eb += gridDim.x) phase_scan(p, eb); }
    else { const int wt = blockIdx.x * 4 + ((threadIdx.x >> 6) - 4); if (wt < 128) sample_chain_wave(p, wt, threadIdx.x & 63); }
  })
  RUN_PHASE(6, {
    for (int wi = blockIdx.x * 8 + (threadIdx.x >> 6); wi < 2048; wi += gridDim.x * 8) hgrn_out_wave(p, wi >> 3, (wi >> 1) & 3, wi & 1, threadIdx.x & 63);
  })
  RUN_PHASE(7, {
    pg8::Gemm g{p.YA, p.Wt_pab, SEQ, 1024, 1024};
    pg8::StaticOrder S; S.init(SEQ, 1024, (int)gridDim.x, (int)blockIdx.x);
    EpiMerge E{p};
    pg8::gemm_phase<EpiMerge, pg8::StaticOrder, false>((PG8_LAS unsigned char*)smem_all, g, S, E, nullptr);
  })
  RUN_PHASE(8, {
    pg8::Gemm g{p.Y, p.Wt_out, SEQ, 1024, 1024};
    pg8::StaticOrder S; S.init(SEQ, 1024, (int)gridDim.x, (int)blockIdx.x);
    if ((int)gridDim.x == (SEQ / 256) * 4) {
      EpiOutLds E{p};
      pg8::gemm_phase<EpiOutLds, pg8::StaticOrder, false>((PG8_LAS unsigned char*)smem_all, g, S, E, nullptr);
    } else {
      EpiOut E{p};
      pg8::gemm_phase<EpiOut, pg8::StaticOrder, false>((PG8_LAS unsigned char*)smem_all, g, S, E, nullptr);
    }
  })
}

#ifndef ONE_LAUNCH
#define ONE_LAUNCH 1
#endif
constexpr size_t kDynLds = 147456;

extern "C" void kernel_launch(void* const* d_in, const int* in_sizes, int n_in, void* d_out, int out_size, void* d_ws, size_t ws_size,
                              hipStream_t stream) {
  static int grid_blocks = 0;
  if (!grid_blocks) {
    int dev = 0, cus = 0, per_cu = 0;
    (void)hipGetDevice(&dev);
    (void)hipDeviceGetAttribute(&cus, hipDeviceAttributeMultiprocessorCount, dev);
    (void)hipFuncSetAttribute((const void*)hybrid_megakernel, hipFuncAttributeMaxDynamicSharedMemorySize, (int)kDynLds);
    (void)hipOccupancyMaxActiveBlocksPerMultiprocessor(&per_cu, hybrid_megakernel, 512, kDynLds);
    if (per_cu > 1) per_cu = 1;
    if (per_cu < 1) per_cu = 1;
    grid_blocks = cus * per_cu;
  }
  Params p{};
  const float* const* in = (const float* const*)d_in;
  p.x_prompt = in[0]; p.x_sample = in[1]; p.cache_k = in[2]; p.cache_v = in[3]; p.state = in[4]; p.c_prompt = in[5]; p.c_sample = in[6];
  p.w_ada = in[7]; p.b_ada = in[8]; p.norm_g = in[9]; p.w_in = in[10]; p.qg = in[11]; p.kg = in[12]; p.sinks = in[13]; p.lb_logits = in[14];
  p.og = in[15]; p.w_merge = in[16]; p.b_merge = in[17]; p.w_pa = in[18]; p.w_pb = in[19]; p.w_out = in[20];
  float* o = (float*)d_out;
  p.out_yp = o; o += (size_t)SEQ * DM;
  p.out_ys = o; o += (size_t)NBT * DM;
  p.out_kp = o; o += 128 * 128;
  p.out_vp = o; o += 128 * 128;
  p.out_sp = o; o += 4 * 128 * 128;
  p.out_ks = o; o += (size_t)NBT * 128 * 128;
  p.out_vs = o; o += (size_t)NBT * 128 * 128;
  p.out_ss = o;
  char* wsp = (char*)d_ws;
  auto take = [&](size_t bytes) { char* r = wsp; wsp += (bytes + 255) & ~(size_t)255; return r; };
  p.bar = (unsigned*)take((size_t)(XCD_BAR_WORDS + 256) * 4);
  p.Wt_all = (bfr*)take((size_t)NALL * 1024 * 2);
  p.Wt_pab = (bfr*)take((size_t)1024 * 1024 * 2);
  p.Wt_out = (bfr*)take((size_t)1024 * 1024 * 2);
  p.Wt_ada = (bfr*)take((size_t)3072 * 1024 * 2);
  p.Cb = (bfr*)take((size_t)256 * 1024 * 2);
  p.mod = (float*)take((size_t)256 * 3072 * 4);
  p.Ys = (bfr*)take((size_t)128 * 1024 * 2);
  p.H = (bfr*)take((size_t)MPAD * 1024 * 2);
  p.YA = p.H; p.YB = p.H + 512;
  p.ZA = (bfr*)take((size_t)MTOT * 512 * 2);
  p.S16 = p.ZA;
  p.Q = (bfr*)take((size_t)MTOT * 512 * 2);
  p.QB = (bfr*)take((size_t)MTOT * 512 * 2);
  p.Y = p.Q;
  p.Kb = (bfr*)take((size_t)MTOT * 128 * 2);
  p.Vb = (bfr*)take((size_t)MTOT * 128 * 2);
  p.IB = (bfr*)take((size_t)MTOT * 512 * 2);
  p.ZB = (bfr*)take((size_t)MTOT * 512 * 2);
  p.ZF = (bfr*)take((size_t)MTOT * 512 * 2);
  p.GA = (bfr*)take((size_t)MTOT * 1024 * 2);
  p.GB = (bfr*)take((size_t)MTOT * 1024 * 2);
  p.dec = (float*)take((size_t)NCH * 4 * 128 * 4);
  p.Ust = p.out_yp;
  if ((size_t)(wsp - (char*)d_ws) > ws_size) { fprintf(stderr, "workspace too small\n"); return; }
  (void)hipMemsetAsync(p.bar, 0, (size_t)(XCD_BAR_WORDS + 256) * 4, stream);
#if ONE_LAUNCH
  p.phase_lo = 0; p.phase_hi = 8;
  void* args[] = {&p};
  hipError_t e = hipLaunchCooperativeKernel((void*)hybrid_megakernel, dim3(grid_blocks), dim3(512), args, kDynLds, stream);
  if (e != hipSuccess) fprintf(stderr, "cooperative launch failed: %s (grid %d)\n", hipGetErrorString(e), grid_blocks);
#else
  for (int ph = 0; ph <= 8; ++ph) {
    p.phase_lo = ph; p.phase_hi = ph;
    hipLaunchKernelGGL(hybrid_megakernel, dim3(grid_blocks), dim3(512), kDynLds, stream, p);
  }
#endif
}
```

```cpp
#include <hip/hip_runtime.h>
#include <cstdio>

#define DI __device__ __forceinline__
typedef unsigned short bfr;
using bf16x8 = __attribute__((ext_vector_type(8))) short;
using f32x16 = __attribute__((ext_vector_type(16))) float;
using u32x4 = __attribute__((ext_vector_type(4))) unsigned;
using u32x2 = __attribute__((ext_vector_type(2))) unsigned;

constexpr int DM = 1024, SEQ = 16384, NBT = 128, MTOT = SEQ + NBT;
constexpr int NALL = 5376;
constexpr int NCH = 256;
constexpr float EPS = 1e-6f;
constexpr int PANEL_CNT_WORD = 3456;
constexpr int LDT = 72;
constexpr int MPAD = 16640;
#define TID ((int)(threadIdx.x & 255))
#define VBID ((int)(blockIdx.x * 2 + (threadIdx.x >> 8)))
#define VGRID ((int)(gridDim.x * 2))

struct Params {
  const float *x_prompt, *x_sample, *cache_k, *cache_v, *state, *c_prompt, *c_sample;
  const float *w_ada, *b_ada, *norm_g, *w_in, *qg, *kg, *sinks, *lb_logits, *og, *w_merge, *b_merge, *w_pa, *w_pb, *w_out;
  float *out_yp, *out_ys, *out_kp, *out_vp, *out_sp, *out_ks, *out_vs, *out_ss;
  bfr *Wt_all, *Wt_pab, *Wt_out, *Wt_ada, *Cb, *H, *Q, *QB, *Kb, *Vb, *ZA, *IB, *ZB, *GA, *GB, *YA, *YB, *Y;
  float *mod, *dec, *Ust;
  bfr* ZF;
  bfr* S16;
  bfr* Ys;
  unsigned* bar;
  int phase_lo, phase_hi;
};

DI unsigned f2bf(float x) { unsigned u = __float_as_uint(x); u += 0x7fffu + ((u >> 16) & 1u); return u >> 16; }
typedef __bf16 hbf2 __attribute__((ext_vector_type(2)));
typedef float hf2 __attribute__((ext_vector_type(2)));
DI unsigned pk2(float a, float b) { hf2 v = {a, b}; return __builtin_bit_cast(unsigned, __builtin_convertvector(v, hbf2)); }
DI float bf2f(unsigned b) { return __uint_as_float(b << 16); }
DI float bflo(unsigned u) { return __uint_as_float(u << 16); }
DI float bfhi(unsigned u) { return __uint_as_float(u & 0xffff0000u); }
DI int crow(int i, int h) { return (i & 3) + 8 * (i >> 2) + 4 * h; }
DI f32x16 mfma(bf16x8 a, bf16x8 b, f32x16 c) { return __builtin_amdgcn_mfma_f32_32x32x16_bf16(a, b, c, 0, 0, 0); }
DI f32x16 zero16() { f32x16 z; _Pragma("unroll") for (int i = 0; i < 16; ++i) z[i] = 0.f; return z; }
DI float frcp(float x) { return __builtin_amdgcn_rcpf(x); }
DI float fexp(float x) { return __builtin_amdgcn_exp2f(x * 1.4426950408889634f); }
DI float sigmoidf_(float x) { return frcp(1.f + fexp(-x)); }
DI float siluf_(float x) { return x * frcp(1.f + fexp(-x)); }
DI u32x2 pack4(float a, float b, float c, float d) { u32x2 r; r[0] = pk2(a, b); r[1] = pk2(c, d); return r; }

DI int wt_row_of_col(int c) {
  const int pn = c >> 8, cl = c & 255;
  int slot;
  if (pn < 3) {
    const int g = cl >> 6, d = cl & 63;
    if (d >= 32) { const int x = d - 32; slot = 128 + 32 * g + 16 * ((x >> 2) & 1) + 4 * (x >> 3) + (x & 3); }
    else { const int fq = 2 * (d >> 4) + ((d >> 2) & 1), n = (d >> 3) & 1, j = d & 3; slot = 32 * g + 16 * n + 4 * fq + j; }
  } else {
    const int bj = cl >> 7, g = (cl >> 5) & 3, x = cl & 31;
    slot = 128 * bj + 32 * g + 16 * ((x >> 2) & 1) + 4 * (x >> 3) + (x & 3);
  }
  return (pn << 8) + slot;
}

DI void gemm_mainloop(const bfr* __restrict__ A, int lda, int m0, const bfr* __restrict__ W, int ldw, int n0, int K,
                      bfr* sA, bfr* sW, f32x16 (&acc)[2][2]) {
  const int t = TID, lane = t & 63, w = t >> 6, wn = w >> 1, wm = w & 1, r = lane & 31, h = lane >> 5;
  const int lrow = t >> 3, lk = (t & 7) * 8;
  const bfr* ap = A + (size_t)(m0 + lrow) * lda + lk;
  const bfr* wp = W + (size_t)(n0 + lrow) * ldw + lk;
  u32x4 ra[4], rw[4];
  _Pragma("unroll") for (int i = 0; i < 4; ++i) {
    ra[i] = *(const u32x4*)(ap + (size_t)(32 * i) * lda);
    rw[i] = *(const u32x4*)(wp + (size_t)(32 * i) * ldw);
  }
  const int nk = K >> 6;
  for (int kt = 0; kt < nk; ++kt) {
    __syncthreads();
    _Pragma("unroll") for (int i = 0; i < 4; ++i) {
      *(u32x4*)(sA + (lrow + 32 * i) * LDT + lk) = ra[i];
      *(u32x4*)(sW + (lrow + 32 * i) * LDT + lk) = rw[i];
    }
    __syncthreads();
    if (kt + 1 < nk) {
      ap += 64; wp += 64;
      _Pragma("unroll") for (int i = 0; i < 4; ++i) {
        ra[i] = *(const u32x4*)(ap + (size_t)(32 * i) * lda);
        rw[i] = *(const u32x4*)(wp + (size_t)(32 * i) * ldw);
      }
    }
    _Pragma("unroll") for (int kk = 0; kk < 4; ++kk) {
      bf16x8 af[2], bf[2];
      _Pragma("unroll") for (int x = 0; x < 2; ++x) {
        af[x] = *(const bf16x8*)(sW + (wn * 64 + x * 32 + r) * LDT + kk * 16 + 8 * h);
        bf[x] = *(const bf16x8*)(sA + (wm * 64 + x * 32 + r) * LDT + kk * 16 + 8 * h);
      }
      _Pragma("unroll") for (int nt = 0; nt < 2; ++nt)
        _Pragma("unroll") for (int mt = 0; mt < 2; ++mt) acc[nt][mt] = mfma(af[nt], bf[mt], acc[nt][mt]);
    }
  }
}

template <int PERMBASE> DI void transpose_tile(const float* __restrict__ src, int N, bfr* __restrict__ dst, int K, int kt, int nt, float* sm) {
  const int t = TID, k0 = kt * 64, n0 = nt * 64;
  __syncthreads();
  _Pragma("unroll") for (int i = 0; i < 16; ++i) {
    int idx = i * 256 + t, kk = idx >> 6, nn = idx & 63;
    sm[kk * 65 + nn] = src[(size_t)(k0 + kk) * N + n0 + nn];
  }
  __syncthreads();
  _Pragma("unroll") for (int i = 0; i < 8; ++i) {
    int idx = i * 256 + t, nn = idx >> 5, kk = (idx & 31) * 2;
    const int drow = PERMBASE >= 0 ? wt_row_of_col(PERMBASE + n0 + nn) : n0 + nn;
    *(unsigned*)(dst + (size_t)drow * K + k0 + kk) = pk2(sm[kk * 65 + nn], sm[(kk + 1) * 65 + nn]);
  }
}

DI void phase_prep(const Params& p, char* smem) {
  float* sm = (float*)smem;
  for (int it = VBID; it < 768; it += VGRID) transpose_tile<-1>(p.w_ada, 3072, p.Wt_ada, 1024, it / 48, it % 48, sm);
  for (int idx = VBID * 256 + TID; idx < 256 * 1024; idx += VGRID * 256) {
    int row = idx >> 10, col = idx & 1023;
    float v = row < 128 ? p.c_sample[row * 1024 + col] : (row == 128 ? p.c_prompt[col] : 0.f);
    p.Cb[idx] = (bfr)f2bf(v);
  }
}
DI void phase_prep2(const Params& p, char* smem, int vb0, int nvb) {
  float* sm = (float*)smem;
  for (int it = vb0; it < 1856; it += nvb) {
    int i = it;
    if (i < 832) { transpose_tile<0>(p.w_in, 3328, p.Wt_all, 1024, i / 52, i % 52, sm); continue; }
    i -= 832;
    if (i < 512) { transpose_tile<3328>(p.w_merge, 2048, p.Wt_all, 1024, i / 32, i % 32, sm); continue; }
    i -= 512;
    if (i < 128) { transpose_tile<-1>(p.w_pa, 1024, p.Wt_pab, 1024, i / 16, i % 16, sm); continue; }
    i -= 128;
    if (i < 128) { transpose_tile<-1>(p.w_pb, 1024, p.Wt_pab + 512, 1024, i / 16, i % 16, sm); continue; }
    i -= 128;
    transpose_tile<-1>(p.w_out, 1024, p.Wt_out, 1024, i / 16, i % 16, sm);
  }
}

DI void phase_mod(const Params& p, char* smem) {
  bfr* sA = (bfr*)smem; bfr* sW = sA + 128 * LDT;
  const int t = TID, lane = t & 63, w = t >> 6, wn = w >> 1, wm = w & 1, r = lane & 31, h = lane >> 5;
  for (int tile = VBID; tile < 48; tile += VGRID) {
    int m0 = (tile / 24) * 128, n0 = (tile % 24) * 128;
    f32x16 acc[2][2];
    _Pragma("unroll") for (int a = 0; a < 2; ++a) _Pragma("unroll") for (int b = 0; b < 2; ++b) acc[a][b] = zero16();
    gemm_mainloop(p.Cb, 1024, m0, p.Wt_ada, 1024, n0, 1024, sA, sW, acc);
    float4 bias[2][4];
    _Pragma("unroll") for (int nt = 0; nt < 2; ++nt) _Pragma("unroll") for (int g = 0; g < 4; ++g) bias[nt][g] = *(const float4*)(p.b_ada + n0 + wn * 64 + nt * 32 + 8 * g + 4 * h);
    _Pragma("unroll") for (int nt = 0; nt < 2; ++nt) _Pragma("unroll") for (int mt = 0; mt < 2; ++mt) {
      int m = m0 + wm * 64 + mt * 32 + r;
      _Pragma("unroll") for (int g = 0; g < 4; ++g) {
        int n = n0 + wn * 64 + nt * 32 + 8 * g + 4 * h;
        float4 b = bias[nt][g];
        float4 o; o.x = acc[nt][mt][4 * g] + b.x; o.y = acc[nt][mt][4 * g + 1] + b.y; o.z = acc[nt][mt][4 * g + 2] + b.z; o.w = acc[nt][mt][4 * g + 3] + b.w;
        *(float4*)(p.mod + (size_t)m * 3072 + n) = o;
      }
    }
  }
}

DI void phase_h(const Params& p) {
  const int lane = threadIdx.x & 63, gw = blockIdx.x * 8 + (threadIdx.x >> 6), nw = gridDim.x * 8;
  float4 g[4];
  _Pragma("unroll") for (int j = 0; j < 4; ++j) g[j] = *(const float4*)(p.norm_g + j * 256 + lane * 4);
  {
    const float* mr = p.mod + (size_t)128 * 3072;
    float4 a[4], bsh[4];
    _Pragma("unroll") for (int j = 0; j < 4; ++j) {
      const int col = j * 256 + lane * 4;
      const float4 sh = *(const float4*)(mr + col), sc = *(const float4*)(mr + 1024 + col);
      a[j].x = g[j].x * (1.f + sc.x); a[j].y = g[j].y * (1.f + sc.y); a[j].z = g[j].z * (1.f + sc.z); a[j].w = g[j].w * (1.f + sc.w);
      bsh[j] = sh;
    }
    for (int r0 = gw; r0 < SEQ; r0 += 8 * nw) {
      float4 xv[8][4];
      _Pragma("unroll") for (int q = 0; q < 8; ++q) {
        const int row = min(r0 + q * nw, SEQ - 1);
        _Pragma("unroll") for (int j = 0; j < 4; ++j) xv[q][j] = *(const float4*)(p.x_prompt + (size_t)row * DM + j * 256 + lane * 4);
      }
      __builtin_amdgcn_sched_barrier(0);
      _Pragma("unroll") for (int q = 0; q < 8; ++q) {
        const int row = r0 + q * nw;
        float ss = 0.f;
        _Pragma("unroll") for (int j = 0; j < 4; ++j) ss += xv[q][j].x * xv[q][j].x + xv[q][j].y * xv[q][j].y + xv[q][j].z * xv[q][j].z + xv[q][j].w * xv[q][j].w;
        _Pragma("unroll") for (int o = 32; o >= 1; o >>= 1) ss += __shfl_xor(ss, o);
        const float rs = rsqrtf(ss * (1.f / DM) + EPS);
        if (row < SEQ) {
          _Pragma("unroll") for (int j = 0; j < 4; ++j)
            *(u32x2*)(p.H + (size_t)row * DM + j * 256 + lane * 4) = pack4(xv[q][j].x * rs * a[j].x + bsh[j].x, xv[q][j].y * rs * a[j].y + bsh[j].y,
                                                                          xv[q][j].z * rs * a[j].z + bsh[j].z, xv[q][j].w * rs * a[j].w + bsh[j].w);
        }
      }
    }
  }
  for (int b = gw; b < NBT; b += nw) {
    const float* xr = p.x_sample + (size_t)b * DM;
    const float* mr = p.mod + (size_t)b * 3072;
    float4 xv[4], sh[4], sc[4]; float ss = 0.f;
    _Pragma("unroll") for (int j = 0; j < 4; ++j) {
      const int col = j * 256 + lane * 4;
      xv[j] = *(const float4*)(xr + col); sh[j] = *(const float4*)(mr + col); sc[j] = *(const float4*)(mr + 1024 + col);
      ss += xv[j].x * xv[j].x + xv[j].y * xv[j].y + xv[j].z * xv[j].z + xv[j].w * xv[j].w;
    }
    _Pragma("unroll") for (int o = 32; o >= 1; o >>= 1) ss += __shfl_xor(ss, o);
    const float rs = rsqrtf(ss * (1.f / DM) + EPS);
    _Pragma("unroll") for (int j = 0; j < 4; ++j)
      *(u32x2*)(p.H + (size_t)(SEQ + b) * DM + j * 256 + lane * 4) = pack4(xv[j].x * rs * g[j].x * (1.f + sc[j].x) + sh[j].x, xv[j].y * rs * g[j].y * (1.f + sc[j].y) + sh[j].y,
                                                                          xv[j].z * rs * g[j].z * (1.f + sc[j].z) + sh[j].z, xv[j].w * rs * g[j].w * (1.f + sc[j].w) + sh[j].w);
  }
}

DI void sincos_red(float a, float& s, float& c) {
  float n = rintf(a * 0.15915494309189535f);
  float rr = fmaf(-n, 6.2831854820251465f, a);
  rr = fmaf(-n, -1.7484555e-7f, rr);
  s = __sinf(rr); c = __cosf(rr);
}

namespace pg8 {
#define PG8_LAS __attribute__((address_space(3)))
typedef unsigned short bf16_t;
typedef short bf16x8 __attribute__((ext_vector_type(8)));
typedef float f32x4 __attribute__((ext_vector_type(4)));
typedef unsigned u32x4 __attribute__((ext_vector_type(4)));
constexpr int BM = 256, BK = 64, HALF = 128, HTB = HALF * BK * 2  , STAGE_BYTES = 8 * HTB, NXCD = 8, WGM = 8;

__host__ __device__ __forceinline__ int lds_byte(int r, int c) { const int st = (r >> 4) * 2 + (c >> 5), rr = r & 15, cc = c & 31, ob = rr * 64 + cc * 2; return st * 1024 + (ob ^ (((ob >> 9) & 1) << 5)); }
__host__ __device__ __forceinline__ void stage_rc(int b, int& R, int& C) { const int st = b / 1024, sb = b % 1024, swz = sb ^ (((sb >> 9) & 1) << 5); R = (st >> 1) * 16 + swz / 64; C = (st & 1) * 32 + (swz % 64) / 2; }
__host__ __device__ __forceinline__ int perm32(int rho) { const int n = rho >> 4, i = rho & 15; return 8 * (i >> 2) + 4 * n + (i & 3); }

struct Unit { int pm, pn; };
struct Gemm { const bf16_t* A; const bf16_t* Bt; int M, N, K; };

struct StaticOrder {
    int nM, nN, nwg, G, c;
    __host__ __device__ void init(int M, int N, int G_, int c_) { nM = M / BM; nN = N / BM; nwg = nM * nN; G = G_; c = c_; }
    __host__ __device__ bool next(int i, Unit& u) const {
        const long L = (long)i * G + c; if (L >= nwg) return false;
        int wgid = (int)L; { const int q = nwg / NXCD, r = nwg % NXCD, xcd = wgid % NXCD, off = wgid / NXCD; wgid = (xcd < r ? xcd * (q + 1) : r * (q + 1) + (xcd - r) * q) + off; }
        const int nig = WGM * nN, gid = wgid / nig, fm = gid * WGM, gsz = (nM - fm) < WGM ? (nM - fm) : WGM;
        u.pm = fm + ((wgid % nig) % gsz); u.pn = (wgid % nig) / gsz; return true;
    }
    __device__ __forceinline__ void a_ready(const Unit&) const {}
    __device__ __forceinline__ void done(const Unit&) const {}
};
template <class Epi, class Sched, bool STAMP = false>
__device__ __forceinline__ void gemm_phase(PG8_LAS unsigned char* lds, const Gemm g, const Sched& S, const Epi& E, unsigned long long* stamps) {
    const int tid = threadIdx.x, wid = __builtin_amdgcn_readfirstlane(tid >> 6), lane = tid & 63, wr = wid >> 2, wc = wid & 3, fr = lane & 15, fq = lane >> 4;
    const int K = g.K, nt = K / BK;
    int ts_lo = 0, ts_hi = 0, nts = 0; const unsigned long long rt_entry = STAMP ? (unsigned long long)wall_clock64() : 0ull;
#define PG8_STAMP() do { if (STAMP && wid == 0 && nts < 64) { const unsigned long long _c = (unsigned long long)clock64(); \
        ts_lo = (lane == nts) ? (int)(unsigned)_c : ts_lo; ts_hi = (lane == nts) ? (int)(unsigned)(_c >> 32) : ts_hi; ++nts; } } while (0)
    PG8_STAMP();
    unsigned voffA[2], voffB[2];
#pragma unroll
    for (int i = 0; i < 2; ++i) { int R, C; stage_rc(tid * 16 + i * 8192, R, C); const int Rb = Epi::PERM ? ((R & ~31) + perm32(R & 31)) : R;
        voffA[i] = (unsigned)(R * K + C) * 2u; voffB[i] = (unsigned)(Rb * K + C) * 2u; }
    const size_t kstep = (size_t)(BK * 2);
    const size_t hstep = (size_t)HALF * K * 2;
    const size_t tstep = 2 * hstep;
    const unsigned ldsw = (unsigned)wid * 1024u;
    const int aoff = lds_byte(wr * 64 + fr, fq * 8), boff = lds_byte(wc * 32 + fr, fq * 8);
#define PG8_SA(b, h) (((b) * 2 + (h)) * HTB)
#define PG8_SB(b, h) ((4 + (b) * 2 + (h)) * HTB)
#define PG8_STAGE(bufoff, gbase, voff) do { _Pragma("unroll") for (int _i = 0; _i < 2; ++_i) \
        __builtin_amdgcn_global_load_lds((const unsigned*)((const char*)(gbase) + (voff)[_i]), (PG8_LAS unsigned*)(lds + (bufoff) + ldsw + _i * 8192), 16, 0, 0); } while (0)
#define PG8_LDA(dst, b, h) do { _Pragma("unroll") for (int m = 0; m < 4; ++m) _Pragma("unroll") for (int k = 0; k < 2; ++k) dst[m][k] = *(const PG8_LAS bf16x8*)(lds + PG8_SA(b, h) + aoff + m * 2048 + k * 1024); } while (0)
#define PG8_LDB(dst, b, h) do { _Pragma("unroll") for (int n = 0; n < 2; ++n) _Pragma("unroll") for (int k = 0; k < 2; ++k) dst[n][k] = *(const PG8_LAS bf16x8*)(lds + PG8_SB(b, h) + boff + n * 2048 + k * 1024); } while (0)
#define PG8_MMA(ai, bj, At, Bt) do { __builtin_amdgcn_s_setprio(1); _Pragma("unroll") for (int m = 0; m < 4; ++m) _Pragma("unroll") for (int n = 0; n < 2; ++n) _Pragma("unroll") for (int k = 0; k < 2; ++k) \
        acc[ai][bj][m][n] = __builtin_amdgcn_mfma_f32_16x16x32_bf16(Bt[n][k], At[m][k], acc[ai][bj][m][n], 0, 0, 0); __builtin_amdgcn_s_setprio(0); } while (0)
#define PG8_WAIT_V(n) asm volatile("s_waitcnt vmcnt(" #n ")" ::: "memory")
#define PG8_WAIT_L(n) asm volatile("s_waitcnt lgkmcnt(" #n ")" ::: "memory")
#define PG8_BAR __builtin_amdgcn_s_barrier()
#define PG8_SCHED __builtin_amdgcn_sched_barrier(0)
    Unit cur, nxt; int ui = 0;
    if (!S.next(0, cur)) return;
    f32x4 acc[2][2][4][2];
#pragma unroll
    for (int a = 0; a < 2; ++a)
#pragma unroll
        for (int b = 0; b < 2; ++b)
#pragma unroll
            for (int m = 0; m < 4; ++m)
#pragma unroll
                for (int n = 0; n < 2; ++n) acc[a][b][m][n] = (f32x4){0.f, 0.f, 0.f, 0.f};
    bf16x8 At[4][2], B0[2][2], B1[2][2];
    const char* cA = (const char*)g.A + (size_t)cur.pm * tstep; const char* cB = (const char*)g.Bt + (size_t)cur.pn * tstep;
    S.a_ready(cur);
    PG8_STAGE(PG8_SB(0, 0), cB, voffB); PG8_STAGE(PG8_SA(0, 0), cA, voffA); PG8_STAGE(PG8_SB(0, 1), cB + hstep, voffB); PG8_STAGE(PG8_SA(0, 1), cA + hstep, voffA);
    if (wr == 1) PG8_BAR;
    PG8_WAIT_V(4); PG8_BAR;
    PG8_STAGE(PG8_SB(1, 0), cB + kstep, voffB); PG8_STAGE(PG8_SA(1, 0), cA + kstep, voffA); PG8_STAGE(PG8_SB(1, 1), cB + hstep + kstep, voffB);
    PG8_WAIT_V(6); PG8_BAR;
    PG8_STAMP();
    for (;;) {
        const bool has_next = S.next(ui + 1, nxt);
        const char* nA = has_next ? (const char*)g.A + (size_t)nxt.pm * tstep : cA; const char* nB = has_next ? (const char*)g.Bt + (size_t)nxt.pn * tstep : cB;
        for (int t = 0; t < nt; t += 2) {
            const bool last = (t == nt - 2);
            const char* a1 = cA + (size_t)(t + 1) * kstep;
            const char* a2 = last ? nA : cA + (size_t)(t + 2) * kstep; const char* b2 = last ? nB : cB + (size_t)(t + 2) * kstep;
            const char* a3 = a2 + kstep; const char* b3 = b2 + kstep;
            if (last && has_next) S.a_ready(nxt);
            if constexpr (Epi::MID_T > 0) { if (t == Epi::MID_T) E.mid(acc, cur, wr, wc, fr, fq); }
            PG8_LDB(B0, 0, 0); PG8_SCHED; PG8_LDA(At, 0, 0); PG8_STAGE(PG8_SA(1, 1), a1 + hstep, voffA);
            PG8_WAIT_L(8); PG8_BAR; PG8_WAIT_L(0); PG8_MMA(0, 0, At, B0); PG8_BAR; PG8_SCHED;
            PG8_LDB(B1, 0, 1); PG8_STAGE(PG8_SB(0, 0), b2, voffB);
            PG8_BAR; PG8_WAIT_L(0); PG8_MMA(0, 1, At, B1); PG8_BAR;
            PG8_LDA(At, 0, 1); PG8_STAGE(PG8_SA(0, 0), a2, voffA);
            PG8_BAR; PG8_WAIT_L(0); PG8_MMA(1, 0, At, B0); PG8_BAR; PG8_SCHED;
            PG8_STAGE(PG8_SB(0, 1), b2 + hstep, voffB);
            PG8_WAIT_V(6); PG8_BAR; PG8_MMA(1, 1, At, B1); PG8_BAR;
            PG8_LDB(B0, 1, 0); PG8_SCHED; PG8_LDA(At, 1, 0); PG8_STAGE(PG8_SA(0, 1), a2 + hstep, voffA);
            PG8_WAIT_L(8); PG8_BAR; PG8_WAIT_L(0); PG8_MMA(0, 0, At, B0); PG8_BAR; PG8_SCHED;
            PG8_LDB(B1, 1, 1); PG8_STAGE(PG8_SB(1, 0), b3, voffB);
            PG8_BAR; PG8_WAIT_L(0); PG8_MMA(0, 1, At, B1); PG8_BAR;
            PG8_LDA(At, 1, 1); PG8_STAGE(PG8_SA(1, 0), a3, voffA);
            PG8_BAR; PG8_WAIT_L(0); PG8_MMA(1, 0, At, B0); PG8_BAR; PG8_SCHED;
            PG8_STAGE(PG8_SB(1, 1), b3 + hstep, voffB);
            PG8_WAIT_V(6); PG8_BAR; PG8_MMA(1, 1, At, B1); PG8_BAR;
        }
        PG8_STAMP();
        if constexpr (!Epi::AFTER_DRAIN) { E(acc, cur, wr, wc, fr, fq); S.done(cur); }
        PG8_STAMP();
        if (!has_next) break;
#pragma unroll
        for (int a = 0; a < 2; ++a)
#pragma unroll
            for (int b = 0; b < 2; ++b)
#pragma unroll
                for (int m = 0; m < 4; ++m)
#pragma unroll
                    for (int n = 0; n < 2; ++n) acc[a][b][m][n] = (f32x4){0.f, 0.f, 0.f, 0.f};
        cur = nxt; cA = nA; cB = nB; ++ui;
    }
    PG8_WAIT_V(0);
    if (wr == 0) PG8_BAR;
    PG8_BAR;
    if constexpr (Epi::AFTER_DRAIN) { E.fused(acc, cur, wr, wc, fr, fq, lds, wid, lane); S.done(cur); }
    PG8_STAMP();
    if (STAMP && wid == 0) { stamps[lane] = lane < nts ? (((unsigned long long)(unsigned)ts_hi << 32) | (unsigned)ts_lo) : 0ull;
        if (lane == 62) stamps[62] = rt_entry; if (lane == 63) stamps[63] = (unsigned long long)wall_clock64(); }
#undef PG8_STAMP
#undef PG8_SA
#undef PG8_SB
#undef PG8_STAGE
#undef PG8_LDA
#undef PG8_LDB
#undef PG8_MMA
#undef PG8_WAIT_V
#undef PG8_WAIT_L
#undef PG8_BAR
#undef PG8_SCHED
}
}
using pf4 = pg8::f32x4;

struct EpiMain {
  static constexpr bool PERM = false, AFTER_DRAIN = false;
  static constexpr int MID_T = 0;
  const Params& p;
  DI void operator()(const pf4 (&acc)[2][2][4][2], const pg8::Unit& u, int wr, int wc, int fr, int fq) const {
    const int pn = u.pn;
    const int rbase = u.pm * 256 + wr * 64 + fr;
    if (pn < 3) {
      const bool isq = pn < 2, isv = (pn == 2) && (wc >= 2);
      const float* gp = isq ? p.qg : p.kg;
      const int d0 = 16 * (fq >> 1) + 4 * (fq & 1), d1 = 32 + 8 * fq;
      float4 g00 = {1.f, 1.f, 1.f, 1.f}, g01 = g00, g10 = g00, g11 = g00;
      if (!isv) { g00 = *(const float4*)(gp + d0); g01 = *(const float4*)(gp + d0 + 8); g10 = *(const float4*)(gp + d1); g11 = *(const float4*)(gp + d1 + 4); }
      _Pragma("unroll") for (int ai = 0; ai < 2; ++ai) {
        if (u.pm * 256 + 128 * ai >= MTOT) continue;
        _Pragma("unroll") for (int m = 0; m < 4; ++m) {
          const int row = rbase + 128 * ai + 16 * m;
          pf4 a00 = acc[ai][0][m][0], a01 = acc[ai][0][m][1], a10 = acc[ai][1][m][0], a11 = acc[ai][1][m][1];
          if (!isv) {
            float ss = 0.f;
            _Pragma("unroll") for (int j = 0; j < 4; ++j) ss += a00[j] * a00[j] + a01[j] * a01[j] + a10[j] * a10[j] + a11[j] * a11[j];
            ss += __shfl_xor(ss, 16); ss += __shfl_xor(ss, 32);
            const float sc = rsqrtf(ss * (1.f / 64.f) + EPS);
            a00[0] *= sc * g00.x; a00[1] *= sc * g00.y; a00[2] *= sc * g00.z; a00[3] *= sc * g00.w;
            a01[0] *= sc * g01.x; a01[1] *= sc * g01.y; a01[2] *= sc * g01.z; a01[3] *= sc * g01.w;
            a10[0] *= sc * g10.x; a10[1] *= sc * g10.y; a10[2] *= sc * g10.z; a10[3] *= sc * g10.w;
            a11[0] *= sc * g11.x; a11[1] *= sc * g11.y; a11[2] *= sc * g11.z; a11[3] *= sc * g11.w;
            if (fq < 2) {
              const float pos = (float)(row < SEQ ? row : SEQ);
              const float invlo[4] = {1.0f, 0.19392274f, 0.03760603f, 0.0072926646f};
              const float invhi[4] = {0.0014142136f, 0.0002742482f, 5.3182957e-05f, 1.0313385e-05f};
              _Pragma("unroll") for (int j = 0; j < 4; ++j) {
                const float inv = (fq & 1) ? invhi[j] : invlo[j];
                float s_, c_; sincos_red(pos * inv, s_, c_);
                const float x1 = a00[j], x2 = a01[j];
                a00[j] = x1 * c_ - x2 * s_; a01[j] = x2 * c_ + x1 * s_;
              }
            }
          }
          if (isq) {
            bfr* qp = p.Q + (size_t)row * 512 + (4 * pn + wc) * 64;
            *(u32x2*)(qp + d0) = pack4(a00[0] * 0.125f, a00[1] * 0.125f, a00[2] * 0.125f, a00[3] * 0.125f);
            *(u32x2*)(qp + d0 + 8) = pack4(a01[0] * 0.125f, a01[1] * 0.125f, a01[2] * 0.125f, a01[3] * 0.125f);
            u32x4 o; o[0] = pk2(a10[0] * 0.125f, a10[1] * 0.125f); o[1] = pk2(a10[2] * 0.125f, a10[3] * 0.125f);
            o[2] = pk2(a11[0] * 0.125f, a11[1] * 0.125f); o[3] = pk2(a11[2] * 0.125f, a11[3] * 0.125f);
            *(u32x4*)(qp + d1) = o;
          } else {
            const int jh = wc & 1;
            bfr* kp = (isv ? p.Vb : p.Kb) + (size_t)row * 128 + jh * 64;
            *(u32x2*)(kp + d0) = pack4(a00[0], a00[1], a00[2], a00[3]);
            *(u32x2*)(kp + d0 + 8) = pack4(a01[0], a01[1], a01[2], a01[3]);
            u32x4 o; o[0] = pk2(a10[0], a10[1]); o[1] = pk2(a10[2], a10[3]); o[2] = pk2(a11[0], a11[1]); o[3] = pk2(a11[2], a11[3]);
            *(u32x4*)(kp + d1) = o;
            float* op = nullptr;
            if (row >= SEQ) op = (isv ? p.out_vs : p.out_ks) + ((size_t)((row - SEQ) * 128 + 127) * 2 + jh) * 64;
            else if (row >= SEQ - 128) op = (isv ? p.out_vp : p.out_kp) + ((size_t)(row - (SEQ - 128)) * 2 + jh) * 64;
            if (op) {
              *(pf4*)(op + d0) = a00; *(pf4*)(op + d0 + 8) = a01; *(pf4*)(op + d1) = a10; *(pf4*)(op + d1 + 4) = a11;
            }
          }
        }
      }
      return;
    }
    const int cw = 32 * wc + 8 * fq;
    bfr* dst; int ld, col, op;
    if (pn < 5) { dst = p.ZA; ld = 512; col = (pn - 3) * 256; op = 1; }
    else if (pn < 7) { dst = p.QB; ld = 512; col = (pn - 5) * 256; op = 0; }
    else if (pn < 9) { dst = p.ZF; ld = 512; col = (pn - 7) * 256; op = 0; }
    else if (pn < 11) { dst = p.IB; ld = 512; col = (pn - 9) * 256; op = 0; }
    else if (pn < 13) { dst = p.ZB; ld = 512; col = (pn - 11) * 256; op = 1; }
    else if (pn < 17) { dst = p.GA; ld = 1024; col = (pn - 13) * 256; op = 2; }
    else { dst = p.GB; ld = 1024; col = (pn - 17) * 256; op = 2; }
    bfr* const obase = dst + (size_t)rbase * ld + col + cw;
    _Pragma("unroll") for (int bj = 0; bj < 2; ++bj) {
      float4 b0 = {0.f, 0.f, 0.f, 0.f}, b1 = b0;
      if (op == 2) { const float* bp = p.b_merge + (pn - 13) * 256 + 128 * bj + cw; b0 = *(const float4*)bp; b1 = *(const float4*)(bp + 4); }
      _Pragma("unroll") for (int ai = 0; ai < 2; ++ai) {
        if (u.pm * 256 + 128 * ai >= MTOT) continue;
        _Pragma("unroll") for (int m = 0; m < 4; ++m) {
          const int row = rbase + 128 * ai + 16 * m;
          pf4 x = acc[ai][bj][m][0], y = acc[ai][bj][m][1];
          if (op == 1) { _Pragma("unroll") for (int j = 0; j < 4; ++j) { x[j] = siluf_(x[j]); y[j] = siluf_(y[j]); } }
          else if (op == 2) {
            x[0] = sigmoidf_(x[0] + b0.x); x[1] = sigmoidf_(x[1] + b0.y); x[2] = sigmoidf_(x[2] + b0.z); x[3] = sigmoidf_(x[3] + b0.w);
            y[0] = sigmoidf_(y[0] + b1.x); y[1] = sigmoidf_(y[1] + b1.y); y[2] = sigmoidf_(y[2] + b1.z); y[3] = sigmoidf_(y[3] + b1.w);
          }
          u32x4 o; o[0] = pk2(x[0], x[1]); o[1] = pk2(x[2], x[3]); o[2] = pk2(y[0], y[1]); o[3] = pk2(y[2], y[3]);
          __builtin_nontemporal_store(o, (u32x4*)(obase + (128 * ai + 16 * m) * ld + 128 * bj));
        }
      }
    }
  }
};

struct EpiMerge {
  static constexpr bool PERM = true, AFTER_DRAIN = false;
  static constexpr int MID_T = 8;
  const Params& p;
  DI void mid(pf4 (&acc)[2][2][4][2], const pg8::Unit& u, int wr, int wc, int fr, int fq) const {
    int rbase = u.pm * 256 + wr * 64 + fr; const int cbase = u.pn * 256 + 32 * wc + 8 * fq;
    asm volatile("" : "+v"(rbase));
    _Pragma("unroll") for (int ai = 0; ai < 2; ++ai) _Pragma("unroll") for (int m = 0; m < 4; ++m) _Pragma("unroll") for (int bj = 0; bj < 2; ++bj) {
      if (bj == 0 && m == 0) __builtin_amdgcn_sched_barrier(0);
      const size_t off = (size_t)(rbase + 128 * ai + 16 * m) * 1024 + cbase + 128 * bj;
      const u32x4 ga = *(const u32x4*)(p.GA + off), gb = *(const u32x4*)(p.GB + off);
      _Pragma("unroll") for (int e = 0; e < 2; ++e) {
        acc[ai][bj][m][0][2 * e] *= bflo(ga[e]) * __builtin_amdgcn_rcpf(fmaxf(bflo(gb[e]), 1e-30f));
        acc[ai][bj][m][0][2 * e + 1] *= bfhi(ga[e]) * __builtin_amdgcn_rcpf(fmaxf(bfhi(gb[e]), 1e-30f));
        acc[ai][bj][m][1][2 * e] *= bflo(ga[2 + e]) * __builtin_amdgcn_rcpf(fmaxf(bflo(gb[2 + e]), 1e-30f));
        acc[ai][bj][m][1][2 * e + 1] *= bfhi(ga[2 + e]) * __builtin_amdgcn_rcpf(fmaxf(bfhi(gb[2 + e]), 1e-30f));
      }
    }
  }
  DI void operator()(const pf4 (&acc)[2][2][4][2], const pg8::Unit& u, int wr, int wc, int fr, int fq) const {
    const int rbase = u.pm * 256 + wr * 64 + fr, cbase = u.pn * 256 + 32 * wc + 8 * fq;
    _Pragma("unroll") for (int ai = 0; ai < 2; ++ai) {
     u32x4 gv[4][2];
     _Pragma("unroll") for (int m = 0; m < 4; ++m) _Pragma("unroll") for (int bj = 0; bj < 2; ++bj) gv[m][bj] = *(const u32x4*)(p.GB + (size_t)(rbase + 128 * ai + 16 * m) * 1024 + cbase + 128 * bj);
     __builtin_amdgcn_sched_barrier(0);
     _Pragma("unroll") for (int m = 0; m < 4; ++m) _Pragma("unroll") for (int bj = 0; bj < 2; ++bj) {
      const size_t off = (size_t)(rbase + 128 * ai + 16 * m) * 1024 + cbase + 128 * bj;
      const u32x4 g = gv[m][bj];
      const pf4 x = acc[ai][bj][m][0], y = acc[ai][bj][m][1];
      u32x4 o; o[0] = pk2(bflo(g[0]) * x[0], bfhi(g[0]) * x[1]); o[1] = pk2(bflo(g[1]) * x[2], bfhi(g[1]) * x[3]);
      o[2] = pk2(bflo(g[2]) * y[0], bfhi(g[2]) * y[1]); o[3] = pk2(bflo(g[3]) * y[2], bfhi(g[3]) * y[3]);
      *(u32x4*)(p.Y + off) = o;
     }
     __builtin_amdgcn_sched_barrier(0);
    }
  }
};

struct EpiOut {
  static constexpr bool PERM = false, AFTER_DRAIN = false;
  static constexpr int MID_T = 0;
  const Params& p;
  DI void operator()(const pf4 (&acc)[2][2][4][2], const pg8::Unit& u, int wr, int wc, int fr, int fq) const {
    const int rbase = u.pm * 256 + wr * 64 + fr, cbase = u.pn * 256 + 32 * wc + 4 * fq;
    const float* gr = p.mod + (size_t)128 * 3072 + 2048;
    _Pragma("unroll") for (int bj = 0; bj < 2; ++bj) _Pragma("unroll") for (int n = 0; n < 2; ++n) {
      const int c = cbase + 128 * bj + 16 * n;
      const pf4 gt = *(const pf4*)(gr + c);
      pf4 xv[8];
      _Pragma("unroll") for (int q = 0; q < 8; ++q) xv[q] = __builtin_nontemporal_load((const pf4*)(p.x_prompt + (size_t)(rbase + 128 * (q >> 2) + 16 * (q & 3)) * DM + c));
      __builtin_amdgcn_sched_barrier(0);
      _Pragma("unroll") for (int q = 0; q < 8; ++q)
        __builtin_nontemporal_store(xv[q] + gt * acc[q >> 2][bj][q & 3][n], (pf4*)(p.out_yp + (size_t)(rbase + 128 * (q >> 2) + 16 * (q & 3)) * DM + c));
      __builtin_amdgcn_sched_barrier(0);
    }
  }
};

struct EpiOutLds {
  static constexpr bool PERM = false, AFTER_DRAIN = true;
  static constexpr int MID_T = 0;
  const Params& p;
  DI void operator()(const pf4 (&)[2][2][4][2], const pg8::Unit&, int, int, int, int) const {}
  DI void fused(const pf4 (&acc)[2][2][4][2], const pg8::Unit& u, int wr, int wc, int fr, int fq, PG8_LAS unsigned char* lds, int, int) const {
    const float* gr = p.mod + (size_t)128 * 3072 + 2048 + u.pn * 256;
    const int tid = threadIdx.x, c = tid & 63, rsub = tid >> 6;
    pf4 gt[2][2];
    _Pragma("unroll") for (int bj = 0; bj < 2; ++bj) _Pragma("unroll") for (int n = 0; n < 2; ++n) gt[bj][n] = *(const pf4*)(gr + 128 * bj + 32 * wc + 16 * n + 4 * fq);
    _Pragma("unroll") for (int ai = 0; ai < 2; ++ai) {
      _Pragma("unroll") for (int m = 0; m < 4; ++m) _Pragma("unroll") for (int bj = 0; bj < 2; ++bj) _Pragma("unroll") for (int n = 0; n < 2; ++n) {
        const int rl = 64 * wr + 16 * m + fr, chunk = 32 * bj + 8 * wc + 4 * n + fq;
        *(PG8_LAS pf4*)(lds + rl * 1024 + ((chunk ^ fr) << 4)) = gt[bj][n] * acc[ai][bj][m][n];
      }
      __syncthreads();
      const size_t g0 = (size_t)(u.pm * 256 + 128 * ai) * DM + u.pn * 256 + 4 * c;
      {
        pf4 xv[16];
        _Pragma("unroll") for (int q = 0; q < 16; ++q) xv[q] = __builtin_nontemporal_load((const pf4*)(p.x_prompt + g0 + (size_t)(q * 8 + rsub) * DM));
        __builtin_amdgcn_sched_barrier(0);
        _Pragma("unroll") for (int q = 0; q < 16; ++q) {
          const int rl = q * 8 + rsub;
          const pf4 st = *(const PG8_LAS pf4*)(lds + rl * 1024 + ((c ^ (rl & 15)) << 4));
          __builtin_nontemporal_store(xv[q] + st, (pf4*)(p.out_yp + g0 + (size_t)rl * DM));
        }
      }
      __syncthreads();
    }
  }
};

DI f32x16 wave_gemm32(const bfr* __restrict__ A, int lda, const bfr* __restrict__ W, int ldw, int K, int lane) {
  const int r = lane & 31, h = lane >> 5;
  const bfr* ap = A + (size_t)r * lda + 8 * h;
  const bfr* wp = W + (size_t)r * ldw + 8 * h;
  f32x16 acc = zero16();
  for (int k0 = 0; k0 < K; k0 += 128) {
    bf16x8 a[8], b[8];
    _Pragma("unroll") for (int q = 0; q < 8; ++q) { a[q] = *(const bf16x8*)(ap + k0 + 16 * q); b[q] = *(const bf16x8*)(wp + k0 + 16 * q); }
    _Pragma("unroll") for (int q = 0; q < 8; ++q) acc = mfma(b[q], a[q], acc);
  }
  return acc;
}

DI void sample_chain_wave(const Params& p, int wt, int lane) {
  const int mt = wt >> 5, nt = wt & 31, r = lane & 31, h = lane >> 5;
  const int m = 32 * mt + r;
  unsigned* cnt = p.bar + PANEL_CNT_WORD + 64 * mt;
  {
    const f32x16 a1 = wave_gemm32(p.YA + (size_t)(SEQ + 32 * mt) * 1024, 1024, p.Wt_pab + (size_t)(32 * nt) * 1024, 1024, 512, lane);
    const f32x16 a2 = wave_gemm32(p.YB + (size_t)(SEQ + 32 * mt) * 1024, 1024, p.Wt_pab + (size_t)(32 * nt) * 1024 + 512, 1024, 512, lane);
    _Pragma("unroll") for (int g = 0; g < 4; ++g) {
      const int n = 32 * nt + 8 * g + 4 * h;
      const u32x2 ga = *(const u32x2*)(p.GA + (size_t)(SEQ + m) * 1024 + n), gb = *(const u32x2*)(p.GB + (size_t)(SEQ + m) * 1024 + n);
      *(u32x2*)(p.Ys + (size_t)m * 1024 + n) = pack4(bflo(ga[0]) * a1[4 * g] + bflo(gb[0]) * a2[4 * g], bfhi(ga[0]) * a1[4 * g + 1] + bfhi(gb[0]) * a2[4 * g + 1],
                                                     bflo(ga[1]) * a1[4 * g + 2] + bflo(gb[1]) * a2[4 * g + 2], bfhi(ga[1]) * a1[4 * g + 3] + bfhi(gb[1]) * a2[4 * g + 3]);
    }
    __builtin_amdgcn_fence(__ATOMIC_RELEASE, "agent");
    asm volatile("s_waitcnt vmcnt(0)" ::: "memory");
    if (lane == 0) __hip_atomic_fetch_add(cnt, 1u, __ATOMIC_RELAXED, __HIP_MEMORY_SCOPE_AGENT);
  }
  {
    unsigned sp = 0;
    while (__hip_atomic_load(cnt, __ATOMIC_RELAXED, __HIP_MEMORY_SCOPE_AGENT) < 32u) { __builtin_amdgcn_s_sleep(2); if (++sp > (1u << 22)) break; }
    __builtin_amdgcn_fence(__ATOMIC_ACQUIRE, "agent");
    asm volatile("s_waitcnt vmcnt(0)" ::: "memory");
  }
  const f32x16 acc = wave_gemm32(p.Ys + (size_t)(32 * mt) * 1024, 1024, p.Wt_out + (size_t)(32 * nt) * 1024, 1024, 1024, lane);
  _Pragma("unroll") for (int g = 0; g < 4; ++g) {
    const int n = 32 * nt + 8 * g + 4 * h;
    const float4 xv = *(const float4*)(p.x_sample + (size_t)m * DM + n), gt = *(const float4*)(p.mod + (size_t)m * 3072 + 2048 + n);
    float4 o;
    o.x = xv.x + gt.x * acc[4 * g]; o.y = xv.y + gt.y * acc[4 * g + 1]; o.z = xv.z + gt.z * acc[4 * g + 2]; o.w = xv.w + gt.w * acc[4 * g + 3];
    *(float4*)(p.out_ys + (size_t)m * DM + n) = o;
  }
}

DI void attn_prompt_wave(const Params& p, int qt, int hd, int lane) {
  const int r = lane & 31, h = lane >> 5, j = hd >> 2;
  const int q0 = qt * 32, q = q0 + r, kb = q0 - 128;
  bf16x8 qf[4];
  _Pragma("unroll") for (int s = 0; s < 4; ++s) qf[s] = *(const bf16x8*)(p.Q + (size_t)q * 512 + hd * 64 + 16 * s + 8 * h);
  f32x16 sacc[5];
  _Pragma("unroll") for (int kt = 0; kt < 5; ++kt) {
    sacc[kt] = zero16();
    int kr = kb + 32 * kt + r; kr = kr < 0 ? 0 : kr;
    _Pragma("unroll") for (int s = 0; s < 4; ++s) {
      bf16x8 kf = *(const bf16x8*)(p.Kb + (size_t)kr * 128 + j * 64 + 16 * s + 8 * h);
      sacc[kt] = mfma(kf, qf[s], sacc[kt]);
    }
  }
  const float sink = p.sinks[hd];
  float mx = sink;
  _Pragma("unroll") for (int kt = 0; kt < 5; ++kt) _Pragma("unroll") for (int i = 0; i < 16; ++i) {
    int key = kb + 32 * kt + crow(i, h), rel = q - key;
    bool valid = (rel >= 0) && (rel < 128) && (key >= 0);
    float sv = valid ? sacc[kt][i] : -INFINITY;
    sacc[kt][i] = sv; mx = fmaxf(mx, sv);
  }
  mx = fmaxf(mx, __shfl_xor(mx, 32));
  float l = 0.f;
  _Pragma("unroll") for (int kt = 0; kt < 5; ++kt) _Pragma("unroll") for (int i = 0; i < 16; ++i) {
    float pv = __expf(sacc[kt][i] - mx); sacc[kt][i] = pv; l += pv;
  }
  l += __shfl_xor(l, 32);
  l += __expf(sink - mx);
  f32x16 oacc[2]; oacc[0] = zero16(); oacc[1] = zero16();
  const bfr* vbase = p.Vb + j * 64 + 2 * r;
  _Pragma("unroll") for (int kt = 0; kt < 5; ++kt) _Pragma("unroll") for (int s2 = 0; s2 < 2; ++s2) {
    u32x4 pp;
    _Pragma("unroll") for (int e = 0; e < 4; ++e) pp[e] = pk2(sacc[kt][8 * s2 + 2 * e], sacc[kt][8 * s2 + 2 * e + 1]);
    unsigned wv[8];
    _Pragma("unroll") for (int jj = 0; jj < 8; ++jj) {
      int key = kb + 32 * kt + 16 * s2 + 8 * (jj >> 2) + 4 * h + (jj & 3); key = key < 0 ? 0 : key;
      wv[jj] = *(const unsigned*)(vbase + (size_t)key * 128);
    }
    u32x4 v0, v1;
    _Pragma("unroll") for (int e = 0; e < 4; ++e) {
      v0[e] = (wv[2 * e] & 0xffffu) | (wv[2 * e + 1] << 16);
      v1[e] = (wv[2 * e] >> 16) | (wv[2 * e + 1] & 0xffff0000u);
    }
    const bf16x8 pa = __builtin_bit_cast(bf16x8, pp);
    oacc[0] = mfma(pa, __builtin_bit_cast(bf16x8, v0), oacc[0]);
    oacc[1] = mfma(pa, __builtin_bit_cast(bf16x8, v1), oacc[1]);
  }
  const float il = frcp(l);
  unsigned za[16];
  _Pragma("unroll") for (int i = 0; i < 16; ++i) za[i] = *(const unsigned*)(p.ZA + (size_t)(q0 + crow(i, h)) * 512 + hd * 64 + 2 * r);
  __builtin_amdgcn_sched_barrier(0);
  _Pragma("unroll") for (int i = 0; i < 16; ++i) {
    const int qi = crow(i, h);
    const float ili = __shfl(il, qi);
    *(unsigned*)(p.YA + (size_t)(q0 + qi) * 1024 + hd * 64 + 2 * r) = pk2(oacc[0][i] * ili * bflo(za[i]), oacc[1][i] * ili * bfhi(za[i]));
  }
}

DI void attn_sample_wave(const Params& p, int b, int hd, float* sw  ) {
  const int lane = threadIdx.x & 63, j = hd >> 2, m = SEQ + b;
  u32x4 qv[8];
  _Pragma("unroll") for (int i = 0; i < 8; ++i) qv[i] = *(const u32x4*)(p.Q + (size_t)m * 512 + hd * 64 + 8 * i);
  float dn = 0.f;
  _Pragma("unroll") for (int i = 0; i < 8; ++i) {
    u32x4 kv = *(const u32x4*)(p.Kb + (size_t)m * 128 + j * 64 + 8 * i);
    _Pragma("unroll") for (int e = 0; e < 4; ++e) dn += bflo(qv[i][e]) * bflo(kv[e]) + bfhi(qv[i][e]) * bfhi(kv[e]);
  }
  float s[2];
  _Pragma("unroll") for (int u = 0; u < 2; ++u) {
    int idx = lane + 1 + 64 * u;
    int ic = idx < 128 ? idx : 127;
    const float* kp = p.cache_k + ((size_t)(b * 128 + ic) * 2 + j) * 64;
    float4 kk[16];
    _Pragma("unroll") for (int i = 0; i < 16; ++i) kk[i] = *(const float4*)(kp + 4 * i);
    __builtin_amdgcn_sched_barrier(0);
    float d = 0.f;
    _Pragma("unroll") for (int i = 0; i < 8; ++i) {
      const float4 k0 = kk[2 * i], k1 = kk[2 * i + 1];
      d += bflo(qv[i][0]) * k0.x + bfhi(qv[i][0]) * k0.y + bflo(qv[i][1]) * k0.z + bfhi(qv[i][1]) * k0.w;
      d += bflo(qv[i][2]) * k1.x + bfhi(qv[i][2]) * k1.y + bflo(qv[i][3]) * k1.z + bfhi(qv[i][3]) * k1.w;
    }
    s[u] = idx < 128 ? d : dn;
  }
  const float sink = p.sinks[hd];
  float mx = fmaxf(fmaxf(s[0], s[1]), sink);
  _Pragma("unroll") for (int o = 32; o >= 1; o >>= 1) mx = fmaxf(mx, __shfl_xor(mx, o));
  float p0 = __expf(s[0] - mx), p1 = __expf(s[1] - mx);
  float l = p0 + p1;
  _Pragma("unroll") for (int o = 32; o >= 1; o >>= 1) l += __shfl_xor(l, o);
  l += __expf(sink - mx);
  sw[lane] = p0; sw[64 + lane] = p1;
  __builtin_amdgcn_s_waitcnt(0xc07f);
  __builtin_amdgcn_wave_barrier();
  float o = 0.f;
  const float* vb = p.cache_v + ((size_t)(b * 128) * 2 + j) * 64 + lane;
  _Pragma("unroll 1") for (int i0 = 0; i0 < 128; i0 += 16) {
    float vv[16];
    _Pragma("unroll") for (int q = 0; q < 16; ++q) vv[q] = vb[(size_t)(i0 + q) * 128];
    __builtin_amdgcn_sched_barrier(0);
    _Pragma("unroll") for (int q = 0; q < 16; ++q) { const float pw = (i0 + q) ? sw[i0 + q - 1] : 0.f; o += pw * vv[q]; }
  }
  o += sw[127] * bf2f(p.Vb[(size_t)m * 128 + j * 64 + lane]);
  size_t off = (size_t)m * 512 + hd * 64 + lane;
  p.YA[(size_t)m * 1024 + hd * 64 + lane] = (bfr)f2bf(o * frcp(l) * bf2f(p.ZA[off]));
  __builtin_amdgcn_wave_barrier();
}

DI void hgrn_gates(const Params& p, int row0, int hh, float* sTot, float (&L)[32], float (&kin)[32], float& t0, float& lc) {
  const int t = TID, c = t & 127, half = t >> 7, ch = hh * 128 + c;
  const float lbv = frcp(1.f + __expf(p.lb_logits[512 + ch] - p.lb_logits[ch]));
  const bfr* zp = p.ZF + (size_t)(row0 + half * 32) * 512 + ch;
  float run = 0.f;
  _Pragma("unroll") for (int jj = 0; jj < 32; ++jj) {
    float z = bf2f(zp[(size_t)jj * 512]);
    z = fminf(fmaxf(z, -30.f), 30.f);
    float em = __expf(-z), sg = frcp(1.f + em);
    float f = lbv + (1.f - lbv) * sg;
    kin[jj] = (1.f - lbv) * em * sg;
    run += __logf(f);
    L[jj] = run;
  }
  sTot[half * 128 + c] = run;
  __syncthreads();
  t0 = sTot[c]; lc = t0 + sTot[128 + c];
  if (half) { _Pragma("unroll") for (int jj = 0; jj < 32; ++jj) L[jj] += t0; }
}

DI void hgrn_fused_item(const Params& p, int n, int hh, char* smem) {
  bfr* sVt = (bfr*)smem;
  bfr* sKt = sVt + 128 * LDT;
  bfr* sQh = sKt + 128 * LDT;
  bfr* sKh = sQh + 64 * 136;
  bfr* sAm = sKt;
  float* sTot = (float*)(sKh + 64 * 136);
  const int t = TID, lane = t & 63, w = t >> 6, h = lane >> 5, c = t & 127, half = t >> 7;
  const int row0 = n * 64;
  __syncthreads();
  {
    const bfr* ip = p.IB + (size_t)(row0 + half * 32) * 512 + hh * 128 + c;
    _Pragma("unroll") for (int q4 = 0; q4 < 4; ++q4) {
      u32x4 o;
      _Pragma("unroll") for (int e = 0; e < 4; ++e) {
        int jj = q4 * 8 + 2 * e;
        o[e] = (unsigned)ip[(size_t)jj * 512] | ((unsigned)ip[(size_t)(jj + 1) * 512] << 16);
      }
      *(u32x4*)(sVt + c * LDT + half * 32 + q4 * 8) = o;
    }
  }
  {
    float L[32], kin[32], t0, lc;
    hgrn_gates(p, row0, hh, sTot, L, kin, t0, lc);
    _Pragma("unroll") for (int q4 = 0; q4 < 4; ++q4) {
      u32x4 o;
      _Pragma("unroll") for (int e = 0; e < 4; ++e) {
        int jj = q4 * 8 + 2 * e;
        o[e] = pk2(kin[jj] * __expf(lc - L[jj]), kin[jj + 1] * __expf(lc - L[jj + 1]));
      }
      *(u32x4*)(sKt + c * LDT + half * 32 + q4 * 8) = o;
    }
    if (half == 0) p.dec[(n * 4 + hh) * 128 + c] = __expf(lc);
    bfr* qp = p.QB + (size_t)(row0 + half * 32) * 512 + hh * 128 + c;
    unsigned qraw[16];
    _Pragma("unroll") for (int e = 0; e < 16; ++e) qraw[e] = (unsigned)qp[(size_t)(2 * e) * 512] | ((unsigned)qp[(size_t)(2 * e + 1) * 512] << 16);
    __builtin_amdgcn_sched_barrier(0);
    _Pragma("unroll") for (int jj = 0; jj < 32; ++jj) {
      const float qv = (jj & 1) ? bfhi(qraw[jj >> 1]) : bflo(qraw[jj >> 1]);
      qp[(size_t)jj * 512] = (bfr)(pk2(qv * __expf(L[jj]), 0.f) & 0xffffu);
      const float dl = L[jj] - t0;
      sQh[(half * 32 + jj) * 136 + c] = (bfr)(pk2(qv * __expf(fminf(dl, 80.f)), 0.f) & 0xffffu);
      sKh[(half * 32 + jj) * 136 + c] = (bfr)(pk2(kin[jj] * __expf(fminf(-dl, 80.f)), 0.f) & 0xffffu);
    }
  }
  __syncthreads();
  {
    int r = lane & 31; asm volatile("" : "+v"(r));
    const int wv = w >> 1, wk = w & 1;
    f32x16 acc[2][2];
    _Pragma("unroll") for (int a = 0; a < 2; ++a) _Pragma("unroll") for (int b = 0; b < 2; ++b) acc[a][b] = zero16();
    _Pragma("unroll") for (int s = 0; s < 4; ++s) {
      bf16x8 af[2], bf[2];
      _Pragma("unroll") for (int x = 0; x < 2; ++x) {
        af[x] = *(const bf16x8*)(sVt + (wv * 64 + x * 32 + r) * LDT + 16 * s + 8 * h);
        bf[x] = *(const bf16x8*)(sKt + (wk * 64 + x * 32 + r) * LDT + 16 * s + 8 * h);
      }
      _Pragma("unroll") for (int a = 0; a < 2; ++a) _Pragma("unroll") for (int b = 0; b < 2; ++b) acc[a][b] = mfma(af[a], bf[b], acc[a][b]);
    }
    float* up = p.Ust + (size_t)(n * 4 + hh) * 16384;
    _Pragma("unroll") for (int a = 0; a < 2; ++a) _Pragma("unroll") for (int b = 0; b < 2; ++b) _Pragma("unroll") for (int i = 0; i < 16; ++i) {
      int v = wv * 64 + a * 32 + crow(i, h), k = wk * 64 + b * 32 + r;
      up[v * 128 + k] = acc[a][b][i];
    }
  }
  const int jt = w >> 1, it = w & 1;
  int r2 = lane & 31; asm volatile("" : "+v"(r2));
  f32x16 am = zero16();
  if (jt <= it) {
    _Pragma("unroll") for (int s = 0; s < 8; ++s) {
      bf16x8 kf = *(const bf16x8*)(sKh + (jt * 32 + r2) * 136 + 16 * s + 8 * h);
      bf16x8 qf = *(const bf16x8*)(sQh + (it * 32 + r2) * 136 + 16 * s + 8 * h);
      am = mfma(kf, qf, am);
    }
  }
  __syncthreads();
  {
    int r3 = lane & 31; asm volatile("" : "+v"(r3));
    const int i = it * 32 + r3;
    _Pragma("unroll") for (int g = 0; g < 4; ++g) {
      int j0 = jt * 32 + 8 * g + 4 * h;
      float x0 = (j0 <= i) ? am[4 * g] : 0.f, x1 = (j0 + 1 <= i) ? am[4 * g + 1] : 0.f;
      float x2 = (j0 + 2 <= i) ? am[4 * g + 2] : 0.f, x3 = (j0 + 3 <= i) ? am[4 * g + 3] : 0.f;
      *(u32x2*)(sAm + i * LDT + j0) = pack4(x0, x1, x2, x3);
    }
  }
  __syncthreads();
  {
    int r = lane & 31; asm volatile("" : "+v"(r));
    f32x16 oacc[2]; oacc[0] = zero16(); oacc[1] = zero16();
    _Pragma("unroll") for (int s = 0; s < 4; ++s) {
      bf16x8 vf = *(const bf16x8*)(sVt + (32 * w + r) * LDT + 16 * s + 8 * h);
      _Pragma("unroll") for (int i2 = 0; i2 < 2; ++i2) {
        bf16x8 af2 = *(const bf16x8*)(sAm + (i2 * 32 + r) * LDT + 16 * s + 8 * h);
        oacc[i2] = mfma(vf, af2, oacc[i2]);
      }
    }
    _Pragma("unroll") for (int i2 = 0; i2 < 2; ++i2) _Pragma("unroll") for (int g = 0; g < 4; ++g)
      *(u32x2*)(p.YB + (size_t)(row0 + i2 * 32 + r) * 1024 + hh * 128 + 32 * w + 8 * g + 4 * h) =
          pack4(oacc[i2][4 * g], oacc[i2][4 * g + 1], oacc[i2][4 * g + 2], oacc[i2][4 * g + 3]);
  }
}

DI void hgrn_sample_wave(const Params& p, int b, int hh, int lane, float* sw  ) {
  const int m = SEQ + b;
  _Pragma("unroll") for (int u = 0; u < 2; ++u) {
    const int k = lane + 64 * u, ch = hh * 128 + k;
    const float lbv = frcp(1.f + __expf(p.lb_logits[512 + ch] - p.lb_logits[ch]));
    float z = bf2f(p.ZF[(size_t)m * 512 + ch]);
    z = fminf(fmaxf(z, -30.f), 30.f);
    const float em = __expf(-z), sg = frcp(1.f + em);
    sw[k] = lbv + (1.f - lbv) * sg; sw[128 + k] = (1.f - lbv) * em * sg; sw[256 + k] = bf2f(p.QB[(size_t)m * 512 + ch]);
  }
  const int v4 = (lane & 31) * 4, kg = lane >> 5;
  const u32x2 vraw = *(const u32x2*)(p.IB + (size_t)m * 512 + hh * 128 + v4);
  const float4 vv = {bflo(vraw[0]), bfhi(vraw[0]), bflo(vraw[1]), bfhi(vraw[1])};
  __builtin_amdgcn_s_waitcnt(0xc07f);
  __builtin_amdgcn_wave_barrier();
  float4 o = {0.f, 0.f, 0.f, 0.f};
  const size_t sb = (size_t)(b * 4 + hh) * 16384 + (size_t)(kg * 64) * 128 + v4;
  const volatile float* swv = sw;
  _Pragma("unroll 1") for (int k0 = 0; k0 < 64; k0 += 16) {
    float4 Sv[16];
    _Pragma("unroll") for (int q = 0; q < 16; ++q) Sv[q] = *(const float4*)(p.state + sb + (k0 + q) * 128);
    __builtin_amdgcn_sched_barrier(0);
    _Pragma("unroll") for (int q = 0; q < 16; ++q) {
      const int k = kg * 64 + k0 + q;
      const float4 S = Sv[q];
      const float f = swv[k], ki = swv[128 + k], qq = swv[256 + k];
      float4 Sn; Sn.x = f * S.x + ki * vv.x; Sn.y = f * S.y + ki * vv.y; Sn.z = f * S.z + ki * vv.z; Sn.w = f * S.w + ki * vv.w;
      *(float4*)(p.out_ss + sb + (k0 + q) * 128) = Sn;
      o.x += qq * Sn.x; o.y += qq * Sn.y; o.z += qq * Sn.z; o.w += qq * Sn.w;
    }
  }
  o.x += __shfl_xor(o.x, 32); o.y += __shfl_xor(o.y, 32); o.z += __shfl_xor(o.z, 32); o.w += __shfl_xor(o.w, 32);
  float ss = o.x * o.x + o.y * o.y + o.z * o.z + o.w * o.w;
  _Pragma("unroll") for (int of = 16; of >= 1; of >>= 1) ss += __shfl_xor(ss, of);
  const float sc = rsqrtf(ss * (1.f / 128.f) + EPS);
  if (kg == 0) {
    const float4 og = *(const float4*)(p.og + v4);
    const u32x2 zb = *(const u32x2*)(p.ZB + (size_t)m * 512 + hh * 128 + v4);
    *(u32x2*)(p.YB + (size_t)m * 1024 + hh * 128 + v4) = pack4(o.x * sc * og.x * bflo(zb[0]), o.y * sc * og.y * bfhi(zb[0]), o.z * sc * og.z * bflo(zb[1]), o.w * sc * og.w * bfhi(zb[1]));
  }
  __builtin_amdgcn_wave_barrier();
}

DI void cache_shift_copy(const Params& p, int gw, int nw, int lane, int part) {
  const int lo = part * (64 * 4064), hi = lo + 64 * 4064, st = nw * 64;
  for (int idx0 = lo + gw * 64 + lane; idx0 < hi; idx0 += 4 * st) {
    const int i0 = idx0, i1 = min(idx0 + st, hi - 1), i2 = min(idx0 + 2 * st, hi - 1), i3 = min(idx0 + 3 * st, hi - 1);
#define CSC_SRC(i) ((size_t)((i) / 4064) * 16384 + 128 + (size_t)((i) % 4064) * 4)
#define CSC_DST(i) ((size_t)((i) / 4064) * 16384 + (size_t)((i) % 4064) * 4)
    const float4 ka = *(const float4*)(p.cache_k + CSC_SRC(i0)), kb = *(const float4*)(p.cache_k + CSC_SRC(i1));
    const float4 kc = *(const float4*)(p.cache_k + CSC_SRC(i2)), kd = *(const float4*)(p.cache_k + CSC_SRC(i3));
    const float4 va = *(const float4*)(p.cache_v + CSC_SRC(i0)), vb = *(const float4*)(p.cache_v + CSC_SRC(i1));
    const float4 vc = *(const float4*)(p.cache_v + CSC_SRC(i2)), vd = *(const float4*)(p.cache_v + CSC_SRC(i3));
    __builtin_amdgcn_sched_barrier(0);
    *(float4*)(p.out_ks + CSC_DST(i0)) = ka; *(float4*)(p.out_vs + CSC_DST(i0)) = va;
    *(float4*)(p.out_ks + CSC_DST(i1)) = kb; *(float4*)(p.out_vs + CSC_DST(i1)) = vb;
    *(float4*)(p.out_ks + CSC_DST(i2)) = kc; *(float4*)(p.out_vs + CSC_DST(i2)) = vc;
    *(float4*)(p.out_ks + CSC_DST(i3)) = kd; *(float4*)(p.out_vs + CSC_DST(i3)) = vd;
#undef CSC_SRC
#undef CSC_DST
  }
}

DI void phase_mix(const Params& p, char* smem, char* smem_all) {
  const int wave = threadIdx.x >> 6, lane = threadIdx.x & 63, gw = blockIdx.x * 8 + wave, nw = gridDim.x * 8;
  float* sw = (float*)(smem_all + wave * 2048);
  if (gw & 1) {
    for (int it = gw >> 1; it < 1024; it += nw >> 1) attn_sample_wave(p, it >> 3, it & 7, sw);
    cache_shift_copy(p, gw >> 1, nw >> 1, lane, 0);
    for (int it = gw; it < 4096; it += nw) attn_prompt_wave(p, it >> 3, it & 7, lane);
  } else {
    int it = gw;
    if (it < 4096) { attn_prompt_wave(p, it >> 3, it & 7, lane); it += nw; }
    if ((gw & 3) == 0) { for (int hs = gw >> 2; hs < 512; hs += nw >> 2) hgrn_sample_wave(p, hs >> 2, hs & 3, lane, sw); }
    cache_shift_copy(p, gw >> 1, nw >> 1, lane, 1);
    for (; it < 4096; it += nw) attn_prompt_wave(p, it >> 3, it & 7, lane);
  }
  for (int it = VBID; it < 1024; it += VGRID) hgrn_fused_item(p, it >> 2, it & 3, smem);
}

#define SCAN_LOAD(U, Dd, N0) _Pragma("unroll") for (int i = 0; i < 32; ++i) { U[i] = up[(size_t)((N0) + i) * 65536]; Dd[i] = dp[((N0) + i) * 512]; }
#define SCAN_STEP(U, Dd, N0) _Pragma("unroll") for (int i = 0; i < 32; ++i) { sp[(size_t)((N0) + i) * 65536] = (bfr)(pk2(S, 0.f) & 0xffffu); S = Dd[i] * S + U[i]; }
DI void phase_scan(const Params& p, int eb) {
  const int e = eb * 256 + threadIdx.x;
  const int hh = e >> 14, k = e & 127, v = (e >> 7) & 127;
  const float* up = p.Ust + e;
  bfr* sp = p.S16 + e;
  const float* dp = p.dec + hh * 128 + k;
  float S = 0.f;
  float ua[32], da[32], ub[32], db[32];
  SCAN_LOAD(ua, da, 0)
  for (int n0 = 0; n0 < NCH; n0 += 64) {
    SCAN_LOAD(ub, db, n0 + 32)
    SCAN_STEP(ua, da, n0)
    if (n0 + 64 < NCH) { SCAN_LOAD(ua, da, n0 + 64) }
    SCAN_STEP(ub, db, n0 + 32)
  }
  p.out_sp[(hh * 128 + k) * 128 + v] = S;
}

DI void hgrn_out_wave(const Params& p, int n, int hh, int it, int lane) {
  const int r = lane & 31, h = lane >> 5;
  const size_t row = (size_t)(n * 64 + it * 32 + r);
  bf16x8 qf[8];
  _Pragma("unroll") for (int s = 0; s < 8; ++s) qf[s] = *(const bf16x8*)(p.QB + row * 512 + hh * 128 + 16 * s + 8 * h);
  const bfr* sb = p.S16 + (size_t)(n * 4 + hh) * 16384 + (size_t)r * 128 + 8 * h;
  f32x16 acc[4];
  _Pragma("unroll") for (int vt = 0; vt < 4; ++vt) {
    acc[vt] = zero16();
    _Pragma("unroll") for (int s = 0; s < 8; ++s) {
      bf16x8 sf = *(const bf16x8*)(sb + vt * 32 * 128 + 16 * s);
      acc[vt] = mfma(sf, qf[s], acc[vt]);
    }
  }
  float ss = 0.f;
  _Pragma("unroll") for (int vt = 0; vt < 4; ++vt) _Pragma("unroll") for (int g = 0; g < 4; ++g) {
    const u32x2 oi = *(const u32x2*)(p.YB + row * 1024 + hh * 128 + 32 * vt + 8 * g + 4 * h);
    acc[vt][4 * g] += bflo(oi[0]); acc[vt][4 * g + 1] += bfhi(oi[0]); acc[vt][4 * g + 2] += bflo(oi[1]); acc[vt][4 * g + 3] += bfhi(oi[1]);
    ss += acc[vt][4 * g] * acc[vt][4 * g] + acc[vt][4 * g + 1] * acc[vt][4 * g + 1] + acc[vt][4 * g + 2] * acc[vt][4 * g + 2] + acc[vt][4 * g + 3] * acc[vt][4 * g + 3];
  }
  ss += __shfl_xor(ss, 32);
  const float sc = rsqrtf(ss * (1.f / 128.f) + EPS);
  u32x2 zbv[16];
  _Pragma("unroll") for (int vt = 0; vt < 4; ++vt) _Pragma("unroll") for (int g = 0; g < 4; ++g) zbv[vt * 4 + g] = *(const u32x2*)(p.ZB + row * 512 + hh * 128 + 32 * vt + 8 * g + 4 * h);
  __builtin_amdgcn_sched_barrier(0);
  _Pragma("unroll") for (int vt = 0; vt < 4; ++vt) _Pragma("unroll") for (int g = 0; g < 4; ++g) {
    const int v = 32 * vt + 8 * g + 4 * h;
    const float4 og = *(const float4*)(p.og + v);
    const u32x2 zb = zbv[vt * 4 + g];
    *(u32x2*)(p.YB + row * 1024 + hh * 128 + v) = pack4(acc[vt][4 * g] * sc * og.x * bflo(zb[0]), acc[vt][4 * g + 1] * sc * og.y * bfhi(zb[0]),
                                                        acc[vt][4 * g + 2] * sc * og.z * bflo(zb[1]), acc[vt][4 * g + 3] * sc * og.w * bfhi(zb[1]));
  }
}

#define XB_TMO      128
#define XB_XCNT(j)  (256  + 64 * (j))
#define XB_XSUB(j)  (1280 + 64 * (j))
#define XB_XGEN(j)  (2304 + 64 * (j))
#define XB_TOP      3328
#define XB_TOPGEN   3392
#define XCD_BAR_WORDS 3456
#define XB_SPIN_CAP (1u << 18)
#define LAS __attribute__((address_space(3)))

__device__ __forceinline__ unsigned xb_ld(unsigned* p)              { return __hip_atomic_load(p, __ATOMIC_RELAXED, __HIP_MEMORY_SCOPE_AGENT); }
__device__ __forceinline__ unsigned xb_add(unsigned* p, unsigned v) { return __hip_atomic_fetch_add(p, v, __ATOMIC_RELAXED, __HIP_MEMORY_SCOPE_AGENT); }
__device__ __forceinline__ unsigned xb_xcc_id() { return (unsigned)__builtin_amdgcn_s_getreg((3 << 11) | 20) & 0xFu; }
#define XB_SPIN(cond, bar) do { unsigned _sp = 0; while (cond) { __builtin_amdgcn_s_sleep(1); \
    if ((++_sp & 255u) == 0u) { if (xb_ld(&(bar)[XB_TMO])) break; if (_sp > XB_SPIN_CAP) { atomicAdd(&(bar)[XB_TMO], 1u); break; } } } } while (0)

struct XcdBarrier {
    unsigned* bar; unsigned x;
    volatile LAS unsigned* st;
};

__device__ __forceinline__ XcdBarrier xcd_barrier_post(unsigned* bar, volatile LAS unsigned* st) {
    XcdBarrier b; b.bar = bar; b.x = xb_xcc_id(); b.st = st;
    if (threadIdx.x == 0) (void)xb_add(&bar[XB_XCNT(b.x)], 1u);
    return b;
}
__device__ __forceinline__ void xcd_barrier_complete(unsigned* bar, unsigned x, unsigned& nloc, unsigned& nx) {
    const unsigned G = gridDim.x * gridDim.y * gridDim.z;
    unsigned sum, cnt, mine, sp = 0u;
    for (;;) {
        sum = 0u; cnt = 0u; mine = 0u;
#pragma unroll
        for (unsigned j = 0; j < 16; ++j) { const unsigned c = xb_ld(&bar[XB_XCNT(j)]); sum += c; cnt += (c > 0u) ? 1u : 0u; mine = (j == x) ? c : mine; }
        if (sum == G) break;
        __builtin_amdgcn_s_sleep(1);
        if ((++sp & 255u) == 0u) { if (xb_ld(&bar[XB_TMO])) break; if (sp > XB_SPIN_CAP) { atomicAdd(&bar[XB_TMO], 1u); break; } }
    }
    nloc = mine > 0u ? mine : 1u; nx = cnt > 0u ? cnt : 1u;
}

__device__ __forceinline__ void xcd_barrier(const XcdBarrier& b) {
    asm volatile("s_waitcnt vmcnt(0)" ::: "memory");
    __syncthreads();
    if (threadIdx.x == 0) {
        unsigned* bar = b.bar;
        __builtin_amdgcn_s_waitcnt(0);
        unsigned nloc = b.st[0], nx = b.st[1];
        if (nloc == 0u) { xcd_barrier_complete(bar, b.x, nloc, nx); b.st[0] = nloc; b.st[1] = nx; }
        const unsigned old = xb_add(&bar[XB_XSUB(b.x)], 1u);
        const unsigned gen = old / nloc;
        if (old + 1u == (gen + 1u) * nloc) {
            __builtin_amdgcn_fence(__ATOMIC_RELEASE, "agent");
            asm volatile("s_waitcnt vmcnt(0)" ::: "memory");
            const unsigned og = xb_add(&bar[XB_TOP], 1u);
            const unsigned tg = og / nx;
            if (og + 1u == (tg + 1u) * nx) xb_add(&bar[XB_TOPGEN], 1u);
            else XB_SPIN(xb_ld(&bar[XB_TOPGEN]) == tg, bar);
            __builtin_amdgcn_fence(__ATOMIC_ACQUIRE, "agent");
            xb_add(&bar[XB_XGEN(b.x)], 1u);
            asm volatile("s_waitcnt vmcnt(0)" ::: "memory");
        } else {
            XB_SPIN(xb_ld(&bar[XB_XGEN(b.x)]) == gen, bar);
            __builtin_amdgcn_fence(__ATOMIC_ACQUIRE, "agent");
            asm volatile("s_waitcnt vmcnt(0)" ::: "memory");
        }
    }
    __syncthreads();
}

static_assert(PANEL_CNT_WORD == XCD_BAR_WORDS, "panel counters follow the barrier words");
__global__ void __launch_bounds__(512, 2) hybrid_megakernel(Params p) {
  extern __shared__ __attribute__((aligned(16))) char smem_all[];
  __shared__ uint4 xb_words;
  if (threadIdx.x == 0) xb_words = make_uint4(0u, 0u, 0u, 0u);
  __syncthreads();
  const XcdBarrier xb = xcd_barrier_post(p.bar, (volatile LAS unsigned*)&xb_words);
  char* smem = smem_all + (threadIdx.x >> 8) * 73728;
#ifndef REPMASK
#define REPMASK 0
#endif
#define RUN_PHASE(n, ...) if (p.phase_lo <= n && n <= p.phase_hi) { if (n != p.phase_lo) xcd_barrier(xb); __VA_ARGS__; if ((REPMASK >> n) & 1) { xcd_barrier(xb); __VA_ARGS__; } }
  RUN_PHASE(0, phase_prep(p, smem))
  RUN_PHASE(1, { if (VBID < 48) phase_mod(p, smem); else phase_prep2(p, smem, VBID - 48, VGRID - 48); })
  RUN_PHASE(2, phase_h(p))
  RUN_PHASE(3, {
    pg8::Gemm g{p.H, p.Wt_all, MPAD, NALL, 1024};
    pg8::StaticOrder S; S.init(MPAD, NALL, (int)gridDim.x, (int)blockIdx.x);
    EpiMain E{p};
    pg8::gemm_phase<EpiMain, pg8::StaticOrder, false>((PG8_LAS unsigned char*)smem_all, g, S, E, nullptr);
  })
  RUN_PHASE(4, phase_mix(p, smem, smem_all))
  RUN_PHASE(5, {
    if (threadIdx.x < 256) { for (int eb = blockIdx.x; eb < 256; eb += gridDim.x) phase_scan(p, eb); }
    else { const int wt = blockIdx.x * 4 + ((threadIdx.x >> 6) - 4); if (wt < 128) sample_chain_wave(p, wt, threadIdx.x & 63); }
  })
  RUN_PHASE(6, {
    for (int wi = blockIdx.x * 8 + (threadIdx.x >> 6); wi < 2048; wi += gridDim.x * 8) hgrn_out_wave(p, wi >> 3, (wi >> 1) & 3, wi & 1, threadIdx.x & 63);
  })
  RUN_PHASE(7, {
    pg8::Gemm g{p.YA, p.Wt_pab, SEQ, 1024, 1024};
    pg8::StaticOrder S; S.init(SEQ, 1024, (int)gridDim.x, (int)blockIdx.x);
    EpiMerge E{p};
    pg8::gemm_phase<EpiMerge, pg8::StaticOrder, false>((PG8_LAS unsigned char*)smem_all, g, S, E, nullptr);
  })
  RUN_PHASE(8, {
    pg8::Gemm g{p.Y, p.Wt_out, SEQ, 1024, 1024};
    pg8::StaticOrder S; S.init(SEQ, 1024, (int)gridDim.x, (int)blockIdx.x);
    if ((int)gridDim.x == (SEQ / 256) * 4) {
      EpiOutLds E{p};
      pg8::gemm_phase<EpiOutLds, pg8::StaticOrder, false>((PG8_LAS unsigned char*)smem_all, g, S, E, nullptr);
    } else {
      EpiOut E{p};
      pg8::gemm_phase<EpiOut, pg8::StaticOrder, false>((PG8_LAS unsigned char*)smem_all, g, S, E, nullptr);
    }
  })
}

#ifndef ONE_LAUNCH
#define ONE_LAUNCH 1
#endif
constexpr size_t kDynLds = 147456;

extern "C" void kernel_launch(void* const* d_in, const int* in_sizes, int n_in, void* d_out, int out_size, void* d_ws, size_t ws_size,
                              hipStream_t stream) {
  static int grid_blocks = 0;
  if (!grid_blocks) {
    int dev = 0, cus = 0, per_cu = 0;
    (void)hipGetDevice(&dev);
    (void)hipDeviceGetAttribute(&cus, hipDeviceAttributeMultiprocessorCount, dev);
    (void)hipFuncSetAttribute((const void*)hybrid_megakernel, hipFuncAttributeMaxDynamicSharedMemorySize, (int)kDynLds);
    (void)hipOccupancyMaxActiveBlocksPerMultiprocessor(&per_cu, hybrid_megakernel, 512, kDynLds);
    if (per_cu > 1) per_cu = 1;
    if (per_cu < 1) per_cu = 1;
    grid_blocks = cus * per_cu;
  }
  Params p{};
  const float* const* in = (const float* const*)d_in;
  p.x_prompt = in[0]; p.x_sample = in[1]; p.cache_k = in[2]; p.cache_v = in[3]; p.state = in[4]; p.c_prompt = in[5]; p.c_sample = in[6];
  p.w_ada = in[7]; p.b_ada = in[8]; p.norm_g = in[9]; p.w_in = in[10]; p.qg = in[11]; p.kg = in[12]; p.sinks = in[13]; p.lb_logits = in[14];
  p.og = in[15]; p.w_merge = in[16]; p.b_merge = in[17]; p.w_pa = in[18]; p.w_pb = in[19]; p.w_out = in[20];
  float* o = (float*)d_out;
  p.out_yp = o; o += (size_t)SEQ * DM;
  p.out_ys = o; o += (size_t)NBT * DM;
  p.out_kp = o; o += 128 * 128;
  p.out_vp = o; o += 128 * 128;
  p.out_sp = o; o += 4 * 128 * 128;
  p.out_ks = o; o += (size_t)NBT * 128 * 128;
  p.out_vs = o; o += (size_t)NBT * 128 * 128;
  p.out_ss = o;
  char* wsp = (char*)d_ws;
  auto take = [&](size_t bytes) { char* r = wsp; wsp += (bytes + 255) & ~(size_t)255; return r; };
  p.bar = (unsigned*)take((size_t)(XCD_BAR_WORDS + 256) * 4);
  p.Wt_all = (bfr*)take((size_t)NALL * 1024 * 2);
  p.Wt_pab = (bfr*)take((size_t)1024 * 1024 * 2);
  p.Wt_out = (bfr*)take((size_t)1024 * 1024 * 2);
  p.Wt_ada = (bfr*)take((size_t)3072 * 1024 * 2);
  p.Cb = (bfr*)take((size_t)256 * 1024 * 2);
  p.mod = (float*)take((size_t)256 * 3072 * 4);
  p.Ys = (bfr*)take((size_t)128 * 1024 * 2);
  p.H = (bfr*)take((size_t)MPAD * 1024 * 2);
  p.YA = p.H; p.YB = p.H + 512;
  p.ZA = (bfr*)take((size_t)MTOT * 512 * 2);
  p.S16 = p.ZA;
  p.Q = (bfr*)take((size_t)MTOT * 512 * 2);
  p.QB = (bfr*)take((size_t)MTOT * 512 * 2);
  p.Y = p.Q;
  p.Kb = (bfr*)take((size_t)MTOT * 128 * 2);
  p.Vb = (bfr*)take((size_t)MTOT * 128 * 2);
  p.IB = (bfr*)take((size_t)MTOT * 512 * 2);
  p.ZB = (bfr*)take((size_t)MTOT * 512 * 2);
  p.ZF = (bfr*)take((size_t)MTOT * 512 * 2);
  p.GA = (bfr*)take((size_t)MTOT * 1024 * 2);
  p.GB = (bfr*)take((size_t)MTOT * 1024 * 2);
  p.dec = (float*)take((size_t)NCH * 4 * 128 * 4);
  p.Ust = p.out_yp;
  if ((size_t)(wsp - (char*)d_ws) > ws_size) { fprintf(stderr, "workspace too small\n"); return; }
  (void)hipMemsetAsync(p.bar, 0, (size_t)(XCD_BAR_WORDS + 256) * 4, stream);
#if ONE_LAUNCH
  p.phase_lo = 0; p.phase_hi = 8;
  void* args[] = {&p};
  hipError_t e = hipLaunchCooperativeKernel((void*)hybrid_megakernel, dim3(grid_blocks), dim3(512), args, kDynLds, stream);
  if (e != hipSuccess) fprintf(stderr, "cooperative launch failed: %s (grid %d)\n", hipGetErrorString(e), grid_blocks);
#else
  for (int ph = 0; ph <= 8; ++ph) {
    p.phase_lo = ph; p.phase_hi = ph;
    hipLaunchKernelGGL(hybrid_megakernel, dim3(grid_blocks), dim3(512), kDynLds, stream, p);
  }
#endif
}
```

```cpp
#include <hip/hip_runtime.h>
#include <cstdio>

#define DI __device__ __forceinline__
typedef unsigned short bfr;
using bf16x8 = __attribute__((ext_vector_type(8))) short;
using f32x16 = __attribute__((ext_vector_type(16))) float;
using u32x4 = __attribute__((ext_vector_type(4))) unsigned;
using u32x2 = __attribute__((ext_vector_type(2))) unsigned;

constexpr int DM = 1024, SEQ = 16384, NBT = 128, MTOT = SEQ + NBT;
constexpr int NALL = 5376;
constexpr int NCH = 256;
constexpr float EPS = 1e-6f;
constexpr float LOG2E = 1.4426950408889634f;
constexpr float QSCALE = 0.125f * 1.4426950408889634f;
constexpr int PANEL_CNT_WORD = 3456;
constexpr int LDT = 72;
constexpr int MPAD = 16640;
#define TID ((int)(threadIdx.x & 255))
#define VBID ((int)(blockIdx.x * 2 + (threadIdx.x >> 8)))
#define VGRID ((int)(gridDim.x * 2))

struct Params {
  const float *x_prompt, *x_sample, *cache_k, *cache_v, *state, *c_prompt, *c_sample;
  const float *w_ada, *b_ada, *norm_g, *w_in, *qg, *kg, *sinks, *lb_logits, *og, *w_merge, *b_merge, *w_pa, *w_pb, *w_out;
  float *out_yp, *out_ys, *out_kp, *out_vp, *out_sp, *out_ks, *out_vs, *out_ss;
  bfr *Wt_all, *Wt_pab, *Wt_out, *Wt_ada, *Cb, *H, *Q, *QB, *Kb, *Vb, *ZA, *IB, *ZB, *GA, *GB, *YA, *YB, *Y;
  float *mod, *dec, *Ust;
  bfr* ZF;
  bfr* S16;
  bfr* Ys;
  unsigned* bar;
  int phase_lo, phase_hi;
};

DI unsigned f2bf(float x) { unsigned u = __float_as_uint(x); u += 0x7fffu + ((u >> 16) & 1u); return u >> 16; }
typedef __bf16 hbf2 __attribute__((ext_vector_type(2)));
typedef float hf2 __attribute__((ext_vector_type(2)));
DI unsigned pk2(float a, float b) { hf2 v = {a, b}; return __builtin_bit_cast(unsigned, __builtin_convertvector(v, hbf2)); }
DI float bf2f(unsigned b) { return __uint_as_float(b << 16); }
DI float bflo(unsigned u) { return __uint_as_float(u << 16); }
DI float bfhi(unsigned u) { return __uint_as_float(u & 0xffff0000u); }
DI int crow(int i, int h) { return (i & 3) + 8 * (i >> 2) + 4 * h; }
DI f32x16 mfma(bf16x8 a, bf16x8 b, f32x16 c) { return __builtin_amdgcn_mfma_f32_32x32x16_bf16(a, b, c, 0, 0, 0); }
DI f32x16 zero16() { f32x16 z; _Pragma("unroll") for (int i = 0; i < 16; ++i) z[i] = 0.f; return z; }
DI float frcp(float x) { return __builtin_amdgcn_rcpf(x); }
DI float fexp(float x) { return __builtin_amdgcn_exp2f(x * 1.4426950408889634f); }
DI float sigmoidf_(float x) { return frcp(1.f + fexp(-x)); }
DI float siluf_(float x) { return x * frcp(1.f + fexp(-x)); }
DI u32x2 pack4(float a, float b, float c, float d) { u32x2 r; r[0] = pk2(a, b); r[1] = pk2(c, d); return r; }

DI int wt_row_of_col(int c) {
  const int pn = c >> 8, cl = c & 255;
  int slot;
  if (pn < 3) {
    const int g = cl >> 6, d = cl & 63;
    if (d >= 32) { const int x = d - 32; slot = 128 + 32 * g + 16 * ((x >> 2) & 1) + 4 * (x >> 3) + (x & 3); }
    else { const int fq = 2 * (d >> 4) + ((d >> 2) & 1), n = (d >> 3) & 1, j = d & 3; slot = 32 * g + 16 * n + 4 * fq + j; }
  } else {
    const int bj = cl >> 7, g = (cl >> 5) & 3, x = cl & 31;
    slot = 128 * bj + 32 * g + 16 * ((x >> 2) & 1) + 4 * (x >> 3) + (x & 3);
  }
  return (pn << 8) + slot;
}

DI void gemm_mainloop(const bfr* __restrict__ A, int lda, int m0, const bfr* __restrict__ W, int ldw, int n0, int K,
                      bfr* sA, bfr* sW, f32x16 (&acc)[2][2]) {
  const int t = TID, lane = t & 63, w = t >> 6, wn = w >> 1, wm = w & 1, r = lane & 31, h = lane >> 5;
  const int lrow = t >> 3, lk = (t & 7) * 8;
  const bfr* ap = A + (size_t)(m0 + lrow) * lda + lk;
  const bfr* wp = W + (size_t)(n0 + lrow) * ldw + lk;
  u32x4 ra[4], rw[4];
  _Pragma("unroll") for (int i = 0; i < 4; ++i) {
    ra[i] = *(const u32x4*)(ap + (size_t)(32 * i) * lda);
    rw[i] = *(const u32x4*)(wp + (size_t)(32 * i) * ldw);
  }
  const int nk = K >> 6;
  for (int kt = 0; kt < nk; ++kt) {
    __syncthreads();
    _Pragma("unroll") for (int i = 0; i < 4; ++i) {
      *(u32x4*)(sA + (lrow + 32 * i) * LDT + lk) = ra[i];
      *(u32x4*)(sW + (lrow + 32 * i) * LDT + lk) = rw[i];
    }
    __syncthreads();
    if (kt + 1 < nk) {
      ap += 64; wp += 64;
      _Pragma("unroll") for (int i = 0; i < 4; ++i) {
        ra[i] = *(const u32x4*)(ap + (size_t)(32 * i) * lda);
        rw[i] = *(const u32x4*)(wp + (size_t)(32 * i) * ldw);
      }
    }
    _Pragma("unroll") for (int kk = 0; kk < 4; ++kk) {
      bf16x8 af[2], bf[2];
      _Pragma("unroll") for (int x = 0; x < 2; ++x) {
        af[x] = *(const bf16x8*)(sW + (wn * 64 + x * 32 + r) * LDT + kk * 16 + 8 * h);
        bf[x] = *(const bf16x8*)(sA + (wm * 64 + x * 32 + r) * LDT + kk * 16 + 8 * h);
      }
      _Pragma("unroll") for (int nt = 0; nt < 2; ++nt)
        _Pragma("unroll") for (int mt = 0; mt < 2; ++mt) acc[nt][mt] = mfma(af[nt], bf[mt], acc[nt][mt]);
    }
  }
}

template <int PERMBASE> DI void transpose_tile(const float* __restrict__ src, int N, bfr* __restrict__ dst, int K, int kt, int nt, float* sm) {
  const int t = TID, k0 = kt * 64, n0 = nt * 64;
  __syncthreads();
  _Pragma("unroll") for (int i = 0; i < 16; ++i) {
    int idx = i * 256 + t, kk = idx >> 6, nn = idx & 63;
    sm[kk * 65 + nn] = src[(size_t)(k0 + kk) * N + n0 + nn];
  }
  __syncthreads();
  _Pragma("unroll") for (int i = 0; i < 8; ++i) {
    int idx = i * 256 + t, nn = idx >> 5, kk = (idx & 31) * 2;
    const int drow = PERMBASE >= 0 ? wt_row_of_col(PERMBASE + n0 + nn) : n0 + nn;
    *(unsigned*)(dst + (size_t)drow * K + k0 + kk) = pk2(sm[kk * 65 + nn], sm[(kk + 1) * 65 + nn]);
  }
}

DI void phase_prep(const Params& p, char* smem) {
  float* sm = (float*)smem;
  for (int it = VBID; it < 768; it += VGRID) transpose_tile<-1>(p.w_ada, 3072, p.Wt_ada, 1024, it / 48, it % 48, sm);
  for (int idx = VBID * 256 + TID; idx < 256 * 1024; idx += VGRID * 256) {
    int row = idx >> 10, col = idx & 1023;
    float v = row < 128 ? p.c_sample[row * 1024 + col] : (row == 128 ? p.c_prompt[col] : 0.f);
    p.Cb[idx] = (bfr)f2bf(v);
  }
}
DI void phase_prep2(const Params& p, char* smem, int vb0, int nvb) {
  float* sm = (float*)smem;
  for (int it = vb0; it < 1856; it += nvb) {
    int i = it;
    if (i < 832) { transpose_tile<0>(p.w_in, 3328, p.Wt_all, 1024, i / 52, i % 52, sm); continue; }
    i -= 832;
    if (i < 512) { transpose_tile<3328>(p.w_merge, 2048, p.Wt_all, 1024, i / 32, i % 32, sm); continue; }
    i -= 512;
    if (i < 128) { transpose_tile<-1>(p.w_pa, 1024, p.Wt_pab, 1024, i / 16, i % 16, sm); continue; }
    i -= 128;
    if (i < 128) { transpose_tile<-1>(p.w_pb, 1024, p.Wt_pab + 512, 1024, i / 16, i % 16, sm); continue; }
    i -= 128;
    transpose_tile<-1>(p.w_out, 1024, p.Wt_out, 1024, i / 16, i % 16, sm);
  }
}

DI void phase_mod(const Params& p, char* smem) {
  bfr* sA = (bfr*)smem; bfr* sW = sA + 128 * LDT;
  const int t = TID, lane = t & 63, w = t >> 6, wn = w >> 1, wm = w & 1, r = lane & 31, h = lane >> 5;
  for (int tile = VBID; tile < 48; tile += VGRID) {
    int m0 = (tile / 24) * 128, n0 = (tile % 24) * 128;
    f32x16 acc[2][2];
    _Pragma("unroll") for (int a = 0; a < 2; ++a) _Pragma("unroll") for (int b = 0; b < 2; ++b) acc[a][b] = zero16();
    gemm_mainloop(p.Cb, 1024, m0, p.Wt_ada, 1024, n0, 1024, sA, sW, acc);
    float4 bias[2][4];
    _Pragma("unroll") for (int nt = 0; nt < 2; ++nt) _Pragma("unroll") for (int g = 0; g < 4; ++g) bias[nt][g] = *(const float4*)(p.b_ada + n0 + wn * 64 + nt * 32 + 8 * g + 4 * h);
    _Pragma("unroll") for (int nt = 0; nt < 2; ++nt) _Pragma("unroll") for (int mt = 0; mt < 2; ++mt) {
      int m = m0 + wm * 64 + mt * 32 + r;
      _Pragma("unroll") for (int g = 0; g < 4; ++g) {
        int n = n0 + wn * 64 + nt * 32 + 8 * g + 4 * h;
        float4 b = bias[nt][g];
        float4 o; o.x = acc[nt][mt][4 * g] + b.x; o.y = acc[nt][mt][4 * g + 1] + b.y; o.z = acc[nt][mt][4 * g + 2] + b.z; o.w = acc[nt][mt][4 * g + 3] + b.w;
        *(float4*)(p.mod + (size_t)m * 3072 + n) = o;
      }
    }
  }
}

DI void phase_h(const Params& p) {
  const int lane = threadIdx.x & 63, gw = blockIdx.x * 8 + (threadIdx.x >> 6), nw = gridDim.x * 8;
  float4 g[4];
  _Pragma("unroll") for (int j = 0; j < 4; ++j) g[j] = *(const float4*)(p.norm_g + j * 256 + lane * 4);
  {
    const float* mr = p.mod + (size_t)128 * 3072;
    float4 a[4], bsh[4];
    _Pragma("unroll") for (int j = 0; j < 4; ++j) {
      const int col = j * 256 + lane * 4;
      const float4 sh = *(const float4*)(mr + col), sc = *(const float4*)(mr + 1024 + col);
      a[j].x = g[j].x * (1.f + sc.x); a[j].y = g[j].y * (1.f + sc.y); a[j].z = g[j].z * (1.f + sc.z); a[j].w = g[j].w * (1.f + sc.w);
      bsh[j] = sh;
    }
    for (int r0 = gw; r0 < SEQ; r0 += 8 * nw) {
      float4 xv[8][4];
      _Pragma("unroll") for (int q = 0; q < 8; ++q) {
        const int row = min(r0 + q * nw, SEQ - 1);
        _Pragma("unroll") for (int j = 0; j < 4; ++j) xv[q][j] = *(const float4*)(p.x_prompt + (size_t)row * DM + j * 256 + lane * 4);
      }
      __builtin_amdgcn_sched_barrier(0);
      _Pragma("unroll") for (int q = 0; q < 8; ++q) {
        const int row = r0 + q * nw;
        float ss = 0.f;
        _Pragma("unroll") for (int j = 0; j < 4; ++j) ss += xv[q][j].x * xv[q][j].x + xv[q][j].y * xv[q][j].y + xv[q][j].z * xv[q][j].z + xv[q][j].w * xv[q][j].w;
        _Pragma("unroll") for (int o = 32; o >= 1; o >>= 1) ss += __shfl_xor(ss, o);
        const float rs = rsqrtf(ss * (1.f / DM) + EPS);
        if (row < SEQ) {
          _Pragma("unroll") for (int j = 0; j < 4; ++j)
            *(u32x2*)(p.H + (size_t)row * DM + j * 256 + lane * 4) = pack4(xv[q][j].x * rs * a[j].x + bsh[j].x, xv[q][j].y * rs * a[j].y + bsh[j].y,
                                                                          xv[q][j].z * rs * a[j].z + bsh[j].z, xv[q][j].w * rs * a[j].w + bsh[j].w);
        }
      }
    }
  }
  for (int b = gw; b < NBT; b += nw) {
    const float* xr = p.x_sample + (size_t)b * DM;
    const float* mr = p.mod + (size_t)b * 3072;
    float4 xv[4], sh[4], sc[4]; float ss = 0.f;
    _Pragma("unroll") for (int j = 0; j < 4; ++j) {
      const int col = j * 256 + lane * 4;
      xv[j] = *(const float4*)(xr + col); sh[j] = *(const float4*)(mr + col); sc[j] = *(const float4*)(mr + 1024 + col);
      ss += xv[j].x * xv[j].x + xv[j].y * xv[j].y + xv[j].z * xv[j].z + xv[j].w * xv[j].w;
    }
    _Pragma("unroll") for (int o = 32; o >= 1; o >>= 1) ss += __shfl_xor(ss, o);
    const float rs = rsqrtf(ss * (1.f / DM) + EPS);
    _Pragma("unroll") for (int j = 0; j < 4; ++j)
      *(u32x2*)(p.H + (size_t)(SEQ + b) * DM + j * 256 + lane * 4) = pack4(xv[j].x * rs * g[j].x * (1.f + sc[j].x) + sh[j].x, xv[j].y * rs * g[j].y * (1.f + sc[j].y) + sh[j].y,
                                                                          xv[j].z * rs * g[j].z * (1.f + sc[j].z) + sh[j].z, xv[j].w * rs * g[j].w * (1.f + sc[j].w) + sh[j].w);
  }
}

DI void sincos_red(float a, float& s, float& c) {
  float n = rintf(a * 0.15915494309189535f);
  float rr = fmaf(-n, 6.2831854820251465f, a);
  rr = fmaf(-n, -1.7484555e-7f, rr);
  s = __sinf(rr); c = __cosf(rr);
}

namespace pg8 {
#define PG8_LAS __attribute__((address_space(3)))
typedef unsigned short bf16_t;
typedef short bf16x8 __attribute__((ext_vector_type(8)));
typedef float f32x4 __attribute__((ext_vector_type(4)));
typedef unsigned u32x4 __attribute__((ext_vector_type(4)));
constexpr int BM = 256, BK = 64, HALF = 128, HTB = HALF * BK * 2  , STAGE_BYTES = 8 * HTB, NXCD = 8, WGM = 8;

__host__ __device__ __forceinline__ int lds_byte(int r, int c) { const int st = (r >> 4) * 2 + (c >> 5), rr = r & 15, cc = c & 31, ob = rr * 64 + cc * 2; return st * 1024 + (ob ^ (((ob >> 9) & 1) << 5)); }
__host__ __device__ __forceinline__ void stage_rc(int b, int& R, int& C) { const int st = b / 1024, sb = b % 1024, swz = sb ^ (((sb >> 9) & 1) << 5); R = (st >> 1) * 16 + swz / 64; C = (st & 1) * 32 + (swz % 64) / 2; }
__host__ __device__ __forceinline__ int perm32(int rho) { const int n = rho >> 4, i = rho & 15; return 8 * (i >> 2) + 4 * n + (i & 3); }

struct Unit { int pm, pn; };
struct Gemm { const bf16_t* A; const bf16_t* Bt; int M, N, K; };

struct StaticOrder {
    int nM, nN, nwg, G, c;
    __host__ __device__ void init(int M, int N, int G_, int c_) { nM = M / BM; nN = N / BM; nwg = nM * nN; G = G_; c = c_; }
    __host__ __device__ bool next(int i, Unit& u) const {
        const long L = (long)i * G + c; if (L >= nwg) return false;
        int wgid = (int)L; { const int q = nwg / NXCD, r = nwg % NXCD, xcd = wgid % NXCD, off = wgid / NXCD; wgid = (xcd < r ? xcd * (q + 1) : r * (q + 1) + (xcd - r) * q) + off; }
        const int nig = WGM * nN, gid = wgid / nig, fm = gid * WGM, gsz = (nM - fm) < WGM ? (nM - fm) : WGM;
        u.pm = fm + ((wgid % nig) % gsz); u.pn = (wgid % nig) / gsz; return true;
    }
    __device__ __forceinline__ void a_ready(const Unit&) const {}
    __device__ __forceinline__ void done(const Unit&) const {}
};
template <class Epi, class Sched, bool STAMP = false>
__device__ __forceinline__ void gemm_phase(PG8_LAS unsigned char* lds, const Gemm g, const Sched& S, const Epi& E, unsigned long long* stamps) {
    const int tid = threadIdx.x, wid = __builtin_amdgcn_readfirstlane(tid >> 6), lane = tid & 63, wr = wid >> 2, wc = wid & 3, fr = lane & 15, fq = lane >> 4;
    const int K = g.K, nt = K / BK;
    int ts_lo = 0, ts_hi = 0, nts = 0; const unsigned long long rt_entry = STAMP ? (unsigned long long)wall_clock64() : 0ull;
#define PG8_STAMP() do { if (STAMP && wid == 0 && nts < 64) { const unsigned long long _c = (unsigned long long)clock64(); \
        ts_lo = (lane == nts) ? (int)(unsigned)_c : ts_lo; ts_hi = (lane == nts) ? (int)(unsigned)(_c >> 32) : ts_hi; ++nts; } } while (0)
    PG8_STAMP();
    unsigned voffA[2], voffB[2];
#pragma unroll
    for (int i = 0; i < 2; ++i) { int R, C; stage_rc(tid * 16 + i * 8192, R, C); const int Rb = Epi::PERM ? ((R & ~31) + perm32(R & 31)) : R;
        voffA[i] = (unsigned)(R * K + C) * 2u; voffB[i] = (unsigned)(Rb * K + C) * 2u; }
    const size_t kstep = (size_t)(BK * 2);
    const size_t hstep = (size_t)HALF * K * 2;
    const size_t tstep = 2 * hstep;
    const unsigned ldsw = (unsigned)wid * 1024u;
    const int aoff = lds_byte(wr * 64 + fr, fq * 8), boff = lds_byte(wc * 32 + fr, fq * 8);
#define PG8_SA(b, h) (((b) * 2 + (h)) * HTB)
#define PG8_SB(b, h) ((4 + (b) * 2 + (h)) * HTB)
#define PG8_STAGE(bufoff, gbase, voff) do { _Pragma("unroll") for (int _i = 0; _i < 2; ++_i) \
        __builtin_amdgcn_global_load_lds((const unsigned*)((const char*)(gbase) + (voff)[_i]), (PG8_LAS unsigned*)(lds + (bufoff) + ldsw + _i * 8192), 16, 0, 0); } while (0)
#define PG8_LDA(dst, b, h) do { _Pragma("unroll") for (int m = 0; m < 4; ++m) _Pragma("unroll") for (int k = 0; k < 2; ++k) dst[m][k] = *(const PG8_LAS bf16x8*)(lds + PG8_SA(b, h) + aoff + m * 2048 + k * 1024); } while (0)
#define PG8_LDB(dst, b, h) do { _Pragma("unroll") for (int n = 0; n < 2; ++n) _Pragma("unroll") for (int k = 0; k < 2; ++k) dst[n][k] = *(const PG8_LAS bf16x8*)(lds + PG8_SB(b, h) + boff + n * 2048 + k * 1024); } while (0)
#define PG8_MMA(ai, bj, At, Bt) do { __builtin_amdgcn_s_setprio(1); _Pragma("unroll") for (int m = 0; m < 4; ++m) _Pragma("unroll") for (int n = 0; n < 2; ++n) _Pragma("unroll") for (int k = 0; k < 2; ++k) \
        acc[ai][bj][m][n] = __builtin_amdgcn_mfma_f32_16x16x32_bf16(Bt[n][k], At[m][k], acc[ai][bj][m][n], 0, 0, 0); __builtin_amdgcn_s_setprio(0); } while (0)
#define PG8_WAIT_V(n) asm volatile("s_waitcnt vmcnt(" #n ")" ::: "memory")
#define PG8_WAIT_L(n) asm volatile("s_waitcnt lgkmcnt(" #n ")" ::: "memory")
#define PG8_BAR __builtin_amdgcn_s_barrier()
#define PG8_SCHED __builtin_amdgcn_sched_barrier(0)
    Unit cur, nxt; int ui = 0;
    if (!S.next(0, cur)) return;
    f32x4 acc[2][2][4][2];
#pragma unroll
    for (int a = 0; a < 2; ++a)
#pragma unroll
        for (int b = 0; b < 2; ++b)
#pragma unroll
            for (int m = 0; m < 4; ++m)
#pragma unroll
                for (int n = 0; n < 2; ++n) acc[a][b][m][n] = (f32x4){0.f, 0.f, 0.f, 0.f};
    bf16x8 At[4][2], B0[2][2], B1[2][2];
    const char* cA = (const char*)g.A + (size_t)cur.pm * tstep; const char* cB = (const char*)g.Bt + (size_t)cur.pn * tstep;
    S.a_ready(cur);
    PG8_STAGE(PG8_SB(0, 0), cB, voffB); PG8_STAGE(PG8_SA(0, 0), cA, voffA); PG8_STAGE(PG8_SB(0, 1), cB + hstep, voffB); PG8_STAGE(PG8_SA(0, 1), cA + hstep, voffA);
    if (wr == 1) PG8_BAR;
    PG8_WAIT_V(4); PG8_BAR;
    PG8_STAGE(PG8_SB(1, 0), cB + kstep, voffB); PG8_STAGE(PG8_SA(1, 0), cA + kstep, voffA); PG8_STAGE(PG8_SB(1, 1), cB + hstep + kstep, voffB);
    PG8_WAIT_V(6); PG8_BAR;
    PG8_STAMP();
    for (;;) {
        const bool has_next = S.next(ui + 1, nxt);
        const char* nA = has_next ? (const char*)g.A + (size_t)nxt.pm * tstep : cA; const char* nB = has_next ? (const char*)g.Bt + (size_t)nxt.pn * tstep : cB;
        for (int t = 0; t < nt; t += 2) {
            const bool last = (t == nt - 2);
            const char* a1 = cA + (size_t)(t + 1) * kstep;
            const char* a2 = last ? nA : cA + (size_t)(t + 2) * kstep; const char* b2 = last ? nB : cB + (size_t)(t + 2) * kstep;
            const char* a3 = a2 + kstep; const char* b3 = b2 + kstep;
            if (last && has_next) S.a_ready(nxt);
            if constexpr (Epi::MID_T > 0) { if (t == Epi::MID_T) E.mid(acc, cur, wr, wc, fr, fq); }
            PG8_LDB(B0, 0, 0); PG8_SCHED; PG8_LDA(At, 0, 0); PG8_STAGE(PG8_SA(1, 1), a1 + hstep, voffA);
            PG8_WAIT_L(8); PG8_BAR; PG8_WAIT_L(0); PG8_MMA(0, 0, At, B0); PG8_BAR; PG8_SCHED;
            PG8_LDB(B1, 0, 1); PG8_STAGE(PG8_SB(0, 0), b2, voffB);
            PG8_BAR; PG8_WAIT_L(0); PG8_MMA(0, 1, At, B1); PG8_BAR;
            PG8_LDA(At, 0, 1); PG8_STAGE(PG8_SA(0, 0), a2, voffA);
            PG8_BAR; PG8_WAIT_L(0); PG8_MMA(1, 0, At, B0); PG8_BAR; PG8_SCHED;
            PG8_STAGE(PG8_SB(0, 1), b2 + hstep, voffB);
            PG8_WAIT_V(6); PG8_BAR; PG8_MMA(1, 1, At, B1); PG8_BAR;
            PG8_LDB(B0, 1, 0); PG8_SCHED; PG8_LDA(At, 1, 0); PG8_STAGE(PG8_SA(0, 1), a2 + hstep, voffA);
            PG8_WAIT_L(8); PG8_BAR; PG8_WAIT_L(0); PG8_MMA(0, 0, At, B0); PG8_BAR; PG8_SCHED;
            PG8_LDB(B1, 1, 1); PG8_STAGE(PG8_SB(1, 0), b3, voffB);
            PG8_BAR; PG8_WAIT_L(0); PG8_MMA(0, 1, At, B1); PG8_BAR;
            PG8_LDA(At, 1, 1); PG8_STAGE(PG8_SA(1, 0), a3, voffA);
            PG8_BAR; PG8_WAIT_L(0); PG8_MMA(1, 0, At, B0); PG8_BAR; PG8_SCHED;
            PG8_STAGE(PG8_SB(1, 1), b3 + hstep, voffB);
            PG8_WAIT_V(6); PG8_BAR; PG8_MMA(1, 1, At, B1); PG8_BAR;
        }
        PG8_STAMP();
        if constexpr (!Epi::AFTER_DRAIN) { E(acc, cur, wr, wc, fr, fq); S.done(cur); }
        PG8_STAMP();
        if (!has_next) break;
#pragma unroll
        for (int a = 0; a < 2; ++a)
#pragma unroll
            for (int b = 0; b < 2; ++b)
#pragma unroll
                for (int m = 0; m < 4; ++m)
#pragma unroll
                    for (int n = 0; n < 2; ++n) acc[a][b][m][n] = (f32x4){0.f, 0.f, 0.f, 0.f};
        cur = nxt; cA = nA; cB = nB; ++ui;
    }
    PG8_WAIT_V(0);
    if (wr == 0) PG8_BAR;
    PG8_BAR;
    if constexpr (Epi::AFTER_DRAIN) { E.fused(acc, cur, wr, wc, fr, fq, lds, wid, lane); S.done(cur); }
    PG8_STAMP();
    if (STAMP && wid == 0) { stamps[lane] = lane < nts ? (((unsigned long long)(unsigned)ts_hi << 32) | (unsigned)ts_lo) : 0ull;
        if (lane == 62) stamps[62] = rt_entry; if (lane == 63) stamps[63] = (unsigned long long)wall_clock64(); }
#undef PG8_STAMP
#undef PG8_SA
#undef PG8_SB
#undef PG8_STAGE
#undef PG8_LDA
#undef PG8_LDB
#undef PG8_MMA
#undef PG8_WAIT_V
#undef PG8_WAIT_L
#undef PG8_BAR
#undef PG8_SCHED
}
}
using pf4 = pg8::f32x4;

struct EpiMain {
  static constexpr bool PERM = false, AFTER_DRAIN = false;
  static constexpr int MID_T = 0;
  const Params& p;
  DI void operator()(const pf4 (&acc)[2][2][4][2], const pg8::Unit& u, int wr, int wc, int fr, int fq) const {
    const int pn = u.pn;
    const int rbase = u.pm * 256 + wr * 64 + fr;
    if (pn < 3) {
      const bool isq = pn < 2, isv = (pn == 2) && (wc >= 2);
      const float* gp = isq ? p.qg : p.kg;
      const int d0 = 16 * (fq >> 1) + 4 * (fq & 1), d1 = 32 + 8 * fq;
      float4 g00 = {1.f, 1.f, 1.f, 1.f}, g01 = g00, g10 = g00, g11 = g00;
      if (!isv) { g00 = *(const float4*)(gp + d0); g01 = *(const float4*)(gp + d0 + 8); g10 = *(const float4*)(gp + d1); g11 = *(const float4*)(gp + d1 + 4); }
      _Pragma("unroll") for (int ai = 0; ai < 2; ++ai) {
        if (u.pm * 256 + 128 * ai >= MTOT) continue;
        _Pragma("unroll") for (int m = 0; m < 4; ++m) {
          const int row = rbase + 128 * ai + 16 * m;
          pf4 a00 = acc[ai][0][m][0], a01 = acc[ai][0][m][1], a10 = acc[ai][1][m][0], a11 = acc[ai][1][m][1];
          if (!isv) {
            float ss = 0.f;
            _Pragma("unroll") for (int j = 0; j < 4; ++j) ss += a00[j] * a00[j] + a01[j] * a01[j] + a10[j] * a10[j] + a11[j] * a11[j];
            ss += __shfl_xor(ss, 16); ss += __shfl_xor(ss, 32);
            const float sc = rsqrtf(ss * (1.f / 64.f) + EPS);
            a00[0] *= sc * g00.x; a00[1] *= sc * g00.y; a00[2] *= sc * g00.z; a00[3] *= sc * g00.w;
            a01[0] *= sc * g01.x; a01[1] *= sc * g01.y; a01[2] *= sc * g01.z; a01[3] *= sc * g01.w;
            a10[0] *= sc * g10.x; a10[1] *= sc * g10.y; a10[2] *= sc * g10.z; a10[3] *= sc * g10.w;
            a11[0] *= sc * g11.x; a11[1] *= sc * g11.y; a11[2] *= sc * g11.z; a11[3] *= sc * g11.w;
            if (fq < 2) {
              const float pos = (float)(row < SEQ ? row : SEQ);
              const float invlo[4] = {1.0f, 0.19392274f, 0.03760603f, 0.0072926646f};
              const float invhi[4] = {0.0014142136f, 0.0002742482f, 5.3182957e-05f, 1.0313385e-05f};
              _Pragma("unroll") for (int j = 0; j < 4; ++j) {
                const float inv = (fq & 1) ? invhi[j] : invlo[j];
                float s_, c_; sincos_red(pos * inv, s_, c_);
                const float x1 = a00[j], x2 = a01[j];
                a00[j] = x1 * c_ - x2 * s_; a01[j] = x2 * c_ + x1 * s_;
              }
            }
          }
          if (isq) {
            bfr* qp = p.Q + (size_t)row * 512 + (4 * pn + wc) * 64;
            *(u32x2*)(qp + d0) = pack4(a00[0] * QSCALE, a00[1] * QSCALE, a00[2] * QSCALE, a00[3] * QSCALE);
            *(u32x2*)(qp + d0 + 8) = pack4(a01[0] * QSCALE, a01[1] * QSCALE, a01[2] * QSCALE, a01[3] * QSCALE);
            u32x4 o; o[0] = pk2(a10[0] * QSCALE, a10[1] * QSCALE); o[1] = pk2(a10[2] * QSCALE, a10[3] * QSCALE);
            o[2] = pk2(a11[0] * QSCALE, a11[1] * QSCALE); o[3] = pk2(a11[2] * QSCALE, a11[3] * QSCALE);
            *(u32x4*)(qp + d1) = o;
          } else {
            const int jh = wc & 1;
            bfr* kp = (isv ? p.Vb : p.Kb) + (size_t)row * 128 + jh * 64;
            *(u32x2*)(kp + d0) = pack4(a00[0], a00[1], a00[2], a00[3]);
            *(u32x2*)(kp + d0 + 8) = pack4(a01[0], a01[1], a01[2], a01[3]);
            u32x4 o; o[0] = pk2(a10[0], a10[1]); o[1] = pk2(a10[2], a10[3]); o[2] = pk2(a11[0], a11[1]); o[3] = pk2(a11[2], a11[3]);
            *(u32x4*)(kp + d1) = o;
            float* op = nullptr;
            if (row >= SEQ) op = (isv ? p.out_vs : p.out_ks) + ((size_t)((row - SEQ) * 128 + 127) * 2 + jh) * 64;
            else if (row >= SEQ - 128) op = (isv ? p.out_vp : p.out_kp) + ((size_t)(row - (SEQ - 128)) * 2 + jh) * 64;
            if (op) {
              *(pf4*)(op + d0) = a00; *(pf4*)(op + d0 + 8) = a01; *(pf4*)(op + d1) = a10; *(pf4*)(op + d1 + 4) = a11;
            }
          }
        }
      }
      return;
    }
    const int cw = 32 * wc + 8 * fq;
    bfr* dst; int ld, col, op;
    if (pn < 5) { dst = p.ZA; ld = 512; col = (pn - 3) * 256; op = 1; }
    else if (pn < 7) { dst = p.QB; ld = 512; col = (pn - 5) * 256; op = 0; }
    else if (pn < 9) { dst = p.ZF; ld = 512; col = (pn - 7) * 256; op = 0; }
    else if (pn < 11) { dst = p.IB; ld = 512; col = (pn - 9) * 256; op = 0; }
    else if (pn < 13) { dst = p.ZB; ld = 512; col = (pn - 11) * 256; op = 1; }
    else if (pn < 17) { dst = p.GA; ld = 1024; col = (pn - 13) * 256; op = 2; }
    else { dst = p.GB; ld = 1024; col = (pn - 17) * 256; op = 2; }
    bfr* const obase = dst + (size_t)rbase * ld + col + cw;
    _Pragma("unroll") for (int bj = 0; bj < 2; ++bj) {
      float4 b0 = {0.f, 0.f, 0.f, 0.f}, b1 = b0;
      if (op == 2) { const float* bp = p.b_merge + (pn - 13) * 256 + 128 * bj + cw; b0 = *(const float4*)bp; b1 = *(const float4*)(bp + 4); }
      _Pragma("unroll") for (int ai = 0; ai < 2; ++ai) {
        if (u.pm * 256 + 128 * ai >= MTOT) continue;
        _Pragma("unroll") for (int m = 0; m < 4; ++m) {
          const int row = rbase + 128 * ai + 16 * m;
          pf4 x = acc[ai][bj][m][0], y = acc[ai][bj][m][1];
          if (op == 1) { _Pragma("unroll") for (int j = 0; j < 4; ++j) { x[j] = siluf_(x[j]); y[j] = siluf_(y[j]); } }
          else if (op == 2) {
            x[0] = sigmoidf_(x[0] + b0.x); x[1] = sigmoidf_(x[1] + b0.y); x[2] = sigmoidf_(x[2] + b0.z); x[3] = sigmoidf_(x[3] + b0.w);
            y[0] = sigmoidf_(y[0] + b1.x); y[1] = sigmoidf_(y[1] + b1.y); y[2] = sigmoidf_(y[2] + b1.z); y[3] = sigmoidf_(y[3] + b1.w);
          }
          u32x4 o; o[0] = pk2(x[0], x[1]); o[1] = pk2(x[2], x[3]); o[2] = pk2(y[0], y[1]); o[3] = pk2(y[2], y[3]);
          __builtin_nontemporal_store(o, (u32x4*)(obase + (128 * ai + 16 * m) * ld + 128 * bj));
        }
      }
    }
  }
};

struct EpiMerge {
  static constexpr bool PERM = true, AFTER_DRAIN = false;
  static constexpr int MID_T = 8;
  const Params& p;
  DI void mid(pf4 (&acc)[2][2][4][2], const pg8::Unit& u, int wr, int wc, int fr, int fq) const {
    int rbase = u.pm * 256 + wr * 64 + fr; const int cbase = u.pn * 256 + 32 * wc + 8 * fq;
    asm volatile("" : "+v"(rbase));
    _Pragma("unroll") for (int ai = 0; ai < 2; ++ai) _Pragma("unroll") for (int m = 0; m < 4; ++m) _Pragma("unroll") for (int bj = 0; bj < 2; ++bj) {
      if (bj == 0 && m == 0) __builtin_amdgcn_sched_barrier(0);
      const size_t off = (size_t)(rbase + 128 * ai + 16 * m) * 1024 + cbase + 128 * bj;
      const u32x4 ga = *(const u32x4*)(p.GA + off), gb = *(const u32x4*)(p.GB + off);
      _Pragma("unroll") for (int e = 0; e < 2; ++e) {
        acc[ai][bj][m][0][2 * e] *= bflo(ga[e]) * __builtin_amdgcn_rcpf(fmaxf(bflo(gb[e]), 1e-30f));
        acc[ai][bj][m][0][2 * e + 1] *= bfhi(ga[e]) * __builtin_amdgcn_rcpf(fmaxf(bfhi(gb[e]), 1e-30f));
        acc[ai][bj][m][1][2 * e] *= bflo(ga[2 + e]) * __builtin_amdgcn_rcpf(fmaxf(bflo(gb[2 + e]), 1e-30f));
        acc[ai][bj][m][1][2 * e + 1] *= bfhi(ga[2 + e]) * __builtin_amdgcn_rcpf(fmaxf(bfhi(gb[2 + e]), 1e-30f));
      }
    }
  }
  DI void operator()(const pf4 (&acc)[2][2][4][2], const pg8::Unit& u, int wr, int wc, int fr, int fq) const {
    const int rbase = u.pm * 256 + wr * 64 + fr, cbase = u.pn * 256 + 32 * wc + 8 * fq;
    _Pragma("unroll") for (int ai = 0; ai < 2; ++ai) {
     u32x4 gv[4][2];
     _Pragma("unroll") for (int m = 0; m < 4; ++m) _Pragma("unroll") for (int bj = 0; bj < 2; ++bj) gv[m][bj] = *(const u32x4*)(p.GB + (size_t)(rbase + 128 * ai + 16 * m) * 1024 + cbase + 128 * bj);
     __builtin_amdgcn_sched_barrier(0);
     _Pragma("unroll") for (int m = 0; m < 4; ++m) _Pragma("unroll") for (int bj = 0; bj < 2; ++bj) {
      const size_t off = (size_t)(rbase + 128 * ai + 16 * m) * 1024 + cbase + 128 * bj;
      const u32x4 g = gv[m][bj];
      const pf4 x = acc[ai][bj][m][0], y = acc[ai][bj][m][1];
      u32x4 o; o[0] = pk2(bflo(g[0]) * x[0], bfhi(g[0]) * x[1]); o[1] = pk2(bflo(g[1]) * x[2], bfhi(g[1]) * x[3]);
      o[2] = pk2(bflo(g[2]) * y[0], bfhi(g[2]) * y[1]); o[3] = pk2(bflo(g[3]) * y[2], bfhi(g[3]) * y[3]);
      *(u32x4*)(p.Y + off) = o;
     }
     __builtin_amdgcn_sched_barrier(0);
    }
  }
};

struct EpiOut {
  static constexpr bool PERM = false, AFTER_DRAIN = false;
  static constexpr int MID_T = 0;
  const Params& p;
  DI void operator()(const pf4 (&acc)[2][2][4][2], const pg8::Unit& u, int wr, int wc, int fr, int fq) const {
    const int rbase = u.pm * 256 + wr * 64 + fr, cbase = u.pn * 256 + 32 * wc + 4 * fq;
    const float* gr = p.mod + (size_t)128 * 3072 + 2048;
    _Pragma("unroll") for (int bj = 0; bj < 2; ++bj) _Pragma("unroll") for (int n = 0; n < 2; ++n) {
      const int c = cbase + 128 * bj + 16 * n;
      const pf4 gt = *(const pf4*)(gr + c);
      pf4 xv[8];
      _Pragma("unroll") for (int q = 0; q < 8; ++q) xv[q] = __builtin_nontemporal_load((const pf4*)(p.x_prompt + (size_t)(rbase + 128 * (q >> 2) + 16 * (q & 3)) * DM + c));
      __builtin_amdgcn_sched_barrier(0);
      _Pragma("unroll") for (int q = 0; q < 8; ++q)
        __builtin_nontemporal_store(xv[q] + gt * acc[q >> 2][bj][q & 3][n], (pf4*)(p.out_yp + (size_t)(rbase + 128 * (q >> 2) + 16 * (q & 3)) * DM + c));
      __builtin_amdgcn_sched_barrier(0);
    }
  }
};

struct EpiOutLds {
  static constexpr bool PERM = false, AFTER_DRAIN = true;
  static constexpr int MID_T = 0;
  const Params& p;
  DI void operator()(const pf4 (&)[2][2][4][2], const pg8::Unit&, int, int, int, int) const {}
  DI void fused(const pf4 (&acc)[2][2][4][2], const pg8::Unit& u, int wr, int wc, int fr, int fq, PG8_LAS unsigned char* lds, int, int) const {
    const float* gr = p.mod + (size_t)128 * 3072 + 2048 + u.pn * 256;
    const int tid = threadIdx.x, c = tid & 63, rsub = tid >> 6;
    pf4 gt[2][2];
    _Pragma("unroll") for (int bj = 0; bj < 2; ++bj) _Pragma("unroll") for (int n = 0; n < 2; ++n) gt[bj][n] = *(const pf4*)(gr + 128 * bj + 32 * wc + 16 * n + 4 * fq);
    _Pragma("unroll") for (int ai = 0; ai < 2; ++ai) {
      _Pragma("unroll") for (int m = 0; m < 4; ++m) _Pragma("unroll") for (int bj = 0; bj < 2; ++bj) _Pragma("unroll") for (int n = 0; n < 2; ++n) {
        const int rl = 64 * wr + 16 * m + fr, chunk = 32 * bj + 8 * wc + 4 * n + fq;
        *(PG8_LAS pf4*)(lds + rl * 1024 + ((chunk ^ fr) << 4)) = gt[bj][n] * acc[ai][bj][m][n];
      }
      __syncthreads();
      const size_t g0 = (size_t)(u.pm * 256 + 128 * ai) * DM + u.pn * 256 + 4 * c;
      {
        pf4 xv[16];
        _Pragma("unroll") for (int q = 0; q < 16; ++q) xv[q] = __builtin_nontemporal_load((const pf4*)(p.x_prompt + g0 + (size_t)(q * 8 + rsub) * DM));
        __builtin_amdgcn_sched_barrier(0);
        _Pragma("unroll") for (int q = 0; q < 16; ++q) {
          const int rl = q * 8 + rsub;
          const pf4 st = *(const PG8_LAS pf4*)(lds + rl * 1024 + ((c ^ (rl & 15)) << 4));
          __builtin_nontemporal_store(xv[q] + st, (pf4*)(p.out_yp + g0 + (size_t)rl * DM));
        }
      }
      __syncthreads();
    }
  }
};

DI f32x16 wave_gemm32(const bfr* __restrict__ A, int lda, const bfr* __restrict__ W, int ldw, int K, int lane) {
  const int r = lane & 31, h = lane >> 5;
  const bfr* ap = A + (size_t)r * lda + 8 * h;
  const bfr* wp = W + (size_t)r * ldw + 8 * h;
  f32x16 acc = zero16();
  for (int k0 = 0; k0 < K; k0 += 128) {
    bf16x8 a[8], b[8];
    _Pragma("unroll") for (int q = 0; q < 8; ++q) { a[q] = *(const bf16x8*)(ap + k0 + 16 * q); b[q] = *(const bf16x8*)(wp + k0 + 16 * q); }
    _Pragma("unroll") for (int q = 0; q < 8; ++q) acc = mfma(b[q], a[q], acc);
  }
  return acc;
}

DI void sample_chain_wave(const Params& p, int wt, int lane) {
  const int mt = wt >> 5, nt = wt & 31, r = lane & 31, h = lane >> 5;
  const int m = 32 * mt + r;
  unsigned* cnt = p.bar + PANEL_CNT_WORD + 64 * mt;
  {
    const f32x16 a1 = wave_gemm32(p.YA + (size_t)(SEQ + 32 * mt) * 1024, 1024, p.Wt_pab + (size_t)(32 * nt) * 1024, 1024, 512, lane);
    const f32x16 a2 = wave_gemm32(p.YB + (size_t)(SEQ + 32 * mt) * 1024, 1024, p.Wt_pab + (size_t)(32 * nt) * 1024 + 512, 1024, 512, lane);
    _Pragma("unroll") for (int g = 0; g < 4; ++g) {
      const int n = 32 * nt + 8 * g + 4 * h;
      const u32x2 ga = *(const u32x2*)(p.GA + (size_t)(SEQ + m) * 1024 + n), gb = *(const u32x2*)(p.GB + (size_t)(SEQ + m) * 1024 + n);
      *(u32x2*)(p.Ys + (size_t)m * 1024 + n) = pack4(bflo(ga[0]) * a1[4 * g] + bflo(gb[0]) * a2[4 * g], bfhi(ga[0]) * a1[4 * g + 1] + bfhi(gb[0]) * a2[4 * g + 1],
                                                     bflo(ga[1]) * a1[4 * g + 2] + bflo(gb[1]) * a2[4 * g + 2], bfhi(ga[1]) * a1[4 * g + 3] + bfhi(gb[1]) * a2[4 * g + 3]);
    }
    __builtin_amdgcn_fence(__ATOMIC_RELEASE, "agent");
    asm volatile("s_waitcnt vmcnt(0)" ::: "memory");
    if (lane == 0) __hip_atomic_fetch_add(cnt, 1u, __ATOMIC_RELAXED, __HIP_MEMORY_SCOPE_AGENT);
  }
  {
    unsigned sp = 0;
    while (__hip_atomic_load(cnt, __ATOMIC_RELAXED, __HIP_MEMORY_SCOPE_AGENT) < 32u) { __builtin_amdgcn_s_sleep(2); if (++sp > (1u << 22)) break; }
    __builtin_amdgcn_fence(__ATOMIC_ACQUIRE, "agent");
    asm volatile("s_waitcnt vmcnt(0)" ::: "memory");
  }
  const f32x16 acc = wave_gemm32(p.Ys + (size_t)(32 * mt) * 1024, 1024, p.Wt_out + (size_t)(32 * nt) * 1024, 1024, 1024, lane);
  _Pragma("unroll") for (int g = 0; g < 4; ++g) {
    const int n = 32 * nt + 8 * g + 4 * h;
    const float4 xv = *(const float4*)(p.x_sample + (size_t)m * DM + n), gt = *(const float4*)(p.mod + (size_t)m * 3072 + 2048 + n);
    float4 o;
    o.x = xv.x + gt.x * acc[4 * g]; o.y = xv.y + gt.y * acc[4 * g + 1]; o.z = xv.z + gt.z * acc[4 * g + 2]; o.w = xv.w + gt.w * acc[4 * g + 3];
    *(float4*)(p.out_ys + (size_t)m * DM + n) = o;
  }
}

DI void attn_prompt_wave(const Params& p, int qt, int hd, int lane) {
  const int r = lane & 31, h = lane >> 5, j = hd >> 2;
  const int q0 = qt * 32, q = q0 + r, kb = q0 - 128;
  bf16x8 qf[4];
  _Pragma("unroll") for (int s = 0; s < 4; ++s) qf[s] = *(const bf16x8*)(p.Q + (size_t)q * 512 + hd * 64 + 16 * s + 8 * h);
  f32x16 sacc[5];
  _Pragma("unroll") for (int kt = 0; kt < 5; ++kt) {
    sacc[kt] = zero16();
    int kr = kb + 32 * kt + r; kr = kr < 0 ? 0 : kr;
    _Pragma("unroll") for (int s = 0; s < 4; ++s) {
      bf16x8 kf = *(const bf16x8*)(p.Kb + (size_t)kr * 128 + j * 64 + 16 * s + 8 * h);
      sacc[kt] = mfma(kf, qf[s], sacc[kt]);
    }
  }
  const float sink = p.sinks[hd] * LOG2E;
  float mx = sink;
  _Pragma("unroll") for (int i = 0; i < 16; ++i) {
    sacc[0][i] = (crow(i, h) > r) ? sacc[0][i] : -INFINITY;
    sacc[4][i] = (crow(i, h) <= r) ? sacc[4][i] : -INFINITY;
  }
  if (q0 < 128) {
    _Pragma("unroll") for (int kt = 0; kt < 4; ++kt) _Pragma("unroll") for (int i = 0; i < 16; ++i)
      sacc[kt][i] = (kb + 32 * kt + crow(i, h) >= 0) ? sacc[kt][i] : -INFINITY;
  }
  _Pragma("unroll") for (int kt = 0; kt < 5; ++kt) _Pragma("unroll") for (int i = 0; i < 16; ++i) mx = fmaxf(mx, sacc[kt][i]);
  mx = fmaxf(mx, __shfl_xor(mx, 32));
  float l = 0.f;
  _Pragma("unroll") for (int kt = 0; kt < 5; ++kt) _Pragma("unroll") for (int i = 0; i < 16; ++i) {
    float pv = __builtin_amdgcn_exp2f(sacc[kt][i] - mx); sacc[kt][i] = pv; l += pv;
  }
  l += __shfl_xor(l, 32);
  l += __builtin_amdgcn_exp2f(sink - mx);
  f32x16 oacc[2]; oacc[0] = zero16(); oacc[1] = zero16();
  const bfr* vbase = p.Vb + j * 64 + 2 * r;
  _Pragma("unroll") for (int kt = 0; kt < 5; ++kt) _Pragma("unroll") for (int s2 = 0; s2 < 2; ++s2) {
    u32x4 pp;
    _Pragma("unroll") for (int e = 0; e < 4; ++e) pp[e] = pk2(sacc[kt][8 * s2 + 2 * e], sacc[kt][8 * s2 + 2 * e + 1]);
    unsigned wv[8];
    _Pragma("unroll") for (int jj = 0; jj < 8; ++jj) {
      int key = kb + 32 * kt + 16 * s2 + 8 * (jj >> 2) + 4 * h + (jj & 3); key = key < 0 ? 0 : key;
      wv[jj] = *(const unsigned*)(vbase + (size_t)key * 128);
    }
    u32x4 v0, v1;
    _Pragma("unroll") for (int e = 0; e < 4; ++e) {
      v0[e] = (wv[2 * e] & 0xffffu) | (wv[2 * e + 1] << 16);
      v1[e] = (wv[2 * e] >> 16) | (wv[2 * e + 1] & 0xffff0000u);
    }
    const bf16x8 pa = __builtin_bit_cast(bf16x8, pp);
    oacc[0] = mfma(pa, __builtin_bit_cast(bf16x8, v0), oacc[0]);
    oacc[1] = mfma(pa, __builtin_bit_cast(bf16x8, v1), oacc[1]);
  }
  const float il = frcp(l);
  unsigned za[16];
  _Pragma("unroll") for (int i = 0; i < 16; ++i) za[i] = *(const unsigned*)(p.ZA + (size_t)(q0 + crow(i, h)) * 512 + hd * 64 + 2 * r);
  __builtin_amdgcn_sched_barrier(0);
  _Pragma("unroll") for (int i = 0; i < 16; ++i) {
    const int qi = crow(i, h);
    const float ili = __shfl(il, qi);
    *(unsigned*)(p.YA + (size_t)(q0 + qi) * 1024 + hd * 64 + 2 * r) = pk2(oacc[0][i] * ili * bflo(za[i]), oacc[1][i] * ili * bfhi(za[i]));
  }
}

DI void attn_sample_wave(const Params& p, int b, int hd, float* sw  ) {
  const int lane = threadIdx.x & 63, j = hd >> 2, m = SEQ + b;
  u32x4 qv[8];
  _Pragma("unroll") for (int i = 0; i < 8; ++i) qv[i] = *(const u32x4*)(p.Q + (size_t)m * 512 + hd * 64 + 8 * i);
  float dn = 0.f;
  _Pragma("unroll") for (int i = 0; i < 8; ++i) {
    u32x4 kv = *(const u32x4*)(p.Kb + (size_t)m * 128 + j * 64 + 8 * i);
    _Pragma("unroll") for (int e = 0; e < 4; ++e) dn += bflo(qv[i][e]) * bflo(kv[e]) + bfhi(qv[i][e]) * bfhi(kv[e]);
  }
  float s[2];
  _Pragma("unroll") for (int u = 0; u < 2; ++u) {
    int idx = lane + 1 + 64 * u;
    int ic = idx < 128 ? idx : 127;
    const float* kp = p.cache_k + ((size_t)(b * 128 + ic) * 2 + j) * 64;
    float4 kk[16];
    _Pragma("unroll") for (int i = 0; i < 16; ++i) kk[i] = *(const float4*)(kp + 4 * i);
    __builtin_amdgcn_sched_barrier(0);
    float d = 0.f;
    _Pragma("unroll") for (int i = 0; i < 8; ++i) {
      const float4 k0 = kk[2 * i], k1 = kk[2 * i + 1];
      d += bflo(qv[i][0]) * k0.x + bfhi(qv[i][0]) * k0.y + bflo(qv[i][1]) * k0.z + bfhi(qv[i][1]) * k0.w;
      d += bflo(qv[i][2]) * k1.x + bfhi(qv[i][2]) * k1.y + bflo(qv[i][3]) * k1.z + bfhi(qv[i][3]) * k1.w;
    }
    s[u] = idx < 128 ? d : dn;
  }
  const float sink = p.sinks[hd] * LOG2E;
  float mx = fmaxf(fmaxf(s[0], s[1]), sink);
  _Pragma("unroll") for (int o = 32; o >= 1; o >>= 1) mx = fmaxf(mx, __shfl_xor(mx, o));
  float p0 = __builtin_amdgcn_exp2f(s[0] - mx), p1 = __builtin_amdgcn_exp2f(s[1] - mx);
  float l = p0 + p1;
  _Pragma("unroll") for (int o = 32; o >= 1; o >>= 1) l += __shfl_xor(l, o);
  l += __builtin_amdgcn_exp2f(sink - mx);
  sw[lane] = p0; sw[64 + lane] = p1;
  __builtin_amdgcn_s_waitcnt(0xc07f);
  __builtin_amdgcn_wave_barrier();
  float o = 0.f;
  const float* vb = p.cache_v + ((size_t)(b * 128) * 2 + j) * 64 + lane;
  _Pragma("unroll 1") for (int i0 = 0; i0 < 128; i0 += 16) {
    float vv[16];
    _Pragma("unroll") for (int q = 0; q < 16; ++q) vv[q] = vb[(size_t)(i0 + q) * 128];
    __builtin_amdgcn_sched_barrier(0);
    _Pragma("unroll") for (int q = 0; q < 16; ++q) { const float pw = (i0 + q) ? sw[i0 + q - 1] : 0.f; o += pw * vv[q]; }
  }
  o += sw[127] * bf2f(p.Vb[(size_t)m * 128 + j * 64 + lane]);
  size_t off = (size_t)m * 512 + hd * 64 + lane;
  p.YA[(size_t)m * 1024 + hd * 64 + lane] = (bfr)f2bf(o * frcp(l) * bf2f(p.ZA[off]));
  __builtin_amdgcn_wave_barrier();
}

DI void hgrn_gates(const Params& p, int row0, int hh, float* sTot, float (&L)[32], float (&kin)[32], float& t0, float& lc) {
  const int t = TID, c = t & 127, half = t >> 7, ch = hh * 128 + c;
  const float lbv = frcp(1.f + __expf(p.lb_logits[512 + ch] - p.lb_logits[ch]));
  const bfr* zp = p.ZF + (size_t)(row0 + half * 32) * 512 + ch;
  float run = 0.f;
  _Pragma("unroll") for (int jj = 0; jj < 32; ++jj) {
    float z = bf2f(zp[(size_t)jj * 512]);
    z = fminf(fmaxf(z, -30.f), 30.f);
    float em = __expf(-z), sg = frcp(1.f + em);
    float f = lbv + (1.f - lbv) * sg;
    kin[jj] = (1.f - lbv) * em * sg;
    run += __logf(f);
    L[jj] = run;
  }
  sTot[half * 128 + c] = run;
  __syncthreads();
  t0 = sTot[c]; lc = t0 + sTot[128 + c];
  if (half) { _Pragma("unroll") for (int jj = 0; jj < 32; ++jj) L[jj] += t0; }
}

DI void hgrn_fused_item(const Params& p, int n, int hh, char* smem) {
  bfr* sVt = (bfr*)smem;
  bfr* sKt = sVt + 128 * LDT;
  bfr* sQh = sKt + 128 * LDT;
  bfr* sKh = sQh + 64 * 136;
  bfr* sAm = sKt;
  float* sTot = (float*)(sKh + 64 * 136);
  const int t = TID, lane = t & 63, w = t >> 6, h = lane >> 5, c = t & 127, half = t >> 7;
  const int row0 = n * 64;
  __syncthreads();
  {
    const bfr* ip = p.IB + (size_t)(row0 + half * 32) * 512 + hh * 128 + c;
    _Pragma("unroll") for (int q4 = 0; q4 < 4; ++q4) {
      u32x4 o;
      _Pragma("unroll") for (int e = 0; e < 4; ++e) {
        int jj = q4 * 8 + 2 * e;
        o[e] = (unsigned)ip[(size_t)jj * 512] | ((unsigned)ip[(size_t)(jj + 1) * 512] << 16);
      }
      *(u32x4*)(sVt + c * LDT + half * 32 + q4 * 8) = o;
    }
  }
  {
    float L[32], kin[32], t0, lc;
    hgrn_gates(p, row0, hh, sTot, L, kin, t0, lc);
    _Pragma("unroll") for (int q4 = 0; q4 < 4; ++q4) {
      u32x4 o;
      _Pragma("unroll") for (int e = 0; e < 4; ++e) {
        int jj = q4 * 8 + 2 * e;
        o[e] = pk2(kin[jj] * __expf(lc - L[jj]), kin[jj + 1] * __expf(lc - L[jj + 1]));
      }
      *(u32x4*)(sKt + c * LDT + half * 32 + q4 * 8) = o;
    }
    if (half == 0) p.dec[(n * 4 + hh) * 128 + c] = __expf(lc);
    bfr* qp = p.QB + (size_t)(row0 + half * 32) * 512 + hh * 128 + c;
    unsigned qraw[16];
    _Pragma("unroll") for (int e = 0; e < 16; ++e) qraw[e] = (unsigned)qp[(size_t)(2 * e) * 512] | ((unsigned)qp[(size_t)(2 * e + 1) * 512] << 16);
    __builtin_amdgcn_sched_barrier(0);
    _Pragma("unroll") for (int jj = 0; jj < 32; ++jj) {
      const float qv = (jj & 1) ? bfhi(qraw[jj >> 1]) : bflo(qraw[jj >> 1]);
      qp[(size_t)jj * 512] = (bfr)(pk2(qv * __expf(L[jj]), 0.f) & 0xffffu);
      const float dl = L[jj] - t0;
      sQh[(half * 32 + jj) * 136 + c] = (bfr)(pk2(qv * __expf(fminf(dl, 80.f)), 0.f) & 0xffffu);
      sKh[(half * 32 + jj) * 136 + c] = (bfr)(pk2(kin[jj] * __expf(fminf(-dl, 80.f)), 0.f) & 0xffffu);
    }
  }
  __syncthreads();
  {
    int r = lane & 31; asm volatile("" : "+v"(r));
    const int wv = w >> 1, wk = w & 1;
    f32x16 acc[2][2];
    _Pragma("unroll") for (int a = 0; a < 2; ++a) _Pragma("unroll") for (int b = 0; b < 2; ++b) acc[a][b] = zero16();
    _Pragma("unroll") for (int s = 0; s < 4; ++s) {
      bf16x8 af[2], bf[2];
      _Pragma("unroll") for (int x = 0; x < 2; ++x) {
        af[x] = *(const bf16x8*)(sVt + (wv * 64 + x * 32 + r) * LDT + 16 * s + 8 * h);
        bf[x] = *(const bf16x8*)(sKt + (wk * 64 + x * 32 + r) * LDT + 16 * s + 8 * h);
      }
      _Pragma("unroll") for (int a = 0; a < 2; ++a) _Pragma("unroll") for (int b = 0; b < 2; ++b) acc[a][b] = mfma(af[a], bf[b], acc[a][b]);
    }
    float* up = p.Ust + (size_t)(n * 4 + hh) * 16384;
    _Pragma("unroll") for (int a = 0; a < 2; ++a) _Pragma("unroll") for (int b = 0; b < 2; ++b) _Pragma("unroll") for (int i = 0; i < 16; ++i) {
      int v = wv * 64 + a * 32 + crow(i, h), k = wk * 64 + b * 32 + r;
      up[v * 128 + k] = acc[a][b][i];
    }
  }
  const int jt = w >> 1, it = w & 1;
  int r2 = lane & 31; asm volatile("" : "+v"(r2));
  f32x16 am = zero16();
  if (jt <= it) {
    _Pragma("unroll") for (int s = 0; s < 8; ++s) {
      bf16x8 kf = *(const bf16x8*)(sKh + (jt * 32 + r2) * 136 + 16 * s + 8 * h);
      bf16x8 qf = *(const bf16x8*)(sQh + (it * 32 + r2) * 136 + 16 * s + 8 * h);
      am = mfma(kf, qf, am);
    }
  }
  __syncthreads();
  {
    int r3 = lane & 31; asm volatile("" : "+v"(r3));
    const int i = it * 32 + r3;
    _Pragma("unroll") for (int g = 0; g < 4; ++g) {
      int j0 = jt * 32 + 8 * g + 4 * h;
      float x0 = (j0 <= i) ? am[4 * g] : 0.f, x1 = (j0 + 1 <= i) ? am[4 * g + 1] : 0.f;
      float x2 = (j0 + 2 <= i) ? am[4 * g + 2] : 0.f, x3 = (j0 + 3 <= i) ? am[4 * g + 3] : 0.f;
      *(u32x2*)(sAm + i * LDT + j0) = pack4(x0, x1, x2, x3);
    }
  }
  __syncthreads();
  {
    int r = lane & 31; asm volatile("" : "+v"(r));
    f32x16 oacc[2]; oacc[0] = zero16(); oacc[1] = zero16();
    _Pragma("unroll") for (int s = 0; s < 4; ++s) {
      bf16x8 vf = *(const bf16x8*)(sVt + (32 * w + r) * LDT + 16 * s + 8 * h);
      _Pragma("unroll") for (int i2 = 0; i2 < 2; ++i2) {
        bf16x8 af2 = *(const bf16x8*)(sAm + (i2 * 32 + r) * LDT + 16 * s + 8 * h);
        oacc[i2] = mfma(vf, af2, oacc[i2]);
      }
    }
    _Pragma("unroll") for (int i2 = 0; i2 < 2; ++i2) _Pragma("unroll") for (int g = 0; g < 4; ++g)
      *(u32x2*)(p.YB + (size_t)(row0 + i2 * 32 + r) * 1024 + hh * 128 + 32 * w + 8 * g + 4 * h) =
          pack4(oacc[i2][4 * g], oacc[i2][4 * g + 1], oacc[i2][4 * g + 2], oacc[i2][4 * g + 3]);
  }
}

DI void hgrn_sample_wave(const Params& p, int b, int hh, int lane, float* sw  ) {
  const int m = SEQ + b;
  _Pragma("unroll") for (int u = 0; u < 2; ++u) {
    const int k = lane + 64 * u, ch = hh * 128 + k;
    const float lbv = frcp(1.f + __expf(p.lb_logits[512 + ch] - p.lb_logits[ch]));
    float z = bf2f(p.ZF[(size_t)m * 512 + ch]);
    z = fminf(fmaxf(z, -30.f), 30.f);
    const float em = __expf(-z), sg = frcp(1.f + em);
    sw[k] = lbv + (1.f - lbv) * sg; sw[128 + k] = (1.f - lbv) * em * sg; sw[256 + k] = bf2f(p.QB[(size_t)m * 512 + ch]);
  }
  const int v4 = (lane & 31) * 4, kg = lane >> 5;
  const u32x2 vraw = *(const u32x2*)(p.IB + (size_t)m * 512 + hh * 128 + v4);
  const float4 vv = {bflo(vraw[0]), bfhi(vraw[0]), bflo(vraw[1]), bfhi(vraw[1])};
  __builtin_amdgcn_s_waitcnt(0xc07f);
  __builtin_amdgcn_wave_barrier();
  float4 o = {0.f, 0.f, 0.f, 0.f};
  const size_t sb = (size_t)(b * 4 + hh) * 16384 + (size_t)(kg * 64) * 128 + v4;
  const volatile float* swv = sw;
  _Pragma("unroll 1") for (int k0 = 0; k0 < 64; k0 += 16) {
    float4 Sv[16];
    _Pragma("unroll") for (int q = 0; q < 16; ++q) Sv[q] = *(const float4*)(p.state + sb + (k0 + q) * 128);
    __builtin_amdgcn_sched_barrier(0);
    _Pragma("unroll") for (int q = 0; q < 16; ++q) {
      const int k = kg * 64 + k0 + q;
      const float4 S = Sv[q];
      const float f = swv[k], ki = swv[128 + k], qq = swv[256 + k];
      float4 Sn; Sn.x = f * S.x + ki * vv.x; Sn.y = f * S.y + ki * vv.y; Sn.z = f * S.z + ki * vv.z; Sn.w = f * S.w + ki * vv.w;
      *(float4*)(p.out_ss + sb + (k0 + q) * 128) = Sn;
      o.x += qq * Sn.x; o.y += qq * Sn.y; o.z += qq * Sn.z; o.w += qq * Sn.w;
    }
  }
  o.x += __shfl_xor(o.x, 32); o.y += __shfl_xor(o.y, 32); o.z += __shfl_xor(o.z, 32); o.w += __shfl_xor(o.w, 32);
  float ss = o.x * o.x + o.y * o.y + o.z * o.z + o.w * o.w;
  _Pragma("unroll") for (int of = 16; of >= 1; of >>= 1) ss += __shfl_xor(ss, of);
  const float sc = rsqrtf(ss * (1.f / 128.f) + EPS);
  if (kg == 0) {
    const float4 og = *(const float4*)(p.og + v4);
    const u32x2 zb = *(const u32x2*)(p.ZB + (size_t)m * 512 + hh * 128 + v4);
    *(u32x2*)(p.YB + (size_t)m * 1024 + hh * 128 + v4) = pack4(o.x * sc * og.x * bflo(zb[0]), o.y * sc * og.y * bfhi(zb[0]), o.z * sc * og.z * bflo(zb[1]), o.w * sc * og.w * bfhi(zb[1]));
  }
  __builtin_amdgcn_wave_barrier();
}

DI void cache_shift_copy(const Params& p, int gw, int nw, int lane, int part) {
  const int lo = part * (64 * 4064), hi = lo + 64 * 4064, st = nw * 64;
  for (int idx0 = lo + gw * 64 + lane; idx0 < hi; idx0 += 4 * st) {
    const int i0 = idx0, i1 = min(idx0 + st, hi - 1), i2 = min(idx0 + 2 * st, hi - 1), i3 = min(idx0 + 3 * st, hi - 1);
#define CSC_SRC(i) ((size_t)((i) / 4064) * 16384 + 128 + (size_t)((i) % 4064) * 4)
#define CSC_DST(i) ((size_t)((i) / 4064) * 16384 + (size_t)((i) % 4064) * 4)
    const float4 ka = *(const float4*)(p.cache_k + CSC_SRC(i0)), kb = *(const float4*)(p.cache_k + CSC_SRC(i1));
    const float4 kc = *(const float4*)(p.cache_k + CSC_SRC(i2)), kd = *(const float4*)(p.cache_k + CSC_SRC(i3));
    const float4 va = *(const float4*)(p.cache_v + CSC_SRC(i0)), vb = *(const float4*)(p.cache_v + CSC_SRC(i1));
    const float4 vc = *(const float4*)(p.cache_v + CSC_SRC(i2)), vd = *(const float4*)(p.cache_v + CSC_SRC(i3));
    __builtin_amdgcn_sched_barrier(0);
    *(float4*)(p.out_ks + CSC_DST(i0)) = ka; *(float4*)(p.out_vs + CSC_DST(i0)) = va;
    *(float4*)(p.out_ks + CSC_DST(i1)) = kb; *(float4*)(p.out_vs + CSC_DST(i1)) = vb;
    *(float4*)(p.out_ks + CSC_DST(i2)) = kc; *(float4*)(p.out_vs + CSC_DST(i2)) = vc;
    *(float4*)(p.out_ks + CSC_DST(i3)) = kd; *(float4*)(p.out_vs + CSC_DST(i3)) = vd;
#undef CSC_SRC
#undef CSC_DST
  }
}

DI void phase_mix(const Params& p, char* smem, char* smem_all) {
  const int wave = threadIdx.x >> 6, lane = threadIdx.x & 63, gw = blockIdx.x * 8 + wave, nw = gridDim.x * 8;
  float* sw = (float*)(smem_all + wave * 2048);
  if (gw & 1) {
    for (int it = gw >> 1; it < 1024; it += nw >> 1) attn_sample_wave(p, it >> 3, it & 7, sw);
    cache_shift_copy(p, gw >> 1, nw >> 1, lane, 0);
    for (int it = gw; it < 4096; it += nw) attn_prompt_wave(p, it >> 3, it & 7, lane);
  } else {
    int it = gw;
    if (it < 4096) { attn_prompt_wave(p, it >> 3, it & 7, lane); it += nw; }
    if ((gw & 3) == 0) { for (int hs = gw >> 2; hs < 512; hs += nw >> 2) hgrn_sample_wave(p, hs >> 2, hs & 3, lane, sw); }
    cache_shift_copy(p, gw >> 1, nw >> 1, lane, 1);
    for (; it < 4096; it += nw) attn_prompt_wave(p, it >> 3, it & 7, lane);
  }
  for (int it = VBID; it < 1024; it += VGRID) hgrn_fused_item(p, it >> 2, it & 3, smem);
}

#define SCAN_LOAD(U, Dd, N0) _Pragma("unroll") for (int i = 0; i < 32; ++i) { U[i] = up[(size_t)((N0) + i) * 65536]; Dd[i] = dp[((N0) + i) * 512]; }
#define SCAN_STEP(U, Dd, N0) _Pragma("unroll") for (int i = 0; i < 32; ++i) { sp[(size_t)((N0) + i) * 65536] = (bfr)(pk2(S, 0.f) & 0xffffu); S = Dd[i] * S + U[i]; }
DI void phase_scan(const Params& p, int eb) {
  const int e = eb * 256 + threadIdx.x;
  const int hh = e >> 14, k = e & 127, v = (e >> 7) & 127;
  const float* up = p.Ust + e;
  bfr* sp = p.S16 + e;
  const float* dp = p.dec + hh * 128 + k;
  float S = 0.f;
  float ua[32], da[32], ub[32], db[32];
  SCAN_LOAD(ua, da, 0)
  for (int n0 = 0; n0 < NCH; n0 += 64) {
    SCAN_LOAD(ub, db, n0 + 32)
    SCAN_STEP(ua, da, n0)
    if (n0 + 64 < NCH) { SCAN_LOAD(ua, da, n0 + 64) }
    SCAN_STEP(ub, db, n0 + 32)
  }
  p.out_sp[(hh * 128 + k) * 128 + v] = S;
}

DI void hgrn_out_wave(const Params& p, int n, int hh, int it, int lane) {
  const int r = lane & 31, h = lane >> 5;
  const size_t row = (size_t)(n * 64 + it * 32 + r);
  bf16x8 qf[8];
  _Pragma("unroll") for (int s = 0; s < 8; ++s) qf[s] = *(const bf16x8*)(p.QB + row * 512 + hh * 128 + 16 * s + 8 * h);
  const bfr* sb = p.S16 + (size_t)(n * 4 + hh) * 16384 + (size_t)r * 128 + 8 * h;
  f32x16 acc[4];
  _Pragma("unroll") for (int vt = 0; vt < 4; ++vt) {
    acc[vt] = zero16();
    _Pragma("unroll") for (int s = 0; s < 8; ++s) {
      bf16x8 sf = *(const bf16x8*)(sb + vt * 32 * 128 + 16 * s);
      acc[vt] = mfma(sf, qf[s], acc[vt]);
    }
  }
  float ss = 0.f;
  _Pragma("unroll") for (int vt = 0; vt < 4; ++vt) _Pragma("unroll") for (int g = 0; g < 4; ++g) {
    const u32x2 oi = *(const u32x2*)(p.YB + row * 1024 + hh * 128 + 32 * vt + 8 * g + 4 * h);
    acc[vt][4 * g] += bflo(oi[0]); acc[vt][4 * g + 1] += bfhi(oi[0]); acc[vt][4 * g + 2] += bflo(oi[1]); acc[vt][4 * g + 3] += bfhi(oi[1]);
    ss += acc[vt][4 * g] * acc[vt][4 * g] + acc[vt][4 * g + 1] * acc[vt][4 * g + 1] + acc[vt][4 * g + 2] * acc[vt][4 * g + 2] + acc[vt][4 * g + 3] * acc[vt][4 * g + 3];
  }
  ss += __shfl_xor(ss, 32);
  const float sc = rsqrtf(ss * (1.f / 128.f) + EPS);
  u32x2 zbv[16];
  _Pragma("unroll") for (int vt = 0; vt < 4; ++vt) _Pragma("unroll") for (int g = 0; g < 4; ++g) zbv[vt * 4 + g] = *(const u32x2*)(p.ZB + row * 512 + hh * 128 + 32 * vt + 8 * g + 4 * h);
  __builtin_amdgcn_sched_barrier(0);
  _Pragma("unroll") for (int vt = 0; vt < 4; ++vt) _Pragma("unroll") for (int g = 0; g < 4; ++g) {
    const int v = 32 * vt + 8 * g + 4 * h;
    const float4 og = *(const float4*)(p.og + v);
    const u32x2 zb = zbv[vt * 4 + g];
    *(u32x2*)(p.YB + row * 1024 + hh * 128 + v) = pack4(acc[vt][4 * g] * sc * og.x * bflo(zb[0]), acc[vt][4 * g + 1] * sc * og.y * bfhi(zb[0]),
                                                        acc[vt][4 * g + 2] * sc * og.z * bflo(zb[1]), acc[vt][4 * g + 3] * sc * og.w * bfhi(zb[1]));
  }
}

#define XB_TMO      128
#define XB_XCNT(j)  (256  + 64 * (j))
#define XB_XSUB(j)  (1280 + 64 * (j))
#define XB_XGEN(j)  (2304 + 64 * (j))
#define XB_TOP      3328
#define XB_TOPGEN   3392
#define XCD_BAR_WORDS 3456
#define XB_SPIN_CAP (1u << 18)
#define LAS __attribute__((address_space(3)))

__device__ __forceinline__ unsigned xb_ld(unsigned* p)              { return __hip_atomic_load(p, __ATOMIC_RELAXED, __HIP_MEMORY_SCOPE_AGENT); }
__device__ __forceinline__ unsigned xb_add(unsigned* p, unsigned v) { return __hip_atomic_fetch_add(p, v, __ATOMIC_RELAXED, __HIP_MEMORY_SCOPE_AGENT); }
__device__ __forceinline__ unsigned xb_xcc_id() { return (unsigned)__builtin_amdgcn_s_getreg((3 << 11) | 20) & 0xFu; }
#define XB_SPIN(cond, bar) do { unsigned _sp = 0; while (cond) { __builtin_amdgcn_s_sleep(1); \
    if ((++_sp & 255u) == 0u) { if (xb_ld(&(bar)[XB_TMO])) break; if (_sp > XB_SPIN_CAP) { atomicAdd(&(bar)[XB_TMO], 1u); break; } } } } while (0)

struct XcdBarrier {
    unsigned* bar; unsigned x;
    volatile LAS unsigned* st;
};

__device__ __forceinline__ XcdBarrier xcd_barrier_post(unsigned* bar, volatile LAS unsigned* st) {
    XcdBarrier b; b.bar = bar; b.x = xb_xcc_id(); b.st = st;
    if (threadIdx.x == 0) (void)xb_add(&bar[XB_XCNT(b.x)], 1u);
    return b;
}
__device__ __forceinline__ void xcd_barrier_complete(unsigned* bar, unsigned x, unsigned& nloc, unsigned& nx) {
    const unsigned G = gridDim.x * gridDim.y * gridDim.z;
    unsigned sum, cnt, mine, sp = 0u;
    for (;;) {
        sum = 0u; cnt = 0u; mine = 0u;
#pragma unroll
        for (unsigned j = 0; j < 16; ++j) { const unsigned c = xb_ld(&bar[XB_XCNT(j)]); sum += c; cnt += (c > 0u) ? 1u : 0u; mine = (j == x) ? c : mine; }
        if (sum == G) break;
        __builtin_amdgcn_s_sleep(1);
        if ((++sp & 255u) == 0u) { if (xb_ld(&bar[XB_TMO])) break; if (sp > XB_SPIN_CAP) { atomicAdd(&bar[XB_TMO], 1u); break; } }
    }
    nloc = mine > 0u ? mine : 1u; nx = cnt > 0u ? cnt : 1u;
}

__device__ __forceinline__ void xcd_barrier(const XcdBarrier& b) {
    asm volatile("s_waitcnt vmcnt(0)" ::: "memory");
    __syncthreads();
    if (threadIdx.x == 0) {
        unsigned* bar = b.bar;
        __builtin_amdgcn_s_waitcnt(0);
        unsigned nloc = b.st[0], nx = b.st[1];
        if (nloc == 0u) { xcd_barrier_complete(bar, b.x, nloc, nx); b.st[0] = nloc; b.st[1] = nx; }
        const unsigned old = xb_add(&bar[XB_XSUB(b.x)], 1u);
        const unsigned gen = old / nloc;
        if (old + 1u == (gen + 1u) * nloc) {
            __builtin_amdgcn_fence(__ATOMIC_RELEASE, "agent");
            asm volatile("s_waitcnt vmcnt(0)" ::: "memory");
            const unsigned og = xb_add(&bar[XB_TOP], 1u);
            const unsigned tg = og / nx;
            if (og + 1u == (tg + 1u) * nx) xb_add(&bar[XB_TOPGEN], 1u);
            else XB_SPIN(xb_ld(&bar[XB_TOPGEN]) == tg, bar);
            __builtin_amdgcn_fence(__ATOMIC_ACQUIRE, "agent");
            xb_add(&bar[XB_XGEN(b.x)], 1u);
            asm volatile("s_waitcnt vmcnt(0)" ::: "memory");
        } else {
            XB_SPIN(xb_ld(&bar[XB_XGEN(b.x)]) == gen, bar);
            __builtin_amdgcn_fence(__ATOMIC_ACQUIRE, "agent");
            asm volatile("s_waitcnt vmcnt(0)" ::: "memory");
        }
    }
    __syncthreads();
}

static_assert(PANEL_CNT_WORD == XCD_BAR_WORDS, "panel counters follow the barrier words");
__global__ void __launch_bounds__(512, 2) hybrid_megakernel(Params p) {
  extern __shared__ __attribute__((aligned(16))) char smem_all[];
  __shared__ uint4 xb_words;
  if (threadIdx.x == 0) xb_words = make_uint4(0u, 0u, 0u, 0u);
  __syncthreads();
  const XcdBarrier xb = xcd_barrier_post(p.bar, (volatile LAS unsigned*)&xb_words);
  char* smem = smem_all + (threadIdx.x >> 8) * 73728;
#ifndef REPMASK
#define REPMASK 0
#endif
#define RUN_PHASE(n, ...) if (p.phase_lo <= n && n <= p.phase_hi) { if (n != p.phase_lo) xcd_barrier(xb); __VA_ARGS__; if ((REPMASK >> n) & 1) { xcd_barrier(xb); __VA_ARGS__; } }
  RUN_PHASE(0, phase_prep(p, smem))
  RUN_PHASE(1, { if (VBID < 48) phase_mod(p, smem); else phase_prep2(p, smem, VBID - 48, VGRID - 48); })
  RUN_PHASE(2, phase_h(p))
  RUN_PHASE(3, {
    pg8::Gemm g{p.H, p.Wt_all, MPAD, NALL, 1024};
    pg8::StaticOrder S; S.init(MPAD, NALL, (int)gridDim.x, (int)blockIdx.x);
    EpiMain E{p};
    pg8::gemm_phase<EpiMain, pg8::StaticOrder, false>((PG8_LAS unsigned char*)smem_all, g, S, E, nullptr);
  })
  RUN_PHASE(4, phase_mix(p, smem, smem_all))
  RUN_PHASE(5, {
    if (threadIdx.x < 256) { for (int eb = blockIdx.x; eb < 256; eb += gridDim.x) phase_scan(p, eb); }
    else { const int wt = blockIdx.x * 4 + ((threadIdx.x >> 6) - 4); if (wt < 128) sample_chain_wave(p, wt, threadIdx.x & 63); }
  })
  RUN_PHASE(6, {
    for (int wi = blockIdx.x * 8 + (threadIdx.x >> 6); wi < 2048; wi += gridDim.x * 8) hgrn_out_wave(p, wi >> 3, (wi >> 1) & 3, wi & 1, threadIdx.x & 63);
  })
  RUN_PHASE(7, {
    pg8::Gemm g{p.YA, p.Wt_pab, SEQ, 1024, 1024};
    pg8::StaticOrder S; S.init(SEQ, 1024, (int)gridDim.x, (int)blockIdx.x);
    EpiMerge E{p};
    pg8::gemm_phase<EpiMerge, pg8::StaticOrder, false>((PG8_LAS unsigned char*)smem_all, g, S, E, nullptr);
  })
  RUN_PHASE(8, {
    pg8::Gemm g{p.Y, p.Wt_out, SEQ, 1024, 1024};
    pg8::StaticOrder S; S.init(SEQ, 1024, (int)gridDim.x, (int)blockIdx.x);
    if ((int)gridDim.x == (SEQ / 256) * 4) {
      EpiOutLds E{p};
      pg8::gemm_phase<EpiOutLds, pg8::StaticOrder, false>((PG8_LAS unsigned char*)smem_all, g, S, E, nullptr);
    } else {
      EpiOut E{p};
      pg8::gemm_phase<EpiOut, pg8::StaticOrder, false>((PG8_LAS unsigned char*)smem_all, g, S, E, nullptr);
    }
  })
}

#ifndef ONE_LAUNCH
#define ONE_LAUNCH 1
#endif
constexpr size_t kDynLds = 147456;

extern "C" void kernel_launch(void* const* d_in, const int* in_sizes, int n_in, void* d_out, int out_size, void* d_ws, size_t ws_size,
                              hipStream_t stream) {
  static int grid_blocks = 0;
  if (!grid_blocks) {
    int dev = 0, cus = 0, per_cu = 0;
    (void)hipGetDevice(&dev);
    (void)hipDeviceGetAttribute(&cus, hipDeviceAttributeMultiprocessorCount, dev);
    (void)hipFuncSetAttribute((const void*)hybrid_megakernel, hipFuncAttributeMaxDynamicSharedMemorySize, (int)kDynLds);
    (void)hipOccupancyMaxActiveBlocksPerMultiprocessor(&per_cu, hybrid_megakernel, 512, kDynLds);
    if (per_cu > 1) per_cu = 1;
    if (per_cu < 1) per_cu = 1;
    grid_blocks = cus * per_cu;
  }
  Params p{};
  const float* const* in = (const float* const*)d_in;
  p.x_prompt = in[0]; p.x_sample = in[1]; p.cache_k = in[2]; p.cache_v = in[3]; p.state = in[4]; p.c_prompt = in[5]; p.c_sample = in[6];
  p.w_ada = in[7]; p.b_ada = in[8]; p.norm_g = in[9]; p.w_in = in[10]; p.qg = in[11]; p.kg = in[12]; p.sinks = in[13]; p.lb_logits = in[14];
  p.og = in[15]; p.w_merge = in[16]; p.b_merge = in[17]; p.w_pa = in[18]; p.w_pb = in[19]; p.w_out = in[20];
  float* o = (float*)d_out;
  p.out_yp = o; o += (size_t)SEQ * DM;
  p.out_ys = o; o += (size_t)NBT * DM;
  p.out_kp = o; o += 128 * 128;
  p.out_vp = o; o += 128 * 128;
  p.out_sp = o; o += 4 * 128 * 128;
  p.out_ks = o; o += (size_t)NBT * 128 * 128;
  p.out_vs = o; o += (size_t)NBT * 128 * 128;
  p.out_ss = o;
  char* wsp = (char*)d_ws;
  auto take = [&](size_t bytes) { char* r = wsp; wsp += (bytes + 255) & ~(size_t)255; return r; };
  p.bar = (unsigned*)take((size_t)(XCD_BAR_WORDS + 256) * 4);
  p.Wt_all = (bfr*)take((size_t)NALL * 1024 * 2);
  p.Wt_pab = (bfr*)take((size_t)1024 * 1024 * 2);
  p.Wt_out = (bfr*)take((size_t)1024 * 1024 * 2);
  p.Wt_ada = (bfr*)take((size_t)3072 * 1024 * 2);
  p.Cb = (bfr*)take((size_t)256 * 1024 * 2);
  p.mod = (float*)take((size_t)256 * 3072 * 4);
  p.Ys = (bfr*)take((size_t)128 * 1024 * 2);
  p.H = (bfr*)take((size_t)MPAD * 1024 * 2);
  p.YA = p.H; p.YB = p.H + 512;
  p.ZA = (bfr*)take((size_t)MTOT * 512 * 2);
  p.S16 = p.ZA;
  p.Q = (bfr*)take((size_t)MTOT * 512 * 2);
  p.QB = (bfr*)take((size_t)MTOT * 512 * 2);
  p.Y = p.Q;
  p.Kb = (bfr*)take((size_t)MTOT * 128 * 2);
  p.Vb = (bfr*)take((size_t)MTOT * 128 * 2);
  p.IB = (bfr*)take((size_t)MTOT * 512 * 2);
  p.ZB = (bfr*)take((size_t)MTOT * 512 * 2);
  p.ZF = (bfr*)take((size_t)MTOT * 512 * 2);
  p.GA = (bfr*)take((size_t)MTOT * 1024 * 2);
  p.GB = (bfr*)take((size_t)MTOT * 1024 * 2);
  p.dec = (float*)take((size_t)NCH * 4 * 128 * 4);
  p.Ust = p.out_yp;
  if ((size_t)(wsp - (char*)d_ws) > ws_size) { fprintf(stderr, "workspace too small\n"); return; }
  (void)hipMemsetAsync(p.bar, 0, (size_t)(XCD_BAR_WORDS + 256) * 4, stream);
#if ONE_LAUNCH
  p.phase_lo = 0; p.phase_hi = 8;
  void* args[] = {&p};
  hipError_t e = hipLaunchCooperativeKernel((void*)hybrid_megakernel, dim3(grid_blocks), dim3(512), args, kDynLds, stream);
  if (e != hipSuccess) fprintf(stderr, "cooperative launch failed: %s (grid %d)\n", hipGetErrorString(e), grid_blocks);
#else
  for (int ph = 0; ph <= 8; ++ph) {
    p.phase_lo = ph; p.phase_hi = ph;
    hipLaunchKernelGGL(hybrid_megakernel, dim3(grid_blocks), dim3(512), kDynLds, stream, p);
  }
#endif
}
```

```cpp
#include <hip/hip_runtime.h>
#include <cstdio>

#define DI __device__ __forceinline__
typedef unsigned short bfr;
using bf16x8 = __attribute__((ext_vector_type(8))) short;
using f32x16 = __attribute__((ext_vector_type(16))) float;
using u32x4 = __attribute__((ext_vector_type(4))) unsigned;
using u32x2 = __attribute__((ext_vector_type(2))) unsigned;

constexpr int DM = 1024, SEQ = 16384, NBT = 128, MTOT = SEQ + NBT;
constexpr int NALL = 5376;
constexpr int NCH = 256;
constexpr float EPS = 1e-6f;
constexpr float LOG2E = 1.4426950408889634f;
constexpr float QSCALE = 0.125f * 1.4426950408889634f;
constexpr int PANEL_CNT_WORD = 3456;
constexpr int LDT = 72;
constexpr int MPAD = 16640;
#define TID ((int)(threadIdx.x & 255))
#define VBID ((int)(blockIdx.x * 2 + (threadIdx.x >> 8)))
#define VGRID ((int)(gridDim.x * 2))

struct Params {
  const float *x_prompt, *x_sample, *cache_k, *cache_v, *state, *c_prompt, *c_sample;
  const float *w_ada, *b_ada, *norm_g, *w_in, *qg, *kg, *sinks, *lb_logits, *og, *w_merge, *b_merge, *w_pa, *w_pb, *w_out;
  float *out_yp, *out_ys, *out_kp, *out_vp, *out_sp, *out_ks, *out_vs, *out_ss;
  bfr *Wt_all, *Wt_pab, *Wt_out, *Wt_ada, *Cb, *H, *Q, *QB, *Kb, *Vb, *ZA, *IB, *ZB, *GA, *GB, *YA, *YB, *Y;
  float *mod, *dec, *Ust;
  bfr* ZF;
  bfr* S16;
  bfr* Ys;
  unsigned* bar;
  int phase_lo, phase_hi;
};

DI unsigned f2bf(float x) { unsigned u = __float_as_uint(x); u += 0x7fffu + ((u >> 16) & 1u); return u >> 16; }
typedef __bf16 hbf2 __attribute__((ext_vector_type(2)));
typedef float hf2 __attribute__((ext_vector_type(2)));
DI unsigned pk2(float a, float b) { hf2 v = {a, b}; return __builtin_bit_cast(unsigned, __builtin_convertvector(v, hbf2)); }
DI float bf2f(unsigned b) { return __uint_as_float(b << 16); }
DI float bflo(unsigned u) { return __uint_as_float(u << 16); }
DI float bfhi(unsigned u) { return __uint_as_float(u & 0xffff0000u); }
DI int crow(int i, int h) { return (i & 3) + 8 * (i >> 2) + 4 * h; }
DI f32x16 mfma(bf16x8 a, bf16x8 b, f32x16 c) { return __builtin_amdgcn_mfma_f32_32x32x16_bf16(a, b, c, 0, 0, 0); }
DI f32x16 zero16() { f32x16 z; _Pragma("unroll") for (int i = 0; i < 16; ++i) z[i] = 0.f; return z; }
DI float frcp(float x) { return __builtin_amdgcn_rcpf(x); }
DI float fexp(float x) { return __builtin_amdgcn_exp2f(x * 1.4426950408889634f); }
DI float sigmoidf_(float x) { return frcp(1.f + fexp(-x)); }
DI float siluf_(float x) { return x * frcp(1.f + fexp(-x)); }
DI u32x2 pack4(float a, float b, float c, float d) { u32x2 r; r[0] = pk2(a, b); r[1] = pk2(c, d); return r; }

DI int wt_row_of_col(int c) {
  const int pn = c >> 8, cl = c & 255;
  int slot;
  if (pn < 3) {
    const int g = cl >> 6, d = cl & 63;
    if (d >= 32) { const int x = d - 32; slot = 128 + 32 * g + 16 * ((x >> 2) & 1) + 4 * (x >> 3) + (x & 3); }
    else { const int fq = 2 * (d >> 4) + ((d >> 2) & 1), n = (d >> 3) & 1, j = d & 3; slot = 32 * g + 16 * n + 4 * fq + j; }
  } else {
    const int bj = cl >> 7, g = (cl >> 5) & 3, x = cl & 31;
    slot = 128 * bj + 32 * g + 16 * ((x >> 2) & 1) + 4 * (x >> 3) + (x & 3);
  }
  return (pn << 8) + slot;
}

DI void gemm_mainloop(const bfr* __restrict__ A, int lda, int m0, const bfr* __restrict__ W, int ldw, int n0, int K,
                      bfr* sA, bfr* sW, f32x16 (&acc)[2][2]) {
  const int t = TID, lane = t & 63, w = t >> 6, wn = w >> 1, wm = w & 1, r = lane & 31, h = lane >> 5;
  const int lrow = t >> 3, lk = (t & 7) * 8;
  const bfr* ap = A + (size_t)(m0 + lrow) * lda + lk;
  const bfr* wp = W + (size_t)(n0 + lrow) * ldw + lk;
  u32x4 ra[4], rw[4];
  _Pragma("unroll") for (int i = 0; i < 4; ++i) {
    ra[i] = *(const u32x4*)(ap + (size_t)(32 * i) * lda);
    rw[i] = *(const u32x4*)(wp + (size_t)(32 * i) * ldw);
  }
  const int nk = K >> 6;
  for (int kt = 0; kt < nk; ++kt) {
    __syncthreads();
    _Pragma("unroll") for (int i = 0; i < 4; ++i) {
      *(u32x4*)(sA + (lrow + 32 * i) * LDT + lk) = ra[i];
      *(u32x4*)(sW + (lrow + 32 * i) * LDT + lk) = rw[i];
    }
    __syncthreads();
    if (kt + 1 < nk) {
      ap += 64; wp += 64;
      _Pragma("unroll") for (int i = 0; i < 4; ++i) {
        ra[i] = *(const u32x4*)(ap + (size_t)(32 * i) * lda);
        rw[i] = *(const u32x4*)(wp + (size_t)(32 * i) * ldw);
      }
    }
    _Pragma("unroll") for (int kk = 0; kk < 4; ++kk) {
      bf16x8 af[2], bf[2];
      _Pragma("unroll") for (int x = 0; x < 2; ++x) {
        af[x] = *(const bf16x8*)(sW + (wn * 64 + x * 32 + r) * LDT + kk * 16 + 8 * h);
        bf[x] = *(const bf16x8*)(sA + (wm * 64 + x * 32 + r) * LDT + kk * 16 + 8 * h);
      }
      _Pragma("unroll") for (int nt = 0; nt < 2; ++nt)
        _Pragma("unroll") for (int mt = 0; mt < 2; ++mt) acc[nt][mt] = mfma(af[nt], bf[mt], acc[nt][mt]);
    }
  }
}

template <int PERMBASE> DI void transpose_tile(const float* __restrict__ src, int N, bfr* __restrict__ dst, int K, int kt, int nt, float* sm) {
  const int t = TID, k0 = kt * 64, n0 = nt * 64;
  __syncthreads();
  _Pragma("unroll") for (int i = 0; i < 16; ++i) {
    int idx = i * 256 + t, kk = idx >> 6, nn = idx & 63;
    sm[kk * 65 + nn] = src[(size_t)(k0 + kk) * N + n0 + nn];
  }
  __syncthreads();
  _Pragma("unroll") for (int i = 0; i < 8; ++i) {
    int idx = i * 256 + t, nn = idx >> 5, kk = (idx & 31) * 2;
    const int drow = PERMBASE >= 0 ? wt_row_of_col(PERMBASE + n0 + nn) : n0 + nn;
    *(unsigned*)(dst + (size_t)drow * K + k0 + kk) = pk2(sm[kk * 65 + nn], sm[(kk + 1) * 65 + nn]);
  }
}

DI void phase_prep(const Params& p, char* smem) {
  float* sm = (float*)smem;
  for (int it = VBID; it < 768; it += VGRID) transpose_tile<-1>(p.w_ada, 3072, p.Wt_ada, 1024, it / 48, it % 48, sm);
  for (int idx = VBID * 256 + TID; idx < 256 * 1024; idx += VGRID * 256) {
    int row = idx >> 10, col = idx & 1023;
    float v = row < 128 ? p.c_sample[row * 1024 + col] : (row == 128 ? p.c_prompt[col] : 0.f);
    p.Cb[idx] = (bfr)f2bf(v);
  }
}
DI void phase_prep2(const Params& p, char* smem, int vb0, int nvb) {
  float* sm = (float*)smem;
  for (int it = vb0; it < 1856; it += nvb) {
    int i = it;
    if (i < 832) { transpose_tile<0>(p.w_in, 3328, p.Wt_all, 1024, i / 52, i % 52, sm); continue; }
    i -= 832;
    if (i < 512) { transpose_tile<3328>(p.w_merge, 2048, p.Wt_all, 1024, i / 32, i % 32, sm); continue; }
    i -= 512;
    if (i < 128) { transpose_tile<-1>(p.w_pa, 1024, p.Wt_pab, 1024, i / 16, i % 16, sm); continue; }
    i -= 128;
    if (i < 128) { transpose_tile<-1>(p.w_pb, 1024, p.Wt_pab + 512, 1024, i / 16, i % 16, sm); continue; }
    i -= 128;
    transpose_tile<-1>(p.w_out, 1024, p.Wt_out, 1024, i / 16, i % 16, sm);
  }
}

DI void phase_mod(const Params& p, char* smem) {
  bfr* sA = (bfr*)smem; bfr* sW = sA + 128 * LDT;
  const int t = TID, lane = t & 63, w = t >> 6, wn = w >> 1, wm = w & 1, r = lane & 31, h = lane >> 5;
  for (int tile = VBID; tile < 48; tile += VGRID) {
    int m0 = (tile / 24) * 128, n0 = (tile % 24) * 128;
    f32x16 acc[2][2];
    _Pragma("unroll") for (int a = 0; a < 2; ++a) _Pragma("unroll") for (int b = 0; b < 2; ++b) acc[a][b] = zero16();
    gemm_mainloop(p.Cb, 1024, m0, p.Wt_ada, 1024, n0, 1024, sA, sW, acc);
    float4 bias[2][4];
    _Pragma("unroll") for (int nt = 0; nt < 2; ++nt) _Pragma("unroll") for (int g = 0; g < 4; ++g) bias[nt][g] = *(const float4*)(p.b_ada + n0 + wn * 64 + nt * 32 + 8 * g + 4 * h);
    _Pragma("unroll") for (int nt = 0; nt < 2; ++nt) _Pragma("unroll") for (int mt = 0; mt < 2; ++mt) {
      int m = m0 + wm * 64 + mt * 32 + r;
      _Pragma("unroll") for (int g = 0; g < 4; ++g) {
        int n = n0 + wn * 64 + nt * 32 + 8 * g + 4 * h;
        float4 b = bias[nt][g];
        float4 o; o.x = acc[nt][mt][4 * g] + b.x; o.y = acc[nt][mt][4 * g + 1] + b.y; o.z = acc[nt][mt][4 * g + 2] + b.z; o.w = acc[nt][mt][4 * g + 3] + b.w;
        *(float4*)(p.mod + (size_t)m * 3072 + n) = o;
      }
    }
  }
}

DI void phase_h(const Params& p) {
  const int lane = threadIdx.x & 63, gw = blockIdx.x * 8 + (threadIdx.x >> 6), nw = gridDim.x * 8;
  float4 g[4];
  _Pragma("unroll") for (int j = 0; j < 4; ++j) g[j] = *(const float4*)(p.norm_g + j * 256 + lane * 4);
  {
    const float* mr = p.mod + (size_t)128 * 3072;
    float4 a[4], bsh[4];
    _Pragma("unroll") for (int j = 0; j < 4; ++j) {
      const int col = j * 256 + lane * 4;
      const float4 sh = *(const float4*)(mr + col), sc = *(const float4*)(mr + 1024 + col);
      a[j].x = g[j].x * (1.f + sc.x); a[j].y = g[j].y * (1.f + sc.y); a[j].z = g[j].z * (1.f + sc.z); a[j].w = g[j].w * (1.f + sc.w);
      bsh[j] = sh;
    }
    for (int r0 = gw; r0 < SEQ; r0 += 8 * nw) {
      float4 xv[8][4];
      _Pragma("unroll") for (int q = 0; q < 8; ++q) {
        const int row = min(r0 + q * nw, SEQ - 1);
        _Pragma("unroll") for (int j = 0; j < 4; ++j) xv[q][j] = *(const float4*)(p.x_prompt + (size_t)row * DM + j * 256 + lane * 4);
      }
      __builtin_amdgcn_sched_barrier(0);
      _Pragma("unroll") for (int q = 0; q < 8; ++q) {
        const int row = r0 + q * nw;
        float ss = 0.f;
        _Pragma("unroll") for (int j = 0; j < 4; ++j) ss += xv[q][j].x * xv[q][j].x + xv[q][j].y * xv[q][j].y + xv[q][j].z * xv[q][j].z + xv[q][j].w * xv[q][j].w;
        _Pragma("unroll") for (int o = 32; o >= 1; o >>= 1) ss += __shfl_xor(ss, o);
        const float rs = rsqrtf(ss * (1.f / DM) + EPS);
        if (row < SEQ) {
          _Pragma("unroll") for (int j = 0; j < 4; ++j)
            *(u32x2*)(p.H + (size_t)row * DM + j * 256 + lane * 4) = pack4(xv[q][j].x * rs * a[j].x + bsh[j].x, xv[q][j].y * rs * a[j].y + bsh[j].y,
                                                                          xv[q][j].z * rs * a[j].z + bsh[j].z, xv[q][j].w * rs * a[j].w + bsh[j].w);
        }
      }
    }
  }
  for (int b = gw; b < NBT; b += nw) {
    const float* xr = p.x_sample + (size_t)b * DM;
    const float* mr = p.mod + (size_t)b * 3072;
    float4 xv[4], sh[4], sc[4]; float ss = 0.f;
    _Pragma("unroll") for (int j = 0; j < 4; ++j) {
      const int col = j * 256 + lane * 4;
      xv[j] = *(const float4*)(xr + col); sh[j] = *(const float4*)(mr + col); sc[j] = *(const float4*)(mr + 1024 + col);
      ss += xv[j].x * xv[j].x + xv[j].y * xv[j].y + xv[j].z * xv[j].z + xv[j].w * xv[j].w;
    }
    _Pragma("unroll") for (int o = 32; o >= 1; o >>= 1) ss += __shfl_xor(ss, o);
    const float rs = rsqrtf(ss * (1.f / DM) + EPS);
    _Pragma("unroll") for (int j = 0; j < 4; ++j)
      *(u32x2*)(p.H + (size_t)(SEQ + b) * DM + j * 256 + lane * 4) = pack4(xv[j].x * rs * g[j].x * (1.f + sc[j].x) + sh[j].x, xv[j].y * rs * g[j].y * (1.f + sc[j].y) + sh[j].y,
                                                                          xv[j].z * rs * g[j].z * (1.f + sc[j].z) + sh[j].z, xv[j].w * rs * g[j].w * (1.f + sc[j].w) + sh[j].w);
  }
}

DI void sincos_red(float a, float& s, float& c) {
  float n = rintf(a * 0.15915494309189535f);
  float rr = fmaf(-n, 6.2831854820251465f, a);
  rr = fmaf(-n, -1.7484555e-7f, rr);
  s = __sinf(rr); c = __cosf(rr);
}

namespace pg8 {
#define PG8_LAS __attribute__((address_space(3)))
typedef unsigned short bf16_t;
typedef short bf16x8 __attribute__((ext_vector_type(8)));
typedef float f32x4 __attribute__((ext_vector_type(4)));
typedef unsigned u32x4 __attribute__((ext_vector_type(4)));
constexpr int BM = 256, BK = 64, HALF = 128, HTB = HALF * BK * 2  , STAGE_BYTES = 8 * HTB, NXCD = 8, WGM = 8;

__host__ __device__ __forceinline__ int lds_byte(int r, int c) { const int st = (r >> 4) * 2 + (c >> 5), rr = r & 15, cc = c & 31, ob = rr * 64 + cc * 2; return st * 1024 + (ob ^ (((ob >> 9) & 1) << 5)); }
__host__ __device__ __forceinline__ void stage_rc(int b, int& R, int& C) { const int st = b / 1024, sb = b % 1024, swz = sb ^ (((sb >> 9) & 1) << 5); R = (st >> 1) * 16 + swz / 64; C = (st & 1) * 32 + (swz % 64) / 2; }
__host__ __device__ __forceinline__ int perm32(int rho) { const int n = rho >> 4, i = rho & 15; return 8 * (i >> 2) + 4 * n + (i & 3); }

struct Unit { int pm, pn; };
struct Gemm { const bf16_t* A; const bf16_t* Bt; int M, N, K; };

struct StaticOrder {
    int nM, nN, nwg, G, c;
    __host__ __device__ void init(int M, int N, int G_, int c_) { nM = M / BM; nN = N / BM; nwg = nM * nN; G = G_; c = c_; }
    __host__ __device__ bool next(int i, Unit& u) const {
        const long L = (long)i * G + c; if (L >= nwg) return false;
        int wgid = (int)L; { const int q = nwg / NXCD, r = nwg % NXCD, xcd = wgid % NXCD, off = wgid / NXCD; wgid = (xcd < r ? xcd * (q + 1) : r * (q + 1) + (xcd - r) * q) + off; }
        const int nig = WGM * nN, gid = wgid / nig, fm = gid * WGM, gsz = (nM - fm) < WGM ? (nM - fm) : WGM;
        u.pm = fm + ((wgid % nig) % gsz); u.pn = (wgid % nig) / gsz; return true;
    }
    __device__ __forceinline__ void a_ready(const Unit&) const {}
    __device__ __forceinline__ void done(const Unit&) const {}
};
template <class Epi, class Sched, bool STAMP = false>
__device__ __forceinline__ void gemm_phase(PG8_LAS unsigned char* lds, const Gemm g, const Sched& S, const Epi& E, unsigned long long* stamps) {
    const int tid = threadIdx.x, wid = __builtin_amdgcn_readfirstlane(tid >> 6), lane = tid & 63, wr = wid >> 2, wc = wid & 3, fr = lane & 15, fq = lane >> 4;
    const int K = g.K, nt = K / BK;
    int ts_lo = 0, ts_hi = 0, nts = 0; const unsigned long long rt_entry = STAMP ? (unsigned long long)wall_clock64() : 0ull;
#define PG8_STAMP() do { if (STAMP && wid == 0 && nts < 64) { const unsigned long long _c = (unsigned long long)clock64(); \
        ts_lo = (lane == nts) ? (int)(unsigned)_c : ts_lo; ts_hi = (lane == nts) ? (int)(unsigned)(_c >> 32) : ts_hi; ++nts; } } while (0)
    PG8_STAMP();
    unsigned voffA[2], voffB[2];
#pragma unroll
    for (int i = 0; i < 2; ++i) { int R, C; stage_rc(tid * 16 + i * 8192, R, C); const int Rb = Epi::PERM ? ((R & ~31) + perm32(R & 31)) : R;
        voffA[i] = (unsigned)(R * K + C) * 2u; voffB[i] = (unsigned)(Rb * K + C) * 2u; }
    const size_t kstep = (size_t)(BK * 2);
    const size_t hstep = (size_t)HALF * K * 2;
    const size_t tstep = 2 * hstep;
    const unsigned ldsw = (unsigned)wid * 1024u;
    const int aoff = lds_byte(wr * 64 + fr, fq * 8), boff = lds_byte(wc * 32 + fr, fq * 8);
#define PG8_SA(b, h) (((b) * 2 + (h)) * HTB)
#define PG8_SB(b, h) ((4 + (b) * 2 + (h)) * HTB)
#define PG8_STAGE(bufoff, gbase, voff) do { _Pragma("unroll") for (int _i = 0; _i < 2; ++_i) \
        __builtin_amdgcn_global_load_lds((const unsigned*)((const char*)(gbase) + (voff)[_i]), (PG8_LAS unsigned*)(lds + (bufoff) + ldsw + _i * 8192), 16, 0, 0); } while (0)
#define PG8_LDA(dst, b, h) do { _Pragma("unroll") for (int m = 0; m < 4; ++m) _Pragma("unroll") for (int k = 0; k < 2; ++k) dst[m][k] = *(const PG8_LAS bf16x8*)(lds + PG8_SA(b, h) + aoff + m * 2048 + k * 1024); } while (0)
#define PG8_LDB(dst, b, h) do { _Pragma("unroll") for (int n = 0; n < 2; ++n) _Pragma("unroll") for (int k = 0; k < 2; ++k) dst[n][k] = *(const PG8_LAS bf16x8*)(lds + PG8_SB(b, h) + boff + n * 2048 + k * 1024); } while (0)
#define PG8_MMA(ai, bj, At, Bt) do { __builtin_amdgcn_s_setprio(1); _Pragma("unroll") for (int m = 0; m < 4; ++m) _Pragma("unroll") for (int n = 0; n < 2; ++n) _Pragma("unroll") for (int k = 0; k < 2; ++k) \
        acc[ai][bj][m][n] = __builtin_amdgcn_mfma_f32_16x16x32_bf16(Bt[n][k], At[m][k], acc[ai][bj][m][n], 0, 0, 0); __builtin_amdgcn_s_setprio(0); } while (0)
#define PG8_WAIT_V(n) asm volatile("s_waitcnt vmcnt(" #n ")" ::: "memory")
#define PG8_WAIT_L(n) asm volatile("s_waitcnt lgkmcnt(" #n ")" ::: "memory")
#define PG8_BAR __builtin_amdgcn_s_barrier()
#define PG8_SCHED __builtin_amdgcn_sched_barrier(0)
    Unit cur, nxt; int ui = 0;
    if (!S.next(0, cur)) return;
    f32x4 acc[2][2][4][2];
#pragma unroll
    for (int a = 0; a < 2; ++a)
#pragma unroll
        for (int b = 0; b < 2; ++b)
#pragma unroll
            for (int m = 0; m < 4; ++m)
#pragma unroll
                for (int n = 0; n < 2; ++n) acc[a][b][m][n] = (f32x4){0.f, 0.f, 0.f, 0.f};
    bf16x8 At[4][2], B0[2][2], B1[2][2];
    const char* cA = (const char*)g.A + (size_t)cur.pm * tstep; const char* cB = (const char*)g.Bt + (size_t)cur.pn * tstep;
    S.a_ready(cur);
    PG8_STAGE(PG8_SB(0, 0), cB, voffB); PG8_STAGE(PG8_SA(0, 0), cA, voffA); PG8_STAGE(PG8_SB(0, 1), cB + hstep, voffB); PG8_STAGE(PG8_SA(0, 1), cA + hstep, voffA);
    if (wr == 1) PG8_BAR;
    PG8_WAIT_V(4); PG8_BAR;
    PG8_STAGE(PG8_SB(1, 0), cB + kstep, voffB); PG8_STAGE(PG8_SA(1, 0), cA + kstep, voffA); PG8_STAGE(PG8_SB(1, 1), cB + hstep + kstep, voffB);
    PG8_WAIT_V(6); PG8_BAR;
    PG8_STAMP();
    for (;;) {
        const bool has_next = S.next(ui + 1, nxt);
        const char* nA = has_next ? (const char*)g.A + (size_t)nxt.pm * tstep : cA; const char* nB = has_next ? (const char*)g.Bt + (size_t)nxt.pn * tstep : cB;
        for (int t = 0; t < nt; t += 2) {
            const bool last = (t == nt - 2);
            const char* a1 = cA + (size_t)(t + 1) * kstep;
            const char* a2 = last ? nA : cA + (size_t)(t + 2) * kstep; const char* b2 = last ? nB : cB + (size_t)(t + 2) * kstep;
            const char* a3 = a2 + kstep; const char* b3 = b2 + kstep;
            if (last && has_next) S.a_ready(nxt);
            if constexpr (Epi::MID_T > 0) { if (t == Epi::MID_T) E.mid(acc, cur, wr, wc, fr, fq); }
            PG8_LDB(B0, 0, 0); PG8_SCHED; PG8_LDA(At, 0, 0); PG8_STAGE(PG8_SA(1, 1), a1 + hstep, voffA);
            PG8_WAIT_L(8); PG8_BAR; PG8_WAIT_L(0); PG8_MMA(0, 0, At, B0); PG8_BAR; PG8_SCHED;
            PG8_LDB(B1, 0, 1); PG8_STAGE(PG8_SB(0, 0), b2, voffB);
            PG8_BAR; PG8_WAIT_L(0); PG8_MMA(0, 1, At, B1); PG8_BAR;
            PG8_LDA(At, 0, 1); PG8_STAGE(PG8_SA(0, 0), a2, voffA);
            PG8_BAR; PG8_WAIT_L(0); PG8_MMA(1, 0, At, B0); PG8_BAR; PG8_SCHED;
            PG8_STAGE(PG8_SB(0, 1), b2 + hstep, voffB);
            PG8_WAIT_V(6); PG8_BAR; PG8_MMA(1, 1, At, B1); PG8_BAR;
            PG8_LDB(B0, 1, 0); PG8_SCHED; PG8_LDA(At, 1, 0); PG8_STAGE(PG8_SA(0, 1), a2 + hstep, voffA);
            PG8_WAIT_L(8); PG8_BAR; PG8_WAIT_L(0); PG8_MMA(0, 0, At, B0); PG8_BAR; PG8_SCHED;
            PG8_LDB(B1, 1, 1); PG8_STAGE(PG8_SB(1, 0), b3, voffB);
            PG8_BAR; PG8_WAIT_L(0); PG8_MMA(0, 1, At, B1); PG8_BAR;
            PG8_LDA(At, 1, 1); PG8_STAGE(PG8_SA(1, 0), a3, voffA);
            PG8_BAR; PG8_WAIT_L(0); PG8_MMA(1, 0, At, B0); PG8_BAR; PG8_SCHED;
            PG8_STAGE(PG8_SB(1, 1), b3 + hstep, voffB);
            PG8_WAIT_V(6); PG8_BAR; PG8_MMA(1, 1, At, B1); PG8_BAR;
        }
        PG8_STAMP();
        if constexpr (!Epi::AFTER_DRAIN) { E(acc, cur, wr, wc, fr, fq); S.done(cur); }
        PG8_STAMP();
        if (!has_next) break;
#pragma unroll
        for (int a = 0; a < 2; ++a)
#pragma unroll
            for (int b = 0; b < 2; ++b)
#pragma unroll
                for (int m = 0; m < 4; ++m)
#pragma unroll
                    for (int n = 0; n < 2; ++n) acc[a][b][m][n] = (f32x4){0.f, 0.f, 0.f, 0.f};
        cur = nxt; cA = nA; cB = nB; ++ui;
    }
    PG8_WAIT_V(0);
    if (wr == 0) PG8_BAR;
    PG8_BAR;
    if constexpr (Epi::AFTER_DRAIN) { E.fused(acc, cur, wr, wc, fr, fq, lds, wid, lane); S.done(cur); }
    PG8_STAMP();
    if (STAMP && wid == 0) { stamps[lane] = lane < nts ? (((unsigned long long)(unsigned)ts_hi << 32) | (unsigned)ts_lo) : 0ull;
        if (lane == 62) stamps[62] = rt_entry; if (lane == 63) stamps[63] = (unsigned long long)wall_clock64(); }
#undef PG8_STAMP
#undef PG8_SA
#undef PG8_SB
#undef PG8_STAGE
#undef PG8_LDA
#undef PG8_LDB
#undef PG8_MMA
#undef PG8_WAIT_V
#undef PG8_WAIT_L
#undef PG8_BAR
#undef PG8_SCHED
}
}
using pf4 = pg8::f32x4;

struct EpiMain {
  static constexpr bool PERM = false, AFTER_DRAIN = false;
  static constexpr int MID_T = 0;
  const Params& p;
  DI void operator()(const pf4 (&acc)[2][2][4][2], const pg8::Unit& u, int wr, int wc, int fr, int fq) const {
    const int pn = u.pn;
    const int rbase = u.pm * 256 + wr * 64 + fr;
    if (pn < 3) {
      const bool isq = pn < 2, isv = (pn == 2) && (wc >= 2);
      const float* gp = isq ? p.qg : p.kg;
      const int d0 = 16 * (fq >> 1) + 4 * (fq & 1), d1 = 32 + 8 * fq;
      float4 g00 = {1.f, 1.f, 1.f, 1.f}, g01 = g00, g10 = g00, g11 = g00;
      if (!isv) { g00 = *(const float4*)(gp + d0); g01 = *(const float4*)(gp + d0 + 8); g10 = *(const float4*)(gp + d1); g11 = *(const float4*)(gp + d1 + 4); }
      _Pragma("unroll") for (int ai = 0; ai < 2; ++ai) {
        if (u.pm * 256 + 128 * ai >= MTOT) continue;
        _Pragma("unroll") for (int m = 0; m < 4; ++m) {
          const int row = rbase + 128 * ai + 16 * m;
          pf4 a00 = acc[ai][0][m][0], a01 = acc[ai][0][m][1], a10 = acc[ai][1][m][0], a11 = acc[ai][1][m][1];
          if (!isv) {
            float ss = 0.f;
            _Pragma("unroll") for (int j = 0; j < 4; ++j) ss += a00[j] * a00[j] + a01[j] * a01[j] + a10[j] * a10[j] + a11[j] * a11[j];
            ss += __shfl_xor(ss, 16); ss += __shfl_xor(ss, 32);
            const float sc = rsqrtf(ss * (1.f / 64.f) + EPS);
            a00[0] *= sc * g00.x; a00[1] *= sc * g00.y; a00[2] *= sc * g00.z; a00[3] *= sc * g00.w;
            a01[0] *= sc * g01.x; a01[1] *= sc * g01.y; a01[2] *= sc * g01.z; a01[3] *= sc * g01.w;
            a10[0] *= sc * g10.x; a10[1] *= sc * g10.y; a10[2] *= sc * g10.z; a10[3] *= sc * g10.w;
            a11[0] *= sc * g11.x; a11[1] *= sc * g11.y; a11[2] *= sc * g11.z; a11[3] *= sc * g11.w;
            if (fq < 2) {
              const float pos = (float)(row < SEQ ? row : SEQ);
              const float invlo[4] = {1.0f, 0.19392274f, 0.03760603f, 0.0072926646f};
              const float invhi[4] = {0.0014142136f, 0.0002742482f, 5.3182957e-05f, 1.0313385e-05f};
              _Pragma("unroll") for (int j = 0; j < 4; ++j) {
                const float inv = (fq & 1) ? invhi[j] : invlo[j];
                float s_, c_; sincos_red(pos * inv, s_, c_);
                const float x1 = a00[j], x2 = a01[j];
                a00[j] = x1 * c_ - x2 * s_; a01[j] = x2 * c_ + x1 * s_;
              }
            }
          }
          if (isq) {
            bfr* qp = p.Q + (size_t)row * 512 + (4 * pn + wc) * 64;
            *(u32x2*)(qp + d0) = pack4(a00[0] * QSCALE, a00[1] * QSCALE, a00[2] * QSCALE, a00[3] * QSCALE);
            *(u32x2*)(qp + d0 + 8) = pack4(a01[0] * QSCALE, a01[1] * QSCALE, a01[2] * QSCALE, a01[3] * QSCALE);
            u32x4 o; o[0] = pk2(a10[0] * QSCALE, a10[1] * QSCALE); o[1] = pk2(a10[2] * QSCALE, a10[3] * QSCALE);
            o[2] = pk2(a11[0] * QSCALE, a11[1] * QSCALE); o[3] = pk2(a11[2] * QSCALE, a11[3] * QSCALE);
            *(u32x4*)(qp + d1) = o;
          } else {
            const int jh = wc & 1;
            bfr* kp = (isv ? p.Vb : p.Kb) + (size_t)row * 128 + jh * 64;
            *(u32x2*)(kp + d0) = pack4(a00[0], a00[1], a00[2], a00[3]);
            *(u32x2*)(kp + d0 + 8) = pack4(a01[0], a01[1], a01[2], a01[3]);
            u32x4 o; o[0] = pk2(a10[0], a10[1]); o[1] = pk2(a10[2], a10[3]); o[2] = pk2(a11[0], a11[1]); o[3] = pk2(a11[2], a11[3]);
            *(u32x4*)(kp + d1) = o;
            float* op = nullptr;
            if (row >= SEQ) op = (isv ? p.out_vs : p.out_ks) + ((size_t)((row - SEQ) * 128 + 127) * 2 + jh) * 64;
            else if (row >= SEQ - 128) op = (isv ? p.out_vp : p.out_kp) + ((size_t)(row - (SEQ - 128)) * 2 + jh) * 64;
            if (op) {
              *(pf4*)(op + d0) = a00; *(pf4*)(op + d0 + 8) = a01; *(pf4*)(op + d1) = a10; *(pf4*)(op + d1 + 4) = a11;
            }
          }
        }
      }
      return;
    }
    const int cw = 32 * wc + 8 * fq;
    bfr* dst; int ld, col, op;
    if (pn < 5) { dst = p.ZA; ld = 512; col = (pn - 3) * 256; op = 1; }
    else if (pn < 7) { dst = p.QB; ld = 512; col = (pn - 5) * 256; op = 0; }
    else if (pn < 9) { dst = p.ZF; ld = 512; col = (pn - 7) * 256; op = 0; }
    else if (pn < 11) { dst = p.IB; ld = 512; col = (pn - 9) * 256; op = 0; }
    else if (pn < 13) { dst = p.ZB; ld = 512; col = (pn - 11) * 256; op = 1; }
    else if (pn < 17) { dst = p.GA; ld = 1024; col = (pn - 13) * 256; op = 2; }
    else { dst = p.GB; ld = 1024; col = (pn - 17) * 256; op = 2; }
    bfr* const obase = dst + (size_t)rbase * ld + col + cw;
    _Pragma("unroll") for (int bj = 0; bj < 2; ++bj) {
      float4 b0 = {0.f, 0.f, 0.f, 0.f}, b1 = b0;
      if (op == 2) { const float* bp = p.b_merge + (pn - 13) * 256 + 128 * bj + cw; b0 = *(const float4*)bp; b1 = *(const float4*)(bp + 4);
        b0.x *= -LOG2E; b0.y *= -LOG2E; b0.z *= -LOG2E; b0.w *= -LOG2E; b1.x *= -LOG2E; b1.y *= -LOG2E; b1.z *= -LOG2E; b1.w *= -LOG2E; }
      _Pragma("unroll") for (int ai = 0; ai < 2; ++ai) {
        if (u.pm * 256 + 128 * ai >= MTOT) continue;
        _Pragma("unroll") for (int m = 0; m < 4; ++m) {
          const int row = rbase + 128 * ai + 16 * m;
          pf4 x = acc[ai][bj][m][0], y = acc[ai][bj][m][1];
          if (op == 1) { _Pragma("unroll") for (int j = 0; j < 4; ++j) { x[j] = siluf_(x[j]); y[j] = siluf_(y[j]); } }
          else if (op == 2) {
            x[0] = frcp(1.f + __builtin_amdgcn_exp2f(fmaf(x[0], -LOG2E, b0.x))); x[1] = frcp(1.f + __builtin_amdgcn_exp2f(fmaf(x[1], -LOG2E, b0.y)));
            x[2] = frcp(1.f + __builtin_amdgcn_exp2f(fmaf(x[2], -LOG2E, b0.z))); x[3] = frcp(1.f + __builtin_amdgcn_exp2f(fmaf(x[3], -LOG2E, b0.w)));
            y[0] = frcp(1.f + __builtin_amdgcn_exp2f(fmaf(y[0], -LOG2E, b1.x))); y[1] = frcp(1.f + __builtin_amdgcn_exp2f(fmaf(y[1], -LOG2E, b1.y)));
            y[2] = frcp(1.f + __builtin_amdgcn_exp2f(fmaf(y[2], -LOG2E, b1.z))); y[3] = frcp(1.f + __builtin_amdgcn_exp2f(fmaf(y[3], -LOG2E, b1.w)));
          }
          u32x4 o; o[0] = pk2(x[0], x[1]); o[1] = pk2(x[2], x[3]); o[2] = pk2(y[0], y[1]); o[3] = pk2(y[2], y[3]);
          __builtin_nontemporal_store(o, (u32x4*)(obase + (128 * ai + 16 * m) * ld + 128 * bj));
        }
      }
    }
  }
};

struct EpiMerge {
  static constexpr bool PERM = true, AFTER_DRAIN = false;
  static constexpr int MID_T = 8;
  const Params& p;
  DI void mid(pf4 (&acc)[2][2][4][2], const pg8::Unit& u, int wr, int wc, int fr, int fq) const {
    int rbase = u.pm * 256 + wr * 64 + fr; const int cbase = u.pn * 256 + 32 * wc + 8 * fq;
    asm volatile("" : "+v"(rbase));
    _Pragma("unroll") for (int ai = 0; ai < 2; ++ai) _Pragma("unroll") for (int m = 0; m < 4; ++m) _Pragma("unroll") for (int bj = 0; bj < 2; ++bj) {
      if (bj == 0 && m == 0) __builtin_amdgcn_sched_barrier(0);
      const size_t off = (size_t)(rbase + 128 * ai + 16 * m) * 1024 + cbase + 128 * bj;
      const u32x4 ga = *(const u32x4*)(p.GA + off), gb = *(const u32x4*)(p.GB + off);
      _Pragma("unroll") for (int e = 0; e < 2; ++e) {
        acc[ai][bj][m][0][2 * e] *= bflo(ga[e]) * __builtin_amdgcn_rcpf(fmaxf(bflo(gb[e]), 1e-30f));
        acc[ai][bj][m][0][2 * e + 1] *= bfhi(ga[e]) * __builtin_amdgcn_rcpf(fmaxf(bfhi(gb[e]), 1e-30f));
        acc[ai][bj][m][1][2 * e] *= bflo(ga[2 + e]) * __builtin_amdgcn_rcpf(fmaxf(bflo(gb[2 + e]), 1e-30f));
        acc[ai][bj][m][1][2 * e + 1] *= bfhi(ga[2 + e]) * __builtin_amdgcn_rcpf(fmaxf(bfhi(gb[2 + e]), 1e-30f));
      }
    }
  }
  DI void operator()(const pf4 (&acc)[2][2][4][2], const pg8::Unit& u, int wr, int wc, int fr, int fq) const {
    const int rbase = u.pm * 256 + wr * 64 + fr, cbase = u.pn * 256 + 32 * wc + 8 * fq;
    _Pragma("unroll") for (int ai = 0; ai < 2; ++ai) {
     u32x4 gv[4][2];
     _Pragma("unroll") for (int m = 0; m < 4; ++m) _Pragma("unroll") for (int bj = 0; bj < 2; ++bj) gv[m][bj] = *(const u32x4*)(p.GB + (size_t)(rbase + 128 * ai + 16 * m) * 1024 + cbase + 128 * bj);
     __builtin_amdgcn_sched_barrier(0);
     _Pragma("unroll") for (int m = 0; m < 4; ++m) _Pragma("unroll") for (int bj = 0; bj < 2; ++bj) {
      const size_t off = (size_t)(rbase + 128 * ai + 16 * m) * 1024 + cbase + 128 * bj;
      const u32x4 g = gv[m][bj];
      const pf4 x = acc[ai][bj][m][0], y = acc[ai][bj][m][1];
      u32x4 o; o[0] = pk2(bflo(g[0]) * x[0], bfhi(g[0]) * x[1]); o[1] = pk2(bflo(g[1]) * x[2], bfhi(g[1]) * x[3]);
      o[2] = pk2(bflo(g[2]) * y[0], bfhi(g[2]) * y[1]); o[3] = pk2(bflo(g[3]) * y[2], bfhi(g[3]) * y[3]);
      *(u32x4*)(p.Y + off) = o;
     }
     __builtin_amdgcn_sched_barrier(0);
    }
  }
};

struct EpiOut {
  static constexpr bool PERM = false, AFTER_DRAIN = false;
  static constexpr int MID_T = 0;
  const Params& p;
  DI void operator()(const pf4 (&acc)[2][2][4][2], const pg8::Unit& u, int wr, int wc, int fr, int fq) const {
    const int rbase = u.pm * 256 + wr * 64 + fr, cbase = u.pn * 256 + 32 * wc + 4 * fq;
    const float* gr = p.mod + (size_t)128 * 3072 + 2048;
    _Pragma("unroll") for (int bj = 0; bj < 2; ++bj) _Pragma("unroll") for (int n = 0; n < 2; ++n) {
      const int c = cbase + 128 * bj + 16 * n;
      const pf4 gt = *(const pf4*)(gr + c);
      pf4 xv[8];
      _Pragma("unroll") for (int q = 0; q < 8; ++q) xv[q] = __builtin_nontemporal_load((const pf4*)(p.x_prompt + (size_t)(rbase + 128 * (q >> 2) + 16 * (q & 3)) * DM + c));
      __builtin_amdgcn_sched_barrier(0);
      _Pragma("unroll") for (int q = 0; q < 8; ++q)
        __builtin_nontemporal_store(xv[q] + gt * acc[q >> 2][bj][q & 3][n], (pf4*)(p.out_yp + (size_t)(rbase + 128 * (q >> 2) + 16 * (q & 3)) * DM + c));
      __builtin_amdgcn_sched_barrier(0);
    }
  }
};

struct EpiOutLds {
  static constexpr bool PERM = false, AFTER_DRAIN = true;
  static constexpr int MID_T = 0;
  const Params& p;
  DI void operator()(const pf4 (&)[2][2][4][2], const pg8::Unit&, int, int, int, int) const {}
  DI void fused(const pf4 (&acc)[2][2][4][2], const pg8::Unit& u, int wr, int wc, int fr, int fq, PG8_LAS unsigned char* lds, int, int) const {
    const float* gr = p.mod + (size_t)128 * 3072 + 2048 + u.pn * 256;
    const int tid = threadIdx.x, c = tid & 63, rsub = tid >> 6;
    pf4 gt[2][2];
    _Pragma("unroll") for (int bj = 0; bj < 2; ++bj) _Pragma("unroll") for (int n = 0; n < 2; ++n) gt[bj][n] = *(const pf4*)(gr + 128 * bj + 32 * wc + 16 * n + 4 * fq);
    _Pragma("unroll") for (int ai = 0; ai < 2; ++ai) {
      _Pragma("unroll") for (int m = 0; m < 4; ++m) _Pragma("unroll") for (int bj = 0; bj < 2; ++bj) _Pragma("unroll") for (int n = 0; n < 2; ++n) {
        const int rl = 64 * wr + 16 * m + fr, chunk = 32 * bj + 8 * wc + 4 * n + fq;
        *(PG8_LAS pf4*)(lds + rl * 1024 + ((chunk ^ fr) << 4)) = gt[bj][n] * acc[ai][bj][m][n];
      }
      __syncthreads();
      const size_t g0 = (size_t)(u.pm * 256 + 128 * ai) * DM + u.pn * 256 + 4 * c;
      {
        pf4 xv[16];
        _Pragma("unroll") for (int q = 0; q < 16; ++q) xv[q] = __builtin_nontemporal_load((const pf4*)(p.x_prompt + g0 + (size_t)(q * 8 + rsub) * DM));
        __builtin_amdgcn_sched_barrier(0);
        _Pragma("unroll") for (int q = 0; q < 16; ++q) {
          const int rl = q * 8 + rsub;
          const pf4 st = *(const PG8_LAS pf4*)(lds + rl * 1024 + ((c ^ (rl & 15)) << 4));
          __builtin_nontemporal_store(xv[q] + st, (pf4*)(p.out_yp + g0 + (size_t)rl * DM));
        }
      }
      __syncthreads();
    }
  }
};

DI f32x16 wave_gemm32(const bfr* __restrict__ A, int lda, const bfr* __restrict__ W, int ldw, int K, int lane) {
  const int r = lane & 31, h = lane >> 5;
  const bfr* ap = A + (size_t)r * lda + 8 * h;
  const bfr* wp = W + (size_t)r * ldw + 8 * h;
  f32x16 acc = zero16();
  for (int k0 = 0; k0 < K; k0 += 128) {
    bf16x8 a[8], b[8];
    _Pragma("unroll") for (int q = 0; q < 8; ++q) { a[q] = *(const bf16x8*)(ap + k0 + 16 * q); b[q] = *(const bf16x8*)(wp + k0 + 16 * q); }
    _Pragma("unroll") for (int q = 0; q < 8; ++q) acc = mfma(b[q], a[q], acc);
  }
  return acc;
}

DI void sample_chain_wave(const Params& p, int wt, int lane) {
  const int mt = wt >> 5, nt = wt & 31, r = lane & 31, h = lane >> 5;
  const int m = 32 * mt + r;
  unsigned* cnt = p.bar + PANEL_CNT_WORD + 64 * mt;
  {
    const f32x16 a1 = wave_gemm32(p.YA + (size_t)(SEQ + 32 * mt) * 1024, 1024, p.Wt_pab + (size_t)(32 * nt) * 1024, 1024, 512, lane);
    const f32x16 a2 = wave_gemm32(p.YB + (size_t)(SEQ + 32 * mt) * 1024, 1024, p.Wt_pab + (size_t)(32 * nt) * 1024 + 512, 1024, 512, lane);
    _Pragma("unroll") for (int g = 0; g < 4; ++g) {
      const int n = 32 * nt + 8 * g + 4 * h;
      const u32x2 ga = *(const u32x2*)(p.GA + (size_t)(SEQ + m) * 1024 + n), gb = *(const u32x2*)(p.GB + (size_t)(SEQ + m) * 1024 + n);
      *(u32x2*)(p.Ys + (size_t)m * 1024 + n) = pack4(bflo(ga[0]) * a1[4 * g] + bflo(gb[0]) * a2[4 * g], bfhi(ga[0]) * a1[4 * g + 1] + bfhi(gb[0]) * a2[4 * g + 1],
                                                     bflo(ga[1]) * a1[4 * g + 2] + bflo(gb[1]) * a2[4 * g + 2], bfhi(ga[1]) * a1[4 * g + 3] + bfhi(gb[1]) * a2[4 * g + 3]);
    }
    __builtin_amdgcn_fence(__ATOMIC_RELEASE, "agent");
    asm volatile("s_waitcnt vmcnt(0)" ::: "memory");
    if (lane == 0) __hip_atomic_fetch_add(cnt, 1u, __ATOMIC_RELAXED, __HIP_MEMORY_SCOPE_AGENT);
  }
  {
    unsigned sp = 0;
    while (__hip_atomic_load(cnt, __ATOMIC_RELAXED, __HIP_MEMORY_SCOPE_AGENT) < 32u) { __builtin_amdgcn_s_sleep(2); if (++sp > (1u << 22)) break; }
    __builtin_amdgcn_fence(__ATOMIC_ACQUIRE, "agent");
    asm volatile("s_waitcnt vmcnt(0)" ::: "memory");
  }
  const f32x16 acc = wave_gemm32(p.Ys + (size_t)(32 * mt) * 1024, 1024, p.Wt_out + (size_t)(32 * nt) * 1024, 1024, 1024, lane);
  _Pragma("unroll") for (int g = 0; g < 4; ++g) {
    const int n = 32 * nt + 8 * g + 4 * h;
    const float4 xv = *(const float4*)(p.x_sample + (size_t)m * DM + n), gt = *(const float4*)(p.mod + (size_t)m * 3072 + 2048 + n);
    float4 o;
    o.x = xv.x + gt.x * acc[4 * g]; o.y = xv.y + gt.y * acc[4 * g + 1]; o.z = xv.z + gt.z * acc[4 * g + 2]; o.w = xv.w + gt.w * acc[4 * g + 3];
    *(float4*)(p.out_ys + (size_t)m * DM + n) = o;
  }
}

DI void attn_prompt_wave(const Params& p, int qt, int hd, int lane) {
  const int r = lane & 31, h = lane >> 5, j = hd >> 2;
  const int q0 = qt * 32, q = q0 + r, kb = q0 - 128;
  bf16x8 qf[4];
  _Pragma("unroll") for (int s = 0; s < 4; ++s) qf[s] = *(const bf16x8*)(p.Q + (size_t)q * 512 + hd * 64 + 16 * s + 8 * h);
  f32x16 sacc[5];
  _Pragma("unroll") for (int kt = 0; kt < 5; ++kt) {
    sacc[kt] = zero16();
    int kr = kb + 32 * kt + r; kr = kr < 0 ? 0 : kr;
    _Pragma("unroll") for (int s = 0; s < 4; ++s) {
      bf16x8 kf = *(const bf16x8*)(p.Kb + (size_t)kr * 128 + j * 64 + 16 * s + 8 * h);
      sacc[kt] = mfma(kf, qf[s], sacc[kt]);
    }
  }
  const float sink = p.sinks[hd] * LOG2E;
  float mx = sink;
  _Pragma("unroll") for (int i = 0; i < 16; ++i) {
    sacc[0][i] = (crow(i, h) > r) ? sacc[0][i] : -INFINITY;
    sacc[4][i] = (crow(i, h) <= r) ? sacc[4][i] : -INFINITY;
  }
  if (q0 < 128) {
    _Pragma("unroll") for (int kt = 0; kt < 4; ++kt) _Pragma("unroll") for (int i = 0; i < 16; ++i)
      sacc[kt][i] = (kb + 32 * kt + crow(i, h) >= 0) ? sacc[kt][i] : -INFINITY;
  }
  _Pragma("unroll") for (int kt = 0; kt < 5; ++kt) _Pragma("unroll") for (int i = 0; i < 16; ++i) mx = fmaxf(mx, sacc[kt][i]);
  mx = fmaxf(mx, __shfl_xor(mx, 32));
  float l = 0.f;
  _Pragma("unroll") for (int kt = 0; kt < 5; ++kt) _Pragma("unroll") for (int i = 0; i < 16; ++i) {
    float pv = __builtin_amdgcn_exp2f(sacc[kt][i] - mx); sacc[kt][i] = pv; l += pv;
  }
  l += __shfl_xor(l, 32);
  l += __builtin_amdgcn_exp2f(sink - mx);
  f32x16 oacc[2]; oacc[0] = zero16(); oacc[1] = zero16();
  const bfr* vbase = p.Vb + j * 64 + 2 * r;
  _Pragma("unroll") for (int kt = 0; kt < 5; ++kt) _Pragma("unroll") for (int s2 = 0; s2 < 2; ++s2) {
    u32x4 pp;
    _Pragma("unroll") for (int e = 0; e < 4; ++e) pp[e] = pk2(sacc[kt][8 * s2 + 2 * e], sacc[kt][8 * s2 + 2 * e + 1]);
    unsigned wv[8];
    _Pragma("unroll") for (int jj = 0; jj < 8; ++jj) {
      int key = kb + 32 * kt + 16 * s2 + 8 * (jj >> 2) + 4 * h + (jj & 3); key = key < 0 ? 0 : key;
      wv[jj] = *(const unsigned*)(vbase + (size_t)key * 128);
    }
    u32x4 v0, v1;
    _Pragma("unroll") for (int e = 0; e < 4; ++e) {
      v0[e] = __builtin_amdgcn_perm(wv[2 * e + 1], wv[2 * e], 0x05040100u);
      v1[e] = __builtin_amdgcn_perm(wv[2 * e + 1], wv[2 * e], 0x07060302u);
    }
    const bf16x8 pa = __builtin_bit_cast(bf16x8, pp);
    oacc[0] = mfma(pa, __builtin_bit_cast(bf16x8, v0), oacc[0]);
    oacc[1] = mfma(pa, __builtin_bit_cast(bf16x8, v1), oacc[1]);
  }
  const float il = frcp(l);
  unsigned za[16];
  _Pragma("unroll") for (int i = 0; i < 16; ++i) za[i] = *(const unsigned*)(p.ZA + (size_t)(q0 + crow(i, h)) * 512 + hd * 64 + 2 * r);
  __builtin_amdgcn_sched_barrier(0);
  _Pragma("unroll") for (int i = 0; i < 16; ++i) {
    const int qi = crow(i, h);
    const float ili = __shfl(il, qi);
    *(unsigned*)(p.YA + (size_t)(q0 + qi) * 1024 + hd * 64 + 2 * r) = pk2(oacc[0][i] * ili * bflo(za[i]), oacc[1][i] * ili * bfhi(za[i]));
  }
}

DI void attn_sample_wave(const Params& p, int b, int hd, float* sw  ) {
  const int lane = threadIdx.x & 63, j = hd >> 2, m = SEQ + b;
  u32x4 qv[8];
  _Pragma("unroll") for (int i = 0; i < 8; ++i) qv[i] = *(const u32x4*)(p.Q + (size_t)m * 512 + hd * 64 + 8 * i);
  float dn = 0.f;
  _Pragma("unroll") for (int i = 0; i < 8; ++i) {
    u32x4 kv = *(const u32x4*)(p.Kb + (size_t)m * 128 + j * 64 + 8 * i);
    _Pragma("unroll") for (int e = 0; e < 4; ++e) dn += bflo(qv[i][e]) * bflo(kv[e]) + bfhi(qv[i][e]) * bfhi(kv[e]);
  }
  float s[2];
  _Pragma("unroll") for (int u = 0; u < 2; ++u) {
    int idx = lane + 1 + 64 * u;
    int ic = idx < 128 ? idx : 127;
    const float* kp = p.cache_k + ((size_t)(b * 128 + ic) * 2 + j) * 64;
    float4 kk[16];
    _Pragma("unroll") for (int i = 0; i < 16; ++i) kk[i] = *(const float4*)(kp + 4 * i);
    __builtin_amdgcn_sched_barrier(0);
    float d = 0.f;
    _Pragma("unroll") for (int i = 0; i < 8; ++i) {
      const float4 k0 = kk[2 * i], k1 = kk[2 * i + 1];
      d += bflo(qv[i][0]) * k0.x + bfhi(qv[i][0]) * k0.y + bflo(qv[i][1]) * k0.z + bfhi(qv[i][1]) * k0.w;
      d += bflo(qv[i][2]) * k1.x + bfhi(qv[i][2]) * k1.y + bflo(qv[i][3]) * k1.z + bfhi(qv[i][3]) * k1.w;
    }
    s[u] = idx < 128 ? d : dn;
  }
  const float sink = p.sinks[hd] * LOG2E;
  float mx = fmaxf(fmaxf(s[0], s[1]), sink);
  _Pragma("unroll") for (int o = 32; o >= 1; o >>= 1) mx = fmaxf(mx, __shfl_xor(mx, o));
  float p0 = __builtin_amdgcn_exp2f(s[0] - mx), p1 = __builtin_amdgcn_exp2f(s[1] - mx);
  float l = p0 + p1;
  _Pragma("unroll") for (int o = 32; o >= 1; o >>= 1) l += __shfl_xor(l, o);
  l += __builtin_amdgcn_exp2f(sink - mx);
  sw[lane] = p0; sw[64 + lane] = p1;
  __builtin_amdgcn_s_waitcnt(0xc07f);
  __builtin_amdgcn_wave_barrier();
  float o = 0.f;
  const float* vb = p.cache_v + ((size_t)(b * 128) * 2 + j) * 64 + lane;
  _Pragma("unroll 1") for (int i0 = 0; i0 < 128; i0 += 16) {
    float vv[16];
    _Pragma("unroll") for (int q = 0; q < 16; ++q) vv[q] = vb[(size_t)(i0 + q) * 128];
    __builtin_amdgcn_sched_barrier(0);
    _Pragma("unroll") for (int q = 0; q < 16; ++q) { const float pw = (i0 + q) ? sw[i0 + q - 1] : 0.f; o += pw * vv[q]; }
  }
  o += sw[127] * bf2f(p.Vb[(size_t)m * 128 + j * 64 + lane]);
  size_t off = (size_t)m * 512 + hd * 64 + lane;
  p.YA[(size_t)m * 1024 + hd * 64 + lane] = (bfr)f2bf(o * frcp(l) * bf2f(p.ZA[off]));
  __builtin_amdgcn_wave_barrier();
}

DI void hgrn_gates(const Params& p, int row0, int hh, float* sTot, float (&L)[32], float (&kin)[32], float& t0, float& lc) {
  const int t = TID, c = t & 127, half = t >> 7, ch = hh * 128 + c;
  const float lbv = frcp(1.f + __expf(p.lb_logits[512 + ch] - p.lb_logits[ch]));
  const bfr* zp = p.ZF + (size_t)(row0 + half * 32) * 512 + ch;
  float run = 0.f;
  _Pragma("unroll") for (int jj = 0; jj < 32; ++jj) {
    float z = bf2f(zp[(size_t)jj * 512]);
    z = fminf(fmaxf(z, -30.f), 30.f);
    float em = __expf(-z), sg = frcp(1.f + em);
    float f = lbv + (1.f - lbv) * sg;
    kin[jj] = (1.f - lbv) * em * sg;
    run += __logf(f);
    L[jj] = run;
  }
  sTot[half * 128 + c] = run;
  __syncthreads();
  t0 = sTot[c]; lc = t0 + sTot[128 + c];
  if (half) { _Pragma("unroll") for (int jj = 0; jj < 32; ++jj) L[jj] += t0; }
}

DI void hgrn_fused_item(const Params& p, int n, int hh, char* smem) {
  bfr* sVt = (bfr*)smem;
  bfr* sKt = sVt + 128 * LDT;
  bfr* sQh = sKt + 128 * LDT;
  bfr* sKh = sQh + 64 * 136;
  bfr* sAm = sKt;
  float* sTot = (float*)(sKh + 64 * 136);
  const int t = TID, lane = t & 63, w = t >> 6, h = lane >> 5, c = t & 127, half = t >> 7;
  const int row0 = n * 64;
  __syncthreads();
  {
    const bfr* ip = p.IB + (size_t)(row0 + half * 32) * 512 + hh * 128 + c;
    _Pragma("unroll") for (int q4 = 0; q4 < 4; ++q4) {
      u32x4 o;
      _Pragma("unroll") for (int e = 0; e < 4; ++e) {
        int jj = q4 * 8 + 2 * e;
        o[e] = (unsigned)ip[(size_t)jj * 512] | ((unsigned)ip[(size_t)(jj + 1) * 512] << 16);
      }
      *(u32x4*)(sVt + c * LDT + half * 32 + q4 * 8) = o;
    }
  }
  {
    float L[32], kin[32], t0, lc;
    hgrn_gates(p, row0, hh, sTot, L, kin, t0, lc);
    _Pragma("unroll") for (int q4 = 0; q4 < 4; ++q4) {
      u32x4 o;
      _Pragma("unroll") for (int e = 0; e < 4; ++e) {
        int jj = q4 * 8 + 2 * e;
        o[e] = pk2(kin[jj] * __expf(lc - L[jj]), kin[jj + 1] * __expf(lc - L[jj + 1]));
      }
      *(u32x4*)(sKt + c * LDT + half * 32 + q4 * 8) = o;
    }
    if (half == 0) p.dec[(n * 4 + hh) * 128 + c] = __expf(lc);
    bfr* qp = p.QB + (size_t)(row0 + half * 32) * 512 + hh * 128 + c;
    unsigned qraw[16];
    _Pragma("unroll") for (int e = 0; e < 16; ++e) qraw[e] = (unsigned)qp[(size_t)(2 * e) * 512] | ((unsigned)qp[(size_t)(2 * e + 1) * 512] << 16);
    __builtin_amdgcn_sched_barrier(0);
    _Pragma("unroll") for (int jj = 0; jj < 32; ++jj) {
      const float qv = (jj & 1) ? bfhi(qraw[jj >> 1]) : bflo(qraw[jj >> 1]);
      qp[(size_t)jj * 512] = (bfr)(pk2(qv * __expf(L[jj]), 0.f) & 0xffffu);
      const float dl = L[jj] - t0;
      sQh[(half * 32 + jj) * 136 + c] = (bfr)(pk2(qv * __expf(fminf(dl, 80.f)), 0.f) & 0xffffu);
      sKh[(half * 32 + jj) * 136 + c] = (bfr)(pk2(kin[jj] * __expf(fminf(-dl, 80.f)), 0.f) & 0xffffu);
    }
  }
  __syncthreads();
  {
    int r = lane & 31; asm volatile("" : "+v"(r));
    const int wv = w >> 1, wk = w & 1;
    f32x16 acc[2][2];
    _Pragma("unroll") for (int a = 0; a < 2; ++a) _Pragma("unroll") for (int b = 0; b < 2; ++b) acc[a][b] = zero16();
    _Pragma("unroll") for (int s = 0; s < 4; ++s) {
      bf16x8 af[2], bf[2];
      _Pragma("unroll") for (int x = 0; x < 2; ++x) {
        af[x] = *(const bf16x8*)(sVt + (wv * 64 + x * 32 + r) * LDT + 16 * s + 8 * h);
        bf[x] = *(const bf16x8*)(sKt + (wk * 64 + x * 32 + r) * LDT + 16 * s + 8 * h);
      }
      _Pragma("unroll") for (int a = 0; a < 2; ++a) _Pragma("unroll") for (int b = 0; b < 2; ++b) acc[a][b] = mfma(af[a], bf[b], acc[a][b]);
    }
    float* up = p.Ust + (size_t)(n * 4 + hh) * 16384;
    _Pragma("unroll") for (int a = 0; a < 2; ++a) _Pragma("unroll") for (int b = 0; b < 2; ++b) _Pragma("unroll") for (int i = 0; i < 16; ++i) {
      int v = wv * 64 + a * 32 + crow(i, h), k = wk * 64 + b * 32 + r;
      up[v * 128 + k] = acc[a][b][i];
    }
  }
  const int jt = w >> 1, it = w & 1;
  int r2 = lane & 31; asm volatile("" : "+v"(r2));
  f32x16 am = zero16();
  if (jt <= it) {
    _Pragma("unroll") for (int s = 0; s < 8; ++s) {
      bf16x8 kf = *(const bf16x8*)(sKh + (jt * 32 + r2) * 136 + 16 * s + 8 * h);
      bf16x8 qf = *(const bf16x8*)(sQh + (it * 32 + r2) * 136 + 16 * s + 8 * h);
      am = mfma(kf, qf, am);
    }
  }
  __syncthreads();
  {
    int r3 = lane & 31; asm volatile("" : "+v"(r3));
    const int i = it * 32 + r3;
    _Pragma("unroll") for (int g = 0; g < 4; ++g) {
      int j0 = jt * 32 + 8 * g + 4 * h;
      float x0 = (j0 <= i) ? am[4 * g] : 0.f, x1 = (j0 + 1 <= i) ? am[4 * g + 1] : 0.f;
      float x2 = (j0 + 2 <= i) ? am[4 * g + 2] : 0.f, x3 = (j0 + 3 <= i) ? am[4 * g + 3] : 0.f;
      *(u32x2*)(sAm + i * LDT + j0) = pack4(x0, x1, x2, x3);
    }
  }
  __syncthreads();
  {
    int r = lane & 31; asm volatile("" : "+v"(r));
    f32x16 oacc[2]; oacc[0] = zero16(); oacc[1] = zero16();
    _Pragma("unroll") for (int s = 0; s < 4; ++s) {
      bf16x8 vf = *(const bf16x8*)(sVt + (32 * w + r) * LDT + 16 * s + 8 * h);
      _Pragma("unroll") for (int i2 = 0; i2 < 2; ++i2) {
        bf16x8 af2 = *(const bf16x8*)(sAm + (i2 * 32 + r) * LDT + 16 * s + 8 * h);
        oacc[i2] = mfma(vf, af2, oacc[i2]);
      }
    }
    _Pragma("unroll") for (int i2 = 0; i2 < 2; ++i2) _Pragma("unroll") for (int g = 0; g < 4; ++g)
      *(u32x2*)(p.YB + (size_t)(row0 + i2 * 32 + r) * 1024 + hh * 128 + 32 * w + 8 * g + 4 * h) =
          pack4(oacc[i2][4 * g], oacc[i2][4 * g + 1], oacc[i2][4 * g + 2], oacc[i2][4 * g + 3]);
  }
}

DI void hgrn_sample_wave(const Params& p, int b, int hh, int lane, float* sw  ) {
  const int m = SEQ + b;
  _Pragma("unroll") for (int u = 0; u < 2; ++u) {
    const int k = lane + 64 * u, ch = hh * 128 + k;
    const float lbv = frcp(1.f + __expf(p.lb_logits[512 + ch] - p.lb_logits[ch]));
    float z = bf2f(p.ZF[(size_t)m * 512 + ch]);
    z = fminf(fmaxf(z, -30.f), 30.f);
    const float em = __expf(-z), sg = frcp(1.f + em);
    sw[k] = lbv + (1.f - lbv) * sg; sw[128 + k] = (1.f - lbv) * em * sg; sw[256 + k] = bf2f(p.QB[(size_t)m * 512 + ch]);
  }
  const int v4 = (lane & 31) * 4, kg = lane >> 5;
  const u32x2 vraw = *(const u32x2*)(p.IB + (size_t)m * 512 + hh * 128 + v4);
  const float4 vv = {bflo(vraw[0]), bfhi(vraw[0]), bflo(vraw[1]), bfhi(vraw[1])};
  __builtin_amdgcn_s_waitcnt(0xc07f);
  __builtin_amdgcn_wave_barrier();
  float4 o = {0.f, 0.f, 0.f, 0.f};
  const size_t sb = (size_t)(b * 4 + hh) * 16384 + (size_t)(kg * 64) * 128 + v4;
  const volatile float* swv = sw;
  _Pragma("unroll 1") for (int k0 = 0; k0 < 64; k0 += 16) {
    float4 Sv[16];
    _Pragma("unroll") for (int q = 0; q < 16; ++q) Sv[q] = *(const float4*)(p.state + sb + (k0 + q) * 128);
    __builtin_amdgcn_sched_barrier(0);
    _Pragma("unroll") for (int q = 0; q < 16; ++q) {
      const int k = kg * 64 + k0 + q;
      const float4 S = Sv[q];
      const float f = swv[k], ki = swv[128 + k], qq = swv[256 + k];
      float4 Sn; Sn.x = f * S.x + ki * vv.x; Sn.y = f * S.y + ki * vv.y; Sn.z = f * S.z + ki * vv.z; Sn.w = f * S.w + ki * vv.w;
      *(float4*)(p.out_ss + sb + (k0 + q) * 128) = Sn;
      o.x += qq * Sn.x; o.y += qq * Sn.y; o.z += qq * Sn.z; o.w += qq * Sn.w;
    }
  }
  o.x += __shfl_xor(o.x, 32); o.y += __shfl_xor(o.y, 32); o.z += __shfl_xor(o.z, 32); o.w += __shfl_xor(o.w, 32);
  float ss = o.x * o.x + o.y * o.y + o.z * o.z + o.w * o.w;
  _Pragma("unroll") for (int of = 16; of >= 1; of >>= 1) ss += __shfl_xor(ss, of);
  const float sc = rsqrtf(ss * (1.f / 128.f) + EPS);
  if (kg == 0) {
    const float4 og = *(const float4*)(p.og + v4);
    const u32x2 zb = *(const u32x2*)(p.ZB + (size_t)m * 512 + hh * 128 + v4);
    *(u32x2*)(p.YB + (size_t)m * 1024 + hh * 128 + v4) = pack4(o.x * sc * og.x * bflo(zb[0]), o.y * sc * og.y * bfhi(zb[0]), o.z * sc * og.z * bflo(zb[1]), o.w * sc * og.w * bfhi(zb[1]));
  }
  __builtin_amdgcn_wave_barrier();
}

DI void cache_shift_copy(const Params& p, int gw, int nw, int lane, int part) {
  const int lo = part * (64 * 4064), hi = lo + 64 * 4064, st = nw * 64;
  for (int idx0 = lo + gw * 64 + lane; idx0 < hi; idx0 += 4 * st) {
    const int i0 = idx0, i1 = min(idx0 + st, hi - 1), i2 = min(idx0 + 2 * st, hi - 1), i3 = min(idx0 + 3 * st, hi - 1);
#define CSC_SRC(i) ((size_t)((i) / 4064) * 16384 + 128 + (size_t)((i) % 4064) * 4)
#define CSC_DST(i) ((size_t)((i) / 4064) * 16384 + (size_t)((i) % 4064) * 4)
    const float4 ka = *(const float4*)(p.cache_k + CSC_SRC(i0)), kb = *(const float4*)(p.cache_k + CSC_SRC(i1));
    const float4 kc = *(const float4*)(p.cache_k + CSC_SRC(i2)), kd = *(const float4*)(p.cache_k + CSC_SRC(i3));
    const float4 va = *(const float4*)(p.cache_v + CSC_SRC(i0)), vb = *(const float4*)(p.cache_v + CSC_SRC(i1));
    const float4 vc = *(const float4*)(p.cache_v + CSC_SRC(i2)), vd = *(const float4*)(p.cache_v + CSC_SRC(i3));
    __builtin_amdgcn_sched_barrier(0);
    *(float4*)(p.out_ks + CSC_DST(i0)) = ka; *(float4*)(p.out_vs + CSC_DST(i0)) = va;
    *(float4*)(p.out_ks + CSC_DST(i1)) = kb; *(float4*)(p.out_vs + CSC_DST(i1)) = vb;
    *(float4*)(p.out_ks + CSC_DST(i2)) = kc; *(float4*)(p.out_vs + CSC_DST(i2)) = vc;
    *(float4*)(p.out_ks + CSC_DST(i3)) = kd; *(float4*)(p.out_vs + CSC_DST(i3)) = vd;
#undef CSC_SRC
#undef CSC_DST
  }
}

DI void phase_mix(const Params& p, char* smem, char* smem_all) {
  const int wave = threadIdx.x >> 6, lane = threadIdx.x & 63, gw = blockIdx.x * 8 + wave, nw = gridDim.x * 8;
  float* sw = (float*)(smem_all + wave * 2048);
  if (gw & 1) {
    for (int it = gw >> 1; it < 1024; it += nw >> 1) attn_sample_wave(p, it >> 3, it & 7, sw);
    cache_shift_copy(p, gw >> 1, nw >> 1, lane, 0);
    for (int it = gw; it < 4096; it += nw) attn_prompt_wave(p, it >> 3, it & 7, lane);
  } else {
    int it = gw;
    if (it < 4096) { attn_prompt_wave(p, it >> 3, it & 7, lane); it += nw; }
    if ((gw & 3) == 0) { for (int hs = gw >> 2; hs < 512; hs += nw >> 2) hgrn_sample_wave(p, hs >> 2, hs & 3, lane, sw); }
    cache_shift_copy(p, gw >> 1, nw >> 1, lane, 1);
    for (; it < 4096; it += nw) attn_prompt_wave(p, it >> 3, it & 7, lane);
  }
  for (int it = VBID; it < 1024; it += VGRID) hgrn_fused_item(p, it >> 2, it & 3, smem);
}

#define SCAN_LOAD(U, Dd, N0) _Pragma("unroll") for (int i = 0; i < 32; ++i) { U[i] = up[(size_t)((N0) + i) * 65536]; Dd[i] = dp[((N0) + i) * 512]; }
#define SCAN_STEP(U, Dd, N0) _Pragma("unroll") for (int i = 0; i < 32; ++i) { sp[(size_t)((N0) + i) * 65536] = (bfr)(pk2(S, 0.f) & 0xffffu); S = Dd[i] * S + U[i]; }
DI void phase_scan(const Params& p, int eb) {
  const int e = eb * 256 + threadIdx.x;
  const int hh = e >> 14, k = e & 127, v = (e >> 7) & 127;
  const float* up = p.Ust + e;
  bfr* sp = p.S16 + e;
  const float* dp = p.dec + hh * 128 + k;
  float S = 0.f;
  float ua[32], da[32], ub[32], db[32];
  SCAN_LOAD(ua, da, 0)
  for (int n0 = 0; n0 < NCH; n0 += 64) {
    SCAN_LOAD(ub, db, n0 + 32)
    SCAN_STEP(ua, da, n0)
    if (n0 + 64 < NCH) { SCAN_LOAD(ua, da, n0 + 64) }
    SCAN_STEP(ub, db, n0 + 32)
  }
  p.out_sp[(hh * 128 + k) * 128 + v] = S;
}

DI void hgrn_out_wave(const Params& p, int n, int hh, int it, int lane) {
  const int r = lane & 31, h = lane >> 5;
  const size_t row = (size_t)(n * 64 + it * 32 + r);
  bf16x8 qf[8];
  _Pragma("unroll") for (int s = 0; s < 8; ++s) qf[s] = *(const bf16x8*)(p.QB + row * 512 + hh * 128 + 16 * s + 8 * h);
  const bfr* sb = p.S16 + (size_t)(n * 4 + hh) * 16384 + (size_t)r * 128 + 8 * h;
  f32x16 acc[4];
  _Pragma("unroll") for (int vt = 0; vt < 4; ++vt) {
    acc[vt] = zero16();
    _Pragma("unroll") for (int s = 0; s < 8; ++s) {
      bf16x8 sf = *(const bf16x8*)(sb + vt * 32 * 128 + 16 * s);
      acc[vt] = mfma(sf, qf[s], acc[vt]);
    }
  }
  float ss = 0.f;
  _Pragma("unroll") for (int vt = 0; vt < 4; ++vt) _Pragma("unroll") for (int g = 0; g < 4; ++g) {
    const u32x2 oi = *(const u32x2*)(p.YB + row * 1024 + hh * 128 + 32 * vt + 8 * g + 4 * h);
    acc[vt][4 * g] += bflo(oi[0]); acc[vt][4 * g + 1] += bfhi(oi[0]); acc[vt][4 * g + 2] += bflo(oi[1]); acc[vt][4 * g + 3] += bfhi(oi[1]);
    ss += acc[vt][4 * g] * acc[vt][4 * g] + acc[vt][4 * g + 1] * acc[vt][4 * g + 1] + acc[vt][4 * g + 2] * acc[vt][4 * g + 2] + acc[vt][4 * g + 3] * acc[vt][4 * g + 3];
  }
  ss += __shfl_xor(ss, 32);
  const float sc = rsqrtf(ss * (1.f / 128.f) + EPS);
  u32x2 zbv[16];
  _Pragma("unroll") for (int vt = 0; vt < 4; ++vt) _Pragma("unroll") for (int g = 0; g < 4; ++g) zbv[vt * 4 + g] = *(const u32x2*)(p.ZB + row * 512 + hh * 128 + 32 * vt + 8 * g + 4 * h);
  __builtin_amdgcn_sched_barrier(0);
  _Pragma("unroll") for (int vt = 0; vt < 4; ++vt) _Pragma("unroll") for (int g = 0; g < 4; ++g) {
    const int v = 32 * vt + 8 * g + 4 * h;
    const float4 og = *(const float4*)(p.og + v);
    const u32x2 zb = zbv[vt * 4 + g];
    *(u32x2*)(p.YB + row * 1024 + hh * 128 + v) = pack4(acc[vt][4 * g] * sc * og.x * bflo(zb[0]), acc[vt][4 * g + 1] * sc * og.y * bfhi(zb[0]),
                                                        acc[vt][4 * g + 2] * sc * og.z * bflo(zb[1]), acc[vt][4 * g + 3] * sc * og.w * bfhi(zb[1]));
  }
}

#define XB_TMO      128
#define XB_XCNT(j)  (256  + 64 * (j))
#define XB_XSUB(j)  (1280 + 64 * (j))
#define XB_XGEN(j)  (2304 + 64 * (j))
#define XB_TOP      3328
#define XB_TOPGEN   3392
#define XCD_BAR_WORDS 3456
#define XB_SPIN_CAP (1u << 18)
#define LAS __attribute__((address_space(3)))

__device__ __forceinline__ unsigned xb_ld(unsigned* p)              { return __hip_atomic_load(p, __ATOMIC_RELAXED, __HIP_MEMORY_SCOPE_AGENT); }
__device__ __forceinline__ unsigned xb_add(unsigned* p, unsigned v) { return __hip_atomic_fetch_add(p, v, __ATOMIC_RELAXED, __HIP_MEMORY_SCOPE_AGENT); }
__device__ __forceinline__ unsigned xb_xcc_id() { return (unsigned)__builtin_amdgcn_s_getreg((3 << 11) | 20) & 0xFu; }
#define XB_SPIN(cond, bar) do { unsigned _sp = 0; while (cond) { __builtin_amdgcn_s_sleep(1); \
    if ((++_sp & 255u) == 0u) { if (xb_ld(&(bar)[XB_TMO])) break; if (_sp > XB_SPIN_CAP) { atomicAdd(&(bar)[XB_TMO], 1u); break; } } } } while (0)

struct XcdBarrier {
    unsigned* bar; unsigned x;
    volatile LAS unsigned* st;
};

__device__ __forceinline__ XcdBarrier xcd_barrier_post(unsigned* bar, volatile LAS unsigned* st) {
    XcdBarrier b; b.bar = bar; b.x = xb_xcc_id(); b.st = st;
    if (threadIdx.x == 0) (void)xb_add(&bar[XB_XCNT(b.x)], 1u);
    return b;
}
__device__ __forceinline__ void xcd_barrier_complete(unsigned* bar, unsigned x, unsigned& nloc, unsigned& nx) {
    const unsigned G = gridDim.x * gridDim.y * gridDim.z;
    unsigned sum, cnt, mine, sp = 0u;
    for (;;) {
        sum = 0u; cnt = 0u; mine = 0u;
#pragma unroll
        for (unsigned j = 0; j < 16; ++j) { const unsigned c = xb_ld(&bar[XB_XCNT(j)]); sum += c; cnt += (c > 0u) ? 1u : 0u; mine = (j == x) ? c : mine; }
        if (sum == G) break;
        __builtin_amdgcn_s_sleep(1);
        if ((++sp & 255u) == 0u) { if (xb_ld(&bar[XB_TMO])) break; if (sp > XB_SPIN_CAP) { atomicAdd(&bar[XB_TMO], 1u); break; } }
    }
    nloc = mine > 0u ? mine : 1u; nx = cnt > 0u ? cnt : 1u;
}

__device__ __forceinline__ void xcd_barrier(const XcdBarrier& b) {
    asm volatile("s_waitcnt vmcnt(0)" ::: "memory");
    __syncthreads();
    if (threadIdx.x == 0) {
        unsigned* bar = b.bar;
        __builtin_amdgcn_s_waitcnt(0);
        unsigned nloc = b.st[0], nx = b.st[1];
        if (nloc == 0u) { xcd_barrier_complete(bar, b.x, nloc, nx); b.st[0] = nloc; b.st[1] = nx; }
        const unsigned old = xb_add(&bar[XB_XSUB(b.x)], 1u);
        const unsigned gen = old / nloc;
        if (old + 1u == (gen + 1u) * nloc) {
            __builtin_amdgcn_fence(__ATOMIC_RELEASE, "agent");
            asm volatile("s_waitcnt vmcnt(0)" ::: "memory");
            const unsigned og = xb_add(&bar[XB_TOP], 1u);
            const unsigned tg = og / nx;
            if (og + 1u == (tg + 1u) * nx) xb_add(&bar[XB_TOPGEN], 1u);
            else XB_SPIN(xb_ld(&bar[XB_TOPGEN]) == tg, bar);
            __builtin_amdgcn_fence(__ATOMIC_ACQUIRE, "agent");
            xb_add(&bar[XB_XGEN(b.x)], 1u);
            asm volatile("s_waitcnt vmcnt(0)" ::: "memory");
        } else {
            XB_SPIN(xb_ld(&bar[XB_XGEN(b.x)]) == gen, bar);
            __builtin_amdgcn_fence(__ATOMIC_ACQUIRE, "agent");
            asm volatile("s_waitcnt vmcnt(0)" ::: "memory");
        }
    }
    __syncthreads();
}

static_assert(PANEL_CNT_WORD == XCD_BAR_WORDS, "panel counters follow the barrier words");
__global__ void __launch_bounds__(512, 2) hybrid_megakernel(Params p) {
  extern __shared__ __attribute__((aligned(16))) char smem_all[];
  __shared__ uint4 xb_words;
  if (threadIdx.x == 0) xb_words = make_uint4(0u, 0u, 0u, 0u);
  __syncthreads();
  const XcdBarrier xb = xcd_barrier_post(p.bar, (volatile LAS unsigned*)&xb_words);
  char* smem = smem_all + (threadIdx.x >> 8) * 73728;
#ifndef REPMASK
#define REPMASK 0
#endif
#define RUN_PHASE(n, ...) if (p.phase_lo <= n && n <= p.phase_hi) { if (n != p.phase_lo) xcd_barrier(xb); __VA_ARGS__; if ((REPMASK >> n) & 1) { xcd_barrier(xb); __VA_ARGS__; } }
  RUN_PHASE(0, phase_prep(p, smem))
  RUN_PHASE(1, { if (VBID < 48) phase_mod(p, smem); else phase_prep2(p, smem, VBID - 48, VGRID - 48); })
  RUN_PHASE(2, phase_h(p))
  RUN_PHASE(3, {
    pg8::Gemm g{p.H, p.Wt_all, MPAD, NALL, 1024};
    pg8::StaticOrder S; S.init(MPAD, NALL, (int)gridDim.x, (int)blockIdx.x);
    EpiMain E{p};
    pg8::gemm_phase<EpiMain, pg8::StaticOrder, false>((PG8_LAS unsigned char*)smem_all, g, S, E, nullptr);
  })
  RUN_PHASE(4, phase_mix(p, smem, smem_all))
  RUN_PHASE(5, {
    if (threadIdx.x < 256) { for (int eb = blockIdx.x; eb < 256; eb += gridDim.x) phase_scan(p, eb); }
    else { const int wt = blockIdx.x * 4 + ((threadIdx.x >> 6) - 4); if (wt < 128) sample_chain_wave(p, wt, threadIdx.x & 63); }
  })
  RUN_PHASE(6, {
    for (int wi = blockIdx.x * 8 + (threadIdx.x >> 6); wi < 2048; wi += gridDim.x * 8) hgrn_out_wave(p, wi >> 3, (wi >> 1) & 3, wi & 1, threadIdx.x & 63);
  })
  RUN_PHASE(7, {
    pg8::Gemm g{p.YA, p.Wt_pab, SEQ, 1024, 1024};
    pg8::StaticOrder S; S.init(SEQ, 1024, (int)gridDim.x, (int)blockIdx.x);
    EpiMerge E{p};
    pg8::gemm_phase<EpiMerge, pg8::StaticOrder, false>((PG8_LAS unsigned char*)smem_all, g, S, E, nullptr);
  })
  RUN_PHASE(8, {
    pg8::Gemm g{p.Y, p.Wt_out, SEQ, 1024, 1024};
    pg8::StaticOrder S; S.init(SEQ, 1024, (int)gridDim.x, (int)blockIdx.x);
    if ((int)gridDim.x == (SEQ / 256) * 4) {
      EpiOutLds E{p};
      pg8::gemm_phase<EpiOutLds, pg8::StaticOrder, false>((PG8_LAS unsigned char*)smem_all, g, S, E, nullptr);
    } else {
      EpiOut E{p};
      pg8::gemm_phase<EpiOut, pg8::StaticOrder, false>((PG8_LAS unsigned char*)smem_all, g, S, E, nullptr);
    }
  })
}

#ifndef ONE_LAUNCH
#define ONE_LAUNCH 1
#endif
constexpr size_t kDynLds = 147456;

extern "C" void kernel_launch(void* const* d_in, const int* in_sizes, int n_in, void* d_out, int out_size, void* d_ws, size_t ws_size,
                              hipStream_t stream) {
  static int grid_blocks = 0;
  if (!grid_blocks) {
    int dev = 0, cus = 0, per_cu = 0;
    (void)hipGetDevice(&dev);
    (void)hipDeviceGetAttribute(&cus, hipDeviceAttributeMultiprocessorCount, dev);
    (void)hipFuncSetAttribute((const void*)hybrid_megakernel, hipFuncAttributeMaxDynamicSharedMemorySize, (int)kDynLds);
    (void)hipOccupancyMaxActiveBlocksPerMultiprocessor(&per_cu, hybrid_megakernel, 512, kDynLds);
    if (per_cu > 1) per_cu = 1;
    if (per_cu < 1) per_cu = 1;
    grid_blocks = cus * per_cu;
  }
  Params p{};
  const float* const* in = (const float* const*)d_in;
  p.x_prompt = in[0]; p.x_sample = in[1]; p.cache_k = in[2]; p.cache_v = in[3]; p.state = in[4]; p.c_prompt = in[5]; p.c_sample = in[6];
  p.w_ada = in[7]; p.b_ada = in[8]; p.norm_g = in[9]; p.w_in = in[10]; p.qg = in[11]; p.kg = in[12]; p.sinks = in[13]; p.lb_logits = in[14];
  p.og = in[15]; p.w_merge = in[16]; p.b_merge = in[17]; p.w_pa = in[18]; p.w_pb = in[19]; p.w_out = in[20];
  float* o = (float*)d_out;
  p.out_yp = o; o += (size_t)SEQ * DM;
  p.out_ys = o; o += (size_t)NBT * DM;
  p.out_kp = o; o += 128 * 128;
  p.out_vp = o; o += 128 * 128;
  p.out_sp = o; o += 4 * 128 * 128;
  p.out_ks = o; o += (size_t)NBT * 128 * 128;
  p.out_vs = o; o += (size_t)NBT * 128 * 128;
  p.out_ss = o;
  char* wsp = (char*)d_ws;
  auto take = [&](size_t bytes) { char* r = wsp; wsp += (bytes + 255) & ~(size_t)255; return r; };
  p.bar = (unsigned*)take((size_t)(XCD_BAR_WORDS + 256) * 4);
  p.Wt_all = (bfr*)take((size_t)NALL * 1024 * 2);
  p.Wt_pab = (bfr*)take((size_t)1024 * 1024 * 2);
  p.Wt_out = (bfr*)take((size_t)1024 * 1024 * 2);
  p.Wt_ada = (bfr*)take((size_t)3072 * 1024 * 2);
  p.Cb = (bfr*)take((size_t)256 * 1024 * 2);
  p.mod = (float*)take((size_t)256 * 3072 * 4);
  p.Ys = (bfr*)take((size_t)128 * 1024 * 2);
  p.H = (bfr*)take((size_t)MPAD * 1024 * 2);
  p.YA = p.H; p.YB = p.H + 512;
  p.ZA = (bfr*)take((size_t)MTOT * 512 * 2);
  p.S16 = p.ZA;
  p.Q = (bfr*)take((size_t)MTOT * 512 * 2);
  p.QB = (bfr*)take((size_t)MTOT * 512 * 2);
  p.Y = p.Q;
  p.Kb = (bfr*)take((size_t)MTOT * 128 * 2);
  p.Vb = (bfr*)take((size_t)MTOT * 128 * 2);
  p.IB = (bfr*)take((size_t)MTOT * 512 * 2);
  p.ZB = (bfr*)take((size_t)MTOT * 512 * 2);
  p.ZF = (bfr*)take((size_t)MTOT * 512 * 2);
  p.GA = (bfr*)take((size_t)MTOT * 1024 * 2);
  p.GB = (bfr*)take((size_t)MTOT * 1024 * 2);
  p.dec = (float*)take((size_t)NCH * 4 * 128 * 4);
  p.Ust = p.out_yp;
  if ((size_t)(wsp - (char*)d_ws) > ws_size) { fprintf(stderr, "workspace too small\n"); return; }
  (void)hipMemsetAsync(p.bar, 0, (size_t)(XCD_BAR_WORDS + 256) * 4, stream);
#if ONE_LAUNCH
  p.phase_lo = 0; p.phase_hi = 8;
  void* args[] = {&p};
  hipError_t e = hipLaunchCooperativeKernel((void*)hybrid_megakernel, dim3(grid_blocks), dim3(512), args, kDynLds, stream);
  if (e != hipSuccess) fprintf(stderr, "cooperative launch failed: %s (grid %d)\n", hipGetErrorString(e), grid_blocks);
#else
  for (int ph = 0; ph <= 8; ++ph) {
    p.phase_lo = ph; p.phase_hi = ph;
    hipLaunchKernelGGL(hybrid_megakernel, dim3(grid_blocks), dim3(512), kDynLds, stream, p);
  }
#endif
}
```

```cpp
#include <hip/hip_runtime.h>
#include <cstdio>

#define DI __device__ __forceinline__
typedef unsigned short bfr;
using bf16x8 = __attribute__((ext_vector_type(8))) short;
using f32x16 = __attribute__((ext_vector_type(16))) float;
using u32x4 = __attribute__((ext_vector_type(4))) unsigned;
using u32x2 = __attribute__((ext_vector_type(2))) unsigned;

constexpr int DM = 1024, SEQ = 16384, NBT = 128, MTOT = SEQ + NBT;
constexpr int NALL = 5376;
constexpr int NCH = 256;
constexpr float EPS = 1e-6f;
constexpr float LOG2E = 1.4426950408889634f;
constexpr float QSCALE = 0.125f * 1.4426950408889634f;
constexpr int PANEL_CNT_WORD = 3456;
constexpr int LDT = 72;
constexpr int MPAD = 16640;
#define TID ((int)(threadIdx.x & 255))
#define VBID ((int)(blockIdx.x * 2 + (threadIdx.x >> 8)))
#define VGRID ((int)(gridDim.x * 2))

struct Params {
  const float *x_prompt, *x_sample, *cache_k, *cache_v, *state, *c_prompt, *c_sample;
  const float *w_ada, *b_ada, *norm_g, *w_in, *qg, *kg, *sinks, *lb_logits, *og, *w_merge, *b_merge, *w_pa, *w_pb, *w_out;
  float *out_yp, *out_ys, *out_kp, *out_vp, *out_sp, *out_ks, *out_vs, *out_ss;
  bfr *Wt_all, *Wt_pab, *Wt_out, *Wt_ada, *Cb, *H, *Q, *QB, *Kb, *Vb, *ZA, *IB, *ZB, *GA, *GB, *YA, *YB, *Y;
  float *mod, *dec, *Ust;
  bfr* ZF;
  bfr* S16;
  bfr* Ys;
  unsigned* bar;
  int phase_lo, phase_hi;
};

DI unsigned f2bf(float x) { unsigned u = __float_as_uint(x); u += 0x7fffu + ((u >> 16) & 1u); return u >> 16; }
typedef __bf16 hbf2 __attribute__((ext_vector_type(2)));
typedef float hf2 __attribute__((ext_vector_type(2)));
DI unsigned pk2(float a, float b) { hf2 v = {a, b}; return __builtin_bit_cast(unsigned, __builtin_convertvector(v, hbf2)); }
DI float bf2f(unsigned b) { return __uint_as_float(b << 16); }
DI float bflo(unsigned u) { return __uint_as_float(u << 16); }
DI float bfhi(unsigned u) { return __uint_as_float(u & 0xffff0000u); }
DI int crow(int i, int h) { return (i & 3) + 8 * (i >> 2) + 4 * h; }
DI f32x16 mfma(bf16x8 a, bf16x8 b, f32x16 c) { return __builtin_amdgcn_mfma_f32_32x32x16_bf16(a, b, c, 0, 0, 0); }
DI f32x16 zero16() { f32x16 z; _Pragma("unroll") for (int i = 0; i < 16; ++i) z[i] = 0.f; return z; }
DI float frcp(float x) { return __builtin_amdgcn_rcpf(x); }
DI float fexp(float x) { return __builtin_amdgcn_exp2f(x * 1.4426950408889634f); }
DI float sigmoidf_(float x) { return frcp(1.f + fexp(-x)); }
DI float siluf_(float x) { return x * frcp(1.f + fexp(-x)); }
DI u32x2 pack4(float a, float b, float c, float d) { u32x2 r; r[0] = pk2(a, b); r[1] = pk2(c, d); return r; }

DI int wt_row_of_col(int c) {
  const int pn = c >> 8, cl = c & 255;
  int slot;
  if (pn < 3) {
    const int g = cl >> 6, d = cl & 63;
    if (d >= 32) { const int x = d - 32; slot = 128 + 32 * g + 16 * ((x >> 2) & 1) + 4 * (x >> 3) + (x & 3); }
    else { const int fq = 2 * (d >> 4) + ((d >> 2) & 1), n = (d >> 3) & 1, j = d & 3; slot = 32 * g + 16 * n + 4 * fq + j; }
  } else {
    const int bj = cl >> 7, g = (cl >> 5) & 3, x = cl & 31;
    slot = 128 * bj + 32 * g + 16 * ((x >> 2) & 1) + 4 * (x >> 3) + (x & 3);
  }
  return (pn << 8) + slot;
}

DI void gemm_mainloop(const bfr* __restrict__ A, int lda, int m0, const bfr* __restrict__ W, int ldw, int n0, int K,
                      bfr* sA, bfr* sW, f32x16 (&acc)[2][2]) {
  const int t = TID, lane = t & 63, w = t >> 6, wn = w >> 1, wm = w & 1, r = lane & 31, h = lane >> 5;
  const int lrow = t >> 3, lk = (t & 7) * 8;
  const bfr* ap = A + (size_t)(m0 + lrow) * lda + lk;
  const bfr* wp = W + (size_t)(n0 + lrow) * ldw + lk;
  u32x4 ra[4], rw[4];
  _Pragma("unroll") for (int i = 0; i < 4; ++i) {
    ra[i] = *(const u32x4*)(ap + (size_t)(32 * i) * lda);
    rw[i] = *(const u32x4*)(wp + (size_t)(32 * i) * ldw);
  }
  const int nk = K >> 6;
  for (int kt = 0; kt < nk; ++kt) {
    __syncthreads();
    _Pragma("unroll") for (int i = 0; i < 4; ++i) {
      *(u32x4*)(sA + (lrow + 32 * i) * LDT + lk) = ra[i];
      *(u32x4*)(sW + (lrow + 32 * i) * LDT + lk) = rw[i];
    }
    __syncthreads();
    if (kt + 1 < nk) {
      ap += 64; wp += 64;
      _Pragma("unroll") for (int i = 0; i < 4; ++i) {
        ra[i] = *(const u32x4*)(ap + (size_t)(32 * i) * lda);
        rw[i] = *(const u32x4*)(wp + (size_t)(32 * i) * ldw);
      }
    }
    _Pragma("unroll") for (int kk = 0; kk < 4; ++kk) {
      bf16x8 af[2], bf[2];
      _Pragma("unroll") for (int x = 0; x < 2; ++x) {
        af[x] = *(const bf16x8*)(sW + (wn * 64 + x * 32 + r) * LDT + kk * 16 + 8 * h);
        bf[x] = *(const bf16x8*)(sA + (wm * 64 + x * 32 + r) * LDT + kk * 16 + 8 * h);
      }
      _Pragma("unroll") for (int nt = 0; nt < 2; ++nt)
        _Pragma("unroll") for (int mt = 0; mt < 2; ++mt) acc[nt][mt] = mfma(af[nt], bf[mt], acc[nt][mt]);
    }
  }
}

template <int PERMBASE> DI void transpose_tile(const float* __restrict__ src, int N, bfr* __restrict__ dst, int K, int kt, int nt, float* sm) {
  const int t = TID, k0 = kt * 64, n0 = nt * 64;
  __syncthreads();
  _Pragma("unroll") for (int i = 0; i < 16; ++i) {
    int idx = i * 256 + t, kk = idx >> 6, nn = idx & 63;
    sm[kk * 65 + nn] = src[(size_t)(k0 + kk) * N + n0 + nn];
  }
  __syncthreads();
  _Pragma("unroll") for (int i = 0; i < 8; ++i) {
    int idx = i * 256 + t, nn = idx >> 5, kk = (idx & 31) * 2;
    const int drow = PERMBASE >= 0 ? wt_row_of_col(PERMBASE + n0 + nn) : n0 + nn;
    *(unsigned*)(dst + (size_t)drow * K + k0 + kk) = pk2(sm[kk * 65 + nn], sm[(kk + 1) * 65 + nn]);
  }
}

DI void phase_prep(const Params& p, char* smem) {
  float* sm = (float*)smem;
  for (int it = VBID; it < 768; it += VGRID) transpose_tile<-1>(p.w_ada, 3072, p.Wt_ada, 1024, it / 48, it % 48, sm);
  for (int idx = VBID * 256 + TID; idx < 256 * 1024; idx += VGRID * 256) {
    int row = idx >> 10, col = idx & 1023;
    float v = row < 128 ? p.c_sample[row * 1024 + col] : (row == 128 ? p.c_prompt[col] : 0.f);
    p.Cb[idx] = (bfr)f2bf(v);
  }
}
DI void phase_prep2(const Params& p, char* smem, int vb0, int nvb) {
  float* sm = (float*)smem;
  for (int it = vb0; it < 1856; it += nvb) {
    int i = it;
    if (i < 832) { transpose_tile<0>(p.w_in, 3328, p.Wt_all, 1024, i / 52, i % 52, sm); continue; }
    i -= 832;
    if (i < 512) { transpose_tile<3328>(p.w_merge, 2048, p.Wt_all, 1024, i / 32, i % 32, sm); continue; }
    i -= 512;
    if (i < 128) { transpose_tile<-1>(p.w_pa, 1024, p.Wt_pab, 1024, i / 16, i % 16, sm); continue; }
    i -= 128;
    if (i < 128) { transpose_tile<-1>(p.w_pb, 1024, p.Wt_pab + 512, 1024, i / 16, i % 16, sm); continue; }
    i -= 128;
    transpose_tile<-1>(p.w_out, 1024, p.Wt_out, 1024, i / 16, i % 16, sm);
  }
}

DI void phase_mod(const Params& p, char* smem) {
  bfr* sA = (bfr*)smem; bfr* sW = sA + 128 * LDT;
  const int t = TID, lane = t & 63, w = t >> 6, wn = w >> 1, wm = w & 1, r = lane & 31, h = lane >> 5;
  for (int tile = VBID; tile < 48; tile += VGRID) {
    int m0 = (tile / 24) * 128, n0 = (tile % 24) * 128;
    f32x16 acc[2][2];
    _Pragma("unroll") for (int a = 0; a < 2; ++a) _Pragma("unroll") for (int b = 0; b < 2; ++b) acc[a][b] = zero16();
    gemm_mainloop(p.Cb, 1024, m0, p.Wt_ada, 1024, n0, 1024, sA, sW, acc);
    float4 bias[2][4];
    _Pragma("unroll") for (int nt = 0; nt < 2; ++nt) _Pragma("unroll") for (int g = 0; g < 4; ++g) bias[nt][g] = *(const float4*)(p.b_ada + n0 + wn * 64 + nt * 32 + 8 * g + 4 * h);
    _Pragma("unroll") for (int nt = 0; nt < 2; ++nt) _Pragma("unroll") for (int mt = 0; mt < 2; ++mt) {
      int m = m0 + wm * 64 + mt * 32 + r;
      _Pragma("unroll") for (int g = 0; g < 4; ++g) {
        int n = n0 + wn * 64 + nt * 32 + 8 * g + 4 * h;
        float4 b = bias[nt][g];
        float4 o; o.x = acc[nt][mt][4 * g] + b.x; o.y = acc[nt][mt][4 * g + 1] + b.y; o.z = acc[nt][mt][4 * g + 2] + b.z; o.w = acc[nt][mt][4 * g + 3] + b.w;
        *(float4*)(p.mod + (size_t)m * 3072 + n) = o;
      }
    }
  }
}

DI void phase_h(const Params& p) {
  const int lane = threadIdx.x & 63, gw = blockIdx.x * 8 + (threadIdx.x >> 6), nw = gridDim.x * 8;
  float4 g[4];
  _Pragma("unroll") for (int j = 0; j < 4; ++j) g[j] = *(const float4*)(p.norm_g + j * 256 + lane * 4);
  {
    const float* mr = p.mod + (size_t)128 * 3072;
    float4 a[4], bsh[4];
    _Pragma("unroll") for (int j = 0; j < 4; ++j) {
      const int col = j * 256 + lane * 4;
      const float4 sh = *(const float4*)(mr + col), sc = *(const float4*)(mr + 1024 + col);
      a[j].x = g[j].x * (1.f + sc.x); a[j].y = g[j].y * (1.f + sc.y); a[j].z = g[j].z * (1.f + sc.z); a[j].w = g[j].w * (1.f + sc.w);
      bsh[j] = sh;
    }
    for (int r0 = gw; r0 < SEQ; r0 += 8 * nw) {
      float4 xv[8][4];
      _Pragma("unroll") for (int q = 0; q < 8; ++q) {
        const int row = min(r0 + q * nw, SEQ - 1);
        _Pragma("unroll") for (int j = 0; j < 4; ++j) xv[q][j] = *(const float4*)(p.x_prompt + (size_t)row * DM + j * 256 + lane * 4);
      }
      __builtin_amdgcn_sched_barrier(0);
      _Pragma("unroll") for (int q = 0; q < 8; ++q) {
        const int row = r0 + q * nw;
        float ss = 0.f;
        _Pragma("unroll") for (int j = 0; j < 4; ++j) ss += xv[q][j].x * xv[q][j].x + xv[q][j].y * xv[q][j].y + xv[q][j].z * xv[q][j].z + xv[q][j].w * xv[q][j].w;
        _Pragma("unroll") for (int o = 32; o >= 1; o >>= 1) ss += __shfl_xor(ss, o);
        const float rs = rsqrtf(ss * (1.f / DM) + EPS);
        if (row < SEQ) {
          _Pragma("unroll") for (int j = 0; j < 4; ++j)
            *(u32x2*)(p.H + (size_t)row * DM + j * 256 + lane * 4) = pack4(xv[q][j].x * rs * a[j].x + bsh[j].x, xv[q][j].y * rs * a[j].y + bsh[j].y,
                                                                          xv[q][j].z * rs * a[j].z + bsh[j].z, xv[q][j].w * rs * a[j].w + bsh[j].w);
        }
      }
    }
  }
  for (int b = gw; b < NBT; b += nw) {
    const float* xr = p.x_sample + (size_t)b * DM;
    const float* mr = p.mod + (size_t)b * 3072;
    float4 xv[4], sh[4], sc[4]; float ss = 0.f;
    _Pragma("unroll") for (int j = 0; j < 4; ++j) {
      const int col = j * 256 + lane * 4;
      xv[j] = *(const float4*)(xr + col); sh[j] = *(const float4*)(mr + col); sc[j] = *(const float4*)(mr + 1024 + col);
      ss += xv[j].x * xv[j].x + xv[j].y * xv[j].y + xv[j].z * xv[j].z + xv[j].w * xv[j].w;
    }
    _Pragma("unroll") for (int o = 32; o >= 1; o >>= 1) ss += __shfl_xor(ss, o);
    const float rs = rsqrtf(ss * (1.f / DM) + EPS);
    _Pragma("unroll") for (int j = 0; j < 4; ++j)
      *(u32x2*)(p.H + (size_t)(SEQ + b) * DM + j * 256 + lane * 4) = pack4(xv[j].x * rs * g[j].x * (1.f + sc[j].x) + sh[j].x, xv[j].y * rs * g[j].y * (1.f + sc[j].y) + sh[j].y,
                                                                          xv[j].z * rs * g[j].z * (1.f + sc[j].z) + sh[j].z, xv[j].w * rs * g[j].w * (1.f + sc[j].w) + sh[j].w);
  }
}

DI void sincos_red(float a, float& s, float& c) {
  float n = rintf(a * 0.15915494309189535f);
  float rr = fmaf(-n, 6.2831854820251465f, a);
  rr = fmaf(-n, -1.7484555e-7f, rr);
  s = __sinf(rr); c = __cosf(rr);
}

namespace pg8 {
#define PG8_LAS __attribute__((address_space(3)))
typedef unsigned short bf16_t;
typedef short bf16x8 __attribute__((ext_vector_type(8)));
typedef float f32x4 __attribute__((ext_vector_type(4)));
typedef unsigned u32x4 __attribute__((ext_vector_type(4)));
constexpr int BM = 256, BK = 64, HALF = 128, HTB = HALF * BK * 2  , STAGE_BYTES = 8 * HTB, NXCD = 8, WGM = 8;

__host__ __device__ __forceinline__ int lds_byte(int r, int c) { const int st = (r >> 4) * 2 + (c >> 5), rr = r & 15, cc = c & 31, ob = rr * 64 + cc * 2; return st * 1024 + (ob ^ (((ob >> 9) & 1) << 5)); }
__host__ __device__ __forceinline__ void stage_rc(int b, int& R, int& C) { const int st = b / 1024, sb = b % 1024, swz = sb ^ (((sb >> 9) & 1) << 5); R = (st >> 1) * 16 + swz / 64; C = (st & 1) * 32 + (swz % 64) / 2; }
__host__ __device__ __forceinline__ int perm32(int rho) { const int n = rho >> 4, i = rho & 15; return 8 * (i >> 2) + 4 * n + (i & 3); }

struct Unit { int pm, pn; };
struct Gemm { const bf16_t* A; const bf16_t* Bt; int M, N, K; };

struct StaticOrder {
    int nM, nN, nwg, G, c;
    __host__ __device__ void init(int M, int N, int G_, int c_) { nM = M / BM; nN = N / BM; nwg = nM * nN; G = G_; c = c_; }
    __host__ __device__ bool next(int i, Unit& u) const {
        const long L = (long)i * G + c; if (L >= nwg) return false;
        int wgid = (int)L; { const int q = nwg / NXCD, r = nwg % NXCD, xcd = wgid % NXCD, off = wgid / NXCD; wgid = (xcd < r ? xcd * (q + 1) : r * (q + 1) + (xcd - r) * q) + off; }
        const int nig = WGM * nN, gid = wgid / nig, fm = gid * WGM, gsz = (nM - fm) < WGM ? (nM - fm) : WGM;
        u.pm = fm + ((wgid % nig) % gsz); u.pn = (wgid % nig) / gsz; return true;
    }
    __device__ __forceinline__ void a_ready(const Unit&) const {}
    __device__ __forceinline__ void done(const Unit&) const {}
};
template <class Epi, class Sched, bool STAMP = false>
__device__ __forceinline__ void gemm_phase(PG8_LAS unsigned char* lds, const Gemm g, const Sched& S, const Epi& E, unsigned long long* stamps) {
    const int tid = threadIdx.x, wid = __builtin_amdgcn_readfirstlane(tid >> 6), lane = tid & 63, wr = wid >> 2, wc = wid & 3, fr = lane & 15, fq = lane >> 4;
    const int K = g.K, nt = K / BK;
    int ts_lo = 0, ts_hi = 0, nts = 0; const unsigned long long rt_entry = STAMP ? (unsigned long long)wall_clock64() : 0ull;
#define PG8_STAMP() do { if (STAMP && wid == 0 && nts < 64) { const unsigned long long _c = (unsigned long long)clock64(); \
        ts_lo = (lane == nts) ? (int)(unsigned)_c : ts_lo; ts_hi = (lane == nts) ? (int)(unsigned)(_c >> 32) : ts_hi; ++nts; } } while (0)
    PG8_STAMP();
    unsigned voffA[2], voffB[2];
#pragma unroll
    for (int i = 0; i < 2; ++i) { int R, C; stage_rc(tid * 16 + i * 8192, R, C); const int Rb = Epi::PERM ? ((R & ~31) + perm32(R & 31)) : R;
        voffA[i] = (unsigned)(R * K + C) * 2u; voffB[i] = (unsigned)(Rb * K + C) * 2u; }
    const size_t kstep = (size_t)(BK * 2);
    const size_t hstep = (size_t)HALF * K * 2;
    const size_t tstep = 2 * hstep;
    const unsigned ldsw = (unsigned)wid * 1024u;
    const int aoff = lds_byte(wr * 64 + fr, fq * 8), boff = lds_byte(wc * 32 + fr, fq * 8);
#define PG8_SA(b, h) (((b) * 2 + (h)) * HTB)
#define PG8_SB(b, h) ((4 + (b) * 2 + (h)) * HTB)
#define PG8_STAGE(bufoff, gbase, voff) do { _Pragma("unroll") for (int _i = 0; _i < 2; ++_i) \
        __builtin_amdgcn_global_load_lds((const unsigned*)((const char*)(gbase) + (voff)[_i]), (PG8_LAS unsigned*)(lds + (bufoff) + ldsw + _i * 8192), 16, 0, 0); } while (0)
#define PG8_LDA(dst, b, h) do { _Pragma("unroll") for (int m = 0; m < 4; ++m) _Pragma("unroll") for (int k = 0; k < 2; ++k) dst[m][k] = *(const PG8_LAS bf16x8*)(lds + PG8_SA(b, h) + aoff + m * 2048 + k * 1024); } while (0)
#define PG8_LDB(dst, b, h) do { _Pragma("unroll") for (int n = 0; n < 2; ++n) _Pragma("unroll") for (int k = 0; k < 2; ++k) dst[n][k] = *(const PG8_LAS bf16x8*)(lds + PG8_SB(b, h) + boff + n * 2048 + k * 1024); } while (0)
#define PG8_MMA(ai, bj, At, Bt) do { __builtin_amdgcn_s_setprio(1); _Pragma("unroll") for (int m = 0; m < 4; ++m) _Pragma("unroll") for (int n = 0; n < 2; ++n) _Pragma("unroll") for (int k = 0; k < 2; ++k) \
        acc[ai][bj][m][n] = __builtin_amdgcn_mfma_f32_16x16x32_bf16(Bt[n][k], At[m][k], acc[ai][bj][m][n], 0, 0, 0); __builtin_amdgcn_s_setprio(0); } while (0)
#define PG8_WAIT_V(n) asm volatile("s_waitcnt vmcnt(" #n ")" ::: "memory")
#define PG8_WAIT_L(n) asm volatile("s_waitcnt lgkmcnt(" #n ")" ::: "memory")
#define PG8_BAR __builtin_amdgcn_s_barrier()
#define PG8_SCHED __builtin_amdgcn_sched_barrier(0)
    Unit cur, nxt; int ui = 0;
    if (!S.next(0, cur)) return;
    f32x4 acc[2][2][4][2];
#pragma unroll
    for (int a = 0; a < 2; ++a)
#pragma unroll
        for (int b = 0; b < 2; ++b)
#pragma unroll
            for (int m = 0; m < 4; ++m)
#pragma unroll
                for (int n = 0; n < 2; ++n) acc[a][b][m][n] = (f32x4){0.f, 0.f, 0.f, 0.f};
    bf16x8 At[4][2], B0[2][2], B1[2][2];
    const char* cA = (const char*)g.A + (size_t)cur.pm * tstep; const char* cB = (const char*)g.Bt + (size_t)cur.pn * tstep;
    S.a_ready(cur);
    PG8_STAGE(PG8_SB(0, 0), cB, voffB); PG8_STAGE(PG8_SA(0, 0), cA, voffA); PG8_STAGE(PG8_SB(0, 1), cB + hstep, voffB); PG8_STAGE(PG8_SA(0, 1), cA + hstep, voffA);
    if (wr == 1) PG8_BAR;
    PG8_WAIT_V(4); PG8_BAR;
    PG8_STAGE(PG8_SB(1, 0), cB + kstep, voffB); PG8_STAGE(PG8_SA(1, 0), cA + kstep, voffA); PG8_STAGE(PG8_SB(1, 1), cB + hstep + kstep, voffB);
    PG8_WAIT_V(6); PG8_BAR;
    PG8_STAMP();
    for (;;) {
        const bool has_next = S.next(ui + 1, nxt);
        const char* nA = has_next ? (const char*)g.A + (size_t)nxt.pm * tstep : cA; const char* nB = has_next ? (const char*)g.Bt + (size_t)nxt.pn * tstep : cB;
        for (int t = 0; t < nt; t += 2) {
            const bool last = (t == nt - 2);
            const char* a1 = cA + (size_t)(t + 1) * kstep;
            const char* a2 = last ? nA : cA + (size_t)(t + 2) * kstep; const char* b2 = last ? nB : cB + (size_t)(t + 2) * kstep;
            const char* a3 = a2 + kstep; const char* b3 = b2 + kstep;
            if (last && has_next) S.a_ready(nxt);
            if constexpr (Epi::MID_T > 0) { if (t == Epi::MID_T) E.mid(acc, cur, wr, wc, fr, fq); }
            PG8_LDB(B0, 0, 0); PG8_SCHED; PG8_LDA(At, 0, 0); PG8_STAGE(PG8_SA(1, 1), a1 + hstep, voffA);
            PG8_WAIT_L(8); PG8_BAR; PG8_WAIT_L(0); PG8_MMA(0, 0, At, B0); PG8_BAR; PG8_SCHED;
            PG8_LDB(B1, 0, 1); PG8_STAGE(PG8_SB(0, 0), b2, voffB);
            PG8_BAR; PG8_WAIT_L(0); PG8_MMA(0, 1, At, B1); PG8_BAR;
            PG8_LDA(At, 0, 1); PG8_STAGE(PG8_SA(0, 0), a2, voffA);
            PG8_BAR; PG8_WAIT_L(0); PG8_MMA(1, 0, At, B0); PG8_BAR; PG8_SCHED;
            PG8_STAGE(PG8_SB(0, 1), b2 + hstep, voffB);
            PG8_WAIT_V(6); PG8_BAR; PG8_MMA(1, 1, At, B1); PG8_BAR;
            PG8_LDB(B0, 1, 0); PG8_SCHED; PG8_LDA(At, 1, 0); PG8_STAGE(PG8_SA(0, 1), a2 + hstep, voffA);
            PG8_WAIT_L(8); PG8_BAR; PG8_WAIT_L(0); PG8_MMA(0, 0, At, B0); PG8_BAR; PG8_SCHED;
            PG8_LDB(B1, 1, 1); PG8_STAGE(PG8_SB(1, 0), b3, voffB);
            PG8_BAR; PG8_WAIT_L(0); PG8_MMA(0, 1, At, B1); PG8_BAR;
            PG8_LDA(At, 1, 1); PG8_STAGE(PG8_SA(1, 0), a3, voffA);
            PG8_BAR; PG8_WAIT_L(0); PG8_MMA(1, 0, At, B0); PG8_BAR; PG8_SCHED;
            PG8_STAGE(PG8_SB(1, 1), b3 + hstep, voffB);
            PG8_WAIT_V(6); PG8_BAR; PG8_MMA(1, 1, At, B1); PG8_BAR;
        }
        PG8_STAMP();
        if constexpr (!Epi::AFTER_DRAIN) { E(acc, cur, wr, wc, fr, fq); S.done(cur); }
        PG8_STAMP();
        if (!has_next) break;
#pragma unroll
        for (int a = 0; a < 2; ++a)
#pragma unroll
            for (int b = 0; b < 2; ++b)
#pragma unroll
                for (int m = 0; m < 4; ++m)
#pragma unroll
                    for (int n = 0; n < 2; ++n) acc[a][b][m][n] = (f32x4){0.f, 0.f, 0.f, 0.f};
        cur = nxt; cA = nA; cB = nB; ++ui;
    }
    PG8_WAIT_V(0);
    if (wr == 0) PG8_BAR;
    PG8_BAR;
    if constexpr (Epi::AFTER_DRAIN) { E.fused(acc, cur, wr, wc, fr, fq, lds, wid, lane); S.done(cur); }
    PG8_STAMP();
    if (STAMP && wid == 0) { stamps[lane] = lane < nts ? (((unsigned long long)(unsigned)ts_hi << 32) | (unsigned)ts_lo) : 0ull;
        if (lane == 62) stamps[62] = rt_entry; if (lane == 63) stamps[63] = (unsigned long long)wall_clock64(); }
#undef PG8_STAMP
#undef PG8_SA
#undef PG8_SB
#undef PG8_STAGE
#undef PG8_LDA
#undef PG8_LDB
#undef PG8_MMA
#undef PG8_WAIT_V
#undef PG8_WAIT_L
#undef PG8_BAR
#undef PG8_SCHED
}
}
using pf4 = pg8::f32x4;

struct EpiMain {
  static constexpr bool PERM = false, AFTER_DRAIN = false;
  static constexpr int MID_T = 0;
  const Params& p;
  DI void operator()(const pf4 (&acc)[2][2][4][2], const pg8::Unit& u, int wr, int wc, int fr, int fq) const {
    const int pn = u.pn;
    const int rbase = u.pm * 256 + wr * 64 + fr;
    if (pn < 3) {
      const bool isq = pn < 2, isv = (pn == 2) && (wc >= 2);
      const float* gp = isq ? p.qg : p.kg;
      const int d0 = 16 * (fq >> 1) + 4 * (fq & 1), d1 = 32 + 8 * fq;
      float4 g00 = {1.f, 1.f, 1.f, 1.f}, g01 = g00, g10 = g00, g11 = g00;
      if (!isv) { g00 = *(const float4*)(gp + d0); g01 = *(const float4*)(gp + d0 + 8); g10 = *(const float4*)(gp + d1); g11 = *(const float4*)(gp + d1 + 4); }
      _Pragma("unroll") for (int ai = 0; ai < 2; ++ai) {
        if (u.pm * 256 + 128 * ai >= MTOT) continue;
        _Pragma("unroll") for (int m = 0; m < 4; ++m) {
          const int row = rbase + 128 * ai + 16 * m;
          pf4 a00 = acc[ai][0][m][0], a01 = acc[ai][0][m][1], a10 = acc[ai][1][m][0], a11 = acc[ai][1][m][1];
          if (!isv) {
            float ss = 0.f;
            _Pragma("unroll") for (int j = 0; j < 4; ++j) ss += a00[j] * a00[j] + a01[j] * a01[j] + a10[j] * a10[j] + a11[j] * a11[j];
            ss += __shfl_xor(ss, 16); ss += __shfl_xor(ss, 32);
            const float sc = rsqrtf(ss * (1.f / 64.f) + EPS);
            a00[0] *= sc * g00.x; a00[1] *= sc * g00.y; a00[2] *= sc * g00.z; a00[3] *= sc * g00.w;
            a01[0] *= sc * g01.x; a01[1] *= sc * g01.y; a01[2] *= sc * g01.z; a01[3] *= sc * g01.w;
            a10[0] *= sc * g10.x; a10[1] *= sc * g10.y; a10[2] *= sc * g10.z; a10[3] *= sc * g10.w;
            a11[0] *= sc * g11.x; a11[1] *= sc * g11.y; a11[2] *= sc * g11.z; a11[3] *= sc * g11.w;
            if (fq < 2) {
              const float pos = (float)(row < SEQ ? row : SEQ);
              const float invlo[4] = {1.0f, 0.19392274f, 0.03760603f, 0.0072926646f};
              const float invhi[4] = {0.0014142136f, 0.0002742482f, 5.3182957e-05f, 1.0313385e-05f};
              _Pragma("unroll") for (int j = 0; j < 4; ++j) {
                const float inv = (fq & 1) ? invhi[j] : invlo[j];
                float s_, c_; sincos_red(pos * inv, s_, c_);
                const float x1 = a00[j], x2 = a01[j];
                a00[j] = x1 * c_ - x2 * s_; a01[j] = x2 * c_ + x1 * s_;
              }
            }
          }
          if (isq) {
            bfr* qp = p.Q + (size_t)row * 512 + (4 * pn + wc) * 64;
            *(u32x2*)(qp + d0) = pack4(a00[0] * QSCALE, a00[1] * QSCALE, a00[2] * QSCALE, a00[3] * QSCALE);
            *(u32x2*)(qp + d0 + 8) = pack4(a01[0] * QSCALE, a01[1] * QSCALE, a01[2] * QSCALE, a01[3] * QSCALE);
            u32x4 o; o[0] = pk2(a10[0] * QSCALE, a10[1] * QSCALE); o[1] = pk2(a10[2] * QSCALE, a10[3] * QSCALE);
            o[2] = pk2(a11[0] * QSCALE, a11[1] * QSCALE); o[3] = pk2(a11[2] * QSCALE, a11[3] * QSCALE);
            *(u32x4*)(qp + d1) = o;
          } else {
            const int jh = wc & 1;
            bfr* kp = (isv ? p.Vb : p.Kb) + (size_t)row * 128 + jh * 64;
            *(u32x2*)(kp + d0) = pack4(a00[0], a00[1], a00[2], a00[3]);
            *(u32x2*)(kp + d0 + 8) = pack4(a01[0], a01[1], a01[2], a01[3]);
            u32x4 o; o[0] = pk2(a10[0], a10[1]); o[1] = pk2(a10[2], a10[3]); o[2] = pk2(a11[0], a11[1]); o[3] = pk2(a11[2], a11[3]);
            *(u32x4*)(kp + d1) = o;
            float* op = nullptr;
            if (row >= SEQ) op = (isv ? p.out_vs : p.out_ks) + ((size_t)((row - SEQ) * 128 + 127) * 2 + jh) * 64;
            else if (row >= SEQ - 128) op = (isv ? p.out_vp : p.out_kp) + ((size_t)(row - (SEQ - 128)) * 2 + jh) * 64;
            if (op) {
              *(pf4*)(op + d0) = a00; *(pf4*)(op + d0 + 8) = a01; *(pf4*)(op + d1) = a10; *(pf4*)(op + d1 + 4) = a11;
            }
          }
        }
      }
      return;
    }
    const int cw = 32 * wc + 8 * fq;
    bfr* dst; int ld, col, op;
    if (pn < 5) { dst = p.ZA; ld = 512; col = (pn - 3) * 256; op = 1; }
    else if (pn < 7) { dst = p.QB; ld = 512; col = (pn - 5) * 256; op = 0; }
    else if (pn < 9) { dst = p.ZF; ld = 512; col = (pn - 7) * 256; op = 0; }
    else if (pn < 11) { dst = p.IB; ld = 512; col = (pn - 9) * 256; op = 0; }
    else if (pn < 13) { dst = p.ZB; ld = 512; col = (pn - 11) * 256; op = 1; }
    else if (pn < 17) { dst = p.GA; ld = 1024; col = (pn - 13) * 256; op = 2; }
    else { dst = p.GB; ld = 1024; col = (pn - 17) * 256; op = 2; }
    bfr* const obase = dst + (size_t)rbase * ld + col + cw;
    _Pragma("unroll") for (int bj = 0; bj < 2; ++bj) {
      float4 b0 = {0.f, 0.f, 0.f, 0.f}, b1 = b0;
      if (op == 2) { const float* bp = p.b_merge + (pn - 13) * 256 + 128 * bj + cw; b0 = *(const float4*)bp; b1 = *(const float4*)(bp + 4);
        b0.x *= -LOG2E; b0.y *= -LOG2E; b0.z *= -LOG2E; b0.w *= -LOG2E; b1.x *= -LOG2E; b1.y *= -LOG2E; b1.z *= -LOG2E; b1.w *= -LOG2E; }
      _Pragma("unroll") for (int ai = 0; ai < 2; ++ai) {
        if (u.pm * 256 + 128 * ai >= MTOT) continue;
        _Pragma("unroll") for (int m = 0; m < 4; ++m) {
          const int row = rbase + 128 * ai + 16 * m;
          pf4 x = acc[ai][bj][m][0], y = acc[ai][bj][m][1];
          if (op == 1) { _Pragma("unroll") for (int j = 0; j < 4; ++j) { x[j] = siluf_(x[j]); y[j] = siluf_(y[j]); } }
          else if (op == 2) {
            x[0] = frcp(1.f + __builtin_amdgcn_exp2f(fmaf(x[0], -LOG2E, b0.x))); x[1] = frcp(1.f + __builtin_amdgcn_exp2f(fmaf(x[1], -LOG2E, b0.y)));
            x[2] = frcp(1.f + __builtin_amdgcn_exp2f(fmaf(x[2], -LOG2E, b0.z))); x[3] = frcp(1.f + __builtin_amdgcn_exp2f(fmaf(x[3], -LOG2E, b0.w)));
            y[0] = frcp(1.f + __builtin_amdgcn_exp2f(fmaf(y[0], -LOG2E, b1.x))); y[1] = frcp(1.f + __builtin_amdgcn_exp2f(fmaf(y[1], -LOG2E, b1.y)));
            y[2] = frcp(1.f + __builtin_amdgcn_exp2f(fmaf(y[2], -LOG2E, b1.z))); y[3] = frcp(1.f + __builtin_amdgcn_exp2f(fmaf(y[3], -LOG2E, b1.w)));
          }
          u32x4 o; o[0] = pk2(x[0], x[1]); o[1] = pk2(x[2], x[3]); o[2] = pk2(y[0], y[1]); o[3] = pk2(y[2], y[3]);
          __builtin_nontemporal_store(o, (u32x4*)(obase + (128 * ai + 16 * m) * ld + 128 * bj));
        }
      }
    }
  }
};

struct EpiMerge {
  static constexpr bool PERM = true, AFTER_DRAIN = false;
  static constexpr int MID_T = 8;
  const Params& p;
  DI void mid(pf4 (&acc)[2][2][4][2], const pg8::Unit& u, int wr, int wc, int fr, int fq) const {
    int rbase = u.pm * 256 + wr * 64 + fr; const int cbase = u.pn * 256 + 32 * wc + 8 * fq;
    asm volatile("" : "+v"(rbase));
    _Pragma("unroll") for (int ai = 0; ai < 2; ++ai) _Pragma("unroll") for (int m = 0; m < 4; ++m) _Pragma("unroll") for (int bj = 0; bj < 2; ++bj) {
      if (bj == 0 && m == 0) __builtin_amdgcn_sched_barrier(0);
      const size_t off = (size_t)(rbase + 128 * ai + 16 * m) * 1024 + cbase + 128 * bj;
      const u32x4 ga = *(const u32x4*)(p.GA + off), gb = *(const u32x4*)(p.GB + off);
      _Pragma("unroll") for (int e = 0; e < 2; ++e) {
        acc[ai][bj][m][0][2 * e] *= bflo(ga[e]) * __builtin_amdgcn_rcpf(fmaxf(bflo(gb[e]), 1e-30f));
        acc[ai][bj][m][0][2 * e + 1] *= bfhi(ga[e]) * __builtin_amdgcn_rcpf(fmaxf(bfhi(gb[e]), 1e-30f));
        acc[ai][bj][m][1][2 * e] *= bflo(ga[2 + e]) * __builtin_amdgcn_rcpf(fmaxf(bflo(gb[2 + e]), 1e-30f));
        acc[ai][bj][m][1][2 * e + 1] *= bfhi(ga[2 + e]) * __builtin_amdgcn_rcpf(fmaxf(bfhi(gb[2 + e]), 1e-30f));
      }
    }
  }
  DI void operator()(const pf4 (&acc)[2][2][4][2], const pg8::Unit& u, int wr, int wc, int fr, int fq) const {
    const int rbase = u.pm * 256 + wr * 64 + fr, cbase = u.pn * 256 + 32 * wc + 8 * fq;
    _Pragma("unroll") for (int ai = 0; ai < 2; ++ai) {
     u32x4 gv[4][2];
     _Pragma("unroll") for (int m = 0; m < 4; ++m) _Pragma("unroll") for (int bj = 0; bj < 2; ++bj) gv[m][bj] = *(const u32x4*)(p.GB + (size_t)(rbase + 128 * ai + 16 * m) * 1024 + cbase + 128 * bj);
     __builtin_amdgcn_sched_barrier(0);
     _Pragma("unroll") for (int m = 0; m < 4; ++m) _Pragma("unroll") for (int bj = 0; bj < 2; ++bj) {
      const size_t off = (size_t)(rbase + 128 * ai + 16 * m) * 1024 + cbase + 128 * bj;
      const u32x4 g = gv[m][bj];
      const pf4 x = acc[ai][bj][m][0], y = acc[ai][bj][m][1];
      u32x4 o; o[0] = pk2(bflo(g[0]) * x[0], bfhi(g[0]) * x[1]); o[1] = pk2(bflo(g[1]) * x[2], bfhi(g[1]) * x[3]);
      o[2] = pk2(bflo(g[2]) * y[0], bfhi(g[2]) * y[1]); o[3] = pk2(bflo(g[3]) * y[2], bfhi(g[3]) * y[3]);
      *(u32x4*)(p.Y + off) = o;
     }
     __builtin_amdgcn_sched_barrier(0);
    }
  }
};

struct EpiOut {
  static constexpr bool PERM = false, AFTER_DRAIN = false;
  static constexpr int MID_T = 0;
  const Params& p;
  DI void operator()(const pf4 (&acc)[2][2][4][2], const pg8::Unit& u, int wr, int wc, int fr, int fq) const {
    const int rbase = u.pm * 256 + wr * 64 + fr, cbase = u.pn * 256 + 32 * wc + 4 * fq;
    const float* gr = p.mod + (size_t)128 * 3072 + 2048;
    _Pragma("unroll") for (int bj = 0; bj < 2; ++bj) _Pragma("unroll") for (int n = 0; n < 2; ++n) {
      const int c = cbase + 128 * bj + 16 * n;
      const pf4 gt = *(const pf4*)(gr + c);
      pf4 xv[8];
      _Pragma("unroll") for (int q = 0; q < 8; ++q) xv[q] = __builtin_nontemporal_load((const pf4*)(p.x_prompt + (size_t)(rbase + 128 * (q >> 2) + 16 * (q & 3)) * DM + c));
      __builtin_amdgcn_sched_barrier(0);
      _Pragma("unroll") for (int q = 0; q < 8; ++q)
        __builtin_nontemporal_store(xv[q] + gt * acc[q >> 2][bj][q & 3][n], (pf4*)(p.out_yp + (size_t)(rbase + 128 * (q >> 2) + 16 * (q & 3)) * DM + c));
      __builtin_amdgcn_sched_barrier(0);
    }
  }
};

struct EpiOutLds {
  static constexpr bool PERM = false, AFTER_DRAIN = true;
  static constexpr int MID_T = 0;
  const Params& p;
  DI void operator()(const pf4 (&)[2][2][4][2], const pg8::Unit&, int, int, int, int) const {}
  DI void fused(const pf4 (&acc)[2][2][4][2], const pg8::Unit& u, int wr, int wc, int fr, int fq, PG8_LAS unsigned char* lds, int, int) const {
    const float* gr = p.mod + (size_t)128 * 3072 + 2048 + u.pn * 256;
    const int tid = threadIdx.x, c = tid & 63, rsub = tid >> 6;
    pf4 gt[2][2];
    _Pragma("unroll") for (int bj = 0; bj < 2; ++bj) _Pragma("unroll") for (int n = 0; n < 2; ++n) gt[bj][n] = *(const pf4*)(gr + 128 * bj + 32 * wc + 16 * n + 4 * fq);
    _Pragma("unroll") for (int ai = 0; ai < 2; ++ai) {
      _Pragma("unroll") for (int m = 0; m < 4; ++m) _Pragma("unroll") for (int bj = 0; bj < 2; ++bj) _Pragma("unroll") for (int n = 0; n < 2; ++n) {
        const int rl = 64 * wr + 16 * m + fr, chunk = 32 * bj + 8 * wc + 4 * n + fq;
        *(PG8_LAS pf4*)(lds + rl * 1024 + ((chunk ^ fr) << 4)) = gt[bj][n] * acc[ai][bj][m][n];
      }
      __syncthreads();
      const size_t g0 = (size_t)(u.pm * 256 + 128 * ai) * DM + u.pn * 256 + 4 * c;
      {
        pf4 xv[16];
        _Pragma("unroll") for (int q = 0; q < 16; ++q) xv[q] = __builtin_nontemporal_load((const pf4*)(p.x_prompt + g0 + (size_t)(q * 8 + rsub) * DM));
        __builtin_amdgcn_sched_barrier(0);
        _Pragma("unroll") for (int q = 0; q < 16; ++q) {
          const int rl = q * 8 + rsub;
          const pf4 st = *(const PG8_LAS pf4*)(lds + rl * 1024 + ((c ^ (rl & 15)) << 4));
          __builtin_nontemporal_store(xv[q] + st, (pf4*)(p.out_yp + g0 + (size_t)rl * DM));
        }
      }
      __syncthreads();
    }
  }
};

DI f32x16 wave_gemm32(const bfr* __restrict__ A, int lda, const bfr* __restrict__ W, int ldw, int K, int lane) {
  const int r = lane & 31, h = lane >> 5;
  const bfr* ap = A + (size_t)r * lda + 8 * h;
  const bfr* wp = W + (size_t)r * ldw + 8 * h;
  f32x16 acc = zero16();
  for (int k0 = 0; k0 < K; k0 += 128) {
    bf16x8 a[8], b[8];
    _Pragma("unroll") for (int q = 0; q < 8; ++q) { a[q] = *(const bf16x8*)(ap + k0 + 16 * q); b[q] = *(const bf16x8*)(wp + k0 + 16 * q); }
    _Pragma("unroll") for (int q = 0; q < 8; ++q) acc = mfma(b[q], a[q], acc);
  }
  return acc;
}

DI void sample_chain_wave(const Params& p, int wt, int lane) {
  const int mt = wt >> 5, nt = wt & 31, r = lane & 31, h = lane >> 5;
  const int m = 32 * mt + r;
  unsigned* cnt = p.bar + PANEL_CNT_WORD + 64 * mt;
  {
    const f32x16 a1 = wave_gemm32(p.YA + (size_t)(SEQ + 32 * mt) * 1024, 1024, p.Wt_pab + (size_t)(32 * nt) * 1024, 1024, 512, lane);
    const f32x16 a2 = wave_gemm32(p.YB + (size_t)(SEQ + 32 * mt) * 1024, 1024, p.Wt_pab + (size_t)(32 * nt) * 1024 + 512, 1024, 512, lane);
    _Pragma("unroll") for (int g = 0; g < 4; ++g) {
      const int n = 32 * nt + 8 * g + 4 * h;
      const u32x2 ga = *(const u32x2*)(p.GA + (size_t)(SEQ + m) * 1024 + n), gb = *(const u32x2*)(p.GB + (size_t)(SEQ + m) * 1024 + n);
      *(u32x2*)(p.Ys + (size_t)m * 1024 + n) = pack4(bflo(ga[0]) * a1[4 * g] + bflo(gb[0]) * a2[4 * g], bfhi(ga[0]) * a1[4 * g + 1] + bfhi(gb[0]) * a2[4 * g + 1],
                                                     bflo(ga[1]) * a1[4 * g + 2] + bflo(gb[1]) * a2[4 * g + 2], bfhi(ga[1]) * a1[4 * g + 3] + bfhi(gb[1]) * a2[4 * g + 3]);
    }
    __builtin_amdgcn_fence(__ATOMIC_RELEASE, "agent");
    asm volatile("s_waitcnt vmcnt(0)" ::: "memory");
    if (lane == 0) __hip_atomic_fetch_add(cnt, 1u, __ATOMIC_RELAXED, __HIP_MEMORY_SCOPE_AGENT);
  }
  {
    unsigned sp = 0;
    while (__hip_atomic_load(cnt, __ATOMIC_RELAXED, __HIP_MEMORY_SCOPE_AGENT) < 32u) { __builtin_amdgcn_s_sleep(2); if (++sp > (1u << 22)) break; }
    __builtin_amdgcn_fence(__ATOMIC_ACQUIRE, "agent");
    asm volatile("s_waitcnt vmcnt(0)" ::: "memory");
  }
  const f32x16 acc = wave_gemm32(p.Ys + (size_t)(32 * mt) * 1024, 1024, p.Wt_out + (size_t)(32 * nt) * 1024, 1024, 1024, lane);
  _Pragma("unroll") for (int g = 0; g < 4; ++g) {
    const int n = 32 * nt + 8 * g + 4 * h;
    const float4 xv = *(const float4*)(p.x_sample + (size_t)m * DM + n), gt = *(const float4*)(p.mod + (size_t)m * 3072 + 2048 + n);
    float4 o;
    o.x = xv.x + gt.x * acc[4 * g]; o.y = xv.y + gt.y * acc[4 * g + 1]; o.z = xv.z + gt.z * acc[4 * g + 2]; o.w = xv.w + gt.w * acc[4 * g + 3];
    *(float4*)(p.out_ys + (size_t)m * DM + n) = o;
  }
}

DI void attn_prompt_wave(const Params& p, int qt, int hd, int lane) {
  const int r = lane & 31, h = lane >> 5, j = hd >> 2;
  const int q0 = qt * 32, q = q0 + r, kb = q0 - 128;
  bf16x8 qf[4];
  _Pragma("unroll") for (int s = 0; s < 4; ++s) qf[s] = *(const bf16x8*)(p.Q + (size_t)q * 512 + hd * 64 + 16 * s + 8 * h);
  f32x16 sacc[5];
  _Pragma("unroll") for (int kt = 0; kt < 5; ++kt) {
    sacc[kt] = zero16();
    int kr = kb + 32 * kt + r; kr = kr < 0 ? 0 : kr;
    _Pragma("unroll") for (int s = 0; s < 4; ++s) {
      bf16x8 kf = *(const bf16x8*)(p.Kb + (size_t)kr * 128 + j * 64 + 16 * s + 8 * h);
      sacc[kt] = mfma(kf, qf[s], sacc[kt]);
    }
  }
  const float sink = p.sinks[hd] * LOG2E;
  float mx = sink;
  _Pragma("unroll") for (int i = 0; i < 16; ++i) {
    sacc[0][i] = (crow(i, h) > r) ? sacc[0][i] : -INFINITY;
    sacc[4][i] = (crow(i, h) <= r) ? sacc[4][i] : -INFINITY;
  }
  if (q0 < 128) {
    _Pragma("unroll") for (int kt = 0; kt < 4; ++kt) _Pragma("unroll") for (int i = 0; i < 16; ++i)
      sacc[kt][i] = (kb + 32 * kt + crow(i, h) >= 0) ? sacc[kt][i] : -INFINITY;
  }
  _Pragma("unroll") for (int kt = 0; kt < 5; ++kt) _Pragma("unroll") for (int i = 0; i < 16; ++i) mx = fmaxf(mx, sacc[kt][i]);
  mx = fmaxf(mx, __shfl_xor(mx, 32));
  float l = 0.f;
  _Pragma("unroll") for (int kt = 0; kt < 5; ++kt) _Pragma("unroll") for (int i = 0; i < 16; ++i) {
    float pv = __builtin_amdgcn_exp2f(sacc[kt][i] - mx); sacc[kt][i] = pv; l += pv;
  }
  l += __shfl_xor(l, 32);
  l += __builtin_amdgcn_exp2f(sink - mx);
  f32x16 oacc[2]; oacc[0] = zero16(); oacc[1] = zero16();
  const bfr* vbase = p.Vb + j * 64 + 2 * r;
  _Pragma("unroll") for (int kt = 0; kt < 5; ++kt) _Pragma("unroll") for (int s2 = 0; s2 < 2; ++s2) {
    u32x4 pp;
    _Pragma("unroll") for (int e = 0; e < 4; ++e) pp[e] = pk2(sacc[kt][8 * s2 + 2 * e], sacc[kt][8 * s2 + 2 * e + 1]);
    unsigned wv[8];
    _Pragma("unroll") for (int jj = 0; jj < 8; ++jj) {
      int key = kb + 32 * kt + 16 * s2 + 8 * (jj >> 2) + 4 * h + (jj & 3); key = key < 0 ? 0 : key;
      wv[jj] = *(const unsigned*)(vbase + (size_t)key * 128);
    }
    u32x4 v0, v1;
    _Pragma("unroll") for (int e = 0; e < 4; ++e) {
      v0[e] = __builtin_amdgcn_perm(wv[2 * e + 1], wv[2 * e], 0x05040100u);
      v1[e] = __builtin_amdgcn_perm(wv[2 * e + 1], wv[2 * e], 0x07060302u);
    }
    const bf16x8 pa = __builtin_bit_cast(bf16x8, pp);
    oacc[0] = mfma(pa, __builtin_bit_cast(bf16x8, v0), oacc[0]);
    oacc[1] = mfma(pa, __builtin_bit_cast(bf16x8, v1), oacc[1]);
  }
  const float il = frcp(l);
  unsigned za[16];
  _Pragma("unroll") for (int i = 0; i < 16; ++i) za[i] = *(const unsigned*)(p.ZA + (size_t)(q0 + crow(i, h)) * 512 + hd * 64 + 2 * r);
  __builtin_amdgcn_sched_barrier(0);
  _Pragma("unroll") for (int i = 0; i < 16; ++i) {
    const int qi = crow(i, h);
    const float ili = __shfl(il, qi);
    *(unsigned*)(p.YA + (size_t)(q0 + qi) * 1024 + hd * 64 + 2 * r) = pk2(oacc[0][i] * ili * bflo(za[i]), oacc[1][i] * ili * bfhi(za[i]));
  }
}

DI void attn_sample_wave(const Params& p, int b, int hd, float* sw  ) {
  const int lane = threadIdx.x & 63, j = hd >> 2, m = SEQ + b;
  u32x4 qv[8];
  _Pragma("unroll") for (int i = 0; i < 8; ++i) qv[i] = *(const u32x4*)(p.Q + (size_t)m * 512 + hd * 64 + 8 * i);
  float dn = 0.f;
  _Pragma("unroll") for (int i = 0; i < 8; ++i) {
    u32x4 kv = *(const u32x4*)(p.Kb + (size_t)m * 128 + j * 64 + 8 * i);
    _Pragma("unroll") for (int e = 0; e < 4; ++e) dn += bflo(qv[i][e]) * bflo(kv[e]) + bfhi(qv[i][e]) * bfhi(kv[e]);
  }
  float s[2];
  _Pragma("unroll") for (int u = 0; u < 2; ++u) {
    int idx = lane + 1 + 64 * u;
    int ic = idx < 128 ? idx : 127;
    const float* kp = p.cache_k + ((size_t)(b * 128 + ic) * 2 + j) * 64;
    float4 kk[16];
    _Pragma("unroll") for (int i = 0; i < 16; ++i) kk[i] = *(const float4*)(kp + 4 * i);
    __builtin_amdgcn_sched_barrier(0);
    float d = 0.f;
    _Pragma("unroll") for (int i = 0; i < 8; ++i) {
      const float4 k0 = kk[2 * i], k1 = kk[2 * i + 1];
      d += bflo(qv[i][0]) * k0.x + bfhi(qv[i][0]) * k0.y + bflo(qv[i][1]) * k0.z + bfhi(qv[i][1]) * k0.w;
      d += bflo(qv[i][2]) * k1.x + bfhi(qv[i][2]) * k1.y + bflo(qv[i][3]) * k1.z + bfhi(qv[i][3]) * k1.w;
    }
    s[u] = idx < 128 ? d : dn;
  }
  const float sink = p.sinks[hd] * LOG2E;
  float mx = fmaxf(fmaxf(s[0], s[1]), sink);
  _Pragma("unroll") for (int o = 32; o >= 1; o >>= 1) mx = fmaxf(mx, __shfl_xor(mx, o));
  float p0 = __builtin_amdgcn_exp2f(s[0] - mx), p1 = __builtin_amdgcn_exp2f(s[1] - mx);
  float l = p0 + p1;
  _Pragma("unroll") for (int o = 32; o >= 1; o >>= 1) l += __shfl_xor(l, o);
  l += __builtin_amdgcn_exp2f(sink - mx);
  sw[lane] = p0; sw[64 + lane] = p1;
  __builtin_amdgcn_s_waitcnt(0xc07f);
  __builtin_amdgcn_wave_barrier();
  float o = 0.f;
  const float* vb = p.cache_v + ((size_t)(b * 128) * 2 + j) * 64 + lane;
  _Pragma("unroll 1") for (int i0 = 0; i0 < 128; i0 += 16) {
    float vv[16];
    _Pragma("unroll") for (int q = 0; q < 16; ++q) vv[q] = vb[(size_t)(i0 + q) * 128];
    __builtin_amdgcn_sched_barrier(0);
    _Pragma("unroll") for (int q = 0; q < 16; ++q) { const float pw = (i0 + q) ? sw[i0 + q - 1] : 0.f; o += pw * vv[q]; }
  }
  o += sw[127] * bf2f(p.Vb[(size_t)m * 128 + j * 64 + lane]);
  size_t off = (size_t)m * 512 + hd * 64 + lane;
  p.YA[(size_t)m * 1024 + hd * 64 + lane] = (bfr)f2bf(o * frcp(l) * bf2f(p.ZA[off]));
  __builtin_amdgcn_wave_barrier();
}

DI void hgrn_gates(const Params& p, int row0, int hh, float* sTot, float (&L)[32], float (&kin)[32], float& t0, float& lc) {
  const int t = TID, c = t & 127, half = t >> 7, ch = hh * 128 + c;
  const float lbv = frcp(1.f + __expf(p.lb_logits[512 + ch] - p.lb_logits[ch]));
  const bfr* zp = p.ZF + (size_t)(row0 + half * 32) * 512 + ch;
  float run = 0.f;
  _Pragma("unroll") for (int jj = 0; jj < 32; ++jj) {
    float z = bf2f(zp[(size_t)jj * 512]);
    z = fminf(fmaxf(z, -30.f), 30.f);
    float em = __expf(-z), sg = frcp(1.f + em);
    float f = lbv + (1.f - lbv) * sg;
    kin[jj] = (1.f - lbv) * em * sg;
    run += __builtin_amdgcn_logf(f);
    L[jj] = run;
  }
  sTot[half * 128 + c] = run;
  __syncthreads();
  t0 = sTot[c]; lc = t0 + sTot[128 + c];
  if (half) { _Pragma("unroll") for (int jj = 0; jj < 32; ++jj) L[jj] += t0; }
}

DI void hgrn_fused_item(const Params& p, int n, int hh, char* smem) {
  bfr* sVt = (bfr*)smem;
  bfr* sKt = sVt + 128 * LDT;
  bfr* sQh = sKt + 128 * LDT;
  bfr* sKh = sQh + 64 * 136;
  bfr* sAm = sKt;
  float* sTot = (float*)(sKh + 64 * 136);
  const int t = TID, lane = t & 63, w = t >> 6, h = lane >> 5, c = t & 127, half = t >> 7;
  const int row0 = n * 64;
  __syncthreads();
  {
    const bfr* ip = p.IB + (size_t)(row0 + half * 32) * 512 + hh * 128 + c;
    _Pragma("unroll") for (int q4 = 0; q4 < 4; ++q4) {
      u32x4 o;
      _Pragma("unroll") for (int e = 0; e < 4; ++e) {
        int jj = q4 * 8 + 2 * e;
        o[e] = (unsigned)ip[(size_t)jj * 512] | ((unsigned)ip[(size_t)(jj + 1) * 512] << 16);
      }
      *(u32x4*)(sVt + c * LDT + half * 32 + q4 * 8) = o;
    }
  }
  {
    float L[32], kin[32], t0, lc;
    hgrn_gates(p, row0, hh, sTot, L, kin, t0, lc);
    const float ec = __builtin_amdgcn_exp2f(lc - t0), et = __builtin_amdgcn_exp2f(t0);
    _Pragma("unroll") for (int q4 = 0; q4 < 4; ++q4) {
      u32x4 o;
      _Pragma("unroll") for (int e = 0; e < 4; ++e) {
        int jj = q4 * 8 + 2 * e;
        kin[jj] *= __builtin_amdgcn_exp2f(fminf(t0 - L[jj], 115.f)); kin[jj + 1] *= __builtin_amdgcn_exp2f(fminf(t0 - L[jj + 1], 115.f));
        o[e] = pk2(kin[jj] * ec, kin[jj + 1] * ec);
      }
      *(u32x4*)(sKt + c * LDT + half * 32 + q4 * 8) = o;
    }
    if (half == 0) p.dec[(n * 4 + hh) * 128 + c] = __builtin_amdgcn_exp2f(lc);
    bfr* qp = p.QB + (size_t)(row0 + half * 32) * 512 + hh * 128 + c;
    unsigned qraw[16];
    _Pragma("unroll") for (int e = 0; e < 16; ++e) qraw[e] = (unsigned)qp[(size_t)(2 * e) * 512] | ((unsigned)qp[(size_t)(2 * e + 1) * 512] << 16);
    __builtin_amdgcn_sched_barrier(0);
    _Pragma("unroll") for (int jj = 0; jj < 32; ++jj) {
      const float qv = (jj & 1) ? bfhi(qraw[jj >> 1]) : bflo(qraw[jj >> 1]);
      const float dl = L[jj] - t0;
      const float qh = qv * __builtin_amdgcn_exp2f(fminf(dl, 115.f));
      qp[(size_t)jj * 512] = (bfr)(pk2(qh * et, 0.f) & 0xffffu);
      sQh[(half * 32 + jj) * 136 + c] = (bfr)(pk2(qh, 0.f) & 0xffffu);
      sKh[(half * 32 + jj) * 136 + c] = (bfr)(pk2(kin[jj], 0.f) & 0xffffu);
    }
  }
  __syncthreads();
  {
    int r = lane & 31; asm volatile("" : "+v"(r));
    const int wv = w >> 1, wk = w & 1;
    f32x16 acc[2][2];
    _Pragma("unroll") for (int a = 0; a < 2; ++a) _Pragma("unroll") for (int b = 0; b < 2; ++b) acc[a][b] = zero16();
    _Pragma("unroll") for (int s = 0; s < 4; ++s) {
      bf16x8 af[2], bf[2];
      _Pragma("unroll") for (int x = 0; x < 2; ++x) {
        af[x] = *(const bf16x8*)(sVt + (wv * 64 + x * 32 + r) * LDT + 16 * s + 8 * h);
        bf[x] = *(const bf16x8*)(sKt + (wk * 64 + x * 32 + r) * LDT + 16 * s + 8 * h);
      }
      _Pragma("unroll") for (int a = 0; a < 2; ++a) _Pragma("unroll") for (int b = 0; b < 2; ++b) acc[a][b] = mfma(af[a], bf[b], acc[a][b]);
    }
    float* up = p.Ust + (size_t)(n * 4 + hh) * 16384;
    _Pragma("unroll") for (int a = 0; a < 2; ++a) _Pragma("unroll") for (int b = 0; b < 2; ++b) _Pragma("unroll") for (int i = 0; i < 16; ++i) {
      int v = wv * 64 + a * 32 + crow(i, h), k = wk * 64 + b * 32 + r;
      up[v * 128 + k] = acc[a][b][i];
    }
  }
  const int jt = w >> 1, it = w & 1;
  int r2 = lane & 31; asm volatile("" : "+v"(r2));
  f32x16 am = zero16();
  if (jt <= it) {
    _Pragma("unroll") for (int s = 0; s < 8; ++s) {
      bf16x8 kf = *(const bf16x8*)(sKh + (jt * 32 + r2) * 136 + 16 * s + 8 * h);
      bf16x8 qf = *(const bf16x8*)(sQh + (it * 32 + r2) * 136 + 16 * s + 8 * h);
      am = mfma(kf, qf, am);
    }
  }
  __syncthreads();
  {
    int r3 = lane & 31; asm volatile("" : "+v"(r3));
    const int i = it * 32 + r3;
    _Pragma("unroll") for (int g = 0; g < 4; ++g) {
      int j0 = jt * 32 + 8 * g + 4 * h;
      float x0 = (j0 <= i) ? am[4 * g] : 0.f, x1 = (j0 + 1 <= i) ? am[4 * g + 1] : 0.f;
      float x2 = (j0 + 2 <= i) ? am[4 * g + 2] : 0.f, x3 = (j0 + 3 <= i) ? am[4 * g + 3] : 0.f;
      *(u32x2*)(sAm + i * LDT + j0) = pack4(x0, x1, x2, x3);
    }
  }
  __syncthreads();
  {
    int r = lane & 31; asm volatile("" : "+v"(r));
    f32x16 oacc[2]; oacc[0] = zero16(); oacc[1] = zero16();
    _Pragma("unroll") for (int s = 0; s < 4; ++s) {
      bf16x8 vf = *(const bf16x8*)(sVt + (32 * w + r) * LDT + 16 * s + 8 * h);
      _Pragma("unroll") for (int i2 = 0; i2 < 2; ++i2) {
        bf16x8 af2 = *(const bf16x8*)(sAm + (i2 * 32 + r) * LDT + 16 * s + 8 * h);
        oacc[i2] = mfma(vf, af2, oacc[i2]);
      }
    }
    _Pragma("unroll") for (int i2 = 0; i2 < 2; ++i2) _Pragma("unroll") for (int g = 0; g < 4; ++g)
      *(u32x2*)(p.YB + (size_t)(row0 + i2 * 32 + r) * 1024 + hh * 128 + 32 * w + 8 * g + 4 * h) =
          pack4(oacc[i2][4 * g], oacc[i2][4 * g + 1], oacc[i2][4 * g + 2], oacc[i2][4 * g + 3]);
  }
}

DI void hgrn_sample_wave(const Params& p, int b, int hh, int lane, float* sw  ) {
  const int m = SEQ + b;
  _Pragma("unroll") for (int u = 0; u < 2; ++u) {
    const int k = lane + 64 * u, ch = hh * 128 + k;
    const float lbv = frcp(1.f + __expf(p.lb_logits[512 + ch] - p.lb_logits[ch]));
    float z = bf2f(p.ZF[(size_t)m * 512 + ch]);
    z = fminf(fmaxf(z, -30.f), 30.f);
    const float em = __expf(-z), sg = frcp(1.f + em);
    sw[k] = lbv + (1.f - lbv) * sg; sw[128 + k] = (1.f - lbv) * em * sg; sw[256 + k] = bf2f(p.QB[(size_t)m * 512 + ch]);
  }
  const int v4 = (lane & 31) * 4, kg = lane >> 5;
  const u32x2 vraw = *(const u32x2*)(p.IB + (size_t)m * 512 + hh * 128 + v4);
  const float4 vv = {bflo(vraw[0]), bfhi(vraw[0]), bflo(vraw[1]), bfhi(vraw[1])};
  __builtin_amdgcn_s_waitcnt(0xc07f);
  __builtin_amdgcn_wave_barrier();
  float4 o = {0.f, 0.f, 0.f, 0.f};
  const size_t sb = (size_t)(b * 4 + hh) * 16384 + (size_t)(kg * 64) * 128 + v4;
  const volatile float* swv = sw;
  _Pragma("unroll 1") for (int k0 = 0; k0 < 64; k0 += 16) {
    float4 Sv[16];
    _Pragma("unroll") for (int q = 0; q < 16; ++q) Sv[q] = *(const float4*)(p.state + sb + (k0 + q) * 128);
    __builtin_amdgcn_sched_barrier(0);
    _Pragma("unroll") for (int q = 0; q < 16; ++q) {
      const int k = kg * 64 + k0 + q;
      const float4 S = Sv[q];
      const float f = swv[k], ki = swv[128 + k], qq = swv[256 + k];
      float4 Sn; Sn.x = f * S.x + ki * vv.x; Sn.y = f * S.y + ki * vv.y; Sn.z = f * S.z + ki * vv.z; Sn.w = f * S.w + ki * vv.w;
      *(float4*)(p.out_ss + sb + (k0 + q) * 128) = Sn;
      o.x += qq * Sn.x; o.y += qq * Sn.y; o.z += qq * Sn.z; o.w += qq * Sn.w;
    }
  }
  o.x += __shfl_xor(o.x, 32); o.y += __shfl_xor(o.y, 32); o.z += __shfl_xor(o.z, 32); o.w += __shfl_xor(o.w, 32);
  float ss = o.x * o.x + o.y * o.y + o.z * o.z + o.w * o.w;
  _Pragma("unroll") for (int of = 16; of >= 1; of >>= 1) ss += __shfl_xor(ss, of);
  const float sc = rsqrtf(ss * (1.f / 128.f) + EPS);
  if (kg == 0) {
    const float4 og = *(const float4*)(p.og + v4);
    const u32x2 zb = *(const u32x2*)(p.ZB + (size_t)m * 512 + hh * 128 + v4);
    *(u32x2*)(p.YB + (size_t)m * 1024 + hh * 128 + v4) = pack4(o.x * sc * og.x * bflo(zb[0]), o.y * sc * og.y * bfhi(zb[0]), o.z * sc * og.z * bflo(zb[1]), o.w * sc * og.w * bfhi(zb[1]));
  }
  __builtin_amdgcn_wave_barrier();
}

DI void cache_shift_copy(const Params& p, int gw, int nw, int lane, int part) {
  const int lo = part * (64 * 4064), hi = lo + 64 * 4064, st = nw * 64;
  for (int idx0 = lo + gw * 64 + lane; idx0 < hi; idx0 += 4 * st) {
    const int i0 = idx0, i1 = min(idx0 + st, hi - 1), i2 = min(idx0 + 2 * st, hi - 1), i3 = min(idx0 + 3 * st, hi - 1);
#define CSC_SRC(i) ((size_t)((i) / 4064) * 16384 + 128 + (size_t)((i) % 4064) * 4)
#define CSC_DST(i) ((size_t)((i) / 4064) * 16384 + (size_t)((i) % 4064) * 4)
    const float4 ka = *(const float4*)(p.cache_k + CSC_SRC(i0)), kb = *(const float4*)(p.cache_k + CSC_SRC(i1));
    const float4 kc = *(const float4*)(p.cache_k + CSC_SRC(i2)), kd = *(const float4*)(p.cache_k + CSC_SRC(i3));
    const float4 va = *(const float4*)(p.cache_v + CSC_SRC(i0)), vb = *(const float4*)(p.cache_v + CSC_SRC(i1));
    const float4 vc = *(const float4*)(p.cache_v + CSC_SRC(i2)), vd = *(const float4*)(p.cache_v + CSC_SRC(i3));
    __builtin_amdgcn_sched_barrier(0);
    *(float4*)(p.out_ks + CSC_DST(i0)) = ka; *(float4*)(p.out_vs + CSC_DST(i0)) = va;
    *(float4*)(p.out_ks + CSC_DST(i1)) = kb; *(float4*)(p.out_vs + CSC_DST(i1)) = vb;
    *(float4*)(p.out_ks + CSC_DST(i2)) = kc; *(float4*)(p.out_vs + CSC_DST(i2)) = vc;
    *(float4*)(p.out_ks + CSC_DST(i3)) = kd; *(float4*)(p.out_vs + CSC_DST(i3)) = vd;
#undef CSC_SRC
#undef CSC_DST
  }
}

DI void phase_mix(const Params& p, char* smem, char* smem_all) {
  const int wave = threadIdx.x >> 6, lane = threadIdx.x & 63, gw = blockIdx.x * 8 + wave, nw = gridDim.x * 8;
  float* sw = (float*)(smem_all + wave * 2048);
  if (gw & 1) {
    for (int it = gw >> 1; it < 1024; it += nw >> 1) attn_sample_wave(p, it >> 3, it & 7, sw);
    cache_shift_copy(p, gw >> 1, nw >> 1, lane, 0);
    for (int it = gw; it < 4096; it += nw) attn_prompt_wave(p, it >> 3, it & 7, lane);
  } else {
    int it = gw;
    if (it < 4096) { attn_prompt_wave(p, it >> 3, it & 7, lane); it += nw; }
    if ((gw & 3) == 0) { for (int hs = gw >> 2; hs < 512; hs += nw >> 2) hgrn_sample_wave(p, hs >> 2, hs & 3, lane, sw); }
    cache_shift_copy(p, gw >> 1, nw >> 1, lane, 1);
    for (; it < 4096; it += nw) attn_prompt_wave(p, it >> 3, it & 7, lane);
  }
  for (int it = VBID; it < 1024; it += VGRID) hgrn_fused_item(p, it >> 2, it & 3, smem);
}

#define SCAN_LOAD(U, Dd, N0) _Pragma("unroll") for (int i = 0; i < 32; ++i) { U[i] = up[(size_t)((N0) + i) * 65536]; Dd[i] = dp[((N0) + i) * 512]; }
#define SCAN_STEP(U, Dd, N0) _Pragma("unroll") for (int i = 0; i < 32; ++i) { sp[(size_t)((N0) + i) * 65536] = (bfr)(pk2(S, 0.f) & 0xffffu); S = Dd[i] * S + U[i]; }
DI void phase_scan(const Params& p, int eb) {
  const int e = eb * 256 + threadIdx.x;
  const int hh = e >> 14, k = e & 127, v = (e >> 7) & 127;
  const float* up = p.Ust + e;
  bfr* sp = p.S16 + e;
  const float* dp = p.dec + hh * 128 + k;
  float S = 0.f;
  float ua[32], da[32], ub[32], db[32];
  SCAN_LOAD(ua, da, 0)
  for (int n0 = 0; n0 < NCH; n0 += 64) {
    SCAN_LOAD(ub, db, n0 + 32)
    SCAN_STEP(ua, da, n0)
    if (n0 + 64 < NCH) { SCAN_LOAD(ua, da, n0 + 64) }
    SCAN_STEP(ub, db, n0 + 32)
  }
  p.out_sp[(hh * 128 + k) * 128 + v] = S;
}

DI void hgrn_out_wave(const Params& p, int n, int hh, int it, int lane) {
  const int r = lane & 31, h = lane >> 5;
  const size_t row = (size_t)(n * 64 + it * 32 + r);
  bf16x8 qf[8];
  _Pragma("unroll") for (int s = 0; s < 8; ++s) qf[s] = *(const bf16x8*)(p.QB + row * 512 + hh * 128 + 16 * s + 8 * h);
  const bfr* sb = p.S16 + (size_t)(n * 4 + hh) * 16384 + (size_t)r * 128 + 8 * h;
  f32x16 acc[4];
  _Pragma("unroll") for (int vt = 0; vt < 4; ++vt) {
    acc[vt] = zero16();
    _Pragma("unroll") for (int s = 0; s < 8; ++s) {
      bf16x8 sf = *(const bf16x8*)(sb + vt * 32 * 128 + 16 * s);
      acc[vt] = mfma(sf, qf[s], acc[vt]);
    }
  }
  float ss = 0.f;
  _Pragma("unroll") for (int vt = 0; vt < 4; ++vt) _Pragma("unroll") for (int g = 0; g < 4; ++g) {
    const u32x2 oi = *(const u32x2*)(p.YB + row * 1024 + hh * 128 + 32 * vt + 8 * g + 4 * h);
    acc[vt][4 * g] += bflo(oi[0]); acc[vt][4 * g + 1] += bfhi(oi[0]); acc[vt][4 * g + 2] += bflo(oi[1]); acc[vt][4 * g + 3] += bfhi(oi[1]);
    ss += acc[vt][4 * g] * acc[vt][4 * g] + acc[vt][4 * g + 1] * acc[vt][4 * g + 1] + acc[vt][4 * g + 2] * acc[vt][4 * g + 2] + acc[vt][4 * g + 3] * acc[vt][4 * g + 3];
  }
  ss += __shfl_xor(ss, 32);
  const float sc = rsqrtf(ss * (1.f / 128.f) + EPS);
  u32x2 zbv[16];
  _Pragma("unroll") for (int vt = 0; vt < 4; ++vt) _Pragma("unroll") for (int g = 0; g < 4; ++g) zbv[vt * 4 + g] = *(const u32x2*)(p.ZB + row * 512 + hh * 128 + 32 * vt + 8 * g + 4 * h);
  __builtin_amdgcn_sched_barrier(0);
  _Pragma("unroll") for (int vt = 0; vt < 4; ++vt) _Pragma("unroll") for (int g = 0; g < 4; ++g) {
    const int v = 32 * vt + 8 * g + 4 * h;
    const float4 og = *(const float4*)(p.og + v);
    const u32x2 zb = zbv[vt * 4 + g];
    *(u32x2*)(p.YB + row * 1024 + hh * 128 + v) = pack4(acc[vt][4 * g] * sc * og.x * bflo(zb[0]), acc[vt][4 * g + 1] * sc * og.y * bfhi(zb[0]),
                                                        acc[vt][4 * g + 2] * sc * og.z * bflo(zb[1]), acc[vt][4 * g + 3] * sc * og.w * bfhi(zb[1]));
  }
}

#define XB_TMO      128
#define XB_XCNT(j)  (256  + 64 * (j))
#define XB_XSUB(j)  (1280 + 64 * (j))
#define XB_XGEN(j)  (2304 + 64 * (j))
#define XB_TOP      3328
#define XB_TOPGEN   3392
#define XCD_BAR_WORDS 3456
#define XB_SPIN_CAP (1u << 18)
#define LAS __attribute__((address_space(3)))

__device__ __forceinline__ unsigned xb_ld(unsigned* p)              { return __hip_atomic_load(p, __ATOMIC_RELAXED, __HIP_MEMORY_SCOPE_AGENT); }
__device__ __forceinline__ unsigned xb_add(unsigned* p, unsigned v) { return __hip_atomic_fetch_add(p, v, __ATOMIC_RELAXED, __HIP_MEMORY_SCOPE_AGENT); }
__device__ __forceinline__ unsigned xb_xcc_id() { return (unsigned)__builtin_amdgcn_s_getreg((3 << 11) | 20) & 0xFu; }
#define XB_SPIN(cond, bar) do { unsigned _sp = 0; while (cond) { __builtin_amdgcn_s_sleep(1); \
    if ((++_sp & 255u) == 0u) { if (xb_ld(&(bar)[XB_TMO])) break; if (_sp > XB_SPIN_CAP) { atomicAdd(&(bar)[XB_TMO], 1u); break; } } } } while (0)

struct XcdBarrier {
    unsigned* bar; unsigned x;
    volatile LAS unsigned* st;
};

__device__ __forceinline__ XcdBarrier xcd_barrier_post(unsigned* bar, volatile LAS unsigned* st) {
    XcdBarrier b; b.bar = bar; b.x = xb_xcc_id(); b.st = st;
    if (threadIdx.x == 0) (void)xb_add(&bar[XB_XCNT(b.x)], 1u);
    return b;
}
__device__ __forceinline__ void xcd_barrier_complete(unsigned* bar, unsigned x, unsigned& nloc, unsigned& nx) {
    const unsigned G = gridDim.x * gridDim.y * gridDim.z;
    unsigned sum, cnt, mine, sp = 0u;
    for (;;) {
        sum = 0u; cnt = 0u; mine = 0u;
#pragma unroll
        for (unsigned j = 0; j < 16; ++j) { const unsigned c = xb_ld(&bar[XB_XCNT(j)]); sum += c; cnt += (c > 0u) ? 1u : 0u; mine = (j == x) ? c : mine; }
        if (sum == G) break;
        __builtin_amdgcn_s_sleep(1);
        if ((++sp & 255u) == 0u) { if (xb_ld(&bar[XB_TMO])) break; if (sp > XB_SPIN_CAP) { atomicAdd(&bar[XB_TMO], 1u); break; } }
    }
    nloc = mine > 0u ? mine : 1u; nx = cnt > 0u ? cnt : 1u;
}

__device__ __forceinline__ void xcd_barrier(const XcdBarrier& b) {
    asm volatile("s_waitcnt vmcnt(0)" ::: "memory");
    __syncthreads();
    if (threadIdx.x == 0) {
        unsigned* bar = b.bar;
        __builtin_amdgcn_s_waitcnt(0);
        unsigned nloc = b.st[0], nx = b.st[1];
        if (nloc == 0u) { xcd_barrier_complete(bar, b.x, nloc, nx); b.st[0] = nloc; b.st[1] = nx; }
        const unsigned old = xb_add(&bar[XB_XSUB(b.x)], 1u);
        const unsigned gen = old / nloc;
        if (old + 1u == (gen + 1u) * nloc) {
            __builtin_amdgcn_fence(__ATOMIC_RELEASE, "agent");
            asm volatile("s_waitcnt vmcnt(0)" ::: "memory");
            const unsigned og = xb_add(&bar[XB_TOP], 1u);
            const unsigned tg = og / nx;
            if (og + 1u == (tg + 1u) * nx) xb_add(&bar[XB_TOPGEN], 1u);
            else XB_SPIN(xb_ld(&bar[XB_TOPGEN]) == tg, bar);
            __builtin_amdgcn_fence(__ATOMIC_ACQUIRE, "agent");
            xb_add(&bar[XB_XGEN(b.x)], 1u);
            asm volatile("s_waitcnt vmcnt(0)" ::: "memory");
        } else {
            XB_SPIN(xb_ld(&bar[XB_XGEN(b.x)]) == gen, bar);
            __builtin_amdgcn_fence(__ATOMIC_ACQUIRE, "agent");
            asm volatile("s_waitcnt vmcnt(0)" ::: "memory");
        }
    }
    __syncthreads();
}

static_assert(PANEL_CNT_WORD == XCD_BAR_WORDS, "panel counters follow the barrier words");
__global__ void __launch_bounds__(512, 2) hybrid_megakernel(Params p) {
  extern __shared__ __attribute__((aligned(16))) char smem_all[];
  __shared__ uint4 xb_words;
  if (threadIdx.x == 0) xb_words = make_uint4(0u, 0u, 0u, 0u);
  __syncthreads();
  const XcdBarrier xb = xcd_barrier_post(p.bar, (volatile LAS unsigned*)&xb_words);
  char* smem = smem_all + (threadIdx.x >> 8) * 73728;
#ifndef REPMASK
#define REPMASK 0
#endif
#define RUN_PHASE(n, ...) if (p.phase_lo <= n && n <= p.phase_hi) { if (n != p.phase_lo) xcd_barrier(xb); __VA_ARGS__; if ((REPMASK >> n) & 1) { xcd_barrier(xb); __VA_ARGS__; } }
  RUN_PHASE(0, phase_prep(p, smem))
  RUN_PHASE(1, { if (VBID < 48) phase_mod(p, smem); else phase_prep2(p, smem, VBID - 48, VGRID - 48); })
  RUN_PHASE(2, phase_h(p))
  RUN_PHASE(3, {
    pg8::Gemm g{p.H, p.Wt_all, MPAD, NALL, 1024};
    pg8::StaticOrder S; S.init(MPAD, NALL, (int)gridDim.x, (int)blockIdx.x);
    EpiMain E{p};
    pg8::gemm_phase<EpiMain, pg8::StaticOrder, false>((PG8_LAS unsigned char*)smem_all, g, S, E, nullptr);
  })
  RUN_PHASE(4, phase_mix(p, smem, smem_all))
  RUN_PHASE(5, {
    if (threadIdx.x < 256) { for (int eb = blockIdx.x; eb < 256; eb += gridDim.x) phase_scan(p, eb); }
    else { const int wt = blockIdx.x * 4 + ((threadIdx.x >> 6) - 4); if (wt < 128) sample_chain_wave(p, wt, threadIdx.x & 63); }
  })
  RUN_PHASE(6, {
    for (int wi = blockIdx.x * 8 + (threadIdx.x >> 6); wi < 2048; wi += gridDim.x * 8) hgrn_out_wave(p, wi >> 3, (wi >> 1) & 3, wi & 1, threadIdx.x & 63);
  })
  RUN_PHASE(7, {
    pg8::Gemm g{p.YA, p.Wt_pab, SEQ, 1024, 1024};
    pg8::StaticOrder S; S.init(SEQ, 1024, (int)gridDim.x, (int)blockIdx.x);
    EpiMerge E{p};
    pg8::gemm_phase<EpiMerge, pg8::StaticOrder, false>((PG8_LAS unsigned char*)smem_all, g, S, E, nullptr);
  })
  RUN_PHASE(8, {
    pg8::Gemm g{p.Y, p.Wt_out, SEQ, 1024, 1024};
    pg8::StaticOrder S; S.init(SEQ, 1024, (int)gridDim.x, (int)blockIdx.x);
    if ((int)gridDim.x == (SEQ / 256) * 4) {
      EpiOutLds E{p};
      pg8::gemm_phase<EpiOutLds, pg8::StaticOrder, false>((PG8_LAS unsigned char*)smem_all, g, S, E, nullptr);
    } else {
      EpiOut E{p};
      pg8::gemm_phase<EpiOut, pg8::StaticOrder, false>((PG8_LAS unsigned char*)smem_all, g, S, E, nullptr);
    }
  })
}

#ifndef ONE_LAUNCH
#define ONE_LAUNCH 1
#endif
constexpr size_t kDynLds = 147456;

extern "C" void kernel_launch(void* const* d_in, const int* in_sizes, int n_in, void* d_out, int out_size, void* d_ws, size_t ws_size,
                              hipStream_t stream) {
  static int grid_blocks = 0;
  if (!grid_blocks) {
    int dev = 0, cus = 0, per_cu = 0;
    (void)hipGetDevice(&dev);
    (void)hipDeviceGetAttribute(&cus, hipDeviceAttributeMultiprocessorCount, dev);
    (void)hipFuncSetAttribute((const void*)hybrid_megakernel, hipFuncAttributeMaxDynamicSharedMemorySize, (int)kDynLds);
    (void)hipOccupancyMaxActiveBlocksPerMultiprocessor(&per_cu, hybrid_megakernel, 512, kDynLds);
    if (per_cu > 1) per_cu = 1;
    if (per_cu < 1) per_cu = 1;
    grid_blocks = cus * per_cu;
  }
  Params p{};
  const float* const* in = (const float* const*)d_in;
  p.x_prompt = in[0]; p.x_sample = in[1]; p.cache_k = in[2]; p.cache_v = in[3]; p.state = in[4]; p.c_prompt = in[5]; p.c_sample = in[6];
  p.w_ada = in[7]; p.b_ada = in[8]; p.norm_g = in[9]; p.w_in = in[10]; p.qg = in[11]; p.kg = in[12]; p.sinks = in[13]; p.lb_logits = in[14];
  p.og = in[15]; p.w_merge = in[16]; p.b_merge = in[17]; p.w_pa = in[18]; p.w_pb = in[19]; p.w_out = in[20];
  float* o = (float*)d_out;
  p.out_yp = o; o += (size_t)SEQ * DM;
  p.out_ys = o; o += (size_t)NBT * DM;
  p.out_kp = o; o += 128 * 128;
  p.out_vp = o; o += 128 * 128;
  p.out_sp = o; o += 4 * 128 * 128;
  p.out_ks = o; o += (size_t)NBT * 128 * 128;
  p.out_vs = o; o += (size_t)NBT * 128 * 128;
  p.out_ss = o;
  char* wsp = (char*)d_ws;
  auto take = [&](size_t bytes) { char* r = wsp; wsp += (bytes + 255) & ~(size_t)255; return r; };
  p.bar = (unsigned*)take((size_t)(XCD_BAR_WORDS + 256) * 4);
  p.Wt_all = (bfr*)take((size_t)NALL * 1024 * 2);
  p.Wt_pab = (bfr*)take((size_t)1024 * 1024 * 2);
  p.Wt_out = (bfr*)take((size_t)1024 * 1024 * 2);
  p.Wt_ada = (bfr*)take((size_t)3072 * 1024 * 2);
  p.Cb = (bfr*)take((size_t)256 * 1024 * 2);
  p.mod = (float*)take((size_t)256 * 3072 * 4);
  p.Ys = (bfr*)take((size_t)128 * 1024 * 2);
  p.H = (bfr*)take((size_t)MPAD * 1024 * 2);
  p.YA = p.H; p.YB = p.H + 512;
  p.ZA = (bfr*)take((size_t)MTOT * 512 * 2);
  p.S16 = p.ZA;
  p.Q = (bfr*)take((size_t)MTOT * 512 * 2);
  p.QB = (bfr*)take((size_t)MTOT * 512 * 2);
  p.Y = p.Q;
  p.Kb = (bfr*)take((size_t)MTOT * 128 * 2);
  p.Vb = (bfr*)take((size_t)MTOT * 128 * 2);
  p.IB = (bfr*)take((size_t)MTOT * 512 * 2);
  p.ZB = (bfr*)take((size_t)MTOT * 512 * 2);
  p.ZF = (bfr*)take((size_t)MTOT * 512 * 2);
  p.GA = (bfr*)take((size_t)MTOT * 1024 * 2);
  p.GB = (bfr*)take((size_t)MTOT * 1024 * 2);
  p.dec = (float*)take((size_t)NCH * 4 * 128 * 4);
  p.Ust = p.out_yp;
  if ((size_t)(wsp - (char*)d_ws) > ws_size) { fprintf(stderr, "workspace too small\n"); return; }
  (void)hipMemsetAsync(p.bar, 0, (size_t)(XCD_BAR_WORDS + 256) * 4, stream);
#if ONE_LAUNCH
  p.phase_lo = 0; p.phase_hi = 8;
  void* args[] = {&p};
  hipError_t e = hipLaunchCooperativeKernel((void*)hybrid_megakernel, dim3(grid_blocks), dim3(512), args, kDynLds, stream);
  if (e != hipSuccess) fprintf(stderr, "cooperative launch failed: %s (grid %d)\n", hipGetErrorString(e), grid_blocks);
#else
  for (int ph = 0; ph <= 8; ++ph) {
    p.phase_lo = ph; p.phase_hi = ph;
    hipLaunchKernelGGL(hybrid_megakernel, dim3(grid_blocks), dim3(512), kDynLds, stream, p);
  }
#endif
}
```

```cpp
#include <hip/hip_runtime.h>
#include <cstdio>

#define DI __device__ __forceinline__
typedef unsigned short bfr;
using bf16x8 = __attribute__((ext_vector_type(8))) short;
using f32x16 = __attribute__((ext_vector_type(16))) float;
using u32x4 = __attribute__((ext_vector_type(4))) unsigned;
using u32x2 = __attribute__((ext_vector_type(2))) unsigned;

constexpr int DM = 1024, SEQ = 16384, NBT = 128, MTOT = SEQ + NBT;
constexpr int NALL = 5376;
constexpr int NCH = 256;
constexpr float EPS = 1e-6f;
constexpr float LOG2E = 1.4426950408889634f;
constexpr float QSCALE = 0.125f * 1.4426950408889634f;
constexpr int PANEL_CNT_WORD = 3456;
constexpr int LDT = 72;
constexpr int MPAD = 16640;
#define TID ((int)(threadIdx.x & 255))
#define VBID ((int)(blockIdx.x * 2 + (threadIdx.x >> 8)))
#define VGRID ((int)(gridDim.x * 2))

struct Params {
  const float *x_prompt, *x_sample, *cache_k, *cache_v, *state, *c_prompt, *c_sample;
  const float *w_ada, *b_ada, *norm_g, *w_in, *qg, *kg, *sinks, *lb_logits, *og, *w_merge, *b_merge, *w_pa, *w_pb, *w_out;
  float *out_yp, *out_ys, *out_kp, *out_vp, *out_sp, *out_ks, *out_vs, *out_ss;
  bfr *Wt_all, *Wt_pab, *Wt_out, *Wt_ada, *Cb, *H, *Q, *QB, *Kb, *Vb, *ZA, *IB, *ZB, *GA, *GB, *YA, *YB, *Y;
  float *mod, *dec, *Ust;
  bfr* ZF;
  bfr* S16;
  bfr* Ys;
  unsigned* bar;
  int phase_lo, phase_hi;
};

DI unsigned f2bf(float x) { unsigned u = __float_as_uint(x); u += 0x7fffu + ((u >> 16) & 1u); return u >> 16; }
typedef __bf16 hbf2 __attribute__((ext_vector_type(2)));
typedef float hf2 __attribute__((ext_vector_type(2)));
DI unsigned pk2(float a, float b) { hf2 v = {a, b}; return __builtin_bit_cast(unsigned, __builtin_convertvector(v, hbf2)); }
DI float bf2f(unsigned b) { return __uint_as_float(b << 16); }
DI float bflo(unsigned u) { return __uint_as_float(u << 16); }
DI float bfhi(unsigned u) { return __uint_as_float(u & 0xffff0000u); }
DI int crow(int i, int h) { return (i & 3) + 8 * (i >> 2) + 4 * h; }
DI f32x16 mfma(bf16x8 a, bf16x8 b, f32x16 c) { return __builtin_amdgcn_mfma_f32_32x32x16_bf16(a, b, c, 0, 0, 0); }
DI f32x16 zero16() { f32x16 z; _Pragma("unroll") for (int i = 0; i < 16; ++i) z[i] = 0.f; return z; }
DI float frcp(float x) { return __builtin_amdgcn_rcpf(x); }
DI float fexp(float x) { return __builtin_amdgcn_exp2f(x * 1.4426950408889634f); }
DI float sigmoidf_(float x) { return frcp(1.f + fexp(-x)); }
DI float siluf_(float x) { return x * frcp(1.f + fexp(-x)); }
DI u32x2 pack4(float a, float b, float c, float d) { u32x2 r; r[0] = pk2(a, b); r[1] = pk2(c, d); return r; }

DI int wt_row_of_col(int c) {
  const int pn = c >> 8, cl = c & 255;
  int slot;
  if (pn < 3) {
    const int g = cl >> 6, d = cl & 63;
    if (d >= 32) { const int x = d - 32; slot = 128 + 32 * g + 16 * ((x >> 2) & 1) + 4 * (x >> 3) + (x & 3); }
    else { const int fq = 2 * (d >> 4) + ((d >> 2) & 1), n = (d >> 3) & 1, j = d & 3; slot = 32 * g + 16 * n + 4 * fq + j; }
  } else {
    const int bj = cl >> 7, g = (cl >> 5) & 3, x = cl & 31;
    slot = 128 * bj + 32 * g + 16 * ((x >> 2) & 1) + 4 * (x >> 3) + (x & 3);
  }
  return (pn << 8) + slot;
}

DI void gemm_mainloop(const bfr* __restrict__ A, int lda, int m0, const bfr* __restrict__ W, int ldw, int n0, int K,
                      bfr* sA, bfr* sW, f32x16 (&acc)[2][2]) {
  const int t = TID, lane = t & 63, w = t >> 6, wn = w >> 1, wm = w & 1, r = lane & 31, h = lane >> 5;
  const int lrow = t >> 3, lk = (t & 7) * 8;
  const bfr* ap = A + (size_t)(m0 + lrow) * lda + lk;
  const bfr* wp = W + (size_t)(n0 + lrow) * ldw + lk;
  u32x4 ra[4], rw[4];
  _Pragma("unroll") for (int i = 0; i < 4; ++i) {
    ra[i] = *(const u32x4*)(ap + (size_t)(32 * i) * lda);
    rw[i] = *(const u32x4*)(wp + (size_t)(32 * i) * ldw);
  }
  const int nk = K >> 6;
  for (int kt = 0; kt < nk; ++kt) {
    __syncthreads();
    _Pragma("unroll") for (int i = 0; i < 4; ++i) {
      *(u32x4*)(sA + (lrow + 32 * i) * LDT + lk) = ra[i];
      *(u32x4*)(sW + (lrow + 32 * i) * LDT + lk) = rw[i];
    }
    __syncthreads();
    if (kt + 1 < nk) {
      ap += 64; wp += 64;
      _Pragma("unroll") for (int i = 0; i < 4; ++i) {
        ra[i] = *(const u32x4*)(ap + (size_t)(32 * i) * lda);
        rw[i] = *(const u32x4*)(wp + (size_t)(32 * i) * ldw);
      }
    }
    _Pragma("unroll") for (int kk = 0; kk < 4; ++kk) {
      bf16x8 af[2], bf[2];
      _Pragma("unroll") for (int x = 0; x < 2; ++x) {
        af[x] = *(const bf16x8*)(sW + (wn * 64 + x * 32 + r) * LDT + kk * 16 + 8 * h);
        bf[x] = *(const bf16x8*)(sA + (wm * 64 + x * 32 + r) * LDT + kk * 16 + 8 * h);
      }
      _Pragma("unroll") for (int nt = 0; nt < 2; ++nt)
        _Pragma("unroll") for (int mt = 0; mt < 2; ++mt) acc[nt][mt] = mfma(af[nt], bf[mt], acc[nt][mt]);
    }
  }
}

template <int PERMBASE> DI void transpose_tile(const float* __restrict__ src, int N, bfr* __restrict__ dst, int K, int kt, int nt, float* sm) {
  const int t = TID, k0 = kt * 64, n0 = nt * 64;
  __syncthreads();
  _Pragma("unroll") for (int i = 0; i < 16; ++i) {
    int idx = i * 256 + t, kk = idx >> 6, nn = idx & 63;
    sm[kk * 65 + nn] = src[(size_t)(k0 + kk) * N + n0 + nn];
  }
  __syncthreads();
  _Pragma("unroll") for (int i = 0; i < 8; ++i) {
    int idx = i * 256 + t, nn = idx >> 5, kk = (idx & 31) * 2;
    const int drow = PERMBASE >= 0 ? wt_row_of_col(PERMBASE + n0 + nn) : n0 + nn;
    *(unsigned*)(dst + (size_t)drow * K + k0 + kk) = pk2(sm[kk * 65 + nn], sm[(kk + 1) * 65 + nn]);
  }
}

DI void phase_prep(const Params& p, char* smem) {
  float* sm = (float*)smem;
  for (int it = VBID; it < 768; it += VGRID) transpose_tile<-1>(p.w_ada, 3072, p.Wt_ada, 1024, it / 48, it % 48, sm);
  for (int idx = VBID * 256 + TID; idx < 256 * 1024; idx += VGRID * 256) {
    int row = idx >> 10, col = idx & 1023;
    float v = row < 128 ? p.c_sample[row * 1024 + col] : (row == 128 ? p.c_prompt[col] : 0.f);
    p.Cb[idx] = (bfr)f2bf(v);
  }
}
DI void phase_prep2(const Params& p, char* smem, int vb0, int nvb) {
  float* sm = (float*)smem;
  for (int it = vb0; it < 1856; it += nvb) {
    int i = it;
    if (i < 832) { transpose_tile<0>(p.w_in, 3328, p.Wt_all, 1024, i / 52, i % 52, sm); continue; }
    i -= 832;
    if (i < 512) { transpose_tile<3328>(p.w_merge, 2048, p.Wt_all, 1024, i / 32, i % 32, sm); continue; }
    i -= 512;
    if (i < 128) { transpose_tile<-1>(p.w_pa, 1024, p.Wt_pab, 1024, i / 16, i % 16, sm); continue; }
    i -= 128;
    if (i < 128) { transpose_tile<-1>(p.w_pb, 1024, p.Wt_pab + 512, 1024, i / 16, i % 16, sm); continue; }
    i -= 128;
    transpose_tile<-1>(p.w_out, 1024, p.Wt_out, 1024, i / 16, i % 16, sm);
  }
}

DI void phase_mod(const Params& p, char* smem) {
  bfr* sA = (bfr*)smem; bfr* sW = sA + 128 * LDT;
  const int t = TID, lane = t & 63, w = t >> 6, wn = w >> 1, wm = w & 1, r = lane & 31, h = lane >> 5;
  for (int tile = VBID; tile < 48; tile += VGRID) {
    int m0 = (tile / 24) * 128, n0 = (tile % 24) * 128;
    f32x16 acc[2][2];
    _Pragma("unroll") for (int a = 0; a < 2; ++a) _Pragma("unroll") for (int b = 0; b < 2; ++b) acc[a][b] = zero16();
    gemm_mainloop(p.Cb, 1024, m0, p.Wt_ada, 1024, n0, 1024, sA, sW, acc);
    float4 bias[2][4];
    _Pragma("unroll") for (int nt = 0; nt < 2; ++nt) _Pragma("unroll") for (int g = 0; g < 4; ++g) bias[nt][g] = *(const float4*)(p.b_ada + n0 + wn * 64 + nt * 32 + 8 * g + 4 * h);
    _Pragma("unroll") for (int nt = 0; nt < 2; ++nt) _Pragma("unroll") for (int mt = 0; mt < 2; ++mt) {
      int m = m0 + wm * 64 + mt * 32 + r;
      _Pragma("unroll") for (int g = 0; g < 4; ++g) {
        int n = n0 + wn * 64 + nt * 32 + 8 * g + 4 * h;
        float4 b = bias[nt][g];
        float4 o; o.x = acc[nt][mt][4 * g] + b.x; o.y = acc[nt][mt][4 * g + 1] + b.y; o.z = acc[nt][mt][4 * g + 2] + b.z; o.w = acc[nt][mt][4 * g + 3] + b.w;
        *(float4*)(p.mod + (size_t)m * 3072 + n) = o;
      }
    }
  }
}

DI void phase_h(const Params& p) {
  const int lane = threadIdx.x & 63, gw = blockIdx.x * 8 + (threadIdx.x >> 6), nw = gridDim.x * 8;
  float4 g[4];
  _Pragma("unroll") for (int j = 0; j < 4; ++j) g[j] = *(const float4*)(p.norm_g + j * 256 + lane * 4);
  {
    const float* mr = p.mod + (size_t)128 * 3072;
    float4 a[4], bsh[4];
    _Pragma("unroll") for (int j = 0; j < 4; ++j) {
      const int col = j * 256 + lane * 4;
      const float4 sh = *(const float4*)(mr + col), sc = *(const float4*)(mr + 1024 + col);
      a[j].x = g[j].x * (1.f + sc.x); a[j].y = g[j].y * (1.f + sc.y); a[j].z = g[j].z * (1.f + sc.z); a[j].w = g[j].w * (1.f + sc.w);
      bsh[j] = sh;
    }
    for (int r0 = gw; r0 < SEQ; r0 += 8 * nw) {
      float4 xv[8][4];
      _Pragma("unroll") for (int q = 0; q < 8; ++q) {
        const int row = min(r0 + q * nw, SEQ - 1);
        _Pragma("unroll") for (int j = 0; j < 4; ++j) xv[q][j] = *(const float4*)(p.x_prompt + (size_t)row * DM + j * 256 + lane * 4);
      }
      __builtin_amdgcn_sched_barrier(0);
      _Pragma("unroll") for (int q = 0; q < 8; ++q) {
        const int row = r0 + q * nw;
        float ss = 0.f;
        _Pragma("unroll") for (int j = 0; j < 4; ++j) ss += xv[q][j].x * xv[q][j].x + xv[q][j].y * xv[q][j].y + xv[q][j].z * xv[q][j].z + xv[q][j].w * xv[q][j].w;
        _Pragma("unroll") for (int o = 32; o >= 1; o >>= 1) ss += __shfl_xor(ss, o);
        const float rs = rsqrtf(ss * (1.f / DM) + EPS);
        if (row < SEQ) {
          _Pragma("unroll") for (int j = 0; j < 4; ++j)
            *(u32x2*)(p.H + (size_t)row * DM + j * 256 + lane * 4) = pack4(xv[q][j].x * rs * a[j].x + bsh[j].x, xv[q][j].y * rs * a[j].y + bsh[j].y,
                                                                          xv[q][j].z * rs * a[j].z + bsh[j].z, xv[q][j].w * rs * a[j].w + bsh[j].w);
        }
      }
    }
  }
  for (int b = gw; b < NBT; b += nw) {
    const float* xr = p.x_sample + (size_t)b * DM;
    const float* mr = p.mod + (size_t)b * 3072;
    float4 xv[4], sh[4], sc[4]; float ss = 0.f;
    _Pragma("unroll") for (int j = 0; j < 4; ++j) {
      const int col = j * 256 + lane * 4;
      xv[j] = *(const float4*)(xr + col); sh[j] = *(const float4*)(mr + col); sc[j] = *(const float4*)(mr + 1024 + col);
      ss += xv[j].x * xv[j].x + xv[j].y * xv[j].y + xv[j].z * xv[j].z + xv[j].w * xv[j].w;
    }
    _Pragma("unroll") for (int o = 32; o >= 1; o >>= 1) ss += __shfl_xor(ss, o);
    const float rs = rsqrtf(ss * (1.f / DM) + EPS);
    _Pragma("unroll") for (int j = 0; j < 4; ++j)
      *(u32x2*)(p.H + (size_t)(SEQ + b) * DM + j * 256 + lane * 4) = pack4(xv[j].x * rs * g[j].x * (1.f + sc[j].x) + sh[j].x, xv[j].y * rs * g[j].y * (1.f + sc[j].y) + sh[j].y,
                                                                          xv[j].z * rs * g[j].z * (1.f + sc[j].z) + sh[j].z, xv[j].w * rs * g[j].w * (1.f + sc[j].w) + sh[j].w);
  }
}

DI void sincos_red(float a, float& s, float& c) {
  float n = rintf(a * 0.15915494309189535f);
  float rr = fmaf(-n, 6.2831854820251465f, a);
  rr = fmaf(-n, -1.7484555e-7f, rr);
  s = __sinf(rr); c = __cosf(rr);
}

namespace pg8 {
#define PG8_LAS __attribute__((address_space(3)))
typedef unsigned short bf16_t;
typedef short bf16x8 __attribute__((ext_vector_type(8)));
typedef float f32x4 __attribute__((ext_vector_type(4)));
typedef unsigned u32x4 __attribute__((ext_vector_type(4)));
constexpr int BM = 256, BK = 64, HALF = 128, HTB = HALF * BK * 2  , STAGE_BYTES = 8 * HTB, NXCD = 8, WGM = 8;

__host__ __device__ __forceinline__ int lds_byte(int r, int c) { const int st = (r >> 4) * 2 + (c >> 5), rr = r & 15, cc = c & 31, ob = rr * 64 + cc * 2; return st * 1024 + (ob ^ (((ob >> 9) & 1) << 5)); }
__host__ __device__ __forceinline__ void stage_rc(int b, int& R, int& C) { const int st = b / 1024, sb = b % 1024, swz = sb ^ (((sb >> 9) & 1) << 5); R = (st >> 1) * 16 + swz / 64; C = (st & 1) * 32 + (swz % 64) / 2; }
__host__ __device__ __forceinline__ int perm32(int rho) { const int n = rho >> 4, i = rho & 15; return 8 * (i >> 2) + 4 * n + (i & 3); }

struct Unit { int pm, pn; };
struct Gemm { const bf16_t* A; const bf16_t* Bt; int M, N, K; };

struct StaticOrder {
    int nM, nN, nwg, G, c;
    __host__ __device__ void init(int M, int N, int G_, int c_) { nM = M / BM; nN = N / BM; nwg = nM * nN; G = G_; c = c_; }
    __host__ __device__ bool next(int i, Unit& u) const {
        const long L = (long)i * G + c; if (L >= nwg) return false;
        int wgid = (int)L; { const int q = nwg / NXCD, r = nwg % NXCD, xcd = wgid % NXCD, off = wgid / NXCD; wgid = (xcd < r ? xcd * (q + 1) : r * (q + 1) + (xcd - r) * q) + off; }
        const int nig = WGM * nN, gid = wgid / nig, fm = gid * WGM, gsz = (nM - fm) < WGM ? (nM - fm) : WGM;
        u.pm = fm + ((wgid % nig) % gsz); u.pn = (wgid % nig) / gsz; return true;
    }
    __device__ __forceinline__ void a_ready(const Unit&) const {}
    __device__ __forceinline__ void done(const Unit&) const {}
};
template <class Epi, class Sched, bool STAMP = false>
__device__ __forceinline__ void gemm_phase(PG8_LAS unsigned char* lds, const Gemm g, const Sched& S, const Epi& E, unsigned long long* stamps) {
    const int tid = threadIdx.x, wid = __builtin_amdgcn_readfirstlane(tid >> 6), lane = tid & 63, wr = wid >> 2, wc = wid & 3, fr = lane & 15, fq = lane >> 4;
    const int K = g.K, nt = K / BK;
    int ts_lo = 0, ts_hi = 0, nts = 0; const unsigned long long rt_entry = STAMP ? (unsigned long long)wall_clock64() : 0ull;
#define PG8_STAMP() do { if (STAMP && wid == 0 && nts < 64) { const unsigned long long _c = (unsigned long long)clock64(); \
        ts_lo = (lane == nts) ? (int)(unsigned)_c : ts_lo; ts_hi = (lane == nts) ? (int)(unsigned)(_c >> 32) : ts_hi; ++nts; } } while (0)
    PG8_STAMP();
    unsigned voffA[2], voffB[2];
#pragma unroll
    for (int i = 0; i < 2; ++i) { int R, C; stage_rc(tid * 16 + i * 8192, R, C); const int Rb = Epi::PERM ? ((R & ~31) + perm32(R & 31)) : R;
        voffA[i] = (unsigned)(R * K + C) * 2u; voffB[i] = (unsigned)(Rb * K + C) * 2u; }
    const size_t kstep = (size_t)(BK * 2);
    const size_t hstep = (size_t)HALF * K * 2;
    const size_t tstep = 2 * hstep;
    const unsigned ldsw = (unsigned)wid * 1024u;
    const int aoff = lds_byte(wr * 64 + fr, fq * 8), boff = lds_byte(wc * 32 + fr, fq * 8);
#define PG8_SA(b, h) (((b) * 2 + (h)) * HTB)
#define PG8_SB(b, h) ((4 + (b) * 2 + (h)) * HTB)
#define PG8_STAGE(bufoff, gbase, voff) do { _Pragma("unroll") for (int _i = 0; _i < 2; ++_i) \
        __builtin_amdgcn_global_load_lds((const unsigned*)((const char*)(gbase) + (voff)[_i]), (PG8_LAS unsigned*)(lds + (bufoff) + ldsw + _i * 8192), 16, 0, 0); } while (0)
#define PG8_LDA(dst, b, h) do { _Pragma("unroll") for (int m = 0; m < 4; ++m) _Pragma("unroll") for (int k = 0; k < 2; ++k) dst[m][k] = *(const PG8_LAS bf16x8*)(lds + PG8_SA(b, h) + aoff + m * 2048 + k * 1024); } while (0)
#define PG8_LDB(dst, b, h) do { _Pragma("unroll") for (int n = 0; n < 2; ++n) _Pragma("unroll") for (int k = 0; k < 2; ++k) dst[n][k] = *(const PG8_LAS bf16x8*)(lds + PG8_SB(b, h) + boff + n * 2048 + k * 1024); } while (0)
#define PG8_MMA(ai, bj, At, Bt) do { __builtin_amdgcn_s_setprio(1); _Pragma("unroll") for (int m = 0; m < 4; ++m) _Pragma("unroll") for (int n = 0; n < 2; ++n) _Pragma("unroll") for (int k = 0; k < 2; ++k) \
        acc[ai][bj][m][n] = __builtin_amdgcn_mfma_f32_16x16x32_bf16(Bt[n][k], At[m][k], acc[ai][bj][m][n], 0, 0, 0); __builtin_amdgcn_s_setprio(0); } while (0)
#define PG8_WAIT_V(n) asm volatile("s_waitcnt vmcnt(" #n ")" ::: "memory")
#define PG8_WAIT_L(n) asm volatile("s_waitcnt lgkmcnt(" #n ")" ::: "memory")
#define PG8_BAR __builtin_amdgcn_s_barrier()
#define PG8_SCHED __builtin_amdgcn_sched_barrier(0)
    Unit cur, nxt; int ui = 0;
    if (!S.next(0, cur)) return;
    f32x4 acc[2][2][4][2];
#pragma unroll
    for (int a = 0; a < 2; ++a)
#pragma unroll
        for (int b = 0; b < 2; ++b)
#pragma unroll
            for (int m = 0; m < 4; ++m)
#pragma unroll
                for (int n = 0; n < 2; ++n) acc[a][b][m][n] = (f32x4){0.f, 0.f, 0.f, 0.f};
    bf16x8 At[4][2], B0[2][2], B1[2][2];
    const char* cA = (const char*)g.A + (size_t)cur.pm * tstep; const char* cB = (const char*)g.Bt + (size_t)cur.pn * tstep;
    S.a_ready(cur);
    PG8_STAGE(PG8_SB(0, 0), cB, voffB); PG8_STAGE(PG8_SA(0, 0), cA, voffA); PG8_STAGE(PG8_SB(0, 1), cB + hstep, voffB); PG8_STAGE(PG8_SA(0, 1), cA + hstep, voffA);
    if (wr == 1) PG8_BAR;
    PG8_WAIT_V(4); PG8_BAR;
    PG8_STAGE(PG8_SB(1, 0), cB + kstep, voffB); PG8_STAGE(PG8_SA(1, 0), cA + kstep, voffA); PG8_STAGE(PG8_SB(1, 1), cB + hstep + kstep, voffB);
    PG8_WAIT_V(6); PG8_BAR;
    PG8_STAMP();
    for (;;) {
        const bool has_next = S.next(ui + 1, nxt);
        const char* nA = has_next ? (const char*)g.A + (size_t)nxt.pm * tstep : cA; const char* nB = has_next ? (const char*)g.Bt + (size_t)nxt.pn * tstep : cB;
        for (int t = 0; t < nt; t += 2) {
            const bool last = (t == nt - 2);
            const char* a1 = cA + (size_t)(t + 1) * kstep;
            const char* a2 = last ? nA : cA + (size_t)(t + 2) * kstep; const char* b2 = last ? nB : cB + (size_t)(t + 2) * kstep;
            const char* a3 = a2 + kstep; const char* b3 = b2 + kstep;
            if (last && has_next) S.a_ready(nxt);
            if constexpr (Epi::MID_T > 0) { if (t == Epi::MID_T) E.mid(acc, cur, wr, wc, fr, fq); }
            PG8_LDB(B0, 0, 0); PG8_SCHED; PG8_LDA(At, 0, 0); PG8_STAGE(PG8_SA(1, 1), a1 + hstep, voffA);
            PG8_WAIT_L(8); PG8_BAR; PG8_WAIT_L(0); PG8_MMA(0, 0, At, B0); PG8_BAR; PG8_SCHED;
            PG8_LDB(B1, 0, 1); PG8_STAGE(PG8_SB(0, 0), b2, voffB);
            PG8_BAR; PG8_WAIT_L(0); PG8_MMA(0, 1, At, B1); PG8_BAR;
            PG8_LDA(At, 0, 1); PG8_STAGE(PG8_SA(0, 0), a2, voffA);
            PG8_BAR; PG8_WAIT_L(0); PG8_MMA(1, 0, At, B0); PG8_BAR; PG8_SCHED;
            PG8_STAGE(PG8_SB(0, 1), b2 + hstep, voffB);
            PG8_WAIT_V(6); PG8_BAR; PG8_MMA(1, 1, At, B1); PG8_BAR;
            PG8_LDB(B0, 1, 0); PG8_SCHED; PG8_LDA(At, 1, 0); PG8_STAGE(PG8_SA(0, 1), a2 + hstep, voffA);
            PG8_WAIT_L(8); PG8_BAR; PG8_WAIT_L(0); PG8_MMA(0, 0, At, B0); PG8_BAR; PG8_SCHED;
            PG8_LDB(B1, 1, 1); PG8_STAGE(PG8_SB(1, 0), b3, voffB);
            PG8_BAR; PG8_WAIT_L(0); PG8_MMA(0, 1, At, B1); PG8_BAR;
            PG8_LDA(At, 1, 1); PG8_STAGE(PG8_SA(1, 0), a3, voffA);
            PG8_BAR; PG8_WAIT_L(0); PG8_MMA(1, 0, At, B0); PG8_BAR; PG8_SCHED;
            PG8_STAGE(PG8_SB(1, 1), b3 + hstep, voffB);
            PG8_WAIT_V(6); PG8_BAR; PG8_MMA(1, 1, At, B1); PG8_BAR;
        }
        PG8_STAMP();
        if constexpr (!Epi::AFTER_DRAIN) { E(acc, cur, wr, wc, fr, fq); S.done(cur); }
        PG8_STAMP();
        if (!has_next) break;
#pragma unroll
        for (int a = 0; a < 2; ++a)
#pragma unroll
            for (int b = 0; b < 2; ++b)
#pragma unroll
                for (int m = 0; m < 4; ++m)
#pragma unroll
                    for (int n = 0; n < 2; ++n) acc[a][b][m][n] = (f32x4){0.f, 0.f, 0.f, 0.f};
        cur = nxt; cA = nA; cB = nB; ++ui;
    }
    PG8_WAIT_V(0);
    if (wr == 0) PG8_BAR;
    PG8_BAR;
    if constexpr (Epi::AFTER_DRAIN) { E.fused(acc, cur, wr, wc, fr, fq, lds, wid, lane); S.done(cur); }
    PG8_STAMP();
    if (STAMP && wid == 0) { stamps[lane] = lane < nts ? (((unsigned long long)(unsigned)ts_hi << 32) | (unsigned)ts_lo) : 0ull;
        if (lane == 62) stamps[62] = rt_entry; if (lane == 63) stamps[63] = (unsigned long long)wall_clock64(); }
#undef PG8_STAMP
#undef PG8_SA
#undef PG8_SB
#undef PG8_STAGE
#undef PG8_LDA
#undef PG8_LDB
#undef PG8_MMA
#undef PG8_WAIT_V
#undef PG8_WAIT_L
#undef PG8_BAR
#undef PG8_SCHED
}
}
using pf4 = pg8::f32x4;

struct EpiMain {
  static constexpr bool PERM = false, AFTER_DRAIN = false;
  static constexpr int MID_T = 0;
  const Params& p;
  DI void operator()(const pf4 (&acc)[2][2][4][2], const pg8::Unit& u, int wr, int wc, int fr, int fq) const {
    const int pn = u.pn;
    const int rbase = u.pm * 256 + wr * 64 + fr;
    if (pn < 3) {
      const bool isq = pn < 2, isv = (pn == 2) && (wc >= 2);
      const float* gp = isq ? p.qg : p.kg;
      const int d0 = 16 * (fq >> 1) + 4 * (fq & 1), d1 = 32 + 8 * fq;
      float4 g00 = {1.f, 1.f, 1.f, 1.f}, g01 = g00, g10 = g00, g11 = g00;
      if (!isv) { g00 = *(const float4*)(gp + d0); g01 = *(const float4*)(gp + d0 + 8); g10 = *(const float4*)(gp + d1); g11 = *(const float4*)(gp + d1 + 4); }
      _Pragma("unroll") for (int ai = 0; ai < 2; ++ai) {
        if (u.pm * 256 + 128 * ai >= MTOT) continue;
        _Pragma("unroll") for (int m = 0; m < 4; ++m) {
          const int row = rbase + 128 * ai + 16 * m;
          pf4 a00 = acc[ai][0][m][0], a01 = acc[ai][0][m][1], a10 = acc[ai][1][m][0], a11 = acc[ai][1][m][1];
          if (!isv) {
            float ss = 0.f;
            _Pragma("unroll") for (int j = 0; j < 4; ++j) ss += a00[j] * a00[j] + a01[j] * a01[j] + a10[j] * a10[j] + a11[j] * a11[j];
            ss += __shfl_xor(ss, 16); ss += __shfl_xor(ss, 32);
            const float sc = rsqrtf(ss * (1.f / 64.f) + EPS);
            a00[0] *= sc * g00.x; a00[1] *= sc * g00.y; a00[2] *= sc * g00.z; a00[3] *= sc * g00.w;
            a01[0] *= sc * g01.x; a01[1] *= sc * g01.y; a01[2] *= sc * g01.z; a01[3] *= sc * g01.w;
            a10[0] *= sc * g10.x; a10[1] *= sc * g10.y; a10[2] *= sc * g10.z; a10[3] *= sc * g10.w;
            a11[0] *= sc * g11.x; a11[1] *= sc * g11.y; a11[2] *= sc * g11.z; a11[3] *= sc * g11.w;
            if (fq < 2) {
              const float pos = (float)(row < SEQ ? row : SEQ);
              const float invlo[4] = {1.0f, 0.19392274f, 0.03760603f, 0.0072926646f};
              const float invhi[4] = {0.0014142136f, 0.0002742482f, 5.3182957e-05f, 1.0313385e-05f};
              _Pragma("unroll") for (int j = 0; j < 4; ++j) {
                const float inv = (fq & 1) ? invhi[j] : invlo[j];
                float s_, c_; sincos_red(pos * inv, s_, c_);
                const float x1 = a00[j], x2 = a01[j];
                a00[j] = x1 * c_ - x2 * s_; a01[j] = x2 * c_ + x1 * s_;
              }
            }
          }
          if (isq) {
            bfr* qp = p.Q + (size_t)row * 512 + (4 * pn + wc) * 64;
            *(u32x2*)(qp + d0) = pack4(a00[0] * QSCALE, a00[1] * QSCALE, a00[2] * QSCALE, a00[3] * QSCALE);
            *(u32x2*)(qp + d0 + 8) = pack4(a01[0] * QSCALE, a01[1] * QSCALE, a01[2] * QSCALE, a01[3] * QSCALE);
            u32x4 o; o[0] = pk2(a10[0] * QSCALE, a10[1] * QSCALE); o[1] = pk2(a10[2] * QSCALE, a10[3] * QSCALE);
            o[2] = pk2(a11[0] * QSCALE, a11[1] * QSCALE); o[3] = pk2(a11[2] * QSCALE, a11[3] * QSCALE);
            *(u32x4*)(qp + d1) = o;
          } else {
            const int jh = wc & 1;
            bfr* kp = (isv ? p.Vb : p.Kb) + (size_t)row * 128 + jh * 64;
            *(u32x2*)(kp + d0) = pack4(a00[0], a00[1], a00[2], a00[3]);
            *(u32x2*)(kp + d0 + 8) = pack4(a01[0], a01[1], a01[2], a01[3]);
            u32x4 o; o[0] = pk2(a10[0], a10[1]); o[1] = pk2(a10[2], a10[3]); o[2] = pk2(a11[0], a11[1]); o[3] = pk2(a11[2], a11[3]);
            *(u32x4*)(kp + d1) = o;
            float* op = nullptr;
            if (row >= SEQ) op = (isv ? p.out_vs : p.out_ks) + ((size_t)((row - SEQ) * 128 + 127) * 2 + jh) * 64;
            else if (row >= SEQ - 128) op = (isv ? p.out_vp : p.out_kp) + ((size_t)(row - (SEQ - 128)) * 2 + jh) * 64;
            if (op) {
              *(pf4*)(op + d0) = a00; *(pf4*)(op + d0 + 8) = a01; *(pf4*)(op + d1) = a10; *(pf4*)(op + d1 + 4) = a11;
            }
          }
        }
      }
      return;
    }
    const int cw = 32 * wc + 8 * fq;
    bfr* dst; int ld, col, op;
    if (pn < 5) { dst = p.ZA; ld = 512; col = (pn - 3) * 256; op = 1; }
    else if (pn < 7) { dst = p.QB; ld = 512; col = (pn - 5) * 256; op = 0; }
    else if (pn < 9) { dst = p.ZF; ld = 512; col = (pn - 7) * 256; op = 0; }
    else if (pn < 11) { dst = p.IB; ld = 512; col = (pn - 9) * 256; op = 0; }
    else if (pn < 13) { dst = p.ZB; ld = 512; col = (pn - 11) * 256; op = 1; }
    else if (pn < 17) { dst = p.GA; ld = 1024; col = (pn - 13) * 256; op = 2; }
    else { dst = p.GB; ld = 1024; col = (pn - 17) * 256; op = 2; }
    bfr* const obase = dst + (size_t)rbase * ld + col + cw;
    _Pragma("unroll") for (int bj = 0; bj < 2; ++bj) {
      float4 b0 = {0.f, 0.f, 0.f, 0.f}, b1 = b0;
      if (op == 2) { const float* bp = p.b_merge + (pn - 13) * 256 + 128 * bj + cw; b0 = *(const float4*)bp; b1 = *(const float4*)(bp + 4);
        b0.x *= -LOG2E; b0.y *= -LOG2E; b0.z *= -LOG2E; b0.w *= -LOG2E; b1.x *= -LOG2E; b1.y *= -LOG2E; b1.z *= -LOG2E; b1.w *= -LOG2E; }
      _Pragma("unroll") for (int ai = 0; ai < 2; ++ai) {
        if (u.pm * 256 + 128 * ai >= MTOT) continue;
        _Pragma("unroll") for (int m = 0; m < 4; ++m) {
          const int row = rbase + 128 * ai + 16 * m;
          pf4 x = acc[ai][bj][m][0], y = acc[ai][bj][m][1];
          if (op == 1) { _Pragma("unroll") for (int j = 0; j < 4; ++j) { x[j] = siluf_(x[j]); y[j] = siluf_(y[j]); } }
          else if (op == 2) {
            x[0] = frcp(1.f + __builtin_amdgcn_exp2f(fmaf(x[0], -LOG2E, b0.x))); x[1] = frcp(1.f + __builtin_amdgcn_exp2f(fmaf(x[1], -LOG2E, b0.y)));
            x[2] = frcp(1.f + __builtin_amdgcn_exp2f(fmaf(x[2], -LOG2E, b0.z))); x[3] = frcp(1.f + __builtin_amdgcn_exp2f(fmaf(x[3], -LOG2E, b0.w)));
            y[0] = frcp(1.f + __builtin_amdgcn_exp2f(fmaf(y[0], -LOG2E, b1.x))); y[1] = frcp(1.f + __builtin_amdgcn_exp2f(fmaf(y[1], -LOG2E, b1.y)));
            y[2] = frcp(1.f + __builtin_amdgcn_exp2f(fmaf(y[2], -LOG2E, b1.z))); y[3] = frcp(1.f + __builtin_amdgcn_exp2f(fmaf(y[3], -LOG2E, b1.w)));
          }
          u32x4 o; o[0] = pk2(x[0], x[1]); o[1] = pk2(x[2], x[3]); o[2] = pk2(y[0], y[1]); o[3] = pk2(y[2], y[3]);
          __builtin_nontemporal_store(o, (u32x4*)(obase + (128 * ai + 16 * m) * ld + 128 * bj));
        }
      }
    }
  }
};

struct EpiMerge {
  static constexpr bool PERM = true, AFTER_DRAIN = false;
  static constexpr int MID_T = 8;
  const Params& p;
  DI void mid(pf4 (&acc)[2][2][4][2], const pg8::Unit& u, int wr, int wc, int fr, int fq) const {
    int rbase = u.pm * 256 + wr * 64 + fr; const int cbase = u.pn * 256 + 32 * wc + 8 * fq;
    asm volatile("" : "+v"(rbase));
    _Pragma("unroll") for (int ai = 0; ai < 2; ++ai) _Pragma("unroll") for (int m = 0; m < 4; ++m) _Pragma("unroll") for (int bj = 0; bj < 2; ++bj) {
      if (bj == 0 && m == 0) __builtin_amdgcn_sched_barrier(0);
      const size_t off = (size_t)(rbase + 128 * ai + 16 * m) * 1024 + cbase + 128 * bj;
      const u32x4 ga = *(const u32x4*)(p.GA + off), gb = *(const u32x4*)(p.GB + off);
      _Pragma("unroll") for (int e = 0; e < 2; ++e) {
        acc[ai][bj][m][0][2 * e] *= bflo(ga[e]) * __builtin_amdgcn_rcpf(fmaxf(bflo(gb[e]), 1e-30f));
        acc[ai][bj][m][0][2 * e + 1] *= bfhi(ga[e]) * __builtin_amdgcn_rcpf(fmaxf(bfhi(gb[e]), 1e-30f));
        acc[ai][bj][m][1][2 * e] *= bflo(ga[2 + e]) * __builtin_amdgcn_rcpf(fmaxf(bflo(gb[2 + e]), 1e-30f));
        acc[ai][bj][m][1][2 * e + 1] *= bfhi(ga[2 + e]) * __builtin_amdgcn_rcpf(fmaxf(bfhi(gb[2 + e]), 1e-30f));
      }
    }
  }
  DI void operator()(const pf4 (&acc)[2][2][4][2], const pg8::Unit& u, int wr, int wc, int fr, int fq) const {
    const int rbase = u.pm * 256 + wr * 64 + fr, cbase = u.pn * 256 + 32 * wc + 8 * fq;
    _Pragma("unroll") for (int ai = 0; ai < 2; ++ai) {
     u32x4 gv[4][2];
     _Pragma("unroll") for (int m = 0; m < 4; ++m) _Pragma("unroll") for (int bj = 0; bj < 2; ++bj) gv[m][bj] = *(const u32x4*)(p.GB + (size_t)(rbase + 128 * ai + 16 * m) * 1024 + cbase + 128 * bj);
     __builtin_amdgcn_sched_barrier(0);
     _Pragma("unroll") for (int m = 0; m < 4; ++m) _Pragma("unroll") for (int bj = 0; bj < 2; ++bj) {
      const size_t off = (size_t)(rbase + 128 * ai + 16 * m) * 1024 + cbase + 128 * bj;
      const u32x4 g = gv[m][bj];
      const pf4 x = acc[ai][bj][m][0], y = acc[ai][bj][m][1];
      u32x4 o; o[0] = pk2(bflo(g[0]) * x[0], bfhi(g[0]) * x[1]); o[1] = pk2(bflo(g[1]) * x[2], bfhi(g[1]) * x[3]);
      o[2] = pk2(bflo(g[2]) * y[0], bfhi(g[2]) * y[1]); o[3] = pk2(bflo(g[3]) * y[2], bfhi(g[3]) * y[3]);
      *(u32x4*)(p.Y + off) = o;
     }
     __builtin_amdgcn_sched_barrier(0);
    }
  }
};

struct EpiOut {
  static constexpr bool PERM = false, AFTER_DRAIN = false;
  static constexpr int MID_T = 0;
  const Params& p;
  DI void operator()(const pf4 (&acc)[2][2][4][2], const pg8::Unit& u, int wr, int wc, int fr, int fq) const {
    const int rbase = u.pm * 256 + wr * 64 + fr, cbase = u.pn * 256 + 32 * wc + 4 * fq;
    const float* gr = p.mod + (size_t)128 * 3072 + 2048;
    _Pragma("unroll") for (int bj = 0; bj < 2; ++bj) _Pragma("unroll") for (int n = 0; n < 2; ++n) {
      const int c = cbase + 128 * bj + 16 * n;
      const pf4 gt = *(const pf4*)(gr + c);
      pf4 xv[8];
      _Pragma("unroll") for (int q = 0; q < 8; ++q) xv[q] = __builtin_nontemporal_load((const pf4*)(p.x_prompt + (size_t)(rbase + 128 * (q >> 2) + 16 * (q & 3)) * DM + c));
      __builtin_amdgcn_sched_barrier(0);
      _Pragma("unroll") for (int q = 0; q < 8; ++q)
        __builtin_nontemporal_store(xv[q] + gt * acc[q >> 2][bj][q & 3][n], (pf4*)(p.out_yp + (size_t)(rbase + 128 * (q >> 2) + 16 * (q & 3)) * DM + c));
      __builtin_amdgcn_sched_barrier(0);
    }
  }
};

struct EpiOutLds {
  static constexpr bool PERM = false, AFTER_DRAIN = true;
  static constexpr int MID_T = 0;
  const Params& p;
  DI void operator()(const pf4 (&)[2][2][4][2], const pg8::Unit&, int, int, int, int) const {}
  DI void fused(const pf4 (&acc)[2][2][4][2], const pg8::Unit& u, int wr, int wc, int fr, int fq, PG8_LAS unsigned char* lds, int, int) const {
    const float* gr = p.mod + (size_t)128 * 3072 + 2048 + u.pn * 256;
    const int tid = threadIdx.x, c = tid & 63, rsub = tid >> 6;
    pf4 gt[2][2];
    _Pragma("unroll") for (int bj = 0; bj < 2; ++bj) _Pragma("unroll") for (int n = 0; n < 2; ++n) gt[bj][n] = *(const pf4*)(gr + 128 * bj + 32 * wc + 16 * n + 4 * fq);
    _Pragma("unroll") for (int ai = 0; ai < 2; ++ai) {
      _Pragma("unroll") for (int m = 0; m < 4; ++m) _Pragma("unroll") for (int bj = 0; bj < 2; ++bj) _Pragma("unroll") for (int n = 0; n < 2; ++n) {
        const int rl = 64 * wr + 16 * m + fr, chunk = 32 * bj + 8 * wc + 4 * n + fq;
        *(PG8_LAS pf4*)(lds + rl * 1024 + ((chunk ^ fr) << 4)) = gt[bj][n] * acc[ai][bj][m][n];
      }
      __syncthreads();
      const size_t g0 = (size_t)(u.pm * 256 + 128 * ai) * DM + u.pn * 256 + 4 * c;
      {
        pf4 xv[16];
        _Pragma("unroll") for (int q = 0; q < 16; ++q) xv[q] = __builtin_nontemporal_load((const pf4*)(p.x_prompt + g0 + (size_t)(q * 8 + rsub) * DM));
        __builtin_amdgcn_sched_barrier(0);
        _Pragma("unroll") for (int q = 0; q < 16; ++q) {
          const int rl = q * 8 + rsub;
          const pf4 st = *(const PG8_LAS pf4*)(lds + rl * 1024 + ((c ^ (rl & 15)) << 4));
          __builtin_nontemporal_store(xv[q] + st, (pf4*)(p.out_yp + g0 + (size_t)rl * DM));
        }
      }
      __syncthreads();
    }
  }
};

DI f32x16 wave_gemm32(const bfr* __restrict__ A, int lda, const bfr* __restrict__ W, int ldw, int K, int lane) {
  const int r = lane & 31, h = lane >> 5;
  const bfr* ap = A + (size_t)r * lda + 8 * h;
  const bfr* wp = W + (size_t)r * ldw + 8 * h;
  f32x16 acc = zero16();
  for (int k0 = 0; k0 < K; k0 += 128) {
    bf16x8 a[8], b[8];
    _Pragma("unroll") for (int q = 0; q < 8; ++q) { a[q] = *(const bf16x8*)(ap + k0 + 16 * q); b[q] = *(const bf16x8*)(wp + k0 + 16 * q); }
    _Pragma("unroll") for (int q = 0; q < 8; ++q) acc = mfma(b[q], a[q], acc);
  }
  return acc;
}

DI void sample_chain_wave(const Params& p, int wt, int lane) {
  const int mt = wt >> 5, nt = wt & 31, r = lane & 31, h = lane >> 5;
  const int m = 32 * mt + r;
  unsigned* cnt = p.bar + PANEL_CNT_WORD + 64 * mt;
  {
    const f32x16 a1 = wave_gemm32(p.YA + (size_t)(SEQ + 32 * mt) * 1024, 1024, p.Wt_pab + (size_t)(32 * nt) * 1024, 1024, 512, lane);
    const f32x16 a2 = wave_gemm32(p.YB + (size_t)(SEQ + 32 * mt) * 1024, 1024, p.Wt_pab + (size_t)(32 * nt) * 1024 + 512, 1024, 512, lane);
    _Pragma("unroll") for (int g = 0; g < 4; ++g) {
      const int n = 32 * nt + 8 * g + 4 * h;
      const u32x2 ga = *(const u32x2*)(p.GA + (size_t)(SEQ + m) * 1024 + n), gb = *(const u32x2*)(p.GB + (size_t)(SEQ + m) * 1024 + n);
      *(u32x2*)(p.Ys + (size_t)m * 1024 + n) = pack4(bflo(ga[0]) * a1[4 * g] + bflo(gb[0]) * a2[4 * g], bfhi(ga[0]) * a1[4 * g + 1] + bfhi(gb[0]) * a2[4 * g + 1],
                                                     bflo(ga[1]) * a1[4 * g + 2] + bflo(gb[1]) * a2[4 * g + 2], bfhi(ga[1]) * a1[4 * g + 3] + bfhi(gb[1]) * a2[4 * g + 3]);
    }
    __builtin_amdgcn_fence(__ATOMIC_RELEASE, "agent");
    asm volatile("s_waitcnt vmcnt(0)" ::: "memory");
    if (lane == 0) __hip_atomic_fetch_add(cnt, 1u, __ATOMIC_RELAXED, __HIP_MEMORY_SCOPE_AGENT);
  }
  {
    unsigned sp = 0;
    while (__hip_atomic_load(cnt, __ATOMIC_RELAXED, __HIP_MEMORY_SCOPE_AGENT) < 32u) { __builtin_amdgcn_s_sleep(2); if (++sp > (1u << 22)) break; }
    __builtin_amdgcn_fence(__ATOMIC_ACQUIRE, "agent");
    asm volatile("s_waitcnt vmcnt(0)" ::: "memory");
  }
  const f32x16 acc = wave_gemm32(p.Ys + (size_t)(32 * mt) * 1024, 1024, p.Wt_out + (size_t)(32 * nt) * 1024, 1024, 1024, lane);
  _Pragma("unroll") for (int g = 0; g < 4; ++g) {
    const int n = 32 * nt + 8 * g + 4 * h;
    const float4 xv = *(const float4*)(p.x_sample + (size_t)m * DM + n), gt = *(const float4*)(p.mod + (size_t)m * 3072 + 2048 + n);
    float4 o;
    o.x = xv.x + gt.x * acc[4 * g]; o.y = xv.y + gt.y * acc[4 * g + 1]; o.z = xv.z + gt.z * acc[4 * g + 2]; o.w = xv.w + gt.w * acc[4 * g + 3];
    *(float4*)(p.out_ys + (size_t)m * DM + n) = o;
  }
}

DI void attn_prompt_wave(const Params& p, int qt, int hd, int lane) {
  const int r = lane & 31, h = lane >> 5, j = hd >> 2;
  const int q0 = qt * 32, q = q0 + r, kb = q0 - 128;
  bf16x8 qf[4];
  _Pragma("unroll") for (int s = 0; s < 4; ++s) qf[s] = *(const bf16x8*)(p.Q + (size_t)q * 512 + hd * 64 + 16 * s + 8 * h);
  f32x16 sacc[5];
  _Pragma("unroll") for (int kt = 0; kt < 5; ++kt) {
    sacc[kt] = zero16();
    int kr = kb + 32 * kt + r; kr = kr < 0 ? 0 : kr;
    _Pragma("unroll") for (int s = 0; s < 4; ++s) {
      bf16x8 kf = *(const bf16x8*)(p.Kb + (size_t)kr * 128 + j * 64 + 16 * s + 8 * h);
      sacc[kt] = mfma(kf, qf[s], sacc[kt]);
    }
  }
  const float sink = p.sinks[hd] * LOG2E;
  float mx = sink;
  _Pragma("unroll") for (int i = 0; i < 16; ++i) {
    sacc[0][i] = (crow(i, h) > r) ? sacc[0][i] : -INFINITY;
    sacc[4][i] = (crow(i, h) <= r) ? sacc[4][i] : -INFINITY;
  }
  if (q0 < 128) {
    _Pragma("unroll") for (int kt = 0; kt < 4; ++kt) _Pragma("unroll") for (int i = 0; i < 16; ++i)
      sacc[kt][i] = (kb + 32 * kt + crow(i, h) >= 0) ? sacc[kt][i] : -INFINITY;
  }
  _Pragma("unroll") for (int kt = 0; kt < 5; ++kt) _Pragma("unroll") for (int i = 0; i < 16; ++i) mx = fmaxf(mx, sacc[kt][i]);
  mx = fmaxf(mx, __shfl_xor(mx, 32));
  float l = 0.f;
  _Pragma("unroll") for (int kt = 0; kt < 5; ++kt) _Pragma("unroll") for (int i = 0; i < 16; ++i) {
    float pv = __builtin_amdgcn_exp2f(sacc[kt][i] - mx); sacc[kt][i] = pv; l += pv;
  }
  l += __shfl_xor(l, 32);
  l += __builtin_amdgcn_exp2f(sink - mx);
  f32x16 oacc[2]; oacc[0] = zero16(); oacc[1] = zero16();
  const bfr* vbase = p.Vb + j * 64 + 2 * r;
  _Pragma("unroll") for (int kt = 0; kt < 5; ++kt) _Pragma("unroll") for (int s2 = 0; s2 < 2; ++s2) {
    u32x4 pp;
    _Pragma("unroll") for (int e = 0; e < 4; ++e) pp[e] = pk2(sacc[kt][8 * s2 + 2 * e], sacc[kt][8 * s2 + 2 * e + 1]);
    unsigned wv[8];
    _Pragma("unroll") for (int jj = 0; jj < 8; ++jj) {
      int key = kb + 32 * kt + 16 * s2 + 8 * (jj >> 2) + 4 * h + (jj & 3); key = key < 0 ? 0 : key;
      wv[jj] = *(const unsigned*)(vbase + (size_t)key * 128);
    }
    u32x4 v0, v1;
    _Pragma("unroll") for (int e = 0; e < 4; ++e) {
      v0[e] = __builtin_amdgcn_perm(wv[2 * e + 1], wv[2 * e], 0x05040100u);
      v1[e] = __builtin_amdgcn_perm(wv[2 * e + 1], wv[2 * e], 0x07060302u);
    }
    const bf16x8 pa = __builtin_bit_cast(bf16x8, pp);
    oacc[0] = mfma(pa, __builtin_bit_cast(bf16x8, v0), oacc[0]);
    oacc[1] = mfma(pa, __builtin_bit_cast(bf16x8, v1), oacc[1]);
  }
  const float il = frcp(l);
  unsigned za[16];
  _Pragma("unroll") for (int i = 0; i < 16; ++i) za[i] = *(const unsigned*)(p.ZA + (size_t)(q0 + crow(i, h)) * 512 + hd * 64 + 2 * r);
  __builtin_amdgcn_sched_barrier(0);
  _Pragma("unroll") for (int i = 0; i < 16; ++i) {
    const int qi = crow(i, h);
    const float ili = __shfl(il, qi);
    *(unsigned*)(p.YA + (size_t)(q0 + qi) * 1024 + hd * 64 + 2 * r) = pk2(oacc[0][i] * ili * bflo(za[i]), oacc[1][i] * ili * bfhi(za[i]));
  }
}

DI void attn_sample_wave(const Params& p, int b, int hd, float* sw  ) {
  const int lane = threadIdx.x & 63, j = hd >> 2, m = SEQ + b;
  u32x4 qv[8];
  _Pragma("unroll") for (int i = 0; i < 8; ++i) qv[i] = *(const u32x4*)(p.Q + (size_t)m * 512 + hd * 64 + 8 * i);
  float dn = 0.f;
  _Pragma("unroll") for (int i = 0; i < 8; ++i) {
    u32x4 kv = *(const u32x4*)(p.Kb + (size_t)m * 128 + j * 64 + 8 * i);
    _Pragma("unroll") for (int e = 0; e < 4; ++e) dn += bflo(qv[i][e]) * bflo(kv[e]) + bfhi(qv[i][e]) * bfhi(kv[e]);
  }
  float s[2];
  _Pragma("unroll") for (int u = 0; u < 2; ++u) {
    int idx = lane + 1 + 64 * u;
    int ic = idx < 128 ? idx : 127;
    const float* kp = p.cache_k + ((size_t)(b * 128 + ic) * 2 + j) * 64;
    float4 kk[16];
    _Pragma("unroll") for (int i = 0; i < 16; ++i) kk[i] = *(const float4*)(kp + 4 * i);
    __builtin_amdgcn_sched_barrier(0);
    float d = 0.f;
    _Pragma("unroll") for (int i = 0; i < 8; ++i) {
      const float4 k0 = kk[2 * i], k1 = kk[2 * i + 1];
      d += bflo(qv[i][0]) * k0.x + bfhi(qv[i][0]) * k0.y + bflo(qv[i][1]) * k0.z + bfhi(qv[i][1]) * k0.w;
      d += bflo(qv[i][2]) * k1.x + bfhi(qv[i][2]) * k1.y + bflo(qv[i][3]) * k1.z + bfhi(qv[i][3]) * k1.w;
    }
    s[u] = idx < 128 ? d : dn;
  }
  const float sink = p.sinks[hd] * LOG2E;
  float mx = fmaxf(fmaxf(s[0], s[1]), sink);
  _Pragma("unroll") for (int o = 32; o >= 1; o >>= 1) mx = fmaxf(mx, __shfl_xor(mx, o));
  float p0 = __builtin_amdgcn_exp2f(s[0] - mx), p1 = __builtin_amdgcn_exp2f(s[1] - mx);
  float l = p0 + p1;
  _Pragma("unroll") for (int o = 32; o >= 1; o >>= 1) l += __shfl_xor(l, o);
  l += __builtin_amdgcn_exp2f(sink - mx);
  sw[lane] = p0; sw[64 + lane] = p1;
  __builtin_amdgcn_s_waitcnt(0xc07f);
  __builtin_amdgcn_wave_barrier();
  float o = 0.f;
  const float* vb = p.cache_v + ((size_t)(b * 128) * 2 + j) * 64 + lane;
  _Pragma("unroll 1") for (int i0 = 0; i0 < 128; i0 += 16) {
    float vv[16];
    _Pragma("unroll") for (int q = 0; q < 16; ++q) vv[q] = vb[(size_t)(i0 + q) * 128];
    __builtin_amdgcn_sched_barrier(0);
    _Pragma("unroll") for (int q = 0; q < 16; ++q) { const float pw = (i0 + q) ? sw[i0 + q - 1] : 0.f; o += pw * vv[q]; }
  }
  o += sw[127] * bf2f(p.Vb[(size_t)m * 128 + j * 64 + lane]);
  size_t off = (size_t)m * 512 + hd * 64 + lane;
  p.YA[(size_t)m * 1024 + hd * 64 + lane] = (bfr)f2bf(o * frcp(l) * bf2f(p.ZA[off]));
  __builtin_amdgcn_wave_barrier();
}

DI void hgrn_gates(const Params& p, int row0, int hh, float* sTot, float (&L)[32], float (&kin)[32], float& t0, float& lc) {
  const int t = TID, c = t & 127, half = t >> 7, ch = hh * 128 + c;
  const float lbv = frcp(1.f + __expf(p.lb_logits[512 + ch] - p.lb_logits[ch]));
  const bfr* zp = p.ZF + (size_t)(row0 + half * 32) * 512 + ch;
  float run = 0.f;
  _Pragma("unroll") for (int jj = 0; jj < 32; ++jj) {
    float z = bf2f(zp[(size_t)jj * 512]);
    z = __builtin_amdgcn_fmed3f(z, -30.f, 30.f);
    float em = __expf(-z), sg = frcp(1.f + em);
    float f = lbv + (1.f - lbv) * sg;
    kin[jj] = (1.f - lbv) * em * sg;
    run += __builtin_amdgcn_logf(f);
    L[jj] = run;
  }
  sTot[half * 128 + c] = run;
  __syncthreads();
  t0 = sTot[c]; lc = t0 + sTot[128 + c];
  if (half) { _Pragma("unroll") for (int jj = 0; jj < 32; ++jj) L[jj] += t0; }
}

DI void hgrn_fused_item(const Params& p, int n, int hh, char* smem) {
  bfr* sVt = (bfr*)smem;
  bfr* sKt = sVt + 128 * LDT;
  bfr* sQh = sKt + 128 * LDT;
  bfr* sKh = sQh + 64 * 136;
  bfr* sAm = sKt;
  float* sTot = (float*)(sKh + 64 * 136);
  const int t = TID, lane = t & 63, w = t >> 6, h = lane >> 5, c = t & 127, half = t >> 7;
  const int row0 = n * 64;
  __syncthreads();
  {
    const bfr* ip = p.IB + (size_t)(row0 + half * 32) * 512 + hh * 128 + c;
    _Pragma("unroll") for (int q4 = 0; q4 < 4; ++q4) {
      u32x4 o;
      _Pragma("unroll") for (int e = 0; e < 4; ++e) {
        int jj = q4 * 8 + 2 * e;
        o[e] = (unsigned)ip[(size_t)jj * 512] | ((unsigned)ip[(size_t)(jj + 1) * 512] << 16);
      }
      *(u32x4*)(sVt + c * LDT + half * 32 + q4 * 8) = o;
    }
  }
  {
    float L[32], kin[32], t0, lc;
    hgrn_gates(p, row0, hh, sTot, L, kin, t0, lc);
    const float ec = __builtin_amdgcn_exp2f(lc - t0), et = __builtin_amdgcn_exp2f(t0);
    _Pragma("unroll") for (int q4 = 0; q4 < 4; ++q4) {
      u32x4 o;
      _Pragma("unroll") for (int e = 0; e < 4; ++e) {
        int jj = q4 * 8 + 2 * e;
        kin[jj] *= __builtin_amdgcn_exp2f(fminf(t0 - L[jj], 115.f)); kin[jj + 1] *= __builtin_amdgcn_exp2f(fminf(t0 - L[jj + 1], 115.f));
        o[e] = pk2(kin[jj] * ec, kin[jj + 1] * ec);
      }
      *(u32x4*)(sKt + c * LDT + half * 32 + q4 * 8) = o;
    }
    if (half == 0) p.dec[(n * 4 + hh) * 128 + c] = __builtin_amdgcn_exp2f(lc);
    bfr* qp = p.QB + (size_t)(row0 + half * 32) * 512 + hh * 128 + c;
    unsigned qraw[16];
    _Pragma("unroll") for (int e = 0; e < 16; ++e) qraw[e] = (unsigned)qp[(size_t)(2 * e) * 512] | ((unsigned)qp[(size_t)(2 * e + 1) * 512] << 16);
    __builtin_amdgcn_sched_barrier(0);
    _Pragma("unroll") for (int jj = 0; jj < 32; ++jj) {
      const float qv = (jj & 1) ? bfhi(qraw[jj >> 1]) : bflo(qraw[jj >> 1]);
      const float dl = L[jj] - t0;
      const float qh = qv * __builtin_amdgcn_exp2f(fminf(dl, 115.f));
      const unsigned qq = pk2(qh * et, qh);
      qp[(size_t)jj * 512] = (bfr)(qq & 0xffffu);
      sQh[(half * 32 + jj) * 136 + c] = (bfr)(qq >> 16);
      if ((jj & 1) == 0) {
        const unsigned kk2 = pk2(kin[jj], kin[jj + 1]);
        sKh[(half * 32 + jj) * 136 + c] = (bfr)(kk2 & 0xffffu);
        sKh[(half * 32 + jj + 1) * 136 + c] = (bfr)(kk2 >> 16);
      }
    }
  }
  __syncthreads();
  {
    int r = lane & 31; asm volatile("" : "+v"(r));
    const int wv = w >> 1, wk = w & 1;
    f32x16 acc[2][2];
    _Pragma("unroll") for (int a = 0; a < 2; ++a) _Pragma("unroll") for (int b = 0; b < 2; ++b) acc[a][b] = zero16();
    _Pragma("unroll") for (int s = 0; s < 4; ++s) {
      bf16x8 af[2], bf[2];
      _Pragma("unroll") for (int x = 0; x < 2; ++x) {
        af[x] = *(const bf16x8*)(sVt + (wv * 64 + x * 32 + r) * LDT + 16 * s + 8 * h);
        bf[x] = *(const bf16x8*)(sKt + (wk * 64 + x * 32 + r) * LDT + 16 * s + 8 * h);
      }
      _Pragma("unroll") for (int a = 0; a < 2; ++a) _Pragma("unroll") for (int b = 0; b < 2; ++b) acc[a][b] = mfma(af[a], bf[b], acc[a][b]);
    }
    float* up = p.Ust + (size_t)(n * 4 + hh) * 16384;
    _Pragma("unroll") for (int a = 0; a < 2; ++a) _Pragma("unroll") for (int b = 0; b < 2; ++b) _Pragma("unroll") for (int i = 0; i < 16; ++i) {
      int v = wv * 64 + a * 32 + crow(i, h), k = wk * 64 + b * 32 + r;
      up[v * 128 + k] = acc[a][b][i];
    }
  }
  const int jt = w >> 1, it = w & 1;
  int r2 = lane & 31; asm volatile("" : "+v"(r2));
  f32x16 am = zero16();
  if (jt <= it) {
    _Pragma("unroll") for (int s = 0; s < 8; ++s) {
      bf16x8 kf = *(const bf16x8*)(sKh + (jt * 32 + r2) * 136 + 16 * s + 8 * h);
      bf16x8 qf = *(const bf16x8*)(sQh + (it * 32 + r2) * 136 + 16 * s + 8 * h);
      am = mfma(kf, qf, am);
    }
  }
  __syncthreads();
  {
    int r3 = lane & 31; asm volatile("" : "+v"(r3));
    const int i = it * 32 + r3;
    _Pragma("unroll") for (int g = 0; g < 4; ++g) {
      int j0 = jt * 32 + 8 * g + 4 * h;
      float x0 = (j0 <= i) ? am[4 * g] : 0.f, x1 = (j0 + 1 <= i) ? am[4 * g + 1] : 0.f;
      float x2 = (j0 + 2 <= i) ? am[4 * g + 2] : 0.f, x3 = (j0 + 3 <= i) ? am[4 * g + 3] : 0.f;
      *(u32x2*)(sAm + i * LDT + j0) = pack4(x0, x1, x2, x3);
    }
  }
  __syncthreads();
  {
    int r = lane & 31; asm volatile("" : "+v"(r));
    f32x16 oacc[2]; oacc[0] = zero16(); oacc[1] = zero16();
    _Pragma("unroll") for (int s = 0; s < 4; ++s) {
      bf16x8 vf = *(const bf16x8*)(sVt + (32 * w + r) * LDT + 16 * s + 8 * h);
      _Pragma("unroll") for (int i2 = 0; i2 < 2; ++i2) {
        bf16x8 af2 = *(const bf16x8*)(sAm + (i2 * 32 + r) * LDT + 16 * s + 8 * h);
        oacc[i2] = mfma(vf, af2, oacc[i2]);
      }
    }
    _Pragma("unroll") for (int i2 = 0; i2 < 2; ++i2) _Pragma("unroll") for (int g = 0; g < 4; ++g)
      *(u32x2*)(p.YB + (size_t)(row0 + i2 * 32 + r) * 1024 + hh * 128 + 32 * w + 8 * g + 4 * h) =
          pack4(oacc[i2][4 * g], oacc[i2][4 * g + 1], oacc[i2][4 * g + 2], oacc[i2][4 * g + 3]);
  }
}

DI void hgrn_sample_wave(const Params& p, int b, int hh, int lane, float* sw  ) {
  const int m = SEQ + b;
  _Pragma("unroll") for (int u = 0; u < 2; ++u) {
    const int k = lane + 64 * u, ch = hh * 128 + k;
    const float lbv = frcp(1.f + __expf(p.lb_logits[512 + ch] - p.lb_logits[ch]));
    float z = bf2f(p.ZF[(size_t)m * 512 + ch]);
    z = __builtin_amdgcn_fmed3f(z, -30.f, 30.f);
    const float em = __expf(-z), sg = frcp(1.f + em);
    sw[k] = lbv + (1.f - lbv) * sg; sw[128 + k] = (1.f - lbv) * em * sg; sw[256 + k] = bf2f(p.QB[(size_t)m * 512 + ch]);
  }
  const int v4 = (lane & 31) * 4, kg = lane >> 5;
  const u32x2 vraw = *(const u32x2*)(p.IB + (size_t)m * 512 + hh * 128 + v4);
  const float4 vv = {bflo(vraw[0]), bfhi(vraw[0]), bflo(vraw[1]), bfhi(vraw[1])};
  __builtin_amdgcn_s_waitcnt(0xc07f);
  __builtin_amdgcn_wave_barrier();
  float4 o = {0.f, 0.f, 0.f, 0.f};
  const size_t sb = (size_t)(b * 4 + hh) * 16384 + (size_t)(kg * 64) * 128 + v4;
  const volatile float* swv = sw;
  _Pragma("unroll 1") for (int k0 = 0; k0 < 64; k0 += 16) {
    float4 Sv[16];
    _Pragma("unroll") for (int q = 0; q < 16; ++q) Sv[q] = *(const float4*)(p.state + sb + (k0 + q) * 128);
    __builtin_amdgcn_sched_barrier(0);
    _Pragma("unroll") for (int q = 0; q < 16; ++q) {
      const int k = kg * 64 + k0 + q;
      const float4 S = Sv[q];
      const float f = swv[k], ki = swv[128 + k], qq = swv[256 + k];
      float4 Sn; Sn.x = f * S.x + ki * vv.x; Sn.y = f * S.y + ki * vv.y; Sn.z = f * S.z + ki * vv.z; Sn.w = f * S.w + ki * vv.w;
      *(float4*)(p.out_ss + sb + (k0 + q) * 128) = Sn;
      o.x += qq * Sn.x; o.y += qq * Sn.y; o.z += qq * Sn.z; o.w += qq * Sn.w;
    }
  }
  o.x += __shfl_xor(o.x, 32); o.y += __shfl_xor(o.y, 32); o.z += __shfl_xor(o.z, 32); o.w += __shfl_xor(o.w, 32);
  float ss = o.x * o.x + o.y * o.y + o.z * o.z + o.w * o.w;
  _Pragma("unroll") for (int of = 16; of >= 1; of >>= 1) ss += __shfl_xor(ss, of);
  const float sc = rsqrtf(ss * (1.f / 128.f) + EPS);
  if (kg == 0) {
    const float4 og = *(const float4*)(p.og + v4);
    const u32x2 zb = *(const u32x2*)(p.ZB + (size_t)m * 512 + hh * 128 + v4);
    *(u32x2*)(p.YB + (size_t)m * 1024 + hh * 128 + v4) = pack4(o.x * sc * og.x * bflo(zb[0]), o.y * sc * og.y * bfhi(zb[0]), o.z * sc * og.z * bflo(zb[1]), o.w * sc * og.w * bfhi(zb[1]));
  }
  __builtin_amdgcn_wave_barrier();
}

DI void cache_shift_copy(const Params& p, int gw, int nw, int lane, int part) {
  const int lo = part * (64 * 4064), hi = lo + 64 * 4064, st = nw * 64;
  for (int idx0 = lo + gw * 64 + lane; idx0 < hi; idx0 += 4 * st) {
    const int i0 = idx0, i1 = min(idx0 + st, hi - 1), i2 = min(idx0 + 2 * st, hi - 1), i3 = min(idx0 + 3 * st, hi - 1);
#define CSC_SRC(i) ((size_t)((i) / 4064) * 16384 + 128 + (size_t)((i) % 4064) * 4)
#define CSC_DST(i) ((size_t)((i) / 4064) * 16384 + (size_t)((i) % 4064) * 4)
    const float4 ka = *(const float4*)(p.cache_k + CSC_SRC(i0)), kb = *(const float4*)(p.cache_k + CSC_SRC(i1));
    const float4 kc = *(const float4*)(p.cache_k + CSC_SRC(i2)), kd = *(const float4*)(p.cache_k + CSC_SRC(i3));
    const float4 va = *(const float4*)(p.cache_v + CSC_SRC(i0)), vb = *(const float4*)(p.cache_v + CSC_SRC(i1));
    const float4 vc = *(const float4*)(p.cache_v + CSC_SRC(i2)), vd = *(const float4*)(p.cache_v + CSC_SRC(i3));
    __builtin_amdgcn_sched_barrier(0);
    *(float4*)(p.out_ks + CSC_DST(i0)) = ka; *(float4*)(p.out_vs + CSC_DST(i0)) = va;
    *(float4*)(p.out_ks + CSC_DST(i1)) = kb; *(float4*)(p.out_vs + CSC_DST(i1)) = vb;
    *(float4*)(p.out_ks + CSC_DST(i2)) = kc; *(float4*)(p.out_vs + CSC_DST(i2)) = vc;
    *(float4*)(p.out_ks + CSC_DST(i3)) = kd; *(float4*)(p.out_vs + CSC_DST(i3)) = vd;
#undef CSC_SRC
#undef CSC_DST
  }
}

DI void phase_mix(const Params& p, char* smem, char* smem_all) {
  const int wave = threadIdx.x >> 6, lane = threadIdx.x & 63, gw = blockIdx.x * 8 + wave, nw = gridDim.x * 8;
  float* sw = (float*)(smem_all + wave * 2048);
  if (gw & 1) {
    for (int it = gw >> 1; it < 1024; it += nw >> 1) attn_sample_wave(p, it >> 3, it & 7, sw);
    cache_shift_copy(p, gw >> 1, nw >> 1, lane, 0);
    for (int it = gw; it < 4096; it += nw) attn_prompt_wave(p, it >> 3, it & 7, lane);
  } else {
    int it = gw;
    if (it < 4096) { attn_prompt_wave(p, it >> 3, it & 7, lane); it += nw; }
    if ((gw & 3) == 0) { for (int hs = gw >> 2; hs < 512; hs += nw >> 2) hgrn_sample_wave(p, hs >> 2, hs & 3, lane, sw); }
    cache_shift_copy(p, gw >> 1, nw >> 1, lane, 1);
    for (; it < 4096; it += nw) attn_prompt_wave(p, it >> 3, it & 7, lane);
  }
  for (int it = VBID; it < 1024; it += VGRID) hgrn_fused_item(p, it >> 2, it & 3, smem);
}

#define SCAN_LOAD(U, Dd, N0) _Pragma("unroll") for (int i = 0; i < 32; ++i) { U[i] = up[(size_t)((N0) + i) * 65536]; Dd[i] = dp[((N0) + i) * 512]; }
#define SCAN_STEP(U, Dd, N0) _Pragma("unroll") for (int i = 0; i < 32; ++i) { sp[(size_t)((N0) + i) * 65536] = (bfr)(pk2(S, 0.f) & 0xffffu); S = Dd[i] * S + U[i]; }
DI void phase_scan(const Params& p, int eb) {
  const int e = eb * 256 + threadIdx.x;
  const int hh = e >> 14, k = e & 127, v = (e >> 7) & 127;
  const float* up = p.Ust + e;
  bfr* sp = p.S16 + e;
  const float* dp = p.dec + hh * 128 + k;
  float S = 0.f;
  float ua[32], da[32], ub[32], db[32];
  SCAN_LOAD(ua, da, 0)
  for (int n0 = 0; n0 < NCH; n0 += 64) {
    SCAN_LOAD(ub, db, n0 + 32)
    SCAN_STEP(ua, da, n0)
    if (n0 + 64 < NCH) { SCAN_LOAD(ua, da, n0 + 64) }
    SCAN_STEP(ub, db, n0 + 32)
  }
  p.out_sp[(hh * 128 + k) * 128 + v] = S;
}

DI void hgrn_out_wave(const Params& p, int n, int hh, int it, int lane) {
  const int r = lane & 31, h = lane >> 5;
  const size_t row = (size_t)(n * 64 + it * 32 + r);
  bf16x8 qf[8];
  _Pragma("unroll") for (int s = 0; s < 8; ++s) qf[s] = *(const bf16x8*)(p.QB + row * 512 + hh * 128 + 16 * s + 8 * h);
  const bfr* sb = p.S16 + (size_t)(n * 4 + hh) * 16384 + (size_t)r * 128 + 8 * h;
  f32x16 acc[4];
  _Pragma("unroll") for (int vt = 0; vt < 4; ++vt) {
    acc[vt] = zero16();
    _Pragma("unroll") for (int s = 0; s < 8; ++s) {
      bf16x8 sf = *(const bf16x8*)(sb + vt * 32 * 128 + 16 * s);
      acc[vt] = mfma(sf, qf[s], acc[vt]);
    }
  }
  float ss = 0.f;
  _Pragma("unroll") for (int vt = 0; vt < 4; ++vt) _Pragma("unroll") for (int g = 0; g < 4; ++g) {
    const u32x2 oi = *(const u32x2*)(p.YB + row * 1024 + hh * 128 + 32 * vt + 8 * g + 4 * h);
    acc[vt][4 * g] += bflo(oi[0]); acc[vt][4 * g + 1] += bfhi(oi[0]); acc[vt][4 * g + 2] += bflo(oi[1]); acc[vt][4 * g + 3] += bfhi(oi[1]);
    ss += acc[vt][4 * g] * acc[vt][4 * g] + acc[vt][4 * g + 1] * acc[vt][4 * g + 1] + acc[vt][4 * g + 2] * acc[vt][4 * g + 2] + acc[vt][4 * g + 3] * acc[vt][4 * g + 3];
  }
  ss += __shfl_xor(ss, 32);
  const float sc = rsqrtf(ss * (1.f / 128.f) + EPS);
  u32x2 zbv[16];
  _Pragma("unroll") for (int vt = 0; vt < 4; ++vt) _Pragma("unroll") for (int g = 0; g < 4; ++g) zbv[vt * 4 + g] = *(const u32x2*)(p.ZB + row * 512 + hh * 128 + 32 * vt + 8 * g + 4 * h);
  __builtin_amdgcn_sched_barrier(0);
  _Pragma("unroll") for (int vt = 0; vt < 4; ++vt) _Pragma("unroll") for (int g = 0; g < 4; ++g) {
    const int v = 32 * vt + 8 * g + 4 * h;
    const float4 og = *(const float4*)(p.og + v);
    const u32x2 zb = zbv[vt * 4 + g];
    *(u32x2*)(p.YB + row * 1024 + hh * 128 + v) = pack4(acc[vt][4 * g] * sc * og.x * bflo(zb[0]), acc[vt][4 * g + 1] * sc * og.y * bfhi(zb[0]),
                                                        acc[vt][4 * g + 2] * sc * og.z * bflo(zb[1]), acc[vt][4 * g + 3] * sc * og.w * bfhi(zb[1]));
  }
}

#define XB_TMO      128
#define XB_XCNT(j)  (256  + 64 * (j))
#define XB_XSUB(j)  (1280 + 64 * (j))
#define XB_XGEN(j)  (2304 + 64 * (j))
#define XB_TOP      3328
#define XB_TOPGEN   3392
#define XCD_BAR_WORDS 3456
#define XB_SPIN_CAP (1u << 18)
#define LAS __attribute__((address_space(3)))

__device__ __forceinline__ unsigned xb_ld(unsigned* p)              { return __hip_atomic_load(p, __ATOMIC_RELAXED, __HIP_MEMORY_SCOPE_AGENT); }
__device__ __forceinline__ unsigned xb_add(unsigned* p, unsigned v) { return __hip_atomic_fetch_add(p, v, __ATOMIC_RELAXED, __HIP_MEMORY_SCOPE_AGENT); }
__device__ __forceinline__ unsigned xb_xcc_id() { return (unsigned)__builtin_amdgcn_s_getreg((3 << 11) | 20) & 0xFu; }
#define XB_SPIN(cond, bar) do { unsigned _sp = 0; while (cond) { __builtin_amdgcn_s_sleep(1); \
    if ((++_sp & 255u) == 0u) { if (xb_ld(&(bar)[XB_TMO])) break; if (_sp > XB_SPIN_CAP) { atomicAdd(&(bar)[XB_TMO], 1u); break; } } } } while (0)

struct XcdBarrier {
    unsigned* bar; unsigned x;
    volatile LAS unsigned* st;
};

__device__ __forceinline__ XcdBarrier xcd_barrier_post(unsigned* bar, volatile LAS unsigned* st) {
    XcdBarrier b; b.bar = bar; b.x = xb_xcc_id(); b.st = st;
    if (threadIdx.x == 0) (void)xb_add(&bar[XB_XCNT(b.x)], 1u);
    return b;
}
__device__ __forceinline__ void xcd_barrier_complete(unsigned* bar, unsigned x, unsigned& nloc, unsigned& nx) {
    const unsigned G = gridDim.x * gridDim.y * gridDim.z;
    unsigned sum, cnt, mine, sp = 0u;
    for (;;) {
        sum = 0u; cnt = 0u; mine = 0u;
#pragma unroll
        for (unsigned j = 0; j < 16; ++j) { const unsigned c = xb_ld(&bar[XB_XCNT(j)]); sum += c; cnt += (c > 0u) ? 1u : 0u; mine = (j == x) ? c : mine; }
        if (sum == G) break;
        __builtin_amdgcn_s_sleep(1);
        if ((++sp & 255u) == 0u) { if (xb_ld(&bar[XB_TMO])) break; if (sp > XB_SPIN_CAP) { atomicAdd(&bar[XB_TMO], 1u); break; } }
    }
    nloc = mine > 0u ? mine : 1u; nx = cnt > 0u ? cnt : 1u;
}

__device__ __forceinline__ void xcd_barrier(const XcdBarrier& b) {
    asm volatile("s_waitcnt vmcnt(0)" ::: "memory");
    __syncthreads();
    if (threadIdx.x == 0) {
        unsigned* bar = b.bar;
        __builtin_amdgcn_s_waitcnt(0);
        unsigned nloc = b.st[0], nx = b.st[1];
        if (nloc == 0u) { xcd_barrier_complete(bar, b.x, nloc, nx); b.st[0] = nloc; b.st[1] = nx; }
        const unsigned old = xb_add(&bar[XB_XSUB(b.x)], 1u);
        const unsigned gen = old / nloc;
        if (old + 1u == (gen + 1u) * nloc) {
            __builtin_amdgcn_fence(__ATOMIC_RELEASE, "agent");
            asm volatile("s_waitcnt vmcnt(0)" ::: "memory");
            const unsigned og = xb_add(&bar[XB_TOP], 1u);
            const unsigned tg = og / nx;
            if (og + 1u == (tg + 1u) * nx) xb_add(&bar[XB_TOPGEN], 1u);
            else XB_SPIN(xb_ld(&bar[XB_TOPGEN]) == tg, bar);
            __builtin_amdgcn_fence(__ATOMIC_ACQUIRE, "agent");
            xb_add(&bar[XB_XGEN(b.x)], 1u);
            asm volatile("s_waitcnt vmcnt(0)" ::: "memory");
        } else {
            XB_SPIN(xb_ld(&bar[XB_XGEN(b.x)]) == gen, bar);
            __builtin_amdgcn_fence(__ATOMIC_ACQUIRE, "agent");
            asm volatile("s_waitcnt vmcnt(0)" ::: "memory");
        }
    }
    __syncthreads();
}

static_assert(PANEL_CNT_WORD == XCD_BAR_WORDS, "panel counters follow the barrier words");
__global__ void __launch_bounds__(512, 2) hybrid_megakernel(Params p) {
  extern __shared__ __attribute__((aligned(16))) char smem_all[];
  __shared__ uint4 xb_words;
  if (threadIdx.x == 0) xb_words = make_uint4(0u, 0u, 0u, 0u);
  __syncthreads();
  const XcdBarrier xb = xcd_barrier_post(p.bar, (volatile LAS unsigned*)&xb_words);
  char* smem = smem_all + (threadIdx.x >> 8) * 73728;
#ifndef REPMASK
#define REPMASK 0
#endif
#define RUN_PHASE(n, ...) if (p.phase_lo <= n && n <= p.phase_hi) { if (n != p.phase_lo) xcd_barrier(xb); __VA_ARGS__; if ((REPMASK >> n) & 1) { xcd_barrier(xb); __VA_ARGS__; } }
  RUN_PHASE(0, phase_prep(p, smem))
  RUN_PHASE(1, { if (VBID < 48) phase_mod(p, smem); else phase_prep2(p, smem, VBID - 48, VGRID - 48); })
  RUN_PHASE(2, phase_h(p))
  RUN_PHASE(3, {
    pg8::Gemm g{p.H, p.Wt_all, MPAD, NALL, 1024};
    pg8::StaticOrder S; S.init(MPAD, NALL, (int)gridDim.x, (int)blockIdx.x);
    EpiMain E{p};
    pg8::gemm_phase<EpiMain, pg8::StaticOrder, false>((PG8_LAS unsigned char*)smem_all, g, S, E, nullptr);
  })
  RUN_PHASE(4, phase_mix(p, smem, smem_all))
  RUN_PHASE(5, {
    if (threadIdx.x < 256) { for (int eb = blockIdx.x; eb < 256; eb += gridDim.x) phase_scan(p, eb); }
    else { const int wt = blockIdx.x * 4 + ((threadIdx.x >> 6) - 4); if (wt < 128) sample_chain_wave(p, wt, threadIdx.x & 63); }
  })
  RUN_PHASE(6, {
    for (int wi = blockIdx.x * 8 + (threadIdx.x >> 6); wi < 2048; wi += gridDim.x * 8) hgrn_out_wave(p, wi >> 3, (wi >> 1) & 3, wi & 1, threadIdx.x & 63);
  })
  RUN_PHASE(7, {
    pg8::Gemm g{p.YA, p.Wt_pab, SEQ, 1024, 1024};
    pg8::StaticOrder S; S.init(SEQ, 1024, (int)gridDim.x, (int)blockIdx.x);
    EpiMerge E{p};
    pg8::gemm_phase<EpiMerge, pg8::StaticOrder, false>((PG8_LAS unsigned char*)smem_all, g, S, E, nullptr);
  })
  RUN_PHASE(8, {
    pg8::Gemm g{p.Y, p.Wt_out, SEQ, 1024, 1024};
    pg8::StaticOrder S; S.init(SEQ, 1024, (int)gridDim.x, (int)blockIdx.x);
    if ((int)gridDim.x == (SEQ / 256) * 4) {
      EpiOutLds E{p};
      pg8::gemm_phase<EpiOutLds, pg8::StaticOrder, false>((PG8_LAS unsigned char*)smem_all, g, S, E, nullptr);
    } else {
      EpiOut E{p};
      pg8::gemm_phase<EpiOut, pg8::StaticOrder, false>((PG8_LAS unsigned char*)smem_all, g, S, E, nullptr);
    }
  })
}

#ifndef ONE_LAUNCH
#define ONE_LAUNCH 1
#endif
constexpr size_t kDynLds = 147456;

extern "C" void kernel_launch(void* const* d_in, const int* in_sizes, int n_in, void* d_out, int out_size, void* d_ws, size_t ws_size,
                              hipStream_t stream) {
  static int grid_blocks = 0;
  if (!grid_blocks) {
    int dev = 0, cus = 0, per_cu = 0;
    (void)hipGetDevice(&dev);
    (void)hipDeviceGetAttribute(&cus, hipDeviceAttributeMultiprocessorCount, dev);
    (void)hipFuncSetAttribute((const void*)hybrid_megakernel, hipFuncAttributeMaxDynamicSharedMemorySize, (int)kDynLds);
    (void)hipOccupancyMaxActiveBlocksPerMultiprocessor(&per_cu, hybrid_megakernel, 512, kDynLds);
    if (per_cu > 1) per_cu = 1;
    if (per_cu < 1) per_cu = 1;
    grid_blocks = cus * per_cu;
  }
  Params p{};
  const float* const* in = (const float* const*)d_in;
  p.x_prompt = in[0]; p.x_sample = in[1]; p.cache_k = in[2]; p.cache_v = in[3]; p.state = in[4]; p.c_prompt = in[5]; p.c_sample = in[6];
  p.w_ada = in[7]; p.b_ada = in[8]; p.norm_g = in[9]; p.w_in = in[10]; p.qg = in[11]; p.kg = in[12]; p.sinks = in[13]; p.lb_logits = in[14];
  p.og = in[15]; p.w_merge = in[16]; p.b_merge = in[17]; p.w_pa = in[18]; p.w_pb = in[19]; p.w_out = in[20];
  float* o = (float*)d_out;
  p.out_yp = o; o += (size_t)SEQ * DM;
  p.out_ys = o; o += (size_t)NBT * DM;
  p.out_kp = o; o += 128 * 128;
  p.out_vp = o; o += 128 * 128;
  p.out_sp = o; o += 4 * 128 * 128;
  p.out_ks = o; o += (size_t)NBT * 128 * 128;
  p.out_vs = o; o += (size_t)NBT * 128 * 128;
  p.out_ss = o;
  char* wsp = (char*)d_ws;
  auto take = [&](size_t bytes) { char* r = wsp; wsp += (bytes + 255) & ~(size_t)255; return r; };
  p.bar = (unsigned*)take((size_t)(XCD_BAR_WORDS + 256) * 4);
  p.Wt_all = (bfr*)take((size_t)NALL * 1024 * 2);
  p.Wt_pab = (bfr*)take((size_t)1024 * 1024 * 2);
  p.Wt_out = (bfr*)take((size_t)1024 * 1024 * 2);
  p.Wt_ada = (bfr*)take((size_t)3072 * 1024 * 2);
  p.Cb = (bfr*)take((size_t)256 * 1024 * 2);
  p.mod = (float*)take((size_t)256 * 3072 * 4);
  p.Ys = (bfr*)take((size_t)128 * 1024 * 2);
  p.H = (bfr*)take((size_t)MPAD * 1024 * 2);
  p.YA = p.H; p.YB = p.H + 512;
  p.ZA = (bfr*)take((size_t)MTOT * 512 * 2);
  p.S16 = p.ZA;
  p.Q = (bfr*)take((size_t)MTOT * 512 * 2);
  p.QB = (bfr*)take((size_t)MTOT * 512 * 2);
  p.Y = p.Q;
  p.Kb = (bfr*)take((size_t)MTOT * 128 * 2);
  p.Vb = (bfr*)take((size_t)MTOT * 128 * 2);
  p.IB = (bfr*)take((size_t)MTOT * 512 * 2);
  p.ZB = (bfr*)take((size_t)MTOT * 512 * 2);
  p.ZF = (bfr*)take((size_t)MTOT * 512 * 2);
  p.GA = (bfr*)take((size_t)MTOT * 1024 * 2);
  p.GB = (bfr*)take((size_t)MTOT * 1024 * 2);
  p.dec = (float*)take((size_t)NCH * 4 * 128 * 4);
  p.Ust = p.out_yp;
  if ((size_t)(wsp - (char*)d_ws) > ws_size) { fprintf(stderr, "workspace too small\n"); return; }
  (void)hipMemsetAsync(p.bar, 0, (size_t)(XCD_BAR_WORDS + 256) * 4, stream);
#if ONE_LAUNCH
  p.phase_lo = 0; p.phase_hi = 8;
  void* args[] = {&p};
  hipError_t e = hipLaunchCooperativeKernel((void*)hybrid_megakernel, dim3(grid_blocks), dim3(512), args, kDynLds, stream);
  if (e != hipSuccess) fprintf(stderr, "cooperative launch failed: %s (grid %d)\n", hipGetErrorString(e), grid_blocks);
#else
  for (int ph = 0; ph <= 8; ++ph) {
    p.phase_lo = ph; p.phase_hi = ph;
    hipLaunchKernelGGL(hybrid_megakernel, dim3(grid_blocks), dim3(512), kDynLds, stream, p);
  }
#endif
}
```
